# Optimizing an MI355X kernel written in HIP

```python
import math
import jax, jax.numpy as jnp
from jax import lax
import numpy as np

D_MODEL = 1024
BATCH = 16
SEQ = 4096
DEPTH = 4

A_WIDTH = D_MODEL // 2
A_GROUPS = 4
A_GROUP_CH = A_WIDTH // A_GROUPS
A_CHUNK = 128
B_HEAD_DIM = 64
B_HEADS = (D_MODEL // 2) // B_HEAD_DIM
B_WIDTH = B_HEADS * B_HEAD_DIM
MOBA_BLOCK = 256
MOBA_TOPK = 3
MOBA_Q_CHUNK = 8
C_HEAD_DIM = 64
C_HEADS = D_MODEL // C_HEAD_DIM
C_WIDTH = C_HEADS * C_HEAD_DIM
DILATED_CONFIGS = ((128, 1), (512, 4), (2048, 16))
DIL_BLOCK = 128
EVEN_IN = 3 * A_WIDTH + 4 * B_WIDTH
EVEN_MIX = A_WIDTH + B_WIDTH
ODD_IN = 4 * C_WIDTH
N_EVEN = (DEPTH + 1) // 2
N_ODD = DEPTH // 2
NORM_EPS = 1e-6

kernel_name = "hybrid_gmlp_moba_dilated_trunk"


def rms_norm(x, g):
    xf = x.astype(jnp.float32)
    y = xf * lax.rsqrt(jnp.mean(xf * xf, axis=-1, keepdims=True) + NORM_EPS)
    return (y * g.astype(jnp.float32)).astype(x.dtype)


def layer_norm(x, g, b):
    xf = x.astype(jnp.float32)
    mu = jnp.mean(xf, axis=-1, keepdims=True)
    xc = xf - mu
    y = xc * lax.rsqrt(jnp.mean(xc * xc, axis=-1, keepdims=True) + NORM_EPS)
    return (y * g.astype(jnp.float32) + b.astype(jnp.float32)).astype(x.dtype)


def chunked_gmlp(u, v, ln_g, ln_b, w_s, b_s):
    Bn, S, _ = u.shape
    u = jax.nn.gelu(u)
    v = layer_norm(jax.nn.gelu(v), ln_g, ln_b)
    vc = v.reshape(Bn, S // A_CHUNK, A_CHUNK, A_GROUPS, A_GROUP_CH)
    w = jnp.tril(w_s).astype(v.dtype)
    mixed = jnp.einsum('gts,bnsgc->bntgc', w, vc) + b_s.T.astype(v.dtype)[None, None, :, :, None]
    return u * mixed.reshape(Bn, S, A_WIDTH)


def moba_attention(q, k, v):
    Bn, S, H, dh = q.shape
    Sp = -(-S // MOBA_BLOCK) * MOBA_BLOCK
    pad = ((0, 0), (0, Sp - S), (0, 0), (0, 0))
    q, k, v = [jnp.pad(t, pad).transpose(0, 2, 1, 3) for t in (q, k, v)]
    nb = Sp // MOBA_BLOCK
    topk = min(MOBA_TOPK, nb)
    scale = dh ** -0.5
    kb = k.reshape(Bn, H, nb, MOBA_BLOCK, dh)
    vb = v.reshape(Bn, H, nb, MOBA_BLOCK, dh)
    k_mean = jnp.mean(kb.astype(jnp.float32), axis=3)
    gate = jnp.einsum('bhsd,bhnd->bhsn', q.astype(jnp.float32), k_mean)
    pos = jnp.arange(Sp)
    past = jnp.arange(nb)[None, :] < (pos // MOBA_BLOCK)[:, None]
    gate = jnp.where(past[None, None], gate, -jnp.inf)
    top_val, top_idx = lax.top_k(gate, topk)
    sel_valid = jnp.isfinite(top_val)
    flat_idx = (jnp.arange(Bn)[:, None, None, None] * H
                + jnp.arange(H)[None, :, None, None]) * nb + top_idx
    kb_flat = kb.reshape(Bn * H * nb, MOBA_BLOCK, dh)
    vb_flat = vb.reshape(Bn * H * nb, MOBA_BLOCK, dh)
    Tq = MOBA_Q_CHUNK
    n_q = Sp // Tq
    q_ch = q.reshape(Bn, H, n_q, Tq, dh).transpose(2, 0, 1, 3, 4)
    idx_ch = flat_idx.reshape(Bn, H, n_q, Tq, topk).transpose(2, 0, 1, 3, 4)
    val_ch = sel_valid.reshape(Bn, H, n_q, Tq, topk).transpose(2, 0, 1, 3, 4)
    n_sel = topk * MOBA_BLOCK

    def step(args):
        qc, ic, vc_, c = args
        blk = (c * Tq) // MOBA_BLOCK
        k_sel = jnp.take(kb_flat, ic, axis=0)
        v_sel = jnp.take(vb_flat, ic, axis=0)
        k_own = lax.dynamic_slice_in_dim(k, blk * MOBA_BLOCK, MOBA_BLOCK, axis=2)
        v_own = lax.dynamic_slice_in_dim(v, blk * MOBA_BLOCK, MOBA_BLOCK, axis=2)
        l_sel = jnp.einsum('bhqd,bhqnkd->bhqnk', qc, k_sel).astype(jnp.float32) * scale
        l_sel = jnp.where(vc_[..., None], l_sel, -jnp.inf).reshape(Bn, H, Tq, n_sel)
        l_own = jnp.einsum('bhqd,bhkd->bhqk', qc, k_own).astype(jnp.float32) * scale
        qpos = c * Tq + jnp.arange(Tq)
        kpos = blk * MOBA_BLOCK + jnp.arange(MOBA_BLOCK)
        l_own = jnp.where((kpos[None, :] <= qpos[:, None])[None, None], l_own, -jnp.inf)
        p = jax.nn.softmax(jnp.concatenate([l_sel, l_own], axis=-1), axis=-1)
        p_sel = p[..., :n_sel].reshape(Bn, H, Tq, topk, MOBA_BLOCK).astype(v.dtype)
        p_own = p[..., n_sel:].astype(v.dtype)
        return (jnp.einsum('bhqnk,bhqnkd->bhqd', p_sel, v_sel)
                + jnp.einsum('bhqk,bhkd->bhqd', p_own, v_own))

    out = lax.map(step, (q_ch, idx_ch, val_ch, jnp.arange(n_q)))
    out = out.transpose(1, 0, 3, 2, 4).reshape(Bn, Sp, H, dh)
    return out[:, :S]


def dilated_window_attention(q, k, v, window, dil):
    Bn, S, H, dh = q.shape
    n_back = window // dil
    L = DIL_BLOCK
    span = dil * L
    Sp = -(-S // span) * span
    M = Sp // dil
    nb = M // L

    def to_blocks(t):
        t = jnp.pad(t, ((0, 0), (0, Sp - S), (0, 0), (0, 0)))
        return t.reshape(Bn, M, dil, H, dh).transpose(0, 2, 1, 3, 4).reshape(Bn, dil, nb, L, H, dh)

    def with_prev(t):
        prev = jnp.pad(t, ((0, 0), (0, 0), (1, 0), (0, 0), (0, 0), (0, 0)))[:, :, :-1]
        return jnp.concatenate([prev, t], axis=3)

    qb, kb, vb = to_blocks(q), to_blocks(k), to_blocks(v)
    kc, vc = with_prev(kb), with_prev(vb)
    logits = jnp.einsum('brnihd,brnjhd->brnhij', qb, kc).astype(jnp.float32) * (dh ** -0.5)
    i = jnp.arange(L)[:, None]
    j = jnp.arange(2 * L)[None, :]
    rel = L + i - j
    band = (rel >= 0) & (rel <= n_back)
    valid = band[None] & ((jnp.arange(nb)[:, None, None] > 0) | (j >= L)[None])
    logits = jnp.where(valid[None, None, :, None], logits, -jnp.inf)
    m = jnp.max(logits, axis=-1, keepdims=True)
    p = jnp.exp(logits - m)
    den = jnp.sum(p, axis=-1)
    o = jnp.einsum('brnhij,brnjhd->brnihd', p.astype(v.dtype), vc).astype(jnp.float32)
    o = o / den.transpose(0, 1, 2, 4, 3)[..., None]
    lse = (m[..., 0] + jnp.log(den)).transpose(0, 1, 2, 4, 3)
    o = o.reshape(Bn, dil, M, H, dh).transpose(0, 2, 1, 3, 4).reshape(Bn, Sp, H, dh)[:, :S]
    lse = lse.reshape(Bn, dil, M, H).transpose(0, 2, 1, 3).reshape(Bn, Sp, H)[:, :S]
    return o, lse


def dilated_mixture(q, k, v):
    outs, lses = [], []
    for window, dil in DILATED_CONFIGS:
        o, l = dilated_window_attention(q, k, v, window, dil)
        outs.append(o)
        lses.append(l)
    wts = jax.nn.softmax(jnp.stack(lses, axis=0), axis=0)
    y = jnp.einsum('gbsh,gbshd->bshd', wts, jnp.stack(outs, axis=0))
    return y.astype(q.dtype)


def even_layer(hn, w_in, w_out, ln_g, ln_b, w_s, b_s):
    Bn, S, _ = hn.shape
    z = hn @ w_in
    cuts = [A_WIDTH, 2 * A_WIDTH, 3 * A_WIDTH, 3 * A_WIDTH + B_WIDTH,
            3 * A_WIDTH + 2 * B_WIDTH, 3 * A_WIDTH + 3 * B_WIDTH]
    u, v, g_a, q, k, vv, g_b = jnp.split(z, cuts, axis=-1)
    y_a = chunked_gmlp(u, v, ln_g, ln_b, w_s, b_s) * jax.nn.silu(g_a)
    hs = (Bn, S, B_HEADS, B_HEAD_DIM)
    y_b = moba_attention(q.reshape(hs), k.reshape(hs), vv.reshape(hs)).reshape(Bn, S, B_WIDTH)
    y_b = y_b * jax.nn.silu(g_b)
    return jnp.concatenate([y_a, y_b], axis=-1) @ w_out


def odd_layer(hn, w_in, w_out):
    Bn, S, _ = hn.shape
    z = hn @ w_in
    q, k, v, g = jnp.split(z, [C_WIDTH, 2 * C_WIDTH, 3 * C_WIDTH], axis=-1)
    hs = (Bn, S, C_HEADS, C_HEAD_DIM)
    y = dilated_mixture(q.reshape(hs), k.reshape(hs), v.reshape(hs)).reshape(Bn, S, C_WIDTH)
    return (y * jax.nn.silu(g)) @ w_out


def setup_inputs(seed: int = 0) -> dict:
    key = jax.random.key(seed)
    ks = jax.random.split(key, 11)
    f32 = jnp.float32
    nrm = jax.random.normal
    return {
        "x": nrm(ks[0], (BATCH, SEQ, D_MODEL), f32),
        "norm_g": 1.0 + 0.05 * nrm(ks[1], (DEPTH, D_MODEL), f32),
        "final_norm_g": 1.0 + 0.05 * nrm(ks[2], (D_MODEL,), f32),
        "ab_w_in": nrm(ks[3], (N_EVEN, D_MODEL, EVEN_IN), f32) * D_MODEL ** -0.5,
        "ab_w_out": nrm(ks[4], (N_EVEN, EVEN_MIX, D_MODEL), f32) * EVEN_MIX ** -0.5,
        "gmlp_ln_g": 1.0 + 0.05 * nrm(ks[5], (N_EVEN, A_WIDTH), f32),
        "gmlp_ln_b": 0.02 * nrm(ks[6], (N_EVEN, A_WIDTH), f32),
        "gmlp_w_s": nrm(ks[7], (N_EVEN, A_GROUPS, A_CHUNK, A_CHUNK), f32) * A_CHUNK ** -0.5,
        "gmlp_b_s": 1.0 + 0.1 * nrm(ks[8], (N_EVEN, A_GROUPS, A_CHUNK), f32),
        "c_w_in": nrm(ks[9], (N_ODD, D_MODEL, ODD_IN), f32) * D_MODEL ** -0.5,
        "c_w_out": nrm(ks[10], (N_ODD, C_WIDTH, D_MODEL), f32) * C_WIDTH ** -0.5,
    }


def reference(x, norm_g, final_norm_g, ab_w_in, ab_w_out, gmlp_ln_g, gmlp_ln_b,
              gmlp_w_s, gmlp_b_s, c_w_in, c_w_out):
    h = x
    for layer in range(DEPTH):
        idx = layer // 2
        hn = rms_norm(h, norm_g[layer])
        if layer % 2 == 0:
            h = h + even_layer(hn, ab_w_in[idx], ab_w_out[idx], gmlp_ln_g[idx],
                               gmlp_ln_b[idx], gmlp_w_s[idx], gmlp_b_s[idx])
        else:
            h = h + odd_layer(hn, c_w_in[idx], c_w_out[idx])
    return rms_norm(h, final_norm_g)
```

```cpp
#include <hip/hip_runtime.h>
#include <hip/hip_cooperative_groups.h>
#include <cstdio>
#include <cstdint>
#include <cmath>
namespace cg = cooperative_groups;
namespace pg8 {
#define PG8_LAS __attribute__((address_space(3)))
typedef unsigned short bf16_t;
typedef short bf16x8 __attribute__((ext_vector_type(8)));
typedef float f32x4 __attribute__((ext_vector_type(4)));
typedef unsigned u32x4 __attribute__((ext_vector_type(4)));
constexpr int BM = 256, BK = 64, HALF = 128, HTB = HALF * BK * 2  , STAGE_BYTES = 8 * HTB, NXCD = 8, WGM = 8;

__host__ __device__ __forceinline__ int lds_byte(int r, int c) { const int st = (r >> 4) * 2 + (c >> 5), rr = r & 15, cc = c & 31, ob = rr * 64 + cc * 2; return st * 1024 + (ob ^ (((ob >> 9) & 1) << 5)); }
__host__ __device__ __forceinline__ void stage_rc(int b, int& R, int& C) { const int st = b / 1024, sb = b % 1024, swz = sb ^ (((sb >> 9) & 1) << 5); R = (st >> 1) * 16 + swz / 64; C = (st & 1) * 32 + (swz % 64) / 2; }
__host__ __device__ __forceinline__ int perm32(int rho) { const int n = rho >> 4, i = rho & 15; return 8 * (i >> 2) + 4 * n + (i & 3); }

struct Unit { int pm, pn; };
struct Gemm { const bf16_t* A; const bf16_t* Bt; int M, N, K; };

struct StaticOrder {
    int nM, nN, nwg, G, c;
    __host__ __device__ void init(int M, int N, int G_, int c_) { nM = M / BM; nN = N / BM; nwg = nM * nN; G = G_; c = c_; }
    __host__ __device__ bool next(int i, Unit& u) const {
        const long L = (long)i * G + c; if (L >= nwg) return false;
        int wgid = (int)L; { const int q = nwg / NXCD, r = nwg % NXCD, xcd = wgid % NXCD, off = wgid / NXCD; wgid = (xcd < r ? xcd * (q + 1) : r * (q + 1) + (xcd - r) * q) + off; }
        const int nig = WGM * nN, gid = wgid / nig, fm = gid * WGM, gsz = (nM - fm) < WGM ? (nM - fm) : WGM;
        u.pm = fm + ((wgid % nig) % gsz); u.pn = (wgid % nig) / gsz; return true;
    }
    __device__ __forceinline__ void a_ready(const Unit&) const {}
    __device__ __forceinline__ void done(const Unit&) const {}
};

__device__ __forceinline__ unsigned cvt_pk_bf16(float lo, float hi) { unsigned r; asm volatile("v_cvt_pk_bf16_f32 %0, %1, %2" : "=v"(r) : "v"(lo), "v"(hi)); return r; }
typedef unsigned u32x2 __attribute__((ext_vector_type(2)));
__device__ __forceinline__ float act_gelu(float x) {
    const float t = x + 0.044715f * x * x * x;
    return x * __builtin_amdgcn_rcpf(1.f + __builtin_amdgcn_exp2f(-2.302208198f * t));
}
__device__ __forceinline__ float act_silu(float x) { return x * __builtin_amdgcn_rcpf(1.f + __builtin_amdgcn_exp2f(-1.4426950409f * x)); }
constexpr float QSCALE = 0.125f * 1.4426950408889634f;
constexpr float NORM_EPS = 1e-6f;

struct EpiIn {
    static constexpr bool PERM = true, AFTER_DRAIN = false;
    bf16_t* Z; int ldz; const PG8_LAS float* rtab; int* seq; float* kmp; int even;
    template <int ACT> __device__ __forceinline__ void body(const f32x4 (&acc)[2][2][4][2], const Unit& u, int wr, int wc, int fr, int fq, const PG8_LAS float* rt) const {
        const int row0 = u.pm * BM + wr * 64 + fr, col0 = u.pn * BM + wc * 32 + 8 * fq;
        float rs[2][4];
#pragma unroll
        for (int ai = 0; ai < 2; ++ai)
#pragma unroll
            for (int m = 0; m < 4; ++m) rs[ai][m] = rt[wr * 64 + fr + ai * HALF + m * 16];
        float cs[2][2][4];
        if (ACT == 4) {
#pragma unroll
            for (int bj = 0; bj < 2; ++bj)
#pragma unroll
                for (int n = 0; n < 2; ++n)
#pragma unroll
                    for (int e = 0; e < 4; ++e) cs[bj][n][e] = 0.f;
        }
#pragma unroll
        for (int ai = 0; ai < 2; ++ai)
#pragma unroll
            for (int m = 0; m < 4; ++m) {
                const int row = row0 + ai * HALF + m * 16;
                const float rstd = rs[ai][m];
                bf16_t* rowp = Z + (size_t)row * ldz + col0;
#pragma unroll
                for (int bj = 0; bj < 2; ++bj) {
                    f32x4 v[2];
#pragma unroll
                    for (int n = 0; n < 2; ++n) {
                        v[n] = acc[ai][bj][m][n] * rstd;
#pragma unroll
                        for (int e = 0; e < 4; ++e) {
                            if (ACT == 1) v[n][e] = act_gelu(v[n][e]);
                            if (ACT == 2) v[n][e] = act_silu(v[n][e]);
                            if (ACT == 3) v[n][e] = v[n][e] * QSCALE;
                            if (ACT == 4) cs[bj][n][e] += v[n][e];
                        }
                    }
                    u32x4 w; w.x = cvt_pk_bf16(v[0][0], v[0][1]); w.y = cvt_pk_bf16(v[0][2], v[0][3]); w.z = cvt_pk_bf16(v[1][0], v[1][1]); w.w = cvt_pk_bf16(v[1][2], v[1][3]);
                    *(u32x4*)(rowp + bj * HALF) = w;
                }
            }
        if (ACT == 4) {
#pragma unroll
            for (int bj = 0; bj < 2; ++bj)
#pragma unroll
                for (int n = 0; n < 2; ++n)
#pragma unroll
                    for (int e = 0; e < 4; ++e) {
                        float s = cs[bj][n][e];
                        s += __shfl_xor(s, 1); s += __shfl_xor(s, 2); s += __shfl_xor(s, 4); s += __shfl_xor(s, 8);
                        cs[bj][n][e] = s;
                    }
            if (fr == 0) {
                float* kp = kmp + ((size_t)u.pm * 2 + wr) * 512 + (col0 - 2048);
#pragma unroll
                for (int bj = 0; bj < 2; ++bj)
#pragma unroll
                    for (int n = 0; n < 2; ++n) *(f32x4*)(kp + bj * HALF + n * 4) = (f32x4){cs[bj][n][0], cs[bj][n][1], cs[bj][n][2], cs[bj][n][3]};
            }
        }
    }
    __device__ __forceinline__ void operator()(const f32x4 (&acc)[2][2][4][2], const Unit& u, int wr, int wc, int fr, int fq) const {
        int act;
        if (even) { const int seg = u.pn >> 1; act = (seg == 0 || seg == 1) ? 1 : (seg == 2 || seg == 6) ? 2 : (seg == 3) ? 3 : (seg == 4) ? 4 : 0; }
        else { const int seg = u.pn >> 2; act = (seg == 0) ? 3 : (seg == 3) ? 2 : 0; }
        const PG8_LAS float* rt = rtab + ((*seq)++) * 256;
        if (act == 0) body<0>(acc, u, wr, wc, fr, fq, rt);
        else if (act == 1) body<1>(acc, u, wr, wc, fr, fq, rt);
        else if (act == 2) body<2>(acc, u, wr, wc, fr, fq, rt);
        else if (act == 3) body<3>(acc, u, wr, wc, fr, fq, rt);
        else body<4>(acc, u, wr, wc, fr, fq, rt);
    }
};
struct EpiOut {
    static constexpr bool PERM = false, AFTER_DRAIN = false;
    const float* resid_f32; float* out_f32; bf16_t* hb; float* ssqp;
    template <bool RF32> __device__ __forceinline__ void body(const f32x4 (&acc)[2][2][4][2], const Unit& u, int wr, int wc, int fr, int fq) const {
        const int row0 = u.pm * BM + wr * 64 + fr, col0 = u.pn * BM + wc * 32 + 4 * fq;
        constexpr int MB = RF32 ? 2 : 4;
#pragma unroll
        for (int ai = 0; ai < 2; ++ai)
#pragma unroll
        for (int m0 = 0; m0 < 4; m0 += MB) {
            f32x4 rf[RF32 ? MB : 1][2][2]; u32x2 rb[RF32 ? 1 : MB][2][2];
#pragma unroll
            for (int mm = 0; mm < MB; ++mm)
#pragma unroll
                for (int bj = 0; bj < 2; ++bj)
#pragma unroll
                    for (int n = 0; n < 2; ++n) {
                        const size_t o2 = (size_t)(row0 + ai * HALF + (m0 + mm) * 16) * 1024 + col0 + bj * HALF + n * 16;
                        if (RF32) rf[RF32 ? mm : 0][bj][n] = *(const f32x4*)(resid_f32 + o2); else rb[RF32 ? 0 : mm][bj][n] = *(const u32x2*)(hb + o2);
                    }
#pragma unroll
            for (int mm = 0; mm < MB; ++mm) {
                const int m = m0 + mm;
                const int row = row0 + ai * HALF + m * 16; const size_t off = (size_t)row * 1024 + col0; float ss = 0.f;
#pragma unroll
                for (int bj = 0; bj < 2; ++bj)
#pragma unroll
                    for (int n = 0; n < 2; ++n) {
                        const size_t o2 = off + bj * HALF + n * 16;
                        f32x4 r;
                        if (RF32) r = rf[RF32 ? mm : 0][bj][n];
                        else { const u32x2 w = rb[RF32 ? 0 : mm][bj][n]; r[0] = __builtin_bit_cast(float, w.x << 16); r[1] = __builtin_bit_cast(float, w.x & 0xffff0000u); r[2] = __builtin_bit_cast(float, w.y << 16); r[3] = __builtin_bit_cast(float, w.y & 0xffff0000u); }
                        const f32x4 o = r + acc[ai][bj][m][n];
                        ss += (o[0] * o[0] + o[1] * o[1]) + (o[2] * o[2] + o[3] * o[3]);
                        if (out_f32) *(f32x4*)(out_f32 + o2) = o;
                        else { u32x2 w; w.x = cvt_pk_bf16(o[0], o[1]); w.y = cvt_pk_bf16(o[2], o[3]); *(u32x2*)(hb + o2) = w; }
                    }
                ss += __shfl_xor(ss, 16); ss += __shfl_xor(ss, 32);
                if (fq == 0) ssqp[(size_t)row * 16 + u.pn * 4 + wc] = ss;
            }
        }
    }
    __device__ __forceinline__ void operator()(const f32x4 (&acc)[2][2][4][2], const Unit& u, int wr, int wc, int fr, int fq) const {
        if (resid_f32) body<true>(acc, u, wr, wc, fr, fq); else body<false>(acc, u, wr, wc, fr, fq);
    }
};
template <class Epi, class Sched, bool ALIGN_EPI = false, bool SP2 = false>
__device__ __forceinline__ void gemm_phase(PG8_LAS unsigned char* lds, const Gemm g, const Sched& S, const Epi& E) {
    int tid_ = threadIdx.x; asm volatile("" : "+v"(tid_));
    const int tid = tid_, wid = __builtin_amdgcn_readfirstlane(tid >> 6), lane = tid & 63, wr = wid >> 2, wc = wid & 3, fr = lane & 15, fq = lane >> 4;
    const int K = g.K, nt = K / BK;
    unsigned voffA[2], voffB[2];
#pragma unroll
    for (int i = 0; i < 2; ++i) { int R, C; stage_rc(tid * 16 + i * 8192, R, C); const int Rb = Epi::PERM ? ((R & ~31) + perm32(R & 31)) : R;
        voffA[i] = (unsigned)(R * K + C) * 2u; voffB[i] = (unsigned)(Rb * K + C) * 2u; }
    const size_t kstep = (size_t)(BK * 2);
    const size_t hstep = (size_t)HALF * K * 2;
    const size_t tstep = 2 * hstep;
    const unsigned ldsw = (unsigned)wid * 1024u;
    const int aoff = lds_byte(wr * 64 + fr, fq * 8), boff = lds_byte(wc * 32 + fr, fq * 8);
#define PG8_SA(b, h) (((b) * 2 + (h)) * HTB)
#define PG8_SB(b, h) ((4 + (b) * 2 + (h)) * HTB)
#define PG8_STAGE(bufoff, gbase, voff) do { _Pragma("unroll") for (int _i = 0; _i < 2; ++_i) \
        __builtin_amdgcn_global_load_lds((const unsigned*)((const char*)(gbase) + (voff)[_i]), (PG8_LAS unsigned*)(lds + (bufoff) + ldsw + _i * 8192), 16, 0, 0); } while (0)
#define PG8_LDA(dst, b, h) do { _Pragma("unroll") for (int m = 0; m < 4; ++m) _Pragma("unroll") for (int k = 0; k < 2; ++k) dst[m][k] = *(const PG8_LAS bf16x8*)(lds + PG8_SA(b, h) + aoff + m * 2048 + k * 1024); } while (0)
#define PG8_LDB(dst, b, h) do { _Pragma("unroll") for (int n = 0; n < 2; ++n) _Pragma("unroll") for (int k = 0; k < 2; ++k) dst[n][k] = *(const PG8_LAS bf16x8*)(lds + PG8_SB(b, h) + boff + n * 2048 + k * 1024); } while (0)
#define PG8_MMA(ai, bj, At, Bt) do { __builtin_amdgcn_s_setprio(1); _Pragma("unroll") for (int m = 0; m < 4; ++m) _Pragma("unroll") for (int n = 0; n < 2; ++n) _Pragma("unroll") for (int k = 0; k < 2; ++k) \
        acc[ai][bj][m][n] = __builtin_amdgcn_mfma_f32_16x16x32_bf16(Bt[n][k], At[m][k], acc[ai][bj][m][n], 0, 0, 0); __builtin_amdgcn_s_setprio(0); } while (0)
#define PG8_WAIT_V(n) asm volatile("s_waitcnt vmcnt(" #n ")" ::: "memory")
#define PG8_WAIT_L(n) asm volatile("s_waitcnt lgkmcnt(" #n ")" ::: "memory")
#define PG8_BAR __builtin_amdgcn_s_barrier()
#define PG8_SCHED __builtin_amdgcn_sched_barrier(0)
    Unit cur, nxt; int ui = 0;
    if (!S.next(0, cur)) return;
    f32x4 acc[2][2][4][2];
#pragma unroll
    for (int a = 0; a < 2; ++a)
#pragma unroll
        for (int b = 0; b < 2; ++b)
#pragma unroll
            for (int m = 0; m < 4; ++m)
#pragma unroll
                for (int n = 0; n < 2; ++n) acc[a][b][m][n] = (f32x4){0.f, 0.f, 0.f, 0.f};
    bf16x8 At[4][2], B0[2][2], B1[2][2];
    const char* cA = (const char*)g.A + (size_t)cur.pm * tstep; const char* cB = (const char*)g.Bt + (size_t)cur.pn * tstep;
    S.a_ready(cur);
    if constexpr (SP2) {
        PG8_STAGE(PG8_SB(0, 0), cB, voffB); PG8_STAGE(PG8_SB(0, 1), cB + hstep, voffB); PG8_STAGE(PG8_SA(0, 0), cA, voffA); PG8_STAGE(PG8_SA(0, 1), cA + hstep, voffA);
        if (wr == 1) PG8_BAR;
        PG8_WAIT_V(2); PG8_BAR;
        PG8_STAGE(PG8_SB(1, 0), cB + kstep, voffB); PG8_STAGE(PG8_SA(1, 0), cA + kstep, voffA); PG8_STAGE(PG8_SB(1, 1), cB + hstep + kstep, voffB);
        PG8_WAIT_V(6); PG8_BAR;
    } else {
        PG8_STAGE(PG8_SB(0, 0), cB, voffB); PG8_STAGE(PG8_SA(0, 0), cA, voffA); PG8_STAGE(PG8_SB(0, 1), cB + hstep, voffB); PG8_STAGE(PG8_SA(0, 1), cA + hstep, voffA);
        if (wr == 1) PG8_BAR;
        PG8_WAIT_V(4); PG8_BAR;
        PG8_STAGE(PG8_SB(1, 0), cB + kstep, voffB); PG8_STAGE(PG8_SA(1, 0), cA + kstep, voffA); PG8_STAGE(PG8_SB(1, 1), cB + hstep + kstep, voffB);
        PG8_WAIT_V(6); PG8_BAR;
    }
    for (;;) {
        const bool has_next = S.next(ui + 1, nxt);
        const char* nA = has_next ? (const char*)g.A + (size_t)nxt.pm * tstep : cA; const char* nB = has_next ? (const char*)g.Bt + (size_t)nxt.pn * tstep : cB;
        for (int t = 0; t < nt; t += 2) {
            const bool last = (t == nt - 2);
            const char* a1 = cA + (size_t)(t + 1) * kstep;
            const char* a2 = last ? nA : cA + (size_t)(t + 2) * kstep; const char* b2 = last ? nB : cB + (size_t)(t + 2) * kstep;
            const char* a3 = a2 + kstep; const char* b3 = b2 + kstep;
            if (last && has_next) S.a_ready(nxt);
            if constexpr (SP2) {
            PG8_LDB(B0, 0, 0); PG8_LDB(B1, 0, 1); PG8_SCHED; PG8_LDA(At, 0, 0); PG8_STAGE(PG8_SA(1, 1), a1 + hstep, voffA);
            PG8_WAIT_V(8); PG8_WAIT_L(0); PG8_BAR; PG8_MMA(0, 0, At, B0); PG8_MMA(0, 1, At, B1); PG8_BAR; PG8_SCHED;
            PG8_LDA(At, 0, 1); PG8_STAGE(PG8_SB(0, 0), b2, voffB); PG8_STAGE(PG8_SB(0, 1), b2 + hstep, voffB); PG8_STAGE(PG8_SA(0, 0), a2, voffA);
            PG8_WAIT_V(8); PG8_WAIT_L(0); PG8_BAR; PG8_MMA(1, 0, At, B0); PG8_MMA(1, 1, At, B1); PG8_BAR; PG8_SCHED;
            PG8_LDB(B0, 1, 0); PG8_LDB(B1, 1, 1); PG8_SCHED; PG8_LDA(At, 1, 0); PG8_STAGE(PG8_SA(0, 1), a2 + hstep, voffA);
            PG8_WAIT_V(8); PG8_WAIT_L(0); PG8_BAR; PG8_MMA(0, 0, At, B0); PG8_MMA(0, 1, At, B1); PG8_BAR; PG8_SCHED;
            PG8_LDA(At, 1, 1); PG8_STAGE(PG8_SB(1, 0), b3, voffB); PG8_STAGE(PG8_SB(1, 1), b3 + hstep, voffB); PG8_STAGE(PG8_SA(1, 0), a3, voffA);
            PG8_WAIT_V(8); PG8_WAIT_L(0); PG8_BAR; PG8_MMA(1, 0, At, B0); PG8_MMA(1, 1, At, B1); PG8_BAR; PG8_SCHED;
            } else {
            PG8_LDB(B0, 0, 0); PG8_SCHED; PG8_LDA(At, 0, 0); PG8_STAGE(PG8_SA(1, 1), a1 + hstep, voffA);
            PG8_WAIT_L(8); PG8_BAR; PG8_WAIT_L(0); PG8_MMA(0, 0, At, B0); PG8_BAR; PG8_SCHED;
            PG8_LDB(B1, 0, 1); PG8_STAGE(PG8_SB(0, 0), b2, voffB);
            PG8_BAR; PG8_WAIT_L(0); PG8_MMA(0, 1, At, B1); PG8_BAR;
            PG8_LDA(At, 0, 1); PG8_STAGE(PG8_SA(0, 0), a2, voffA);
            PG8_BAR; PG8_WAIT_L(0); PG8_MMA(1, 0, At, B0); PG8_BAR; PG8_SCHED;
            PG8_STAGE(PG8_SB(0, 1), b2 + hstep, voffB);
            PG8_WAIT_V(6); PG8_BAR; PG8_MMA(1, 1, At, B1); PG8_BAR;
            PG8_LDB(B0, 1, 0); PG8_SCHED; PG8_LDA(At, 1, 0); PG8_STAGE(PG8_SA(0, 1), a2 + hstep, voffA);
            PG8_WAIT_L(8); PG8_BAR; PG8_WAIT_L(0); PG8_MMA(0, 0, At, B0); PG8_BAR; PG8_SCHED;
            PG8_LDB(B1, 1, 1); PG8_STAGE(PG8_SB(1, 0), b3, voffB);
            PG8_BAR; PG8_WAIT_L(0); PG8_MMA(0, 1, At, B1); PG8_BAR;
            PG8_LDA(At, 1, 1); PG8_STAGE(PG8_SA(1, 0), a3, voffA);
            PG8_BAR; PG8_WAIT_L(0); PG8_MMA(1, 0, At, B0); PG8_BAR; PG8_SCHED;
            PG8_STAGE(PG8_SB(1, 1), b3 + hstep, voffB);
            PG8_WAIT_V(6); PG8_BAR; PG8_MMA(1, 1, At, B1); PG8_BAR;
            }
        }
        if constexpr (ALIGN_EPI) { if (wr == 0) PG8_BAR; }
        if constexpr (!Epi::AFTER_DRAIN) { E(acc, cur, wr, wc, fr, fq); S.done(cur); }
        if (!has_next) break;
#pragma unroll
        for (int a = 0; a < 2; ++a)
#pragma unroll
            for (int b = 0; b < 2; ++b)
#pragma unroll
                for (int m = 0; m < 4; ++m)
#pragma unroll
                    for (int n = 0; n < 2; ++n) acc[a][b][m][n] = (f32x4){0.f, 0.f, 0.f, 0.f};
        cur = nxt; cA = nA; cB = nB; ++ui;
        if constexpr (ALIGN_EPI) { if (wr == 1) PG8_BAR; }
    }
    PG8_WAIT_V(0);
    if constexpr (!ALIGN_EPI) { if (wr == 0) PG8_BAR; }
    PG8_BAR;
    if constexpr (Epi::AFTER_DRAIN) { E.fused(acc, cur, wr, wc, fr, fq, lds, wid, lane); S.done(cur); }
#undef PG8_SA
#undef PG8_SB
#undef PG8_STAGE
#undef PG8_LDA
#undef PG8_LDB
#undef PG8_MMA
#undef PG8_WAIT_V
#undef PG8_WAIT_L
#undef PG8_BAR
#undef PG8_SCHED
}
}
#define GAS __attribute__((address_space(1)))
#define LAS __attribute__((address_space(3)))
typedef unsigned short bf16;
typedef unsigned v4u __attribute__((ext_vector_type(4)));
typedef unsigned v2u __attribute__((ext_vector_type(2)));
typedef float f32x4 __attribute__((ext_vector_type(4)));
typedef float f32x16 __attribute__((ext_vector_type(16)));
typedef short bf16x8 __attribute__((ext_vector_type(8)));
typedef short s16x4 __attribute__((ext_vector_type(4)));
#define LDS_WAIT() asm volatile("s_waitcnt lgkmcnt(0)" ::: "memory")
using pg8::cvt_pk_bf16; using pg8::NORM_EPS; using pg8::QSCALE;

constexpr int NWAVES = 8, NTHREADS = 512;
constexpr int D = 1024, BATCH = 16, SEQ = 4096, M = BATCH * SEQ;
constexpr int EVEN_IN = 3584, ODD_IN = 4096;
constexpr size_t MiB = 1u << 20;
constexpr size_t WS_WE_IN = 0, WS_WE_OUT = 14 * MiB, WS_WO_IN = 18 * MiB, WS_WO_OUT = 34 * MiB, WS_WS = 38 * MiB, WS_SSQ = 39 * MiB, WS_KMP = 43 * MiB,
                 WS_HB = 44 * MiB, WS_Y = 172 * MiB, WS_Z = 300 * MiB, WS_CTL = 812 * MiB, WS_END = 813 * MiB;
constexpr int LDS_BYTES = 131072 + 1024 + 16384;

__device__ __forceinline__ unsigned f2bf(float f) { unsigned u = __builtin_bit_cast(unsigned, f); return (u + 0x7fffu + ((u >> 16) & 1u)) >> 16; }
__device__ __forceinline__ unsigned pk2(float lo, float hi) { return f2bf(lo) | (f2bf(hi) << 16); }
__device__ __forceinline__ float bf_lo(unsigned w) { return __builtin_bit_cast(float, w << 16); }
__device__ __forceinline__ float bf_hi(unsigned w) { return __builtin_bit_cast(float, w & 0xffff0000u); }
__device__ __forceinline__ float wave_sum(float v) {
#pragma unroll
    for (int o = 1; o < 64; o <<= 1) v += __shfl_xor(v, o);
    return v;
}
typedef float f32x2_t __attribute__((ext_vector_type(2))); typedef __bf16 bf16x2_t __attribute__((ext_vector_type(2)));
__device__ __forceinline__ unsigned cvtpk_s(float lo, float hi) { f32x2_t v = {lo, hi}; bf16x2_t b = __builtin_convertvector(v, bf16x2_t); return __builtin_bit_cast(unsigned, b); }
__device__ __forceinline__ int crow(int r, int hi) { return (r & 3) + 8 * (r >> 2) + 4 * hi; }
__device__ __forceinline__ s16x4 vtr(const LAS unsigned char* p) { return __builtin_bit_cast(s16x4, __builtin_amdgcn_ds_read_tr16_b64_v4i16((LAS s16x4*)p)); }

__device__ __forceinline__ void transpose_item(const float* W, const float* g, int K, int N, bf16* WT, LAS float* scr, int item, int lane) {
    const int nblk = N / 32, kb = item / nblk, nb = item % nblk, k0 = 64 * kb, n0 = 32 * nb;
#pragma unroll 8
    for (int i = 0; i < 32; ++i) { const int kk = 2 * i + (lane >> 5); const float sc = g ? g[k0 + kk] : 1.f; scr[kk * 33 + (lane & 31)] = W[(size_t)(k0 + kk) * N + n0 + (lane & 31)] * sc; }
    LDS_WAIT(); asm volatile("" ::: "memory");
    const int c = lane & 7;
#pragma unroll
    for (int j = 0; j < 4; ++j) { const int n = (lane >> 3) + 8 * j; const LAS float* s = scr + (8 * c) * 33 + n;
        v4u o; o.x = pk2(s[0 * 33], s[1 * 33]); o.y = pk2(s[2 * 33], s[3 * 33]); o.z = pk2(s[4 * 33], s[5 * 33]); o.w = pk2(s[6 * 33], s[7 * 33]);
        *(v4u*)(WT + (size_t)(n0 + n) * K + k0 + 8 * c) = o; }
    LDS_WAIT(); asm volatile("" ::: "memory");
}

struct Args {
    const float *x, *norm_g, *final_g, *ab_w_in, *ab_w_out, *ln_g, *ln_b, *w_s, *b_s, *c_w_in, *c_w_out;
    float* out; unsigned char* ws;
};

__device__ __forceinline__ void phase_prologue(const Args& A, LAS unsigned char* lds, int gwv, int NGW, int wave, int lane) {
    LAS float* scr = (LAS float*)(lds + wave * 16384);
    constexpr int I_EIN = 16 * (EVEN_IN / 32), I_OUT = 16 * 32, I_OIN = 16 * (ODD_IN / 32), I_PAIR = I_EIN + I_OUT + I_OIN + I_OUT;
    for (int it = gwv; it < 2 * I_PAIR; it += NGW) {
        const int i = it / I_PAIR; int r = it % I_PAIR;
        if (r < I_EIN) { transpose_item(A.ab_w_in + (size_t)i * D * EVEN_IN, A.norm_g + (2 * i) * D, D, EVEN_IN, (bf16*)(A.ws + WS_WE_IN) + (size_t)i * EVEN_IN * D, scr, r, lane); continue; } r -= I_EIN;
        if (r < I_OUT) { transpose_item(A.ab_w_out + (size_t)i * D * D, nullptr, D, D, (bf16*)(A.ws + WS_WE_OUT) + (size_t)i * D * D, scr, r, lane); continue; } r -= I_OUT;
        if (r < I_OIN) { transpose_item(A.c_w_in + (size_t)i * D * ODD_IN, A.norm_g + (2 * i + 1) * D, D, ODD_IN, (bf16*)(A.ws + WS_WO_IN) + (size_t)i * ODD_IN * D, scr, r, lane); continue; } r -= I_OIN;
        transpose_item(A.c_w_out + (size_t)i * D * D, nullptr, D, D, (bf16*)(A.ws + WS_WO_OUT) + (size_t)i * D * D, scr, r, lane);
    }
    { bf16* wst = (bf16*)(A.ws + WS_WS);
      for (int e = gwv * 64 + lane; e < 2 * 4 * 128 * 128; e += NGW * 64) { const int s = e & 127, t = (e >> 7) & 127; wst[e] = (bf16)f2bf(s <= t ? A.w_s[e] : 0.f); } }
    bf16* hb = (bf16*)(A.ws + WS_HB); float* ssqp = (float*)(A.ws + WS_SSQ);
    for (int m = gwv; m < M; m += 2 * NGW) {
        const int m2 = m + NGW;
        const f32x4* xr = (const f32x4*)(A.x + (size_t)m * D) + lane; const f32x4* xr2 = (const f32x4*)(A.x + (size_t)m2 * D) + lane;
        f32x4 v[4], w4[4];
#pragma unroll
        for (int j = 0; j < 4; ++j) { v[j] = xr[64 * j]; w4[j] = xr2[64 * j]; }
        float s = 0.f, s2 = 0.f;
#pragma unroll
        for (int j = 0; j < 4; ++j) { s += (v[j][0] * v[j][0] + v[j][1] * v[j][1]) + (v[j][2] * v[j][2] + v[j][3] * v[j][3]); s2 += (w4[j][0] * w4[j][0] + w4[j][1] * w4[j][1]) + (w4[j][2] * w4[j][2] + w4[j][3] * w4[j][3]); }
        s = wave_sum(s); s2 = wave_sum(s2);
        v2u* o8 = (v2u*)(hb + (size_t)m * D) + lane; v2u* o82 = (v2u*)(hb + (size_t)m2 * D) + lane;
#pragma unroll
        for (int j = 0; j < 4; ++j) { v2u w; w.x = cvtpk_s(v[j][0], v[j][1]); w.y = cvtpk_s(v[j][2], v[j][3]); o8[64 * j] = w; v2u w2; w2.x = cvtpk_s(w4[j][0], w4[j][1]); w2.y = cvtpk_s(w4[j][2], w4[j][3]); o82[64 * j] = w2; }
        if (lane < 16) { ssqp[(size_t)m * 16 + lane] = (lane == 0) ? s : 0.f; ssqp[(size_t)m2 * 16 + lane] = (lane == 0) ? s2 : 0.f; }
    }
}

__device__ __forceinline__ void phase_gmlp(const Args& A, int li, LAS unsigned char* lds, int vcu, int G, int wave, int lane) {
    const bf16* Z = (const bf16*)(A.ws + WS_Z); bf16* Y = (bf16*)(A.ws + WS_Y);
    const bf16* wst = (const bf16*)(A.ws + WS_WS) + (size_t)li * 4 * 128 * 128;
    const float* lng = A.ln_g + li * 512; const float* lnb = A.ln_b + li * 512; const float* bs = A.b_s + li * 4 * 128;
    const int r32 = lane & 31, hi = lane >> 5, grp = lane >> 4, qq = (lane & 15) >> 2, pp = lane & 3;
    float gg[8], gb[8];
#pragma unroll
    for (int j = 0; j < 8; ++j) { gg[j] = lng[8 * lane + j]; gb[j] = lnb[8 * lane + j]; }
    for (int u = vcu; u < M / 128; u += G) {
        const size_t row0 = (size_t)u * 128;
#pragma unroll 1
        for (int r4 = 0; r4 < 16; r4 += 4) {
            v4u wv[4];
#pragma unroll
            for (int k = 0; k < 4; ++k) wv[k] = *(const v4u*)(Z + (row0 + wave * 16 + r4 + k) * EVEN_IN + 512 + 8 * lane);
#pragma unroll
            for (int k = 0; k < 4; ++k) {
                const int s = wave * 16 + r4 + k; const v4u w = wv[k];
                float x[8] = {bf_lo(w.x), bf_hi(w.x), bf_lo(w.y), bf_hi(w.y), bf_lo(w.z), bf_hi(w.z), bf_lo(w.w), bf_hi(w.w)};
                float sm = 0.f;
#pragma unroll
                for (int j = 0; j < 8; ++j) sm += x[j];
                const float mean = wave_sum(sm) * (1.f / 512.f); float sq = 0.f;
#pragma unroll
                for (int j = 0; j < 8; ++j) { x[j] -= mean; sq += x[j] * x[j]; }
                const float rstd = __builtin_amdgcn_rsqf(wave_sum(sq) * (1.f / 512.f) + NORM_EPS);
#pragma unroll
                for (int j = 0; j < 8; ++j) x[j] = x[j] * rstd * gg[j] + gb[j];
                v4u o; o.x = cvtpk_s(x[0], x[1]); o.y = cvtpk_s(x[2], x[3]); o.z = cvtpk_s(x[4], x[5]); o.w = cvtpk_s(x[6], x[7]);
                *(LAS v4u*)(lds + ((s >> 3) * 16 + (lane >> 2)) * 512 + (s & 7) * 64 + (lane & 3) * 16) = o;
            }
        }
        __syncthreads();
        const int g = wave >> 1;
#pragma unroll 1
        for (int t2 = 0; t2 < 2; ++t2) {
            const int tt = (wave & 1) * 2 + t2;
            f32x16 acc[4];
#pragma unroll
            for (int ct = 0; ct < 4; ++ct) acc[ct] = f32x16{};
            const bf16* wrow = wst + ((size_t)g * 128 + 32 * tt + r32) * 128 + 8 * hi;
            const int nks = 2 * (tt + 1);
            bf16x8 bw[8];
#pragma unroll
            for (int ks = 0; ks < 8; ++ks) bw[ks] = (ks < nks) ? *(const bf16x8*)(wrow + 16 * ks) : bf16x8{};
#pragma unroll
            for (int ks = 0; ks < 8; ++ks) if (ks < nks) {
                const bf16x8 bfrag = bw[ks];
#pragma unroll
                for (int ct = 0; ct < 4; ++ct) {
                    const LAS unsigned char* p = lds + ((2 * ks + hi) * 16 + 4 * g + ct) * 512 + qq * 64 + (16 * (grp & 1) + 4 * pp) * 2;
                    const s16x4 lo = vtr(p), hi4 = vtr(p + 256);
                    const bf16x8 afrag = (bf16x8){lo[0], lo[1], lo[2], lo[3], hi4[0], hi4[1], hi4[2], hi4[3]};
                    acc[ct] = __builtin_amdgcn_mfma_f32_32x32x16_bf16(afrag, bfrag, acc[ct], 0, 0, 0);
                }
            }
            const int t = 32 * tt + r32; const size_t row = row0 + t; const float bias = bs[g * 128 + t];
            v2u ub[4][4], gb2[4][4];
#pragma unroll
            for (int ct = 0; ct < 4; ++ct)
#pragma unroll
                for (int rq = 0; rq < 4; ++rq) { const int c = g * 128 + 32 * ct + 8 * rq + 4 * hi; ub[ct][rq] = *(const v2u*)(Z + row * EVEN_IN + c); gb2[ct][rq] = *(const v2u*)(Z + row * EVEN_IN + 1024 + c); }
#pragma unroll
            for (int ct = 0; ct < 4; ++ct)
#pragma unroll
                for (int rq = 0; rq < 4; ++rq) {
                    const int c = g * 128 + 32 * ct + 8 * rq + 4 * hi;
                    const v2u uu = ub[ct][rq], ga = gb2[ct][rq];
                    const float y0 = bf_lo(uu.x) * (acc[ct][4 * rq + 0] + bias) * bf_lo(ga.x), y1 = bf_hi(uu.x) * (acc[ct][4 * rq + 1] + bias) * bf_hi(ga.x);
                    const float y2 = bf_lo(uu.y) * (acc[ct][4 * rq + 2] + bias) * bf_lo(ga.y), y3 = bf_hi(uu.y) * (acc[ct][4 * rq + 3] + bias) * bf_hi(ga.y);
                    v2u o; o.x = cvtpk_s(y0, y1); o.y = cvtpk_s(y2, y3);
                    *(v2u*)(Y + row * D + c) = o;
                }
        }
        __syncthreads();
    }
}

struct AttnSt { f32x16 o0, o1; float m, l; };
template <class MaskF>
__device__ __forceinline__ void attn_tile(AttnSt& st, const bf16x8 (&qf)[4], const bf16* kp, const bf16* vp0, const bf16* vp1, const bf16* vp2, const bf16* vp3, LAS unsigned char* vl, int lane, bool domask, MaskF mask) {
    const int hi = lane >> 5, grp = lane >> 4, qq = (lane & 15) >> 2, pp = lane & 3;
    bf16x8 kf[4]; v4u vv[4];
#pragma unroll
    for (int d0 = 0; d0 < 4; ++d0) kf[d0] = *(const bf16x8*)(kp + 16 * d0);
    vv[0] = *(const v4u*)vp0; vv[1] = *(const v4u*)vp1; vv[2] = *(const v4u*)vp2; vv[3] = *(const v4u*)vp3;
    f32x16 s = f32x16{};
#pragma unroll
    for (int d0 = 0; d0 < 4; ++d0) s = __builtin_amdgcn_mfma_f32_32x32x16_bf16(kf[d0], qf[d0], s, 0, 0, 0);
#pragma unroll
    for (int it = 0; it < 4; ++it) *(LAS v4u*)(vl + (it * 2 + ((lane & 7) >> 2)) * 512 + (lane >> 3) * 64 + (lane & 3) * 16) = vv[it];
    if (domask) {
#pragma unroll
        for (int r = 0; r < 16; ++r) if (!mask(crow(r, hi))) s[r] = -INFINITY;
    }
    float mt = s[0];
#pragma unroll
    for (int r = 1; r < 16; ++r) mt = fmaxf(mt, s[r]);
    mt = fmaxf(mt, __shfl_xor(mt, 32));
    const float mn = fmaxf(st.m, mt);
    if (__any(mn > st.m)) {
        const float f = __builtin_amdgcn_exp2f(st.m - mn); st.l *= f; st.m = mn;
#pragma unroll
        for (int r = 0; r < 16; ++r) { st.o0[r] *= f; st.o1[r] *= f; }
    }
    float ps = 0.f;
#pragma unroll
    for (int r = 0; r < 16; ++r) { s[r] = __builtin_amdgcn_exp2f(s[r] - st.m); ps += s[r]; }
    st.l += ps;
    v4u pw0, pw1;
    pw0.x = cvtpk_s(s[0], s[1]); pw0.y = cvtpk_s(s[2], s[3]); pw0.z = cvtpk_s(s[4], s[5]); pw0.w = cvtpk_s(s[6], s[7]);
    pw1.x = cvtpk_s(s[8], s[9]); pw1.y = cvtpk_s(s[10], s[11]); pw1.z = cvtpk_s(s[12], s[13]); pw1.w = cvtpk_s(s[14], s[15]);
    const bf16x8 pf0 = __builtin_bit_cast(bf16x8, pw0), pf1 = __builtin_bit_cast(bf16x8, pw1);
    const LAS unsigned char* tb = vl + (4 * hi + qq) * 64 + (16 * (grp & 1) + 4 * pp) * 2;
#define VFRAG(ks, d0) ({ const s16x4 lo_ = vtr(tb + ((2 * (ks)) * 2 + (d0)) * 512), hi_ = vtr(tb + ((2 * (ks) + 1) * 2 + (d0)) * 512); (bf16x8){lo_[0], lo_[1], lo_[2], lo_[3], hi_[0], hi_[1], hi_[2], hi_[3]}; })
    st.o0 = __builtin_amdgcn_mfma_f32_32x32x16_bf16(VFRAG(0, 0), pf0, st.o0, 0, 0, 0);
    st.o1 = __builtin_amdgcn_mfma_f32_32x32x16_bf16(VFRAG(0, 1), pf0, st.o1, 0, 0, 0);
    st.o0 = __builtin_amdgcn_mfma_f32_32x32x16_bf16(VFRAG(1, 0), pf1, st.o0, 0, 0, 0);
    st.o1 = __builtin_amdgcn_mfma_f32_32x32x16_bf16(VFRAG(1, 1), pf1, st.o1, 0, 0, 0);
#undef VFRAG
}
__device__ __forceinline__ void attn_store(const AttnSt& st, const bf16* grow, bf16* yrow, int lane) {
    const int hi = lane >> 5;
    const float lt = st.l + __shfl_xor(st.l, 32), inv = 1.0f / lt;
    v2u ga[2][4];
#pragma unroll
    for (int d0 = 0; d0 < 2; ++d0)
#pragma unroll
        for (int rq = 0; rq < 4; ++rq) ga[d0][rq] = *(const v2u*)(grow + 32 * d0 + 8 * rq + 4 * hi);
#pragma unroll
    for (int d0 = 0; d0 < 2; ++d0)
#pragma unroll
        for (int rq = 0; rq < 4; ++rq) {
            const int d = 32 * d0 + 8 * rq + 4 * hi;
            const v2u g = ga[d0][rq];
            const f32x16& o = d0 ? st.o1 : st.o0;
            v2u w; w.x = cvtpk_s(o[4 * rq + 0] * inv * bf_lo(g.x), o[4 * rq + 1] * inv * bf_hi(g.x)); w.y = cvtpk_s(o[4 * rq + 2] * inv * bf_lo(g.y), o[4 * rq + 3] * inv * bf_hi(g.y));
            *(v2u*)(yrow + d) = w;
        }
}

__device__ __forceinline__ void attn_gate_load(v2u (&ga)[2][4], const bf16* grow, int lane) {
    const int hi = lane >> 5;
#pragma unroll
    for (int d0 = 0; d0 < 2; ++d0)
#pragma unroll
        for (int rq = 0; rq < 4; ++rq) ga[d0][rq] = *(const v2u*)(grow + 32 * d0 + 8 * rq + 4 * hi);
}
__device__ __forceinline__ void attn_store_g(const AttnSt& st, const v2u (&ga)[2][4], bf16* yrow, int lane) {
    const int hi = lane >> 5;
    const float lt = st.l + __shfl_xor(st.l, 32), inv = 1.0f / lt;
#pragma unroll
    for (int d0 = 0; d0 < 2; ++d0)
#pragma unroll
        for (int rq = 0; rq < 4; ++rq) {
            const int d = 32 * d0 + 8 * rq + 4 * hi; const v2u g = ga[d0][rq]; const f32x16& o = d0 ? st.o1 : st.o0;
            v2u w; w.x = cvtpk_s(o[4 * rq + 0] * inv * bf_lo(g.x), o[4 * rq + 1] * inv * bf_hi(g.x)); w.y = cvtpk_s(o[4 * rq + 2] * inv * bf_lo(g.y), o[4 * rq + 3] * inv * bf_hi(g.y));
            *(v2u*)(yrow + d) = w;
        }
}
struct TileRegs { v4u kk[4]; v4u vv[4]; };
__device__ __forceinline__ void attn_load(TileRegs& R, int kvoff, const bf16* vp0, const bf16* vp1, const bf16* vp2, const bf16* vp3) {
    R.kk[0] = *(const v4u*)(vp0 - kvoff); R.kk[1] = *(const v4u*)(vp1 - kvoff); R.kk[2] = *(const v4u*)(vp2 - kvoff); R.kk[3] = *(const v4u*)(vp3 - kvoff);
    R.vv[0] = *(const v4u*)vp0; R.vv[1] = *(const v4u*)vp1; R.vv[2] = *(const v4u*)vp2; R.vv[3] = *(const v4u*)vp3;
}
__device__ __forceinline__ void attn_load_k(TileRegs& R, int kvoff, const bf16* vp0, const bf16* vp1, const bf16* vp2, const bf16* vp3) {
    R.kk[0] = *(const v4u*)(vp0 - kvoff); R.kk[1] = *(const v4u*)(vp1 - kvoff); R.kk[2] = *(const v4u*)(vp2 - kvoff); R.kk[3] = *(const v4u*)(vp3 - kvoff);
}
__device__ __forceinline__ void attn_load_v(TileRegs& R, const bf16* vp0, const bf16* vp1, const bf16* vp2, const bf16* vp3) {
    R.vv[0] = *(const v4u*)vp0; R.vv[1] = *(const v4u*)vp1; R.vv[2] = *(const v4u*)vp2; R.vv[3] = *(const v4u*)vp3;
}
template <int MODE>
__device__ __forceinline__ void attn_compute(AttnSt& st, const bf16x8 (&qf)[4], const TileRegs& R, LAS unsigned char* vl, int lane, bool keep, int dd0, int kmin) {
    const int r32 = lane & 31, hi = lane >> 5, grp = lane >> 4, qq = (lane & 15) >> 2, pp = lane & 3;
    LAS unsigned char* kl = vl + 32768;
#pragma unroll
    for (int it = 0; it < 4; ++it) { const int row = it * 8 + (lane >> 3); *(LAS v4u*)(kl + row * 128 + (((lane & 7) ^ (row & 7)) << 4)) = R.kk[it]; }
#pragma unroll
    for (int it = 0; it < 4; ++it) *(LAS v4u*)(vl + (it * 2 + ((lane & 7) >> 2)) * 512 + (lane >> 3) * 64 + (lane & 3) * 16) = R.vv[it];
    f32x16 s = f32x16{};
#pragma unroll
    for (int d0 = 0; d0 < 4; ++d0) {
        const v4u kw = *(const LAS v4u*)(kl + r32 * 128 + (((2 * d0 + hi) ^ (r32 & 7)) << 4));
        s = __builtin_amdgcn_mfma_f32_32x32x16_bf16(__builtin_bit_cast(bf16x8, kw), qf[d0], s, 0, 0, 0);
    }
    if (MODE == 1) {
#pragma unroll
        for (int r = 0; r < 16; ++r) if (crow(r, hi) > r32) s[r] = -INFINITY;
    } else if (MODE == 2) {
#pragma unroll
        for (int r = 0; r < 16; ++r) s[r] = keep ? s[r] : -INFINITY;
    } else if (MODE == 3) {
        const int ddh = dd0 - 4 * hi, kmh = kmin - 4 * hi;
#pragma unroll
        for (int r = 0; r < 16; ++r) { const int c = (r & 3) + 8 * (r >> 2); if ((unsigned)(ddh - c) > 128u || c < kmh) s[r] = -INFINITY; }
    }
    float mt = s[0];
#pragma unroll
    for (int r = 1; r < 16; ++r) mt = fmaxf(mt, s[r]);
    mt = fmaxf(mt, __shfl_xor(mt, 32));
    const float mn = fmaxf(st.m, mt);
    if (__any(mn > st.m)) {
        const float f = __builtin_amdgcn_exp2f(st.m - mn); st.l *= f; st.m = mn;
#pragma unroll
        for (int r = 0; r < 16; ++r) { st.o0[r] *= f; st.o1[r] *= f; }
    }
    float ps = 0.f;
#pragma unroll
    for (int r = 0; r < 16; ++r) { s[r] = __builtin_amdgcn_exp2f(s[r] - st.m); ps += s[r]; }
    st.l += ps;
    v4u pw0, pw1;
    pw0.x = cvtpk_s(s[0], s[1]); pw0.y = cvtpk_s(s[2], s[3]); pw0.z = cvtpk_s(s[4], s[5]); pw0.w = cvtpk_s(s[6], s[7]);
    pw1.x = cvtpk_s(s[8], s[9]); pw1.y = cvtpk_s(s[10], s[11]); pw1.z = cvtpk_s(s[12], s[13]); pw1.w = cvtpk_s(s[14], s[15]);
    const bf16x8 pf0 = __builtin_bit_cast(bf16x8, pw0), pf1 = __builtin_bit_cast(bf16x8, pw1);
    const LAS unsigned char* tb = vl + (4 * hi + qq) * 64 + (16 * (grp & 1) + 4 * pp) * 2;
#define VFRAG(ks, d0) ({ const s16x4 lo_ = vtr(tb + ((2 * (ks)) * 2 + (d0)) * 512), hi_ = vtr(tb + ((2 * (ks) + 1) * 2 + (d0)) * 512); (bf16x8){lo_[0], lo_[1], lo_[2], lo_[3], hi_[0], hi_[1], hi_[2], hi_[3]}; })
    st.o0 = __builtin_amdgcn_mfma_f32_32x32x16_bf16(VFRAG(0, 0), pf0, st.o0, 0, 0, 0);
    st.o1 = __builtin_amdgcn_mfma_f32_32x32x16_bf16(VFRAG(0, 1), pf0, st.o1, 0, 0, 0);
    st.o0 = __builtin_amdgcn_mfma_f32_32x32x16_bf16(VFRAG(1, 0), pf1, st.o0, 0, 0, 0);
    st.o1 = __builtin_amdgcn_mfma_f32_32x32x16_bf16(VFRAG(1, 1), pf1, st.o1, 0, 0, 0);
#undef VFRAG
}

template <class MaskF>
__device__ __forceinline__ void attn_subtile_lds(AttnSt& st, const bf16x8 (&qf)[4], const LAS unsigned char* kb, const LAS unsigned char* vl, int lane, bool domask, MaskF mask) {
    const int r32 = lane & 31, hi = lane >> 5, grp = lane >> 4, qq = (lane & 15) >> 2, pp = lane & 3;
    f32x16 s = f32x16{};
#pragma unroll
    for (int d0 = 0; d0 < 4; ++d0) {
        const bf16x8 kf = *(const LAS bf16x8*)(kb + r32 * 128 + (((2 * d0 + hi) ^ (r32 & 7)) << 4));
        s = __builtin_amdgcn_mfma_f32_32x32x16_bf16(kf, qf[d0], s, 0, 0, 0);
    }
    if (domask) {
#pragma unroll
        for (int r = 0; r < 16; ++r) if (!mask(crow(r, hi))) s[r] = -INFINITY;
    }
    float mt = s[0];
#pragma unroll
    for (int r = 1; r < 16; ++r) mt = fmaxf(mt, s[r]);
    mt = fmaxf(mt, __shfl_xor(mt, 32));
    const float mn = fmaxf(st.m, mt);
    if (__any(mn > st.m)) {
        const float f = __builtin_amdgcn_exp2f(st.m - mn); st.l *= f; st.m = mn;
#pragma unroll
        for (int r = 0; r < 16; ++r) { st.o0[r] *= f; st.o1[r] *= f; }
    }
    float ps = 0.f;
#pragma unroll
    for (int r = 0; r < 16; ++r) { s[r] = __builtin_amdgcn_exp2f(s[r] - st.m); ps += s[r]; }
    st.l += ps;
    v4u pw0, pw1;
    pw0.x = cvtpk_s(s[0], s[1]); pw0.y = cvtpk_s(s[2], s[3]); pw0.z = cvtpk_s(s[4], s[5]); pw0.w = cvtpk_s(s[6], s[7]);
    pw1.x = cvtpk_s(s[8], s[9]); pw1.y = cvtpk_s(s[10], s[11]); pw1.z = cvtpk_s(s[12], s[13]); pw1.w = cvtpk_s(s[14], s[15]);
    const bf16x8 pf0 = __builtin_bit_cast(bf16x8, pw0), pf1 = __builtin_bit_cast(bf16x8, pw1);
    const LAS unsigned char* tb = vl + (4 * hi + qq) * 64 + (16 * (grp & 1) + 4 * pp) * 2;
#define VFRAG(ks, d0) ({ const s16x4 lo_ = vtr(tb + ((2 * (ks)) * 2 + (d0)) * 512), hi_ = vtr(tb + ((2 * (ks) + 1) * 2 + (d0)) * 512); (bf16x8){lo_[0], lo_[1], lo_[2], lo_[3], hi_[0], hi_[1], hi_[2], hi_[3]}; })
    st.o0 = __builtin_amdgcn_mfma_f32_32x32x16_bf16(VFRAG(0, 0), pf0, st.o0, 0, 0, 0);
    st.o1 = __builtin_amdgcn_mfma_f32_32x32x16_bf16(VFRAG(0, 1), pf0, st.o1, 0, 0, 0);
    st.o0 = __builtin_amdgcn_mfma_f32_32x32x16_bf16(VFRAG(1, 0), pf1, st.o0, 0, 0, 0);
    st.o1 = __builtin_amdgcn_mfma_f32_32x32x16_bf16(VFRAG(1, 1), pf1, st.o1, 0, 0, 0);
#undef VFRAG
}
template <int M0, int M1>
__device__ __forceinline__ void attn_tile64_lds(AttnSt& st, const bf16x8 (&qf)[4], const LAS unsigned char* kb, const LAS unsigned char* vb, int lane, bool keep) {
    const int r32 = lane & 31, hi = lane >> 5, grp = lane >> 4, qq = (lane & 15) >> 2, pp = lane & 3;
    f32x16 s0 = f32x16{}, s1 = f32x16{};
#pragma unroll
    for (int d0 = 0; d0 < 4; ++d0) {
        const int ko = r32 * 128 + (((2 * d0 + hi) ^ (r32 & 7)) << 4);
        const v4u k0 = *(const LAS v4u*)(kb + ko), k1 = *(const LAS v4u*)(kb + 4096 + ko);
        s0 = __builtin_amdgcn_mfma_f32_32x32x16_bf16(__builtin_bit_cast(bf16x8, k0), qf[d0], s0, 0, 0, 0);
        s1 = __builtin_amdgcn_mfma_f32_32x32x16_bf16(__builtin_bit_cast(bf16x8, k1), qf[d0], s1, 0, 0, 0);
    }
    if (M0 == 1 || M1 == 1) {
#pragma unroll
        for (int r = 0; r < 16; ++r) {
            if (M0 == 1) { if (crow(r, hi) > r32) s0[r] = -INFINITY; }
            if (M1 == 1) { if (crow(r, hi) > r32) s1[r] = -INFINITY; }
        }
    }
    float mt = fmaxf(s0[0], s1[0]);
#pragma unroll
    for (int r = 1; r < 16; ++r) mt = fmaxf(mt, fmaxf(s0[r], s1[r]));
    mt = fmaxf(mt, __shfl_xor(mt, 32));
    const float mn = fmaxf(st.m, mt);
    if (__any(mn > st.m)) {
        const float f = __builtin_amdgcn_exp2f(st.m - mn); st.l *= f; st.m = mn;
#pragma unroll
        for (int r = 0; r < 16; ++r) { st.o0[r] *= f; st.o1[r] *= f; }
    }
    const float mo = (M0 == 2 && !keep) ? INFINITY : st.m;
    const f32x2_t mo2 = {mo, mo}; f32x2_t acc2 = {0.f, 0.f};
#pragma unroll
    for (int r = 0; r < 16; r += 2) {
        f32x2_t v0 = (f32x2_t){s0[r], s0[r + 1]} - mo2, v1 = (f32x2_t){s1[r], s1[r + 1]} - mo2;
        v0.x = __builtin_amdgcn_exp2f(v0.x); v0.y = __builtin_amdgcn_exp2f(v0.y); v1.x = __builtin_amdgcn_exp2f(v1.x); v1.y = __builtin_amdgcn_exp2f(v1.y);
        acc2 += v0; acc2 += v1;
        s0[r] = v0.x; s0[r + 1] = v0.y; s1[r] = v1.x; s1[r + 1] = v1.y;
    }
    st.l += acc2.x + acc2.y;
    v4u p00, p01, p10, p11;
    p00.x = cvtpk_s(s0[0], s0[1]); p00.y = cvtpk_s(s0[2], s0[3]); p00.z = cvtpk_s(s0[4], s0[5]); p00.w = cvtpk_s(s0[6], s0[7]);
    p01.x = cvtpk_s(s0[8], s0[9]); p01.y = cvtpk_s(s0[10], s0[11]); p01.z = cvtpk_s(s0[12], s0[13]); p01.w = cvtpk_s(s0[14], s0[15]);
    p10.x = cvtpk_s(s1[0], s1[1]); p10.y = cvtpk_s(s1[2], s1[3]); p10.z = cvtpk_s(s1[4], s1[5]); p10.w = cvtpk_s(s1[6], s1[7]);
    p11.x = cvtpk_s(s1[8], s1[9]); p11.y = cvtpk_s(s1[10], s1[11]); p11.z = cvtpk_s(s1[12], s1[13]); p11.w = cvtpk_s(s1[14], s1[15]);
    const bf16x8 f00 = __builtin_bit_cast(bf16x8, p00), f01 = __builtin_bit_cast(bf16x8, p01), f10 = __builtin_bit_cast(bf16x8, p10), f11 = __builtin_bit_cast(bf16x8, p11);
    const LAS unsigned char* tb = vb + (4 * hi + qq) * 64 + (16 * (grp & 1) + 4 * pp) * 2;
#define VFRAG(sub, ks, d0) ({ const s16x4 lo_ = vtr(tb + (sub) * 4096 + ((2 * (ks)) * 2 + (d0)) * 512), hi_ = vtr(tb + (sub) * 4096 + ((2 * (ks) + 1) * 2 + (d0)) * 512); (bf16x8){lo_[0], lo_[1], lo_[2], lo_[3], hi_[0], hi_[1], hi_[2], hi_[3]}; })
    st.o0 = __builtin_amdgcn_mfma_f32_32x32x16_bf16(VFRAG(0, 0, 0), f00, st.o0, 0, 0, 0);
    st.o1 = __builtin_amdgcn_mfma_f32_32x32x16_bf16(VFRAG(0, 0, 1), f00, st.o1, 0, 0, 0);
    st.o0 = __builtin_amdgcn_mfma_f32_32x32x16_bf16(VFRAG(0, 1, 0), f01, st.o0, 0, 0, 0);
    st.o1 = __builtin_amdgcn_mfma_f32_32x32x16_bf16(VFRAG(0, 1, 1), f01, st.o1, 0, 0, 0);
    st.o0 = __builtin_amdgcn_mfma_f32_32x32x16_bf16(VFRAG(1, 0, 0), f10, st.o0, 0, 0, 0);
    st.o1 = __builtin_amdgcn_mfma_f32_32x32x16_bf16(VFRAG(1, 0, 1), f10, st.o1, 0, 0, 0);
    st.o0 = __builtin_amdgcn_mfma_f32_32x32x16_bf16(VFRAG(1, 1, 0), f11, st.o0, 0, 0, 0);
    st.o1 = __builtin_amdgcn_mfma_f32_32x32x16_bf16(VFRAG(1, 1, 1), f11, st.o1, 0, 0, 0);
#undef VFRAG
}
__device__ __forceinline__ void phase_moba_s(const Args& A, LAS unsigned char* lds, int G, int vcu, int wave, int lane) {
    const bf16* Z = (const bf16*)(A.ws + WS_Z); bf16* Y = (bf16*)(A.ws + WS_Y); const float* kmp = (const float*)(A.ws + WS_KMP);
    const int r32 = lane & 31, hi = lane >> 5, tid = wave * 64 + lane;
    const int skey = tid >> 3, sch = tid & 7;
    const int kwoff = skey * 128 + ((sch ^ (skey & 7)) << 4);
    const int vwoff = ((skey >> 3) * 2 + (sch >> 2)) * 512 + (skey & 7) * 64 + (sch & 3) * 16;
    for (int U = vcu; U < 2048; U += G) {
        const int it8 = U >> 8, v = U & 255, j = v & 7;
        const int blk = (it8 & 1) ? 15 - j : j, bh = (v >> 3) * 4 + (it8 >> 1);
        const int b = bh >> 3, hh = bh & 7, q0 = blk * 256 + 32 * wave;
        const size_t rowbase = (size_t)b * SEQ;
        const bf16* zq = Z + (rowbase + q0 + r32) * EVEN_IN;
        const bf16* Kh = Z + rowbase * EVEN_IN + 2048 + hh * 64 + (size_t)skey * EVEN_IN + 8 * sch; const bf16* Vh = Kh + 512;
        v4u kreg = *(const v4u*)(Kh + (size_t)(blk * 256) * EVEN_IN), vreg = *(const v4u*)(Vh + (size_t)(blk * 256) * EVEN_IN);
        bf16x8 qf[4];
#pragma unroll
        for (int d0 = 0; d0 < 4; ++d0) qf[d0] = *(const bf16x8*)(zq + 1536 + hh * 64 + 16 * d0 + 8 * hi);
        v2u gg[2][4]; attn_gate_load(gg, zq + 3072 + hh * 64, lane);
        unsigned sel = 0u;
        if (blk > 0) {
            f32x16 gt = f32x16{};
#pragma unroll
            for (int d0 = 0; d0 < 4; ++d0) {
                bf16x8 kmf = bf16x8{};
                if (r32 < 16) {
                    const float* p0 = kmp + (((size_t)b * 16 + r32) * 2) * 512 + hh * 64 + 16 * d0 + 8 * hi;
                    const f32x4 a0 = *(const f32x4*)p0, a1 = *(const f32x4*)(p0 + 4), b0 = *(const f32x4*)(p0 + 512), b1 = *(const f32x4*)(p0 + 516);
                    const f32x4 s0 = a0 + b0, s1 = a1 + b1;
                    v4u w; w.x = pk2(s0[0], s0[1]); w.y = pk2(s0[2], s0[3]); w.z = pk2(s1[0], s1[1]); w.w = pk2(s1[2], s1[3]);
                    kmf = __builtin_bit_cast(bf16x8, w);
                }
                gt = __builtin_amdgcn_mfma_f32_32x32x16_bf16(kmf, qf[d0], gt, 0, 0, 0);
            }
            float gv[16];
#pragma unroll
            for (int r = 0; r < 8; ++r) {
                const float mine = gt[r], oth = __shfl_xor(mine, 32);
                const float vlo = hi ? oth : mine, vhi = hi ? mine : oth;
                gv[(r & 3) + 8 * (r >> 2)] = vlo; gv[(r & 3) + 8 * (r >> 2) + 4] = vhi;
            }
#pragma unroll
            for (int n = 0; n < 16; ++n) if (n >= blk) gv[n] = -INFINITY;
#pragma unroll
            for (int it = 0; it < 3; ++it) {
                float best = -INFINITY; int bi = -1;
#pragma unroll
                for (int n = 0; n < 16; ++n) { const bool ok = (gv[n] > best) && !((sel >> n) & 1u); best = ok ? gv[n] : best; bi = ok ? n : bi; }
                if (bi >= 0) sel |= 1u << bi;
            }
        }
        AttnSt st; st.o0 = f32x16{}; st.o1 = f32x16{}; st.m = -1e30f; st.l = 0.f;
#define MB_LOAD(key0_) do { kreg = *(const v4u*)(Kh + (size_t)(key0_) * EVEN_IN); vreg = *(const v4u*)(Vh + (size_t)(key0_) * EVEN_IN); } while (0)
#define MB_STORE(buf_) do { *(LAS v4u*)(lds + (buf_) * 8192 + kwoff) = kreg; *(LAS v4u*)(lds + 16384 + (buf_) * 8192 + vwoff) = vreg; } while (0)
        MB_STORE(0);
        __syncthreads();
#pragma unroll 1
        for (int t = 0; t < 4; ++t) {
            const int buf = t & 1;
            if (t < 3) MB_LOAD(blk * 256 + 64 * (t + 1)); else if (blk > 0) MB_LOAD(0);
            const LAS unsigned char* kb = lds + buf * 8192; const LAS unsigned char* vb = lds + 16384 + buf * 8192;
            if (2 * t + 1 < wave) attn_tile64_lds<0, 0>(st, qf, kb, vb, lane, true);
            else if (2 * t + 1 == wave) attn_tile64_lds<0, 1>(st, qf, kb, vb, lane, true);
            else if (2 * t == wave) attn_subtile_lds(st, qf, kb, vb, lane, true, [&](int kk) { return kk <= r32; });
            if (t < 3 || blk > 0) MB_STORE(buf ^ 1);
            __syncthreads();
        }
        const int P = 4 * blk;
#pragma unroll 1
        for (int p = 0; p < P; ++p) {
            const int buf = p & 1;
            if (p + 1 < P) MB_LOAD(64 * (p + 1));
            const LAS unsigned char* kb = lds + buf * 8192; const LAS unsigned char* vb = lds + 16384 + buf * 8192;
            const bool mysel = (sel >> (p >> 2)) & 1u;
            if (__any(mysel)) {
                attn_tile64_lds<2, 2>(st, qf, kb, vb, lane, mysel);
            }
            if (p + 1 < P) MB_STORE(buf ^ 1);
            __syncthreads();
        }
#undef MB_LOAD
#undef MB_STORE
        attn_store_g(st, gg, Y + (rowbase + q0 + r32) * D + 512 + hh * 64, lane);
    }
}

__device__ __forceinline__ void phase_moba_old(const Args& A, LAS unsigned char* lds, int gwv, int NGW, int wave, int lane) {
    const bf16* Z = (const bf16*)(A.ws + WS_Z); bf16* Y = (bf16*)(A.ws + WS_Y); const float* kmp = (const float*)(A.ws + WS_KMP);
    LAS unsigned char* vl = lds + wave * 4096;
    const int r32 = lane & 31, hi = lane >> 5;
#ifdef OLD_NEWMAP
    for (int U = gwv >> 3; U < 2048; U += NGW >> 3) {
        const int it8 = U >> 8, v = U & 255, j = v & 7;
        const int blk = (it8 & 1) ? 15 - j : j, bh = (v >> 3) * 4 + (it8 >> 1);
        const int b = bh >> 3, hh = bh & 7, q0 = blk * 256 + 32 * wave;
#else
    for (int U = gwv; U < 16384; U += NGW) {
        const int rd = U >> 11, g2 = U & 2047, X = g2 >> 8, lwv = g2 & 255;
        const int bh = 16 * X + 2 * rd + (lwv >> 7); int gi = lwv & 127; if (rd & 1) gi = 127 - gi;
        const int b = bh >> 3, hh = bh & 7, q0 = gi * 32, blk = q0 >> 8;
#endif
        const size_t rowbase = (size_t)b * SEQ;
        const bf16* zq = Z + (rowbase + q0 + r32) * EVEN_IN;
        bf16x8 qf[4];
#pragma unroll
        for (int d0 = 0; d0 < 4; ++d0) qf[d0] = *(const bf16x8*)(zq + 1536 + hh * 64 + 16 * d0 + 8 * hi);
        unsigned sel = 0u;
        if (blk > 0) {
            f32x16 gt = f32x16{};
#pragma unroll
            for (int d0 = 0; d0 < 4; ++d0) {
                bf16x8 kmf = bf16x8{};
                if (r32 < 16) {
                    const float* p0 = kmp + (((size_t)b * 16 + r32) * 2) * 512 + hh * 64 + 16 * d0 + 8 * hi;
                    const f32x4 a0 = *(const f32x4*)p0, a1 = *(const f32x4*)(p0 + 4), b0 = *(const f32x4*)(p0 + 512), b1 = *(const f32x4*)(p0 + 516);
                    const f32x4 s0 = a0 + b0, s1 = a1 + b1;
                    v4u w; w.x = pk2(s0[0], s0[1]); w.y = pk2(s0[2], s0[3]); w.z = pk2(s1[0], s1[1]); w.w = pk2(s1[2], s1[3]);
                    kmf = __builtin_bit_cast(bf16x8, w);
                }
                gt = __builtin_amdgcn_mfma_f32_32x32x16_bf16(kmf, qf[d0], gt, 0, 0, 0);
            }
            float gv[16];
#pragma unroll
            for (int r = 0; r < 8; ++r) {
                const float mine = gt[r], oth = __shfl_xor(mine, 32);
                const float vlo = hi ? oth : mine, vhi = hi ? mine : oth;
                gv[(r & 3) + 8 * (r >> 2)] = vlo; gv[(r & 3) + 8 * (r >> 2) + 4] = vhi;
            }
#pragma unroll
            for (int n = 0; n < 16; ++n) if (n >= blk) gv[n] = -INFINITY;
#pragma unroll
            for (int it = 0; it < 3; ++it) {
                float best = -INFINITY; int bi = -1;
#pragma unroll
                for (int n = 0; n < 16; ++n) { const bool ok = (gv[n] > best) && !((sel >> n) & 1u); best = ok ? gv[n] : best; bi = ok ? n : bi; }
                if (bi >= 0) sel |= 1u << bi;
            }
        }
        AttnSt st; st.o0 = f32x16{}; st.o1 = f32x16{}; st.m = -1e30f; st.l = 0.f;
        const bf16* Kh = Z + rowbase * EVEN_IN + 2048 + hh * 64; const bf16* Vh = Z + rowbase * EVEN_IN + 2560 + hh * 64;
        const size_t vrow8 = (size_t)8 * EVEN_IN;
        const int ndiag = (q0 & 255) >> 5;
        for (int kt = 0; kt <= ndiag; ++kt) {
            const size_t k0 = (size_t)blk * 256 + kt * 32;
            const bf16* vp = Vh + (k0 + (lane >> 3)) * EVEN_IN + 8 * (lane & 7);
            attn_tile(st, qf, Kh + (k0 + r32) * EVEN_IN + 8 * hi, vp, vp + vrow8, vp + 2 * vrow8, vp + 3 * vrow8, vl, lane, kt == ndiag, [&](int kk) { return kk <= r32; });
        }
        for (int n = 0; n < blk; ++n) {
            const bool mysel = (sel >> n) & 1u;
            if (!__any(mysel)) continue;
            for (int kt = 0; kt < 8; ++kt) {
                const size_t k0 = (size_t)n * 256 + kt * 32;
                const bf16* vp = Vh + (k0 + (lane >> 3)) * EVEN_IN + 8 * (lane & 7);
                attn_tile(st, qf, Kh + (k0 + r32) * EVEN_IN + 8 * hi, vp, vp + vrow8, vp + 2 * vrow8, vp + 3 * vrow8, vl, lane, true, [&](int) { return mysel; });
            }
        }
        attn_store(st, zq + 3072 + hh * 64, Y + (rowbase + q0 + r32) * D + 512 + hh * 64, lane);
    }
}


__device__ __forceinline__ void phase_moba_p(const Args& A, LAS unsigned char* lds, int gwv, int NGW, int wave, int lane) {
    const bf16* Z = (const bf16*)(A.ws + WS_Z); bf16* Y = (bf16*)(A.ws + WS_Y); const float* kmp = (const float*)(A.ws + WS_KMP);
    LAS unsigned char* vl = lds + wave * 4096;
    const int r32 = lane & 31, hi = lane >> 5;
    for (int U = gwv; U < 16384; U += NGW) {
        const int rd = U >> 11, g2 = U & 2047, X = g2 >> 8, lwv = g2 & 255;
        const int bh = 16 * X + 2 * rd + (lwv >> 7); int gi = lwv & 127; if (rd & 1) gi = 127 - gi;
        const int b = bh >> 3, hh = bh & 7, q0 = gi * 32, blk = q0 >> 8;
        const size_t rowbase = (size_t)b * SEQ;
        const bf16* zq = Z + (rowbase + q0 + r32) * EVEN_IN;
        bf16x8 qf[4];
#pragma unroll
        for (int d0 = 0; d0 < 4; ++d0) qf[d0] = *(const bf16x8*)(zq + 1536 + hh * 64 + 16 * d0 + 8 * hi);
        unsigned sel = 0u;
        if (blk > 0) {
            f32x16 gt = f32x16{};
#pragma unroll
            for (int d0 = 0; d0 < 4; ++d0) {
                bf16x8 kmf = bf16x8{};
                if (r32 < 16) {
                    const float* p0 = kmp + (((size_t)b * 16 + r32) * 2) * 512 + hh * 64 + 16 * d0 + 8 * hi;
                    const f32x4 a0 = *(const f32x4*)p0, a1 = *(const f32x4*)(p0 + 4), b0 = *(const f32x4*)(p0 + 512), b1 = *(const f32x4*)(p0 + 516);
                    const f32x4 s0 = a0 + b0, s1 = a1 + b1;
                    v4u w; w.x = pk2(s0[0], s0[1]); w.y = pk2(s0[2], s0[3]); w.z = pk2(s1[0], s1[1]); w.w = pk2(s1[2], s1[3]);
                    kmf = __builtin_bit_cast(bf16x8, w);
                }
                gt = __builtin_amdgcn_mfma_f32_32x32x16_bf16(kmf, qf[d0], gt, 0, 0, 0);
            }
            float gv[16];
#pragma unroll
            for (int r = 0; r < 8; ++r) {
                const float mine = gt[r], oth = __shfl_xor(mine, 32);
                const float vlo = hi ? oth : mine, vhi = hi ? mine : oth;
                gv[(r & 3) + 8 * (r >> 2)] = vlo; gv[(r & 3) + 8 * (r >> 2) + 4] = vhi;
            }
#pragma unroll
            for (int n = 0; n < 16; ++n) if (n >= blk) gv[n] = -INFINITY;
#pragma unroll
            for (int it = 0; it < 3; ++it) {
                float best = -INFINITY; int bi = -1;
#pragma unroll
                for (int n = 0; n < 16; ++n) { const bool ok = (gv[n] > best) && !((sel >> n) & 1u); best = ok ? gv[n] : best; bi = ok ? n : bi; }
                if (bi >= 0) sel |= 1u << bi;
            }
        }
        unsigned anym = 0u;
#pragma unroll
        for (int n = 0; n < 15; ++n) if (__any((sel >> n) & 1u)) anym |= 1u << n;
        anym = (unsigned)__builtin_amdgcn_readfirstlane((int)anym);
        AttnSt st; st.o0 = f32x16{}; st.o1 = f32x16{}; st.m = -1e30f; st.l = 0.f;
        const bf16* Kh = Z + rowbase * EVEN_IN + 2048 + hh * 64; const bf16* Vh = Z + rowbase * EVEN_IN + 2560 + hh * 64;
        const size_t vrow8 = (size_t)8 * EVEN_IN;
        const int ndiag = (q0 & 255) >> 5;
#define MB_LOADT(R, nn, kk_) do { const size_t k0_ = (size_t)((nn) < 0 ? blk : (nn)) * 256 + (kk_) * 32; const bf16* vp_ = Vh + (k0_ + (lane >> 3)) * EVEN_IN + 8 * (lane & 7); \
            attn_load(R, 512, vp_, vp_ + vrow8, vp_ + 2 * vrow8, vp_ + 3 * vrow8); } while (0)
#define MB_COMP(R, nn, kk_) do { if ((nn) < 0) { if ((kk_) == ndiag) attn_compute<1>(st, qf, R, vl, lane, true, 0, 0); else attn_compute<0>(st, qf, R, vl, lane, true, 0, 0); } \
            else attn_compute<2>(st, qf, R, vl, lane, ((sel >> (nn)) & 1u) != 0u, 0, 0); } while (0)
#define MB_ADV(nn, kk_, more) do { more = true; if ((nn) < 0) { if ((kk_) < ndiag) ++(kk_); else { (kk_) = 0; if (anym) (nn) = __builtin_ctz(anym); else more = false; } } \
            else if ((kk_) < 7) ++(kk_); else { (kk_) = 0; const unsigned rest_ = anym & ~((2u << (nn)) - 1u); if (rest_) (nn) = __builtin_ctz(rest_); else more = false; } } while (0)
        TileRegs RA, RB; int cn = -1, ck = 0;
        MB_LOADT(RA, cn, ck);
        for (;;) {
            int nn = cn, nk = ck; bool more; MB_ADV(nn, nk, more);
            if (more) MB_LOADT(RB, nn, nk);
            MB_COMP(RA, cn, ck);
            if (!more) break;
            cn = nn; ck = nk; MB_ADV(nn, nk, more);
            if (more) MB_LOADT(RA, nn, nk);
            MB_COMP(RB, cn, ck);
            if (!more) break;
            cn = nn; ck = nk;
        }
#undef MB_LOADT
#undef MB_COMP
#undef MB_ADV
        attn_store(st, zq + 3072 + hh * 64, Y + (rowbase + q0 + r32) * D + 512 + hh * 64, lane);
    }
}

__device__ __forceinline__ void phase_dilated_p(const Args& A, LAS unsigned char* lds, int gwv, int NGW, int wave, int lane) {
    const bf16* Z = (const bf16*)(A.ws + WS_Z); bf16* Y = (bf16*)(A.ws + WS_Y);
    LAS unsigned char* vl = lds + wave * 4096;
    const int r32 = lane & 31, hi = lane >> 5;
    for (int U = gwv; U < 32768; U += NGW) {
        const int rd = U >> 11, g2 = U & 2047, X = g2 >> 8, lwv = g2 & 255;
        const int bh = 32 * X + 2 * rd + (lwv >> 7), gi = lwv & 127, c = gi >> 4, r16 = gi & 15;
        const int b = bh >> 4, hh = bh & 15;
        const size_t rowbase = (size_t)b * SEQ;
        const int tq = 512 * c + r16 + 16 * r32;
        const bf16* zq = Z + (rowbase + tq) * ODD_IN;
        bf16x8 qf[4];
#pragma unroll
        for (int d0 = 0; d0 < 4; ++d0) qf[d0] = *(const bf16x8*)(zq + hh * 64 + 16 * d0 + 8 * hi);
        AttnSt st; st.o0 = f32x16{}; st.o1 = f32x16{}; st.m = -1e30f; st.l = 0.f;
        const bf16* Kh = Z + rowbase * ODD_IN + 1024 + hh * 64; const bf16* Vh = Z + rowbase * ODD_IN + 2048 + hh * 64;
#define DL_DIL(cfg) ((cfg) == 0 ? 16 : (cfg) == 1 ? 4 : 1)
#define DL_NT(cfg) ((cfg) == 0 ? 5 : (cfg) == 1 ? 8 : 20)
#define DL_MBASE(cfg) ((512 * c + r16 - (r16 & (DL_DIL(cfg) - 1))) / DL_DIL(cfg) - 128)
#define DL_TAU0(cfg) (DL_MBASE(cfg) < 0 ? (-DL_MBASE(cfg)) / 32 : 0)
#define DL_LOADT(R, cfg, tau) do { const int dil_ = DL_DIL(cfg), rdl_ = r16 & (dil_ - 1), m0_ = DL_MBASE(cfg) + 32 * (tau); \
            const int mv_ = m0_ + (lane >> 3); const int mv0_ = mv_ < 0 ? 0 : mv_, mv1_ = mv_ + 8 < 0 ? 0 : mv_ + 8, mv2_ = mv_ + 16 < 0 ? 0 : mv_ + 16, mv3_ = mv_ + 24 < 0 ? 0 : mv_ + 24; \
            const bf16* vb_ = Vh + (size_t)rdl_ * ODD_IN + 8 * (lane & 7); const size_t vst_ = (size_t)dil_ * ODD_IN; \
            attn_load(R, 1024, vb_ + mv0_ * vst_, vb_ + mv1_ * vst_, vb_ + mv2_ * vst_, vb_ + mv3_ * vst_); } while (0)
#define DL_COMP(R, cfg, tau) do { const int m0_ = DL_MBASE(cfg) + 32 * (tau); \
            if ((cfg) == 0 && (tau) >= 1 && (tau) <= 3 && m0_ >= 0) attn_compute<0>(st, qf, R, vl, lane, true, 0, 0); \
            else attn_compute<3>(st, qf, R, vl, lane, true, 128 + (16 / DL_DIL(cfg)) * r32 - 32 * (tau), -m0_); } while (0)
#define DL_ADV(cfg, tau, more) do { more = true; if ((tau) + 1 < DL_NT(cfg)) ++(tau); else if ((cfg) < 2) { ++(cfg); (tau) = DL_TAU0(cfg); } else more = false; } while (0)
        TileRegs RA, RB; int cc = 0, ct = DL_TAU0(0);
        DL_LOADT(RA, cc, ct);
        for (;;) {
            int nc = cc, nt = ct; bool more; DL_ADV(nc, nt, more);
            if (more) DL_LOADT(RB, nc, nt);
            DL_COMP(RA, cc, ct);
            if (!more) break;
            cc = nc; ct = nt; DL_ADV(nc, nt, more);
            if (more) DL_LOADT(RA, nc, nt);
            DL_COMP(RB, cc, ct);
            if (!more) break;
            cc = nc; ct = nt;
        }
#undef DL_DIL
#undef DL_NT
#undef DL_MBASE
#undef DL_TAU0
#undef DL_LOADT
#undef DL_COMP
#undef DL_ADV
        attn_store(st, zq + 3072 + hh * 64, Y + (rowbase + tq) * D + hh * 64, lane);
    }
}


__device__ __forceinline__ void attn_stage2(const TileRegs& RA, const TileRegs& RB, LAS unsigned char* wl, int lane) {
    LAS unsigned char* vla = wl; LAS unsigned char* vlb = wl + 4096; LAS unsigned char* kla = wl + 8192; LAS unsigned char* klb = wl + 12288;
#pragma unroll
    for (int it = 0; it < 4; ++it) { const int row = it * 8 + (lane >> 3); const int ko = row * 128 + (((lane & 7) ^ (row & 7)) << 4); *(LAS v4u*)(kla + ko) = RA.kk[it]; *(LAS v4u*)(klb + ko) = RB.kk[it]; }
#pragma unroll
    for (int it = 0; it < 4; ++it) { const int vo = (it * 2 + ((lane & 7) >> 2)) * 512 + (lane >> 3) * 64 + (lane & 3) * 16; *(LAS v4u*)(vla + vo) = RA.vv[it]; *(LAS v4u*)(vlb + vo) = RB.vv[it]; }
}
template <int MODE, class MidF>
__device__ __forceinline__ void attn_compute2_lds(AttnSt& a, AttnSt& b, const bf16x8 (&qa)[4], const bf16x8 (&qb)[4], LAS unsigned char* wl, int lane, int dd0, int kmina, int kminb, MidF mid) {
    const int r32 = lane & 31, hi = lane >> 5, grp = lane >> 4, qq = (lane & 15) >> 2, pp = lane & 3;
    LAS unsigned char* vla = wl; LAS unsigned char* vlb = wl + 4096; LAS unsigned char* kla = wl + 8192; LAS unsigned char* klb = wl + 12288;
    f32x16 sa = f32x16{}, sb = f32x16{};
#pragma unroll
    for (int d0 = 0; d0 < 4; ++d0) {
        const int ko = r32 * 128 + (((2 * d0 + hi) ^ (r32 & 7)) << 4);
        const v4u kwa = *(const LAS v4u*)(kla + ko), kwb = *(const LAS v4u*)(klb + ko);
        sa = __builtin_amdgcn_mfma_f32_32x32x16_bf16(__builtin_bit_cast(bf16x8, kwa), qa[d0], sa, 0, 0, 0);
        sb = __builtin_amdgcn_mfma_f32_32x32x16_bf16(__builtin_bit_cast(bf16x8, kwb), qb[d0], sb, 0, 0, 0);
    }
    if (MODE == 3) {
        const int ddh = dd0 - 4 * hi, kma = kmina - 4 * hi, kmb = kminb - 4 * hi;
#pragma unroll
        for (int r = 0; r < 16; ++r) { const int c = (r & 3) + 8 * (r >> 2); const bool band = (unsigned)(ddh - c) <= 128u; if (!band || c < kma) sa[r] = -INFINITY; if (!band || c < kmb) sb[r] = -INFINITY; }
    }
    float mta = sa[0], mtb = sb[0];
#pragma unroll
    for (int r = 1; r < 16; ++r) { mta = fmaxf(mta, sa[r]); mtb = fmaxf(mtb, sb[r]); }
    mta = fmaxf(mta, __shfl_xor(mta, 32)); mtb = fmaxf(mtb, __shfl_xor(mtb, 32));
    const float mna = fmaxf(a.m, mta), mnb = fmaxf(b.m, mtb);
    const float fa = __builtin_amdgcn_exp2f(a.m - mna), fb = __builtin_amdgcn_exp2f(b.m - mnb);
    a.l *= fa; a.m = mna; b.l *= fb; b.m = mnb;
#pragma unroll
    for (int r = 0; r < 16; ++r) { a.o0[r] *= fa; a.o1[r] *= fa; b.o0[r] *= fb; b.o1[r] *= fb; }
    float psa = 0.f, psb = 0.f;
#pragma unroll
    for (int r = 0; r < 16; ++r) { sa[r] = __builtin_amdgcn_exp2f(sa[r] - mna); sb[r] = __builtin_amdgcn_exp2f(sb[r] - mnb); psa += sa[r]; psb += sb[r]; }
    a.l += psa; b.l += psb;
    v4u pa0, pa1, pb0, pb1;
    pa0.x = cvtpk_s(sa[0], sa[1]); pa0.y = cvtpk_s(sa[2], sa[3]); pa0.z = cvtpk_s(sa[4], sa[5]); pa0.w = cvtpk_s(sa[6], sa[7]);
    pa1.x = cvtpk_s(sa[8], sa[9]); pa1.y = cvtpk_s(sa[10], sa[11]); pa1.z = cvtpk_s(sa[12], sa[13]); pa1.w = cvtpk_s(sa[14], sa[15]);
    pb0.x = cvtpk_s(sb[0], sb[1]); pb0.y = cvtpk_s(sb[2], sb[3]); pb0.z = cvtpk_s(sb[4], sb[5]); pb0.w = cvtpk_s(sb[6], sb[7]);
    pb1.x = cvtpk_s(sb[8], sb[9]); pb1.y = cvtpk_s(sb[10], sb[11]); pb1.z = cvtpk_s(sb[12], sb[13]); pb1.w = cvtpk_s(sb[14], sb[15]);
    const bf16x8 fa0 = __builtin_bit_cast(bf16x8, pa0), fa1 = __builtin_bit_cast(bf16x8, pa1), fb0 = __builtin_bit_cast(bf16x8, pb0), fb1 = __builtin_bit_cast(bf16x8, pb1);
    __builtin_amdgcn_sched_barrier(0); mid(); __builtin_amdgcn_sched_barrier(0);
    const int to = (4 * hi + qq) * 64 + (16 * (grp & 1) + 4 * pp) * 2;
#define VFRAG2(base, ks, d0) ({ const s16x4 lo_ = vtr((base) + to + ((2 * (ks)) * 2 + (d0)) * 512), hi_ = vtr((base) + to + ((2 * (ks) + 1) * 2 + (d0)) * 512); (bf16x8){lo_[0], lo_[1], lo_[2], lo_[3], hi_[0], hi_[1], hi_[2], hi_[3]}; })
    a.o0 = __builtin_amdgcn_mfma_f32_32x32x16_bf16(VFRAG2(vla, 0, 0), fa0, a.o0, 0, 0, 0);
    b.o0 = __builtin_amdgcn_mfma_f32_32x32x16_bf16(VFRAG2(vlb, 0, 0), fb0, b.o0, 0, 0, 0);
    a.o1 = __builtin_amdgcn_mfma_f32_32x32x16_bf16(VFRAG2(vla, 0, 1), fa0, a.o1, 0, 0, 0);
    b.o1 = __builtin_amdgcn_mfma_f32_32x32x16_bf16(VFRAG2(vlb, 0, 1), fb0, b.o1, 0, 0, 0);
    a.o0 = __builtin_amdgcn_mfma_f32_32x32x16_bf16(VFRAG2(vla, 1, 0), fa1, a.o0, 0, 0, 0);
    b.o0 = __builtin_amdgcn_mfma_f32_32x32x16_bf16(VFRAG2(vlb, 1, 0), fb1, b.o0, 0, 0, 0);
    a.o1 = __builtin_amdgcn_mfma_f32_32x32x16_bf16(VFRAG2(vla, 1, 1), fa1, a.o1, 0, 0, 0);
    b.o1 = __builtin_amdgcn_mfma_f32_32x32x16_bf16(VFRAG2(vlb, 1, 1), fb1, b.o1, 0, 0, 0);
#undef VFRAG2
}
template <int MODE, class PreF, class MidF>
__device__ __forceinline__ void attn_compute2_kv(AttnSt& a, AttnSt& b, const bf16x8 (&qa)[4], const bf16x8 (&qb)[4], TileRegs& RA, TileRegs& RB, LAS unsigned char* wl, int lane, int dd0, int kmina, int kminb, PreF pre, MidF mid) {
    const int r32 = lane & 31, hi = lane >> 5, grp = lane >> 4, qq = (lane & 15) >> 2, pp = lane & 3;
    LAS unsigned char* vla = wl; LAS unsigned char* vlb = wl + 4096; LAS unsigned char* kla = wl + 8192; LAS unsigned char* klb = wl + 12288;
#pragma unroll
    for (int it = 0; it < 4; ++it) { const int row = it * 8 + (lane >> 3); const int ko = row * 128 + (((lane & 7) ^ (row & 7)) << 4); *(LAS v4u*)(kla + ko) = RA.kk[it]; *(LAS v4u*)(klb + ko) = RB.kk[it]; }
    pre();
#pragma unroll
    for (int it = 0; it < 4; ++it) { const int vo = (it * 2 + ((lane & 7) >> 2)) * 512 + (lane >> 3) * 64 + (lane & 3) * 16; *(LAS v4u*)(vla + vo) = RA.vv[it]; *(LAS v4u*)(vlb + vo) = RB.vv[it]; }
    f32x16 sa = f32x16{}, sb = f32x16{};
#pragma unroll
    for (int d0 = 0; d0 < 4; ++d0) {
        const int ko = r32 * 128 + (((2 * d0 + hi) ^ (r32 & 7)) << 4);
        const v4u kwa = *(const LAS v4u*)(kla + ko), kwb = *(const LAS v4u*)(klb + ko);
        sa = __builtin_amdgcn_mfma_f32_32x32x16_bf16(__builtin_bit_cast(bf16x8, kwa), qa[d0], sa, 0, 0, 0);
        sb = __builtin_amdgcn_mfma_f32_32x32x16_bf16(__builtin_bit_cast(bf16x8, kwb), qb[d0], sb, 0, 0, 0);
    }
    if (MODE == 3) {
        const int ddh = dd0 - 4 * hi;
        if (kmina <= 0 && kminb <= 0) {
#pragma unroll
            for (int r = 0; r < 16; ++r) { const int c = (r & 3) + 8 * (r >> 2); const bool band = (unsigned)(ddh - c) <= 128u; sa[r] = band ? sa[r] : -INFINITY; sb[r] = band ? sb[r] : -INFINITY; }
        } else {
            const int kma = kmina - 4 * hi, kmb = kminb - 4 * hi;
#pragma unroll
            for (int r = 0; r < 16; ++r) { const int c = (r & 3) + 8 * (r >> 2); const bool band = (unsigned)(ddh - c) <= 128u; if (!band || c < kma) sa[r] = -INFINITY; if (!band || c < kmb) sb[r] = -INFINITY; }
        }
    }
    float mta = sa[0], mtb = sb[0];
#pragma unroll
    for (int r = 1; r < 16; ++r) { mta = fmaxf(mta, sa[r]); mtb = fmaxf(mtb, sb[r]); }
    mta = fmaxf(mta, __shfl_xor(mta, 32)); mtb = fmaxf(mtb, __shfl_xor(mtb, 32));
    const float mna = fmaxf(a.m, mta), mnb = fmaxf(b.m, mtb);
    const float fa = __builtin_amdgcn_exp2f(a.m - mna), fb = __builtin_amdgcn_exp2f(b.m - mnb);
    a.l *= fa; a.m = mna; b.l *= fb; b.m = mnb;
#pragma unroll
    for (int r = 0; r < 16; ++r) { a.o0[r] *= fa; a.o1[r] *= fa; b.o0[r] *= fb; b.o1[r] *= fb; }
    const f32x2_t ma2 = {mna, mna}, mb2 = {mnb, mnb}; f32x2_t acca = {0.f, 0.f}, accb = {0.f, 0.f};
#pragma unroll
    for (int r = 0; r < 16; r += 2) {
        f32x2_t va = (f32x2_t){sa[r], sa[r + 1]} - ma2, vb = (f32x2_t){sb[r], sb[r + 1]} - mb2;
        va.x = __builtin_amdgcn_exp2f(va.x); va.y = __builtin_amdgcn_exp2f(va.y); vb.x = __builtin_amdgcn_exp2f(vb.x); vb.y = __builtin_amdgcn_exp2f(vb.y);
        acca += va; accb += vb;
        sa[r] = va.x; sa[r + 1] = va.y; sb[r] = vb.x; sb[r + 1] = vb.y;
    }
    a.l += acca.x + acca.y; b.l += accb.x + accb.y;
    v4u pa0, pa1, pb0, pb1;
    pa0.x = cvtpk_s(sa[0], sa[1]); pa0.y = cvtpk_s(sa[2], sa[3]); pa0.z = cvtpk_s(sa[4], sa[5]); pa0.w = cvtpk_s(sa[6], sa[7]);
    pa1.x = cvtpk_s(sa[8], sa[9]); pa1.y = cvtpk_s(sa[10], sa[11]); pa1.z = cvtpk_s(sa[12], sa[13]); pa1.w = cvtpk_s(sa[14], sa[15]);
    pb0.x = cvtpk_s(sb[0], sb[1]); pb0.y = cvtpk_s(sb[2], sb[3]); pb0.z = cvtpk_s(sb[4], sb[5]); pb0.w = cvtpk_s(sb[6], sb[7]);
    pb1.x = cvtpk_s(sb[8], sb[9]); pb1.y = cvtpk_s(sb[10], sb[11]); pb1.z = cvtpk_s(sb[12], sb[13]); pb1.w = cvtpk_s(sb[14], sb[15]);
    const bf16x8 fa0 = __builtin_bit_cast(bf16x8, pa0), fa1 = __builtin_bit_cast(bf16x8, pa1), fb0 = __builtin_bit_cast(bf16x8, pb0), fb1 = __builtin_bit_cast(bf16x8, pb1);
    __builtin_amdgcn_sched_barrier(0); mid(); __builtin_amdgcn_sched_barrier(0);
    const int to = (4 * hi + qq) * 64 + (16 * (grp & 1) + 4 * pp) * 2;
#define VFRAG2(base, ks, d0) ({ const s16x4 lo_ = vtr((base) + to + ((2 * (ks)) * 2 + (d0)) * 512), hi_ = vtr((base) + to + ((2 * (ks) + 1) * 2 + (d0)) * 512); (bf16x8){lo_[0], lo_[1], lo_[2], lo_[3], hi_[0], hi_[1], hi_[2], hi_[3]}; })
    a.o0 = __builtin_amdgcn_mfma_f32_32x32x16_bf16(VFRAG2(vla, 0, 0), fa0, a.o0, 0, 0, 0);
    b.o0 = __builtin_amdgcn_mfma_f32_32x32x16_bf16(VFRAG2(vlb, 0, 0), fb0, b.o0, 0, 0, 0);
    a.o1 = __builtin_amdgcn_mfma_f32_32x32x16_bf16(VFRAG2(vla, 0, 1), fa0, a.o1, 0, 0, 0);
    b.o1 = __builtin_amdgcn_mfma_f32_32x32x16_bf16(VFRAG2(vlb, 0, 1), fb0, b.o1, 0, 0, 0);
    a.o0 = __builtin_amdgcn_mfma_f32_32x32x16_bf16(VFRAG2(vla, 1, 0), fa1, a.o0, 0, 0, 0);
    b.o0 = __builtin_amdgcn_mfma_f32_32x32x16_bf16(VFRAG2(vlb, 1, 0), fb1, b.o0, 0, 0, 0);
    a.o1 = __builtin_amdgcn_mfma_f32_32x32x16_bf16(VFRAG2(vla, 1, 1), fa1, a.o1, 0, 0, 0);
    b.o1 = __builtin_amdgcn_mfma_f32_32x32x16_bf16(VFRAG2(vlb, 1, 1), fb1, b.o1, 0, 0, 0);
#undef VFRAG2
}
template <int MODE>
__device__ __forceinline__ void attn_compute2(AttnSt& a, AttnSt& b, const bf16x8 (&qa)[4], const bf16x8 (&qb)[4], const TileRegs& RA, const TileRegs& RB, LAS unsigned char* wl, int lane, int dd0, int kmina, int kminb) {
    attn_stage2(RA, RB, wl, lane); attn_compute2_lds<MODE>(a, b, qa, qb, wl, lane, dd0, kmina, kminb, [] {});
}

__device__ __forceinline__ void phase_dilated_2(const Args& A, LAS unsigned char* lds, int gwv, int NGW, int wave, int lane) {
    const bf16* Z = (const bf16*)(A.ws + WS_Z); bf16* Y = (bf16*)(A.ws + WS_Y);
    LAS unsigned char* wl = lds + wave * 16384;
    const int r32 = lane & 31, hi = lane >> 5;
    for (int U = gwv; U < 16384; U += NGW) {
        const int rd = U >> 10, g2 = U & 1023, X = g2 >> 7, lp = g2 & 127;
        const int bh = 32 * X + 2 * rd + (lp >> 6), pi = lp & 63, c = pi >> 3, r16a = 2 * (pi & 7);
        const int b = bh >> 4, hh = bh & 15;
        const size_t rowbase = (size_t)b * SEQ;
        const int tqa = 512 * c + r16a + 16 * r32;
        const bf16* zqa = Z + (rowbase + tqa) * ODD_IN; const bf16* zqb = zqa + ODD_IN;
        bf16x8 qa[4], qb[4];
#pragma unroll
        for (int d0 = 0; d0 < 4; ++d0) { qa[d0] = *(const bf16x8*)(zqa + hh * 64 + 16 * d0 + 8 * hi); qb[d0] = *(const bf16x8*)(zqb + hh * 64 + 16 * d0 + 8 * hi); }
        AttnSt sa, sb; sa.o0 = f32x16{}; sa.o1 = f32x16{}; sa.m = -1e30f; sa.l = 0.f; sb.o0 = f32x16{}; sb.o1 = f32x16{}; sb.m = -1e30f; sb.l = 0.f;
        const bf16* Vh = Z + rowbase * ODD_IN + 2048 + hh * 64 + 8 * (lane & 7);
#pragma unroll 1
        for (int cfg = 0; cfg < 3; ++cfg) {
            const int dil = (cfg == 0) ? 16 : (cfg == 1) ? 4 : 1, sstep = 16 / dil, ntile = (cfg == 0) ? 5 : (cfg == 1) ? 8 : 20;
            const int rdla = r16a & (dil - 1), rdlb = (r16a + 1) & (dil - 1);
            const int mba = (512 * c + r16a - rdla) / dil - 128, mbb = (512 * c + r16a + 1 - rdlb) / dil - 128;
            const int tau0 = mbb < 0 ? (-mbb) / 32 : 0;
            const size_t vst = (size_t)dil * ODD_IN;
#pragma unroll 1
            for (int tau = tau0; tau < ntile; ++tau) {
                TileRegs RA, RB;
                { const int mv = mba + 32 * tau + (lane >> 3); const int m0_ = mv < 0 ? 0 : mv, m1_ = mv + 8 < 0 ? 0 : mv + 8, m2_ = mv + 16 < 0 ? 0 : mv + 16, m3_ = mv + 24 < 0 ? 0 : mv + 24;
                  const bf16* vb = Vh + (size_t)rdla * ODD_IN; attn_load(RA, 1024, vb + m0_ * vst, vb + m1_ * vst, vb + m2_ * vst, vb + m3_ * vst); }
                { const int mv = mbb + 32 * tau + (lane >> 3); const int m0_ = mv < 0 ? 0 : mv, m1_ = mv + 8 < 0 ? 0 : mv + 8, m2_ = mv + 16 < 0 ? 0 : mv + 16, m3_ = mv + 24 < 0 ? 0 : mv + 24;
                  const bf16* vb = Vh + (size_t)rdlb * ODD_IN; attn_load(RB, 1024, vb + m0_ * vst, vb + m1_ * vst, vb + m2_ * vst, vb + m3_ * vst); }
                attn_compute2<3>(sa, sb, qa, qb, RA, RB, wl, lane, 128 + sstep * r32 - 32 * tau, -(mba + 32 * tau), -(mbb + 32 * tau));
            }
        }
        attn_store(sa, zqa + 3072 + hh * 64, Y + (rowbase + tqa) * D + hh * 64, lane);
        attn_store(sb, zqb + 3072 + hh * 64, Y + (rowbase + tqa + 1) * D + hh * 64, lane);
    }
}


__device__ __forceinline__ void attn_state_store(const AttnSt& st, bf16* orow, float* lsep, int lane) {
    const int hi = lane >> 5;
    const float lt = st.l + __shfl_xor(st.l, 32), inv = 1.0f / lt;
#pragma unroll
    for (int d0 = 0; d0 < 2; ++d0)
#pragma unroll
        for (int rq = 0; rq < 4; ++rq) {
            const int d = 32 * d0 + 8 * rq + 4 * hi; const f32x16& o = d0 ? st.o1 : st.o0;
            v2u w; w.x = pk2(o[4 * rq + 0] * inv, o[4 * rq + 1] * inv); w.y = pk2(o[4 * rq + 2] * inv, o[4 * rq + 3] * inv);
            *(v2u*)(orow + d) = w;
        }
    if (hi == 0) *lsep = st.m + __builtin_amdgcn_logf(lt);
}
__device__ __forceinline__ void attn_state_load(AttnSt& st, const bf16* orow, const float* lsep, int lane) {
    const int hi = lane >> 5;
#pragma unroll
    for (int d0 = 0; d0 < 2; ++d0)
#pragma unroll
        for (int rq = 0; rq < 4; ++rq) {
            const int d = 32 * d0 + 8 * rq + 4 * hi; const v2u w = *(const v2u*)(orow + d);
            f32x16& o = d0 ? st.o1 : st.o0;
            o[4 * rq + 0] = bf_lo(w.x); o[4 * rq + 1] = bf_hi(w.x); o[4 * rq + 2] = bf_lo(w.y); o[4 * rq + 3] = bf_hi(w.y);
        }
    st.m = *lsep; st.l = hi ? 0.f : 1.f;
}

__device__ __forceinline__ void phase_dilated_3(const Args& A, LAS unsigned char* lds, int G, int vcu, int wave, int lane) {
    const bf16* Z = (const bf16*)(A.ws + WS_Z); bf16* Y = (bf16*)(A.ws + WS_Y);
    bf16* EX = (bf16*)A.out; float* LSE = A.out + (size_t)32 * 1024 * 1024;
    LAS unsigned char* wl = lds + wave * 16384;
    const int r32 = lane & 31, hi = lane >> 5;
    bf16x8 nqa[4], nqb[4];
#define D3_QLOAD(U_) do { const int c_ = (U_) >> 8, bh_ = (U_) & 255; const bf16* zq_ = Z + ((size_t)(bh_ >> 4) * SEQ + 512 * c_ + 2 * wave + 16 * r32) * ODD_IN + (bh_ & 15) * 64 + 8 * hi; \
        _Pragma("unroll") for (int d0 = 0; d0 < 4; ++d0) { nqa[d0] = *(const bf16x8*)(zq_ + 16 * d0); nqb[d0] = *(const bf16x8*)(zq_ + ODD_IN + 16 * d0); } } while (0)
    if (vcu < 2048) D3_QLOAD(vcu);
    for (int U = vcu; U < 2048; U += G) {
        const int c = U >> 8, bh = U & 255, b = bh >> 4, hh = bh & 15, T0 = 512 * c;
        const size_t rowbase = (size_t)b * SEQ;
        const bf16* Vh = Z + rowbase * ODD_IN + 2048 + hh * 64 + 8 * (lane & 7);
        {
            const int r16a = 2 * wave, pa = r16a + 16 * r32;
            bf16x8 qa[4], qb[4];
#pragma unroll
            for (int d0 = 0; d0 < 4; ++d0) { qa[d0] = nqa[d0]; qb[d0] = nqb[d0]; }
            AttnSt sa, sb; sa.o0 = f32x16{}; sa.o1 = f32x16{}; sa.m = -1e30f; sa.l = 0.f; sb.o0 = f32x16{}; sb.o1 = f32x16{}; sb.m = -1e30f; sb.l = 0.f;
#define P1_PARAMS(ti) const int dil_ = (ti) < 5 ? 16 : 4, tau_ = (ti) < 5 ? (ti) : (ti) - 5; const int rdla_ = r16a & (dil_ - 1), rdlb_ = (r16a + 1) & (dil_ - 1); const int mba_ = (T0 + r16a - rdla_) / dil_ - 128 + 32 * tau_
#define P1_ADDR(ti) P1_PARAMS(ti); const size_t vst_ = (size_t)dil_ * ODD_IN; const int mv = mba_ + (lane >> 3); const int m0_ = mv < 0 ? 0 : mv, m1_ = mv + 8 < 0 ? 0 : mv + 8, m2_ = mv + 16 < 0 ? 0 : mv + 16, m3_ = mv + 24 < 0 ? 0 : mv + 24; \
                const bf16* va_ = Vh + (size_t)rdla_ * ODD_IN; const bf16* vb_ = Vh + (size_t)rdlb_ * ODD_IN
#define P1_LOADK(ti) do { P1_ADDR(ti); attn_load_k(RA, 1024, va_ + m0_ * vst_, va_ + m1_ * vst_, va_ + m2_ * vst_, va_ + m3_ * vst_); attn_load_k(RB, 1024, vb_ + m0_ * vst_, vb_ + m1_ * vst_, vb_ + m2_ * vst_, vb_ + m3_ * vst_); } while (0)
#define P1_LOADV(ti) do { P1_ADDR(ti); attn_load_v(RA, va_ + m0_ * vst_, va_ + m1_ * vst_, va_ + m2_ * vst_, va_ + m3_ * vst_); attn_load_v(RB, vb_ + m0_ * vst_, vb_ + m1_ * vst_, vb_ + m2_ * vst_, vb_ + m3_ * vst_); } while (0)
#pragma unroll 1
            for (int ti = 0; ti < 13; ++ti) {
                { P1_PARAMS(ti); if (mba_ + 31 < 0) continue; }
                TileRegs RA, RB;
                P1_LOADK(ti);
                P1_PARAMS(ti);
                attn_compute2_kv<3>(sa, sb, qa, qb, RA, RB, wl, lane, 128 + (16 / dil_) * r32 - 32 * tau_, -mba_, -mba_, [&] { P1_LOADV(ti); }, [] {});
            }
#undef P1_ADDR
#undef P1_LOADK
#undef P1_LOADV
#undef P1_PARAMS
            attn_state_store(sa, EX + ((size_t)U * 512 + pa) * 64, LSE + (size_t)U * 512 + pa, lane);
            attn_state_store(sb, EX + ((size_t)U * 512 + pa + 1) * 64, LSE + (size_t)U * 512 + pa + 1, lane);
        }
        {
            const int pa = 64 * wave + r32, pb = pa + 32;
            bf16x8 qa[4], qb[4];
            { const bf16* zqa = Z + (rowbase + T0 + pa) * ODD_IN + hh * 64 + 8 * hi;
#pragma unroll
              for (int d0 = 0; d0 < 4; ++d0) { qa[d0] = *(const bf16x8*)(zqa + 16 * d0); qb[d0] = *(const bf16x8*)(zqa + (size_t)32 * ODD_IN + 16 * d0); } }
            asm volatile("s_waitcnt vmcnt(0)" ::: "memory");
            __syncthreads();
            v2u gga[2][4], ggb[2][4];
            { const bf16* zg = Z + (rowbase + T0 + pa) * ODD_IN + 3072 + hh * 64; attn_gate_load(gga, zg, lane); attn_gate_load(ggb, zg + (size_t)32 * ODD_IN, lane); }
            AttnSt sa, sb;
            attn_state_load(sa, EX + ((size_t)U * 512 + pa) * 64, LSE + (size_t)U * 512 + pa, lane);
            attn_state_load(sb, EX + ((size_t)U * 512 + pb) * 64, LSE + (size_t)U * 512 + pb, lane);
            const int mba = T0 + 64 * wave - 128, mbb = mba + 32;
            const size_t vst = (size_t)ODD_IN;
#define P2_ADDR(tau) const int mva = mba + 32 * (tau) + (lane >> 3), mvb = mva + 32; \
                const int a0_ = mva < 0 ? 0 : mva, a1_ = mva + 8 < 0 ? 0 : mva + 8, a2_ = mva + 16 < 0 ? 0 : mva + 16, a3_ = mva + 24 < 0 ? 0 : mva + 24; \
                const int b0_ = mvb < 0 ? 0 : mvb, b1_ = mvb + 8 < 0 ? 0 : mvb + 8, b2_ = mvb + 16 < 0 ? 0 : mvb + 16, b3_ = mvb + 24 < 0 ? 0 : mvb + 24
#define P2_LOADK(tau) do { P2_ADDR(tau); attn_load_k(RA, 1024, Vh + a0_ * vst, Vh + a1_ * vst, Vh + a2_ * vst, Vh + a3_ * vst); attn_load_k(RB, 1024, Vh + b0_ * vst, Vh + b1_ * vst, Vh + b2_ * vst, Vh + b3_ * vst); } while (0)
#define P2_LOADV(tau) do { P2_ADDR(tau); attn_load_v(RA, Vh + a0_ * vst, Vh + a1_ * vst, Vh + a2_ * vst, Vh + a3_ * vst); attn_load_v(RB, Vh + b0_ * vst, Vh + b1_ * vst, Vh + b2_ * vst, Vh + b3_ * vst); } while (0)
#pragma unroll 1
            for (int tau = 0; tau < 5; ++tau) {
                if (mbb + 32 * tau + 31 < 0) continue;
                TileRegs RA, RB;
                P2_LOADK(tau);
                attn_compute2_kv<3>(sa, sb, qa, qb, RA, RB, wl, lane, 128 + r32 - 32 * tau, -(mba + 32 * tau), -(mbb + 32 * tau), [&] { P2_LOADV(tau); }, [] {});
            }
#undef P2_ADDR
#undef P2_LOADK
#undef P2_LOADV
            { int pa2 = pa; asm volatile("" : "+v"(pa2));
              bf16* yr = Y + (rowbase + T0 + pa2) * D + hh * 64;
              { const int Un = U + G < 2048 ? U + G : U; D3_QLOAD(Un); }
              attn_store_g(sa, gga, yr, lane); attn_store_g(sb, ggb, yr + (size_t)32 * D, lane); }
        }
    }
}
#undef D3_QLOAD

__device__ __forceinline__ void phase_dilated(const Args& A, LAS unsigned char* lds, int gwv, int NGW, int wave, int lane) {
    const bf16* Z = (const bf16*)(A.ws + WS_Z); bf16* Y = (bf16*)(A.ws + WS_Y);
    LAS unsigned char* vl = lds + wave * 4096;
    const int r32 = lane & 31, hi = lane >> 5;
    for (int U = gwv; U < 32768; U += NGW) {
        const int rd = U >> 11, g2 = U & 2047, X = g2 >> 8, lwv = g2 & 255;
        const int bh = 32 * X + 2 * rd + (lwv >> 7), gi = lwv & 127, c = gi >> 4, r16 = gi & 15;
        const int b = bh >> 4, hh = bh & 15;
        const size_t rowbase = (size_t)b * SEQ;
        const int tq = 512 * c + r16 + 16 * r32;
        const bf16* zq = Z + (rowbase + tq) * ODD_IN;
        bf16x8 qf[4];
#pragma unroll
        for (int d0 = 0; d0 < 4; ++d0) qf[d0] = *(const bf16x8*)(zq + hh * 64 + 16 * d0 + 8 * hi);
        AttnSt st; st.o0 = f32x16{}; st.o1 = f32x16{}; st.m = -1e30f; st.l = 0.f;
        const bf16* Kh = Z + rowbase * ODD_IN + 1024 + hh * 64; const bf16* Vh = Z + rowbase * ODD_IN + 2048 + hh * 64;
#pragma unroll 1
        for (int cfg = 0; cfg < 3; ++cfg) {
            const int dil = (cfg == 0) ? 16 : (cfg == 1) ? 4 : 1, sstep = 16 / dil, ntile = (cfg == 0) ? 5 : (cfg == 1) ? 8 : 20;
            const int rdl = r16 & (dil - 1), mbase = (512 * c + r16 - rdl) / dil - 128;
            for (int tau = 0; tau < ntile; ++tau) {
                const int m0 = mbase + 32 * tau;
                if (m0 + 31 < 0) continue;
                const int mk = m0 + r32, mkc = mk < 0 ? 0 : mk;
                const bf16* kp = Kh + (size_t)(rdl + dil * mkc) * ODD_IN + 8 * hi;
                const int mv = m0 + (lane >> 3);
                const int mv0 = mv < 0 ? 0 : mv, mv1 = mv + 8 < 0 ? 0 : mv + 8, mv2 = mv + 16 < 0 ? 0 : mv + 16, mv3 = mv + 24 < 0 ? 0 : mv + 24;
                const bf16* vb = Vh + (size_t)rdl * ODD_IN + 8 * (lane & 7); const size_t vst = (size_t)dil * ODD_IN;
                const int dd0 = 128 + sstep * r32 - 32 * tau;
                attn_tile(st, qf, kp, vb + mv0 * vst, vb + mv1 * vst, vb + mv2 * vst, vb + mv3 * vst, vl, lane, true,
                          [&](int kk) { const int dd = dd0 - kk; return dd >= 0 && dd <= 128 && (m0 + kk) >= 0; });
            }
        }
        attn_store(st, zq + 3072 + hh * 64, Y + (rowbase + tq) * D + hh * 64, lane);
    }
}
#define XB_TMO      128
#define XB_XCNT(j)  (256  + 64 * (j))
#define XB_XSUB(j)  (1280 + 64 * (j))
#define XB_XGEN(j)  (2304 + 64 * (j))
#define XB_TOP      3328
#define XB_TOPGEN   3392
#define XCD_BAR_WORDS 3456
#define XB_SPIN_CAP (1u << 18)

__device__ __forceinline__ unsigned xb_ld(unsigned* p)              { return __hip_atomic_load(p, __ATOMIC_RELAXED, __HIP_MEMORY_SCOPE_AGENT); }
__device__ __forceinline__ unsigned xb_add(unsigned* p, unsigned v) { return __hip_atomic_fetch_add(p, v, __ATOMIC_RELAXED, __HIP_MEMORY_SCOPE_AGENT); }
__device__ __forceinline__ unsigned xb_xcc_id() { return (unsigned)__builtin_amdgcn_s_getreg((3 << 11) | 20) & 0xFu; }
#define XB_SPIN(cond, bar) do { unsigned _sp = 0; while (cond) { __builtin_amdgcn_s_sleep(1); \
    if ((++_sp & 255u) == 0u) { if (xb_ld(&(bar)[XB_TMO])) break; if (_sp > XB_SPIN_CAP) { atomicAdd(&(bar)[XB_TMO], 1u); break; } } } } while (0)

struct XcdBarrier {
    unsigned* bar; unsigned x;
    volatile LAS unsigned* st;
};

__device__ __forceinline__ XcdBarrier xcd_barrier_post(unsigned* bar, volatile LAS unsigned* st) {
    XcdBarrier b; b.bar = bar; b.x = xb_xcc_id(); b.st = st;
    if (threadIdx.x == 0) (void)xb_add(&bar[XB_XCNT(b.x)], 1u);
    return b;
}
__device__ __forceinline__ void xcd_barrier_complete(unsigned* bar, unsigned x, unsigned& nloc, unsigned& nx) {
    const unsigned G = gridDim.x * gridDim.y * gridDim.z;
    unsigned sum, cnt, mine, sp = 0u;
    for (;;) {
        sum = 0u; cnt = 0u; mine = 0u;
#pragma unroll
        for (unsigned j = 0; j < 16; ++j) { const unsigned c = xb_ld(&bar[XB_XCNT(j)]); sum += c; cnt += (c > 0u) ? 1u : 0u; mine = (j == x) ? c : mine; }
        if (sum == G) break;
        __builtin_amdgcn_s_sleep(1);
        if ((++sp & 255u) == 0u) { if (xb_ld(&bar[XB_TMO])) break; if (sp > XB_SPIN_CAP) { atomicAdd(&bar[XB_TMO], 1u); break; } }
    }
    nloc = mine > 0u ? mine : 1u; nx = cnt > 0u ? cnt : 1u;
}

__device__ __forceinline__ void xcd_barrier(const XcdBarrier& b) {
    asm volatile("s_waitcnt vmcnt(0)" ::: "memory");
    __syncthreads();
    if (threadIdx.x == 0) {
        unsigned* bar = b.bar;
        __builtin_amdgcn_s_waitcnt(0);
        unsigned nloc = b.st[0], nx = b.st[1];
        if (nloc == 0u) { xcd_barrier_complete(bar, b.x, nloc, nx); b.st[0] = nloc; b.st[1] = nx; }
        const unsigned old = xb_add(&bar[XB_XSUB(b.x)], 1u);
        const unsigned gen = old / nloc;
        if (old + 1u == (gen + 1u) * nloc) {
            __builtin_amdgcn_fence(__ATOMIC_RELEASE, "agent");
            asm volatile("s_waitcnt vmcnt(0)" ::: "memory");
            const unsigned og = xb_add(&bar[XB_TOP], 1u);
            const unsigned tg = og / nx;
            if (og + 1u == (tg + 1u) * nx) xb_add(&bar[XB_TOPGEN], 1u);
            else XB_SPIN(xb_ld(&bar[XB_TOPGEN]) == tg, bar);
            __builtin_amdgcn_fence(__ATOMIC_ACQUIRE, "agent");
            xb_add(&bar[XB_XGEN(b.x)], 1u);
            asm volatile("s_waitcnt vmcnt(0)" ::: "memory");
        } else {
            XB_SPIN(xb_ld(&bar[XB_XGEN(b.x)]) == gen, bar);
            __builtin_amdgcn_fence(__ATOMIC_ACQUIRE, "agent");
            asm volatile("s_waitcnt vmcnt(0)" ::: "memory");
        }
    }
    __syncthreads();
}
__device__ __forceinline__ void phase_final(const Args& A, int gwv, int NGW, int lane) {
    const float* ssqp = (const float*)(A.ws + WS_SSQ);
    f32x4 fg[4];
#pragma unroll
    for (int j = 0; j < 4; ++j) fg[j] = *((const f32x4*)A.final_g + lane + 64 * j);
    for (int m = gwv; m < M; m += 2 * NGW) {
        const int m2 = m + NGW;
        const f32x4* sp = (const f32x4*)(ssqp + (size_t)m * 16); const f32x4* sp2 = (const f32x4*)(ssqp + (size_t)m2 * 16);
        f32x4* hr = (f32x4*)(A.out + (size_t)m * D) + lane; f32x4* hr2 = (f32x4*)(A.out + (size_t)m2 * D) + lane;
        const f32x4 a = sp[0], b = sp[1], c = sp[2], d = sp[3], a2 = sp2[0], b2 = sp2[1], c2 = sp2[2], d2 = sp2[3];
        f32x4 v[4], w[4];
#pragma unroll
        for (int j = 0; j < 4; ++j) { v[j] = hr[64 * j]; w[j] = hr2[64 * j]; }
        const float ss = (((a[0] + a[1]) + (a[2] + a[3])) + ((b[0] + b[1]) + (b[2] + b[3]))) + (((c[0] + c[1]) + (c[2] + c[3])) + ((d[0] + d[1]) + (d[2] + d[3])));
        const float ss2 = (((a2[0] + a2[1]) + (a2[2] + a2[3])) + ((b2[0] + b2[1]) + (b2[2] + b2[3]))) + (((c2[0] + c2[1]) + (c2[2] + c2[3])) + ((d2[0] + d2[1]) + (d2[2] + d2[3])));
        const float rstd = __builtin_amdgcn_rsqf(ss * (1.0f / 1024.0f) + NORM_EPS), rstd2 = __builtin_amdgcn_rsqf(ss2 * (1.0f / 1024.0f) + NORM_EPS);
#pragma unroll
        for (int j = 0; j < 4; ++j) { hr[64 * j] = v[j] * rstd * fg[j]; hr2[64 * j] = w[j] * rstd2 * fg[j]; }
    }
}

#define CAS __attribute__((address_space(4)))
#define FRESH_IDS() int lane = lane_k, wave = wave_k, vcu = vcu_k; asm volatile("" : "+v"(lane), "+s"(wave), "+s"(vcu)); const int gwv = vcu * NWAVES + wave; (void)gwv;
#define GRID_SYNC() do { asm volatile("s_waitcnt vmcnt(0) lgkmcnt(0)" ::: "memory"); __syncthreads(); \
    if (wave_k == 0) { __builtin_amdgcn_fence(__ATOMIC_RELEASE, "agent"); asm volatile("s_waitcnt vmcnt(0)" ::: "memory"); } \
    grid.sync(); \
    if (wave_k == 0) { __builtin_amdgcn_fence(__ATOMIC_ACQUIRE, "agent"); asm volatile("s_waitcnt vmcnt(0)" ::: "memory"); } \
    __syncthreads(); } while (0)
#ifdef NO_XBAR
#define XBAR_SYNC() GRID_SYNC()
#else
#define XBAR_SYNC() xcd_barrier(xbar)
#endif
#define FRESH_ARGS() ({ const CAS Args* ap_ = (const CAS Args*)__builtin_amdgcn_kernarg_segment_ptr(); asm volatile("" : "+s"(ap_)); Args a_; a_ = *(const Args*)ap_; a_; })
__global__ void __launch_bounds__(NTHREADS, 2) mega_fwd(Args Akern) {
    extern __shared__ __attribute__((aligned(16))) unsigned char lds_raw[];
    cg::grid_group grid = cg::this_grid();
    LAS unsigned char* lds = (LAS unsigned char*)lds_raw;
    const int tid = threadIdx.x, lane_k = tid & 63, wave_k = __builtin_amdgcn_readfirstlane(tid >> 6);
    const int G = gridDim.x, bx = blockIdx.x;
    const int vcu_k = (G % 8 == 0) ? (bx % 8) * (G / 8) + bx / 8 : bx;
    const int NGW = G * NWAVES;
    if (tid < 2) ((volatile LAS unsigned*)(lds + 131072))[tid] = 0u;
    __syncthreads();
    const XcdBarrier xbar = xcd_barrier_post((unsigned*)(Akern.ws + WS_CTL), (volatile LAS unsigned*)(lds + 131072));

#ifndef NO_PRO
    { FRESH_IDS(); const Args A = FRESH_ARGS(); phase_prologue(A, lds, gwv, NGW, wave, lane); }
#endif
    GRID_SYNC();
#pragma unroll 1
    for (int layer = 0; layer < 4; ++layer) {
        const int li = layer >> 1; const int even = !(layer & 1);
        {
            const Args A = FRESH_ARGS(); bf16* hb = (bf16*)(A.ws + WS_HB); bf16* Zb = (bf16*)(A.ws + WS_Z); float* ssqp = (float*)(A.ws + WS_SSQ); float* kmp = (float*)(A.ws + WS_KMP);
            const int N = even ? EVEN_IN : ODD_IN;
            const bf16* Wt = even ? (const bf16*)(A.ws + WS_WE_IN) + (size_t)li * EVEN_IN * D : (const bf16*)(A.ws + WS_WO_IN) + (size_t)li * ODD_IN * D;
            pg8::Gemm g{hb, Wt, M, N, D}; pg8::StaticOrder S; S.init(M, N, G, bx);
            LAS float* rtab = (LAS float*)(lds + 131072 + 1024);
            {
                int tidl = tid; asm volatile("" : "+v"(tidl));
                const int rl = tidl & 255, half = tidl >> 8;
#pragma unroll 1
                for (int kb = 0; kb < 8; kb += 4) {
                    f32x4 pv[4][4]; int have[4];
#pragma unroll
                    for (int k = 0; k < 4; ++k) {
                        pg8::Unit uu; have[k] = S.next(2 * (kb + k) + half, uu) ? 1 : 0;
                        const float* sp = ssqp + ((size_t)(have[k] ? uu.pm : 0) * 256 + rl) * 16;
#pragma unroll
                        for (int q4 = 0; q4 < 4; ++q4) pv[k][q4] = *(const f32x4*)(sp + 4 * q4);
                    }
#pragma unroll
                    for (int k = 0; k < 4; ++k) {
                        const f32x4 a = pv[k][0], b = pv[k][1], c = pv[k][2], d = pv[k][3];
                        const float ss = (((a[0] + a[1]) + (a[2] + a[3])) + ((b[0] + b[1]) + (b[2] + b[3]))) + (((c[0] + c[1]) + (c[2] + c[3])) + ((d[0] + d[1]) + (d[2] + d[3])));
                        if (have[k]) rtab[(2 * (kb + k) + half) * 256 + rl] = __builtin_amdgcn_rsqf(ss * (1.0f / 1024.0f) + NORM_EPS);
                    }
                }
                __syncthreads();
            }
            int eseq = 0;
            pg8::EpiIn E{Zb, N, rtab, &eseq, kmp, even};
#ifdef PROBE_GIN2
            pg8::gemm_phase<pg8::EpiIn, pg8::StaticOrder, true, true>(lds, g, S, E);
#endif
#ifndef NO_GIN
            pg8::gemm_phase<pg8::EpiIn, pg8::StaticOrder, true, true>(lds, g, S, E);
#endif
        }
        XBAR_SYNC();
#ifdef PROBE_MIX2
        for (int rep = 0; rep < 2; ++rep)
#endif
#ifdef PROBE_MIX2_EVEN
        for (int rep = 0; rep < (even ? 2 : 1); ++rep)
#endif
        { __syncthreads(); FRESH_IDS(); const Args A = FRESH_ARGS();
        if (even) {
#ifndef NO_GMLP
            phase_gmlp(A, li, lds, vcu, G, wave, lane);
#endif
#ifdef PROBE_GMLP2
            phase_gmlp(A, li, lds, vcu, G, wave, lane);
#endif
#ifndef NO_MOBA
#if defined(NO_PIPE)
            phase_moba_old(A, lds, gwv, NGW, wave, lane);
#elif defined(MOBA_PIPE)
            phase_moba_p(A, lds, gwv, NGW, wave, lane);
#else
            phase_moba_s(A, lds, G, vcu, wave, lane);
#endif
#endif
        } else {
#ifndef NO_DIL
#if defined(NO_PIPE)
            phase_dilated(A, lds, gwv, NGW, wave, lane);
#elif defined(DIL_PIPE)
            phase_dilated_p(A, lds, gwv, NGW, wave, lane);
#elif defined(DIL_2)
            phase_dilated_2(A, lds, gwv, NGW, wave, lane);
#else
            phase_dilated_3(A, lds, G, vcu, wave, lane);
#endif
#endif
        } }
        XBAR_SYNC();
        {
            const Args A = FRESH_ARGS(); bf16* hb = (bf16*)(A.ws + WS_HB); bf16* Yb = (bf16*)(A.ws + WS_Y); float* ssqp = (float*)(A.ws + WS_SSQ);
            const bf16* Wt = even ? (const bf16*)(A.ws + WS_WE_OUT) + (size_t)li * D * D : (const bf16*)(A.ws + WS_WO_OUT) + (size_t)li * D * D;
            pg8::Gemm g{Yb, Wt, M, D, D}; pg8::StaticOrder S; S.init(M, D, G, bx);
            pg8::EpiOut E{layer == 0 ? A.x : nullptr, layer == 3 ? A.out : nullptr, hb, ssqp};
#ifndef NO_GOUT
            pg8::gemm_phase<pg8::EpiOut, pg8::StaticOrder, true, true>(lds, g, S, E);
#endif
        }
        XBAR_SYNC();
    }
#ifndef NO_FIN
    { FRESH_IDS(); const Args A = FRESH_ARGS(); phase_final(A, gwv, NGW, lane); }
#endif
}

extern "C" void kernel_launch(void* const* d_in, const int* in_sizes, int n_in, void* d_out, int out_size, void* d_ws, size_t ws_size, hipStream_t stream) {
    static int grid = 0;
    if (grid == 0) {
        if (n_in != 11 || in_sizes[0] != M * D || out_size != M * D || ws_size < WS_END) { fprintf(stderr, "kernel_launch: unexpected shapes (n_in %d, in0 %d, out %d, ws %zu)\n", n_in, n_in > 0 ? in_sizes[0] : -1, out_size, ws_size); grid = -1; return; }
        int dev = 0, cus = 0, per_cu = 0;
        if (hipGetDevice(&dev) != hipSuccess || hipDeviceGetAttribute(&cus, hipDeviceAttributeMultiprocessorCount, dev) != hipSuccess) { grid = -1; return; }
        if (hipFuncSetAttribute((const void*)mega_fwd, hipFuncAttributeMaxDynamicSharedMemorySize, LDS_BYTES) != hipSuccess) { fprintf(stderr, "kernel_launch: hipFuncSetAttribute failed\n"); grid = -1; return; }
        if (hipOccupancyMaxActiveBlocksPerMultiprocessor(&per_cu, (const void*)mega_fwd, NTHREADS, LDS_BYTES) != hipSuccess || per_cu < 1) { fprintf(stderr, "kernel_launch: occupancy query says %d\n", per_cu); per_cu = 1; }
        (void)hipGetLastError();
        grid = cus;
    }
    if (grid < 0) return;
    Args a{};
    a.x = (const float*)d_in[0]; a.norm_g = (const float*)d_in[1]; a.final_g = (const float*)d_in[2]; a.ab_w_in = (const float*)d_in[3]; a.ab_w_out = (const float*)d_in[4];
    a.ln_g = (const float*)d_in[5]; a.ln_b = (const float*)d_in[6]; a.w_s = (const float*)d_in[7]; a.b_s = (const float*)d_in[8]; a.c_w_in = (const float*)d_in[9]; a.c_w_out = (const float*)d_in[10];
    a.out = (float*)d_out; a.ws = (unsigned char*)d_ws;
    if (hipMemsetAsync((char*)d_ws + WS_CTL, 0, 16384, stream) != hipSuccess) { fprintf(stderr, "kernel_launch: hipMemsetAsync failed\n"); return; }
    void* args[] = {&a};
    const hipError_t e = hipLaunchCooperativeKernel((const void*)mega_fwd, dim3(grid), dim3(NTHREADS), args, LDS_BYTES, stream);
    if (e != hipSuccess) fprintf(stderr, "kernel_launch: cooperative launch failed: %s (grid %d)\n", hipGetErrorString(e), grid);
}
```

```cpp
#include <hip/hip_runtime.h>
#include <hip/hip_cooperative_groups.h>
#include <cstdio>
#include <cstdint>
#include <cmath>
namespace cg = cooperative_groups;
namespace pg8 {
#define PG8_LAS __attribute__((address_space(3)))
typedef unsigned short bf16_t;
typedef short bf16x8 __attribute__((ext_vector_type(8)));
typedef float f32x4 __attribute__((ext_vector_type(4)));
typedef unsigned u32x4 __attribute__((ext_vector_type(4)));
constexpr int BM = 256, BK = 64, HALF = 128, HTB = HALF * BK * 2  , STAGE_BYTES = 8 * HTB, NXCD = 8, WGM = 8;

__host__ __device__ __forceinline__ int lds_byte(int r, int c) { const int st = (r >> 4) * 2 + (c >> 5), rr = r & 15, cc = c & 31, ob = rr * 64 + cc * 2; return st * 1024 + (ob ^ (((ob >> 9) & 1) << 5)); }
__host__ __device__ __forceinline__ void stage_rc(int b, int& R, int& C) { const int st = b / 1024, sb = b % 1024, swz = sb ^ (((sb >> 9) & 1) << 5); R = (st >> 1) * 16 + swz / 64; C = (st & 1) * 32 + (swz % 64) / 2; }
__host__ __device__ __forceinline__ int perm32(int rho) { const int n = rho >> 4, i = rho & 15; return 8 * (i >> 2) + 4 * n + (i & 3); }

struct Unit { int pm, pn; };
struct Gemm { const bf16_t* A; const bf16_t* Bt; int M, N, K; };

struct StaticOrder {
    int nM, nN, nwg, G, c;
    __host__ __device__ void init(int M, int N, int G_, int c_) { nM = M / BM; nN = N / BM; nwg = nM * nN; G = G_; c = c_; }
    __host__ __device__ bool next(int i, Unit& u) const {
        const long L = (long)i * G + c; if (L >= nwg) return false;
        int wgid = (int)L; { const int q = nwg / NXCD, r = nwg % NXCD, xcd = wgid % NXCD, off = wgid / NXCD; wgid = (xcd < r ? xcd * (q + 1) : r * (q + 1) + (xcd - r) * q) + off; }
        const int nig = WGM * nN, gid = wgid / nig, fm = gid * WGM, gsz = (nM - fm) < WGM ? (nM - fm) : WGM;
        u.pm = fm + ((wgid % nig) % gsz); u.pn = (wgid % nig) / gsz; return true;
    }
    __device__ __forceinline__ void a_ready(const Unit&) const {}
    __device__ __forceinline__ void done(const Unit&) const {}
};

__device__ __forceinline__ unsigned cvt_pk_bf16(float lo, float hi) { unsigned r; asm volatile("v_cvt_pk_bf16_f32 %0, %1, %2" : "=v"(r) : "v"(lo), "v"(hi)); return r; }
typedef unsigned u32x2 __attribute__((ext_vector_type(2)));
__device__ __forceinline__ float act_gelu(float x) {
    const float t = x + 0.044715f * x * x * x;
    return x * __builtin_amdgcn_rcpf(1.f + __builtin_amdgcn_exp2f(-2.302208198f * t));
}
__device__ __forceinline__ float act_silu(float x) { return x * __builtin_amdgcn_rcpf(1.f + __builtin_amdgcn_exp2f(-1.4426950409f * x)); }
constexpr float QSCALE = 0.125f * 1.4426950408889634f;
constexpr float NORM_EPS = 1e-6f;

struct EpiIn {
    static constexpr bool PERM = true, AFTER_DRAIN = false;
    bf16_t* Z; int ldz; const PG8_LAS float* rtab; int* seq; float* kmp; int even;
    template <int ACT> __device__ __forceinline__ void body(const f32x4 (&acc)[2][2][4][2], const Unit& u, int wr, int wc, int fr, int fq, const PG8_LAS float* rt) const {
        const int row0 = u.pm * BM + wr * 64 + fr, col0 = u.pn * BM + wc * 32 + 8 * fq;
        float rs[2][4];
#pragma unroll
        for (int ai = 0; ai < 2; ++ai)
#pragma unroll
            for (int m = 0; m < 4; ++m) rs[ai][m] = rt[wr * 64 + fr + ai * HALF + m * 16];
        float cs[2][2][4];
        if (ACT == 4) {
#pragma unroll
            for (int bj = 0; bj < 2; ++bj)
#pragma unroll
                for (int n = 0; n < 2; ++n)
#pragma unroll
                    for (int e = 0; e < 4; ++e) cs[bj][n][e] = 0.f;
        }
#pragma unroll
        for (int ai = 0; ai < 2; ++ai)
#pragma unroll
            for (int m = 0; m < 4; ++m) {
                const int row = row0 + ai * HALF + m * 16;
                const float rstd = rs[ai][m];
                bf16_t* rowp = Z + (size_t)row * ldz + col0;
#pragma unroll
                for (int bj = 0; bj < 2; ++bj) {
                    f32x4 v[2];
#pragma unroll
                    for (int n = 0; n < 2; ++n) {
                        v[n] = acc[ai][bj][m][n] * rstd;
#pragma unroll
                        for (int e = 0; e < 4; ++e) {
                            if (ACT == 1) v[n][e] = act_gelu(v[n][e]);
                            if (ACT == 2) v[n][e] = act_silu(v[n][e]);
                            if (ACT == 3) v[n][e] = v[n][e] * QSCALE;
                            if (ACT == 4) cs[bj][n][e] += v[n][e];
                        }
                    }
                    u32x4 w; w.x = cvt_pk_bf16(v[0][0], v[0][1]); w.y = cvt_pk_bf16(v[0][2], v[0][3]); w.z = cvt_pk_bf16(v[1][0], v[1][1]); w.w = cvt_pk_bf16(v[1][2], v[1][3]);
                    *(u32x4*)(rowp + bj * HALF) = w;
                }
            }
        if (ACT == 4) {
#pragma unroll
            for (int bj = 0; bj < 2; ++bj)
#pragma unroll
                for (int n = 0; n < 2; ++n)
#pragma unroll
                    for (int e = 0; e < 4; ++e) {
                        float s = cs[bj][n][e];
                        s += __shfl_xor(s, 1); s += __shfl_xor(s, 2); s += __shfl_xor(s, 4); s += __shfl_xor(s, 8);
                        cs[bj][n][e] = s;
                    }
            if (fr == 0) {
                float* kp = kmp + ((size_t)u.pm * 2 + wr) * 512 + (col0 - 2048);
#pragma unroll
                for (int bj = 0; bj < 2; ++bj)
#pragma unroll
                    for (int n = 0; n < 2; ++n) *(f32x4*)(kp + bj * HALF + n * 4) = (f32x4){cs[bj][n][0], cs[bj][n][1], cs[bj][n][2], cs[bj][n][3]};
            }
        }
    }
    __device__ __forceinline__ void operator()(const f32x4 (&acc)[2][2][4][2], const Unit& u, int wr, int wc, int fr, int fq) const {
        int act;
        if (even) { const int seg = u.pn >> 1; act = (seg == 0 || seg == 1) ? 1 : (seg == 2 || seg == 6) ? 2 : (seg == 3) ? 3 : (seg == 4) ? 4 : 0; }
        else { const int seg = u.pn >> 2; act = (seg == 0) ? 3 : (seg == 3) ? 2 : 0; }
        const PG8_LAS float* rt = rtab + ((*seq)++) * 256;
        if (act == 0) body<0>(acc, u, wr, wc, fr, fq, rt);
        else if (act == 1) body<1>(acc, u, wr, wc, fr, fq, rt);
        else if (act == 2) body<2>(acc, u, wr, wc, fr, fq, rt);
        else if (act == 3) body<3>(acc, u, wr, wc, fr, fq, rt);
        else body<4>(acc, u, wr, wc, fr, fq, rt);
    }
};
struct EpiOut {
    static constexpr bool PERM = false, AFTER_DRAIN = false;
    const float* resid_f32; float* out_f32; bf16_t* hb; float* ssqp;
    template <bool RF32> __device__ __forceinline__ void body(const f32x4 (&acc)[2][2][4][2], const Unit& u, int wr, int wc, int fr, int fq) const {
        const int row0 = u.pm * BM + wr * 64 + fr, col0 = u.pn * BM + wc * 32 + 4 * fq;
        constexpr int MB = RF32 ? 2 : 4;
#pragma unroll
        for (int ai = 0; ai < 2; ++ai)
#pragma unroll
        for (int m0 = 0; m0 < 4; m0 += MB) {
            f32x4 rf[RF32 ? MB : 1][2][2]; u32x2 rb[RF32 ? 1 : MB][2][2];
#pragma unroll
            for (int mm = 0; mm < MB; ++mm)
#pragma unroll
                for (int bj = 0; bj < 2; ++bj)
#pragma unroll
                    for (int n = 0; n < 2; ++n) {
                        const size_t o2 = (size_t)(row0 + ai * HALF + (m0 + mm) * 16) * 1024 + col0 + bj * HALF + n * 16;
                        if (RF32) rf[RF32 ? mm : 0][bj][n] = *(const f32x4*)(resid_f32 + o2); else rb[RF32 ? 0 : mm][bj][n] = *(const u32x2*)(hb + o2);
                    }
#pragma unroll
            for (int mm = 0; mm < MB; ++mm) {
                const int m = m0 + mm;
                const int row = row0 + ai * HALF + m * 16; const size_t off = (size_t)row * 1024 + col0; float ss = 0.f;
#pragma unroll
                for (int bj = 0; bj < 2; ++bj)
#pragma unroll
                    for (int n = 0; n < 2; ++n) {
                        const size_t o2 = off + bj * HALF + n * 16;
                        f32x4 r;
                        if (RF32) r = rf[RF32 ? mm : 0][bj][n];
                        else { const u32x2 w = rb[RF32 ? 0 : mm][bj][n]; r[0] = __builtin_bit_cast(float, w.x << 16); r[1] = __builtin_bit_cast(float, w.x & 0xffff0000u); r[2] = __builtin_bit_cast(float, w.y << 16); r[3] = __builtin_bit_cast(float, w.y & 0xffff0000u); }
                        const f32x4 o = r + acc[ai][bj][m][n];
                        ss += (o[0] * o[0] + o[1] * o[1]) + (o[2] * o[2] + o[3] * o[3]);
                        if (out_f32) *(f32x4*)(out_f32 + o2) = o;
                        else { u32x2 w; w.x = cvt_pk_bf16(o[0], o[1]); w.y = cvt_pk_bf16(o[2], o[3]); *(u32x2*)(hb + o2) = w; }
                    }
                ss += __shfl_xor(ss, 16); ss += __shfl_xor(ss, 32);
                if (fq == 0) ssqp[(size_t)row * 16 + u.pn * 4 + wc] = ss;
            }
        }
    }
    __device__ __forceinline__ void operator()(const f32x4 (&acc)[2][2][4][2], const Unit& u, int wr, int wc, int fr, int fq) const {
        if (resid_f32) body<true>(acc, u, wr, wc, fr, fq); else body<false>(acc, u, wr, wc, fr, fq);
    }
};
template <class Epi, class Sched, bool ALIGN_EPI = false, bool SP2 = false>
__device__ __forceinline__ void gemm_phase(PG8_LAS unsigned char* lds, const Gemm g, const Sched& S, const Epi& E) {
    int tid_ = threadIdx.x; asm volatile("" : "+v"(tid_));
    const int tid = tid_, wid = __builtin_amdgcn_readfirstlane(tid >> 6), lane = tid & 63, wr = wid >> 2, wc = wid & 3, fr = lane & 15, fq = lane >> 4;
    const int K = g.K, nt = K / BK;
    unsigned voffA[2], voffB[2];
#pragma unroll
    for (int i = 0; i < 2; ++i) { int R, C; stage_rc(tid * 16 + i * 8192, R, C); const int Rb = Epi::PERM ? ((R & ~31) + perm32(R & 31)) : R;
        voffA[i] = (unsigned)(R * K + C) * 2u; voffB[i] = (unsigned)(Rb * K + C) * 2u; }
    const size_t kstep = (size_t)(BK * 2);
    const size_t hstep = (size_t)HALF * K * 2;
    const size_t tstep = 2 * hstep;
    const unsigned ldsw = (unsigned)wid * 1024u;
    const int aoff = lds_byte(wr * 64 + fr, fq * 8), boff = lds_byte(wc * 32 + fr, fq * 8);
#define PG8_SA(b, h) (((b) * 2 + (h)) * HTB)
#define PG8_SB(b, h) ((4 + (b) * 2 + (h)) * HTB)
#define PG8_STAGE(bufoff, gbase, voff) do { _Pragma("unroll") for (int _i = 0; _i < 2; ++_i) \
        __builtin_amdgcn_global_load_lds((const unsigned*)((const char*)(gbase) + (voff)[_i]), (PG8_LAS unsigned*)(lds + (bufoff) + ldsw + _i * 8192), 16, 0, 0); } while (0)
#define PG8_LDA(dst, b, h) do { _Pragma("unroll") for (int m = 0; m < 4; ++m) _Pragma("unroll") for (int k = 0; k < 2; ++k) dst[m][k] = *(const PG8_LAS bf16x8*)(lds + PG8_SA(b, h) + aoff + m * 2048 + k * 1024); } while (0)
#define PG8_LDB(dst, b, h) do { _Pragma("unroll") for (int n = 0; n < 2; ++n) _Pragma("unroll") for (int k = 0; k < 2; ++k) dst[n][k] = *(const PG8_LAS bf16x8*)(lds + PG8_SB(b, h) + boff + n * 2048 + k * 1024); } while (0)
#define PG8_MMA(ai, bj, At, Bt) do { __builtin_amdgcn_s_setprio(1); _Pragma("unroll") for (int m = 0; m < 4; ++m) _Pragma("unroll") for (int n = 0; n < 2; ++n) _Pragma("unroll") for (int k = 0; k < 2; ++k) \
        acc[ai][bj][m][n] = __builtin_amdgcn_mfma_f32_16x16x32_bf16(Bt[n][k], At[m][k], acc[ai][bj][m][n], 0, 0, 0); __builtin_amdgcn_s_setprio(0); } while (0)
#define PG8_WAIT_V(n) asm volatile("s_waitcnt vmcnt(" #n ")" ::: "memory")
#define PG8_WAIT_L(n) asm volatile("s_waitcnt lgkmcnt(" #n ")" ::: "memory")
#define PG8_BAR __builtin_amdgcn_s_barrier()
#define PG8_SCHED __builtin_amdgcn_sched_barrier(0)
    Unit cur, nxt; int ui = 0;
    if (!S.next(0, cur)) return;
    f32x4 acc[2][2][4][2];
#pragma unroll
    for (int a = 0; a < 2; ++a)
#pragma unroll
        for (int b = 0; b < 2; ++b)
#pragma unroll
            for (int m = 0; m < 4; ++m)
#pragma unroll
                for (int n = 0; n < 2; ++n) acc[a][b][m][n] = (f32x4){0.f, 0.f, 0.f, 0.f};
    bf16x8 At[4][2], B0[2][2], B1[2][2];
    const char* cA = (const char*)g.A + (size_t)cur.pm * tstep; const char* cB = (const char*)g.Bt + (size_t)cur.pn * tstep;
    S.a_ready(cur);
    if constexpr (SP2) {
        PG8_STAGE(PG8_SB(0, 0), cB, voffB); PG8_STAGE(PG8_SB(0, 1), cB + hstep, voffB); PG8_STAGE(PG8_SA(0, 0), cA, voffA); PG8_STAGE(PG8_SA(0, 1), cA + hstep, voffA);
        if (wr == 1) PG8_BAR;
        PG8_WAIT_V(2); PG8_BAR;
        PG8_STAGE(PG8_SB(1, 0), cB + kstep, voffB); PG8_STAGE(PG8_SA(1, 0), cA + kstep, voffA); PG8_STAGE(PG8_SB(1, 1), cB + hstep + kstep, voffB);
        PG8_WAIT_V(6); PG8_BAR;
    } else {
        PG8_STAGE(PG8_SB(0, 0), cB, voffB); PG8_STAGE(PG8_SA(0, 0), cA, voffA); PG8_STAGE(PG8_SB(0, 1), cB + hstep, voffB); PG8_STAGE(PG8_SA(0, 1), cA + hstep, voffA);
        if (wr == 1) PG8_BAR;
        PG8_WAIT_V(4); PG8_BAR;
        PG8_STAGE(PG8_SB(1, 0), cB + kstep, voffB); PG8_STAGE(PG8_SA(1, 0), cA + kstep, voffA); PG8_STAGE(PG8_SB(1, 1), cB + hstep + kstep, voffB);
        PG8_WAIT_V(6); PG8_BAR;
    }
    for (;;) {
        const bool has_next = S.next(ui + 1, nxt);
        const char* nA = has_next ? (const char*)g.A + (size_t)nxt.pm * tstep : cA; const char* nB = has_next ? (const char*)g.Bt + (size_t)nxt.pn * tstep : cB;
        for (int t = 0; t < nt; t += 2) {
            const bool last = (t == nt - 2);
            const char* a1 = cA + (size_t)(t + 1) * kstep;
            const char* a2 = last ? nA : cA + (size_t)(t + 2) * kstep; const char* b2 = last ? nB : cB + (size_t)(t + 2) * kstep;
            const char* a3 = a2 + kstep; const char* b3 = b2 + kstep;
            if (last && has_next) S.a_ready(nxt);
            if constexpr (SP2) {
            PG8_LDB(B0, 0, 0); PG8_LDB(B1, 0, 1); PG8_SCHED; PG8_LDA(At, 0, 0); PG8_STAGE(PG8_SA(1, 1), a1 + hstep, voffA);
            PG8_WAIT_V(8); PG8_WAIT_L(0); PG8_BAR; PG8_MMA(0, 0, At, B0); PG8_MMA(0, 1, At, B1); PG8_BAR; PG8_SCHED;
            PG8_LDA(At, 0, 1); PG8_STAGE(PG8_SB(0, 0), b2, voffB); PG8_STAGE(PG8_SB(0, 1), b2 + hstep, voffB); PG8_STAGE(PG8_SA(0, 0), a2, voffA);
            PG8_WAIT_V(8); PG8_WAIT_L(0); PG8_BAR; PG8_MMA(1, 0, At, B0); PG8_MMA(1, 1, At, B1); PG8_BAR; PG8_SCHED;
            PG8_LDB(B0, 1, 0); PG8_LDB(B1, 1, 1); PG8_SCHED; PG8_LDA(At, 1, 0); PG8_STAGE(PG8_SA(0, 1), a2 + hstep, voffA);
            PG8_WAIT_V(8); PG8_WAIT_L(0); PG8_BAR; PG8_MMA(0, 0, At, B0); PG8_MMA(0, 1, At, B1); PG8_BAR; PG8_SCHED;
            PG8_LDA(At, 1, 1); PG8_STAGE(PG8_SB(1, 0), b3, voffB); PG8_STAGE(PG8_SB(1, 1), b3 + hstep, voffB); PG8_STAGE(PG8_SA(1, 0), a3, voffA);
            PG8_WAIT_V(8); PG8_WAIT_L(0); PG8_BAR; PG8_MMA(1, 0, At, B0); PG8_MMA(1, 1, At, B1); PG8_BAR; PG8_SCHED;
            } else {
            PG8_LDB(B0, 0, 0); PG8_SCHED; PG8_LDA(At, 0, 0); PG8_STAGE(PG8_SA(1, 1), a1 + hstep, voffA);
            PG8_WAIT_L(8); PG8_BAR; PG8_WAIT_L(0); PG8_MMA(0, 0, At, B0); PG8_BAR; PG8_SCHED;
            PG8_LDB(B1, 0, 1); PG8_STAGE(PG8_SB(0, 0), b2, voffB);
            PG8_BAR; PG8_WAIT_L(0); PG8_MMA(0, 1, At, B1); PG8_BAR;
            PG8_LDA(At, 0, 1); PG8_STAGE(PG8_SA(0, 0), a2, voffA);
            PG8_BAR; PG8_WAIT_L(0); PG8_MMA(1, 0, At, B0); PG8_BAR; PG8_SCHED;
            PG8_STAGE(PG8_SB(0, 1), b2 + hstep, voffB);
            PG8_WAIT_V(6); PG8_BAR; PG8_MMA(1, 1, At, B1); PG8_BAR;
            PG8_LDB(B0, 1, 0); PG8_SCHED; PG8_LDA(At, 1, 0); PG8_STAGE(PG8_SA(0, 1), a2 + hstep, voffA);
            PG8_WAIT_L(8); PG8_BAR; PG8_WAIT_L(0); PG8_MMA(0, 0, At, B0); PG8_BAR; PG8_SCHED;
            PG8_LDB(B1, 1, 1); PG8_STAGE(PG8_SB(1, 0), b3, voffB);
            PG8_BAR; PG8_WAIT_L(0); PG8_MMA(0, 1, At, B1); PG8_BAR;
            PG8_LDA(At, 1, 1); PG8_STAGE(PG8_SA(1, 0), a3, voffA);
            PG8_BAR; PG8_WAIT_L(0); PG8_MMA(1, 0, At, B0); PG8_BAR; PG8_SCHED;
            PG8_STAGE(PG8_SB(1, 1), b3 + hstep, voffB);
            PG8_WAIT_V(6); PG8_BAR; PG8_MMA(1, 1, At, B1); PG8_BAR;
            }
        }
        if constexpr (ALIGN_EPI) { if (wr == 0) PG8_BAR; }
        if constexpr (!Epi::AFTER_DRAIN) { E(acc, cur, wr, wc, fr, fq); S.done(cur); }
        if (!has_next) break;
#pragma unroll
        for (int a = 0; a < 2; ++a)
#pragma unroll
            for (int b = 0; b < 2; ++b)
#pragma unroll
                for (int m = 0; m < 4; ++m)
#pragma unroll
                    for (int n = 0; n < 2; ++n) acc[a][b][m][n] = (f32x4){0.f, 0.f, 0.f, 0.f};
        cur = nxt; cA = nA; cB = nB; ++ui;
        if constexpr (ALIGN_EPI) { if (wr == 1) PG8_BAR; }
    }
    PG8_WAIT_V(0);
    if constexpr (!ALIGN_EPI) { if (wr == 0) PG8_BAR; }
    PG8_BAR;
    if constexpr (Epi::AFTER_DRAIN) { E.fused(acc, cur, wr, wc, fr, fq, lds, wid, lane); S.done(cur); }
#undef PG8_SA
#undef PG8_SB
#undef PG8_STAGE
#undef PG8_LDA
#undef PG8_LDB
#undef PG8_MMA
#undef PG8_WAIT_V
#undef PG8_WAIT_L
#undef PG8_BAR
#undef PG8_SCHED
}
}
#define GAS __attribute__((address_space(1)))
#define LAS __attribute__((address_space(3)))
typedef unsigned short bf16;
typedef unsigned v4u __attribute__((ext_vector_type(4)));
typedef unsigned v2u __attribute__((ext_vector_type(2)));
typedef float f32x4 __attribute__((ext_vector_type(4)));
typedef float f32x16 __attribute__((ext_vector_type(16)));
typedef short bf16x8 __attribute__((ext_vector_type(8)));
typedef short s16x4 __attribute__((ext_vector_type(4)));
#define LDS_WAIT() asm volatile("s_waitcnt lgkmcnt(0)" ::: "memory")
using pg8::cvt_pk_bf16; using pg8::NORM_EPS; using pg8::QSCALE;

constexpr int NWAVES = 8, NTHREADS = 512;
constexpr float RESCALE_THR = 8.0f;
constexpr int D = 1024, BATCH = 16, SEQ = 4096, M = BATCH * SEQ;
constexpr int EVEN_IN = 3584, ODD_IN = 4096;
constexpr size_t MiB = 1u << 20;
constexpr size_t WS_WE_IN = 0, WS_WE_OUT = 14 * MiB, WS_WO_IN = 18 * MiB, WS_WO_OUT = 34 * MiB, WS_WS = 38 * MiB, WS_SSQ = 39 * MiB, WS_KMP = 43 * MiB,
                 WS_HB = 44 * MiB, WS_Y = 172 * MiB, WS_Z = 300 * MiB, WS_CTL = 812 * MiB, WS_END = 813 * MiB;
constexpr int LDS_BYTES = 131072 + 1024 + 16384;

__device__ __forceinline__ unsigned f2bf(float f) { unsigned u = __builtin_bit_cast(unsigned, f); return (u + 0x7fffu + ((u >> 16) & 1u)) >> 16; }
__device__ __forceinline__ unsigned pk2(float lo, float hi) { return f2bf(lo) | (f2bf(hi) << 16); }
__device__ __forceinline__ float bf_lo(unsigned w) { return __builtin_bit_cast(float, w << 16); }
__device__ __forceinline__ float bf_hi(unsigned w) { return __builtin_bit_cast(float, w & 0xffff0000u); }
__device__ __forceinline__ float wave_sum(float v) {
#pragma unroll
    for (int o = 1; o < 64; o <<= 1) v += __shfl_xor(v, o);
    return v;
}
typedef float f32x2_t __attribute__((ext_vector_type(2))); typedef __bf16 bf16x2_t __attribute__((ext_vector_type(2)));
__device__ __forceinline__ unsigned cvtpk_s(float lo, float hi) { f32x2_t v = {lo, hi}; bf16x2_t b = __builtin_convertvector(v, bf16x2_t); return __builtin_bit_cast(unsigned, b); }
__device__ __forceinline__ int crow(int r, int hi) { return (r & 3) + 8 * (r >> 2) + 4 * hi; }
__device__ __forceinline__ s16x4 vtr(const LAS unsigned char* p) { return __builtin_bit_cast(s16x4, __builtin_amdgcn_ds_read_tr16_b64_v4i16((LAS s16x4*)p)); }

__device__ __forceinline__ void transpose_item(const float* W, const float* g, int K, int N, bf16* WT, LAS float* scr, int item, int lane) {
    const int nblk = N / 32, kb = item / nblk, nb = item % nblk, k0 = 64 * kb, n0 = 32 * nb;
#pragma unroll 8
    for (int i = 0; i < 32; ++i) { const int kk = 2 * i + (lane >> 5); const float sc = g ? g[k0 + kk] : 1.f; scr[kk * 33 + (lane & 31)] = W[(size_t)(k0 + kk) * N + n0 + (lane & 31)] * sc; }
    LDS_WAIT(); asm volatile("" ::: "memory");
    const int c = lane & 7;
#pragma unroll
    for (int j = 0; j < 4; ++j) { const int n = (lane >> 3) + 8 * j; const LAS float* s = scr + (8 * c) * 33 + n;
        v4u o; o.x = pk2(s[0 * 33], s[1 * 33]); o.y = pk2(s[2 * 33], s[3 * 33]); o.z = pk2(s[4 * 33], s[5 * 33]); o.w = pk2(s[6 * 33], s[7 * 33]);
        *(v4u*)(WT + (size_t)(n0 + n) * K + k0 + 8 * c) = o; }
    LDS_WAIT(); asm volatile("" ::: "memory");
}

struct Args {
    const float *x, *norm_g, *final_g, *ab_w_in, *ab_w_out, *ln_g, *ln_b, *w_s, *b_s, *c_w_in, *c_w_out;
    float* out; unsigned char* ws;
};

__device__ __forceinline__ void phase_prologue(const Args& A, LAS unsigned char* lds, int gwv, int NGW, int wave, int lane) {
    LAS float* scr = (LAS float*)(lds + wave * 16384);
    constexpr int I_EIN = 16 * (EVEN_IN / 32), I_OUT = 16 * 32, I_OIN = 16 * (ODD_IN / 32), I_PAIR = I_EIN + I_OUT + I_OIN + I_OUT;
    for (int it = gwv; it < 2 * I_PAIR; it += NGW) {
        const int i = it / I_PAIR; int r = it % I_PAIR;
        if (r < I_EIN) { transpose_item(A.ab_w_in + (size_t)i * D * EVEN_IN, A.norm_g + (2 * i) * D, D, EVEN_IN, (bf16*)(A.ws + WS_WE_IN) + (size_t)i * EVEN_IN * D, scr, r, lane); continue; } r -= I_EIN;
        if (r < I_OUT) { transpose_item(A.ab_w_out + (size_t)i * D * D, nullptr, D, D, (bf16*)(A.ws + WS_WE_OUT) + (size_t)i * D * D, scr, r, lane); continue; } r -= I_OUT;
        if (r < I_OIN) { transpose_item(A.c_w_in + (size_t)i * D * ODD_IN, A.norm_g + (2 * i + 1) * D, D, ODD_IN, (bf16*)(A.ws + WS_WO_IN) + (size_t)i * ODD_IN * D, scr, r, lane); continue; } r -= I_OIN;
        transpose_item(A.c_w_out + (size_t)i * D * D, nullptr, D, D, (bf16*)(A.ws + WS_WO_OUT) + (size_t)i * D * D, scr, r, lane);
    }
    { bf16* wst = (bf16*)(A.ws + WS_WS);
      for (int e = gwv * 64 + lane; e < 2 * 4 * 128 * 128; e += NGW * 64) { const int s = e & 127, t = (e >> 7) & 127; wst[e] = (bf16)f2bf(s <= t ? A.w_s[e] : 0.f); } }
    bf16* hb = (bf16*)(A.ws + WS_HB); float* ssqp = (float*)(A.ws + WS_SSQ);
    for (int m = gwv; m < M; m += 2 * NGW) {
        const int m2 = m + NGW;
        const f32x4* xr = (const f32x4*)(A.x + (size_t)m * D) + lane; const f32x4* xr2 = (const f32x4*)(A.x + (size_t)m2 * D) + lane;
        f32x4 v[4], w4[4];
#pragma unroll
        for (int j = 0; j < 4; ++j) { v[j] = xr[64 * j]; w4[j] = xr2[64 * j]; }
        float s = 0.f, s2 = 0.f;
#pragma unroll
        for (int j = 0; j < 4; ++j) { s += (v[j][0] * v[j][0] + v[j][1] * v[j][1]) + (v[j][2] * v[j][2] + v[j][3] * v[j][3]); s2 += (w4[j][0] * w4[j][0] + w4[j][1] * w4[j][1]) + (w4[j][2] * w4[j][2] + w4[j][3] * w4[j][3]); }
        s = wave_sum(s); s2 = wave_sum(s2);
        v2u* o8 = (v2u*)(hb + (size_t)m * D) + lane; v2u* o82 = (v2u*)(hb + (size_t)m2 * D) + lane;
#pragma unroll
        for (int j = 0; j < 4; ++j) { v2u w; w.x = cvtpk_s(v[j][0], v[j][1]); w.y = cvtpk_s(v[j][2], v[j][3]); o8[64 * j] = w; v2u w2; w2.x = cvtpk_s(w4[j][0], w4[j][1]); w2.y = cvtpk_s(w4[j][2], w4[j][3]); o82[64 * j] = w2; }
        if (lane < 16) { ssqp[(size_t)m * 16 + lane] = (lane == 0) ? s : 0.f; ssqp[(size_t)m2 * 16 + lane] = (lane == 0) ? s2 : 0.f; }
    }
}

__device__ __forceinline__ void phase_gmlp(const Args& A, int li, LAS unsigned char* lds, int vcu, int G, int wave, int lane) {
    const bf16* Z = (const bf16*)(A.ws + WS_Z); bf16* Y = (bf16*)(A.ws + WS_Y);
    const bf16* wst = (const bf16*)(A.ws + WS_WS) + (size_t)li * 4 * 128 * 128;
    const float* lng = A.ln_g + li * 512; const float* lnb = A.ln_b + li * 512; const float* bs = A.b_s + li * 4 * 128;
    const int r32 = lane & 31, hi = lane >> 5, grp = lane >> 4, qq = (lane & 15) >> 2, pp = lane & 3;
    float gg[8], gb[8];
#pragma unroll
    for (int j = 0; j < 8; ++j) { gg[j] = lng[8 * lane + j]; gb[j] = lnb[8 * lane + j]; }
    for (int u = vcu; u < M / 128; u += G) {
        const size_t row0 = (size_t)u * 128;
#pragma unroll 1
        for (int r4 = 0; r4 < 16; r4 += 8) {
            v4u wv[8];
#pragma unroll
            for (int k = 0; k < 8; ++k) wv[k] = *(const v4u*)(Z + (row0 + wave * 16 + r4 + k) * EVEN_IN + 512 + 8 * lane);
#pragma unroll
            for (int k = 0; k < 8; ++k) {
                const int s = wave * 16 + r4 + k; const v4u w = wv[k];
                float x[8] = {bf_lo(w.x), bf_hi(w.x), bf_lo(w.y), bf_hi(w.y), bf_lo(w.z), bf_hi(w.z), bf_lo(w.w), bf_hi(w.w)};
                float sm = 0.f;
#pragma unroll
                for (int j = 0; j < 8; ++j) sm += x[j];
                const float mean = wave_sum(sm) * (1.f / 512.f); float sq = 0.f;
#pragma unroll
                for (int j = 0; j < 8; ++j) { x[j] -= mean; sq += x[j] * x[j]; }
                const float rstd = __builtin_amdgcn_rsqf(wave_sum(sq) * (1.f / 512.f) + NORM_EPS);
#pragma unroll
                for (int j = 0; j < 8; ++j) x[j] = x[j] * rstd * gg[j] + gb[j];
                v4u o; o.x = cvtpk_s(x[0], x[1]); o.y = cvtpk_s(x[2], x[3]); o.z = cvtpk_s(x[4], x[5]); o.w = cvtpk_s(x[6], x[7]);
                *(LAS v4u*)(lds + ((s >> 3) * 16 + (lane >> 2)) * 512 + (s & 7) * 64 + (lane & 3) * 16) = o;
            }
        }
        __syncthreads();
        const int g = wave >> 1;
#pragma unroll 1
        for (int t2 = 0; t2 < 2; ++t2) {
            const int tt = (wave & 1) * 2 + t2;
            f32x16 acc[4];
#pragma unroll
            for (int ct = 0; ct < 4; ++ct) acc[ct] = f32x16{};
            const bf16* wrow = wst + ((size_t)g * 128 + 32 * tt + r32) * 128 + 8 * hi;
            bf16x8 bw[8];
#pragma unroll
            for (int ks = 0; ks < 8; ++ks) bw[ks] = *(const bf16x8*)(wrow + 16 * ks);
#pragma unroll
            for (int ks = 0; ks < 8; ++ks) {
                const bf16x8 bfrag = bw[ks];
#pragma unroll
                for (int ct = 0; ct < 4; ++ct) {
                    const LAS unsigned char* p = lds + ((2 * ks + hi) * 16 + 4 * g + ct) * 512 + qq * 64 + (16 * (grp & 1) + 4 * pp) * 2;
                    const s16x4 lo = vtr(p), hi4 = vtr(p + 256);
                    const bf16x8 afrag = (bf16x8){lo[0], lo[1], lo[2], lo[3], hi4[0], hi4[1], hi4[2], hi4[3]};
                    acc[ct] = __builtin_amdgcn_mfma_f32_32x32x16_bf16(afrag, bfrag, acc[ct], 0, 0, 0);
                }
            }
            const int t = 32 * tt + r32; const size_t row = row0 + t; const float bias = bs[g * 128 + t];
            v2u ub[4][4], gb2[4][4];
#pragma unroll
            for (int ct = 0; ct < 4; ++ct)
#pragma unroll
                for (int rq = 0; rq < 4; ++rq) { const int c = g * 128 + 32 * ct + 8 * rq + 4 * hi; ub[ct][rq] = *(const v2u*)(Z + row * EVEN_IN + c); gb2[ct][rq] = *(const v2u*)(Z + row * EVEN_IN + 1024 + c); }
#pragma unroll
            for (int ct = 0; ct < 4; ++ct)
#pragma unroll
                for (int rq = 0; rq < 4; ++rq) {
                    const int c = g * 128 + 32 * ct + 8 * rq + 4 * hi;
                    const v2u uu = ub[ct][rq], ga = gb2[ct][rq];
                    const float y0 = bf_lo(uu.x) * (acc[ct][4 * rq + 0] + bias) * bf_lo(ga.x), y1 = bf_hi(uu.x) * (acc[ct][4 * rq + 1] + bias) * bf_hi(ga.x);
                    const float y2 = bf_lo(uu.y) * (acc[ct][4 * rq + 2] + bias) * bf_lo(ga.y), y3 = bf_hi(uu.y) * (acc[ct][4 * rq + 3] + bias) * bf_hi(ga.y);
                    v2u o; o.x = cvtpk_s(y0, y1); o.y = cvtpk_s(y2, y3);
                    *(v2u*)(Y + row * D + c) = o;
                }
        }
        __syncthreads();
    }
}

struct AttnSt { f32x16 o0, o1; float m, l; };
template <class MaskF>
__device__ __forceinline__ void attn_tile(AttnSt& st, const bf16x8 (&qf)[4], const bf16* kp, const bf16* vp0, const bf16* vp1, const bf16* vp2, const bf16* vp3, LAS unsigned char* vl, int lane, bool domask, MaskF mask) {
    const int hi = lane >> 5, grp = lane >> 4, qq = (lane & 15) >> 2, pp = lane & 3;
    bf16x8 kf[4]; v4u vv[4];
#pragma unroll
    for (int d0 = 0; d0 < 4; ++d0) kf[d0] = *(const bf16x8*)(kp + 16 * d0);
    vv[0] = *(const v4u*)vp0; vv[1] = *(const v4u*)vp1; vv[2] = *(const v4u*)vp2; vv[3] = *(const v4u*)vp3;
    f32x16 s = f32x16{};
#pragma unroll
    for (int d0 = 0; d0 < 4; ++d0) s = __builtin_amdgcn_mfma_f32_32x32x16_bf16(kf[d0], qf[d0], s, 0, 0, 0);
#pragma unroll
    for (int it = 0; it < 4; ++it) *(LAS v4u*)(vl + (it * 2 + ((lane & 7) >> 2)) * 512 + (lane >> 3) * 64 + (lane & 3) * 16) = vv[it];
    if (domask) {
#pragma unroll
        for (int r = 0; r < 16; ++r) if (!mask(crow(r, hi))) s[r] = -INFINITY;
    }
    float mt = s[0];
#pragma unroll
    for (int r = 1; r < 16; ++r) mt = fmaxf(mt, s[r]);
    mt = fmaxf(mt, __shfl_xor(mt, 32));
    if (__any(mt > st.m + RESCALE_THR)) {
        const float mn = fmaxf(st.m, mt);
        const float f = __builtin_amdgcn_exp2f(st.m - mn); st.l *= f; st.m = mn;
#pragma unroll
        for (int r = 0; r < 16; ++r) { st.o0[r] *= f; st.o1[r] *= f; }
    }
    float ps = 0.f;
#pragma unroll
    for (int r = 0; r < 16; ++r) { s[r] = __builtin_amdgcn_exp2f(s[r] - st.m); ps += s[r]; }
    st.l += ps;
    v4u pw0, pw1;
    pw0.x = cvtpk_s(s[0], s[1]); pw0.y = cvtpk_s(s[2], s[3]); pw0.z = cvtpk_s(s[4], s[5]); pw0.w = cvtpk_s(s[6], s[7]);
    pw1.x = cvtpk_s(s[8], s[9]); pw1.y = cvtpk_s(s[10], s[11]); pw1.z = cvtpk_s(s[12], s[13]); pw1.w = cvtpk_s(s[14], s[15]);
    const bf16x8 pf0 = __builtin_bit_cast(bf16x8, pw0), pf1 = __builtin_bit_cast(bf16x8, pw1);
    const LAS unsigned char* tb = vl + (4 * hi + qq) * 64 + (16 * (grp & 1) + 4 * pp) * 2;
#define VFRAG(ks, d0) ({ const s16x4 lo_ = vtr(tb + ((2 * (ks)) * 2 + (d0)) * 512), hi_ = vtr(tb + ((2 * (ks) + 1) * 2 + (d0)) * 512); (bf16x8){lo_[0], lo_[1], lo_[2], lo_[3], hi_[0], hi_[1], hi_[2], hi_[3]}; })
    st.o0 = __builtin_amdgcn_mfma_f32_32x32x16_bf16(VFRAG(0, 0), pf0, st.o0, 0, 0, 0);
    st.o1 = __builtin_amdgcn_mfma_f32_32x32x16_bf16(VFRAG(0, 1), pf0, st.o1, 0, 0, 0);
    st.o0 = __builtin_amdgcn_mfma_f32_32x32x16_bf16(VFRAG(1, 0), pf1, st.o0, 0, 0, 0);
    st.o1 = __builtin_amdgcn_mfma_f32_32x32x16_bf16(VFRAG(1, 1), pf1, st.o1, 0, 0, 0);
#undef VFRAG
}
__device__ __forceinline__ void attn_store(const AttnSt& st, const bf16* grow, bf16* yrow, int lane) {
    const int hi = lane >> 5;
    const float lt = st.l + __shfl_xor(st.l, 32), inv = 1.0f / lt;
    v2u ga[2][4];
#pragma unroll
    for (int d0 = 0; d0 < 2; ++d0)
#pragma unroll
        for (int rq = 0; rq < 4; ++rq) ga[d0][rq] = *(const v2u*)(grow + 32 * d0 + 8 * rq + 4 * hi);
#pragma unroll
    for (int d0 = 0; d0 < 2; ++d0)
#pragma unroll
        for (int rq = 0; rq < 4; ++rq) {
            const int d = 32 * d0 + 8 * rq + 4 * hi;
            const v2u g = ga[d0][rq];
            const f32x16& o = d0 ? st.o1 : st.o0;
            v2u w; w.x = cvtpk_s(o[4 * rq + 0] * inv * bf_lo(g.x), o[4 * rq + 1] * inv * bf_hi(g.x)); w.y = cvtpk_s(o[4 * rq + 2] * inv * bf_lo(g.y), o[4 * rq + 3] * inv * bf_hi(g.y));
            *(v2u*)(yrow + d) = w;
        }
}

__device__ __forceinline__ void attn_gate_load(v2u (&ga)[2][4], const bf16* grow, int lane) {
    const int hi = lane >> 5;
#pragma unroll
    for (int d0 = 0; d0 < 2; ++d0)
#pragma unroll
        for (int rq = 0; rq < 4; ++rq) ga[d0][rq] = *(const v2u*)(grow + 32 * d0 + 8 * rq + 4 * hi);
}
__device__ __forceinline__ void attn_store_g(const AttnSt& st, const v2u (&ga)[2][4], bf16* yrow, int lane) {
    const int hi = lane >> 5;
    const float lt = st.l + __shfl_xor(st.l, 32), inv = 1.0f / lt;
#pragma unroll
    for (int d0 = 0; d0 < 2; ++d0)
#pragma unroll
        for (int rq = 0; rq < 4; ++rq) {
            const int d = 32 * d0 + 8 * rq + 4 * hi; const v2u g = ga[d0][rq]; const f32x16& o = d0 ? st.o1 : st.o0;
            v2u w; w.x = cvtpk_s(o[4 * rq + 0] * inv * bf_lo(g.x), o[4 * rq + 1] * inv * bf_hi(g.x)); w.y = cvtpk_s(o[4 * rq + 2] * inv * bf_lo(g.y), o[4 * rq + 3] * inv * bf_hi(g.y));
            *(v2u*)(yrow + d) = w;
        }
}
struct TileRegs { v4u kk[4]; v4u vv[4]; };
__device__ __forceinline__ void attn_load(TileRegs& R, int kvoff, const bf16* vp0, const bf16* vp1, const bf16* vp2, const bf16* vp3) {
    R.kk[0] = *(const v4u*)(vp0 - kvoff); R.kk[1] = *(const v4u*)(vp1 - kvoff); R.kk[2] = *(const v4u*)(vp2 - kvoff); R.kk[3] = *(const v4u*)(vp3 - kvoff);
    R.vv[0] = *(const v4u*)vp0; R.vv[1] = *(const v4u*)vp1; R.vv[2] = *(const v4u*)vp2; R.vv[3] = *(const v4u*)vp3;
}
__device__ __forceinline__ void attn_load_k(TileRegs& R, int kvoff, const bf16* vp0, const bf16* vp1, const bf16* vp2, const bf16* vp3) {
    R.kk[0] = *(const v4u*)(vp0 - kvoff); R.kk[1] = *(const v4u*)(vp1 - kvoff); R.kk[2] = *(const v4u*)(vp2 - kvoff); R.kk[3] = *(const v4u*)(vp3 - kvoff);
}
__device__ __forceinline__ void attn_load_v(TileRegs& R, const bf16* vp0, const bf16* vp1, const bf16* vp2, const bf16* vp3) {
    R.vv[0] = *(const v4u*)vp0; R.vv[1] = *(const v4u*)vp1; R.vv[2] = *(const v4u*)vp2; R.vv[3] = *(const v4u*)vp3;
}
template <int MODE>
__device__ __forceinline__ void attn_compute(AttnSt& st, const bf16x8 (&qf)[4], const TileRegs& R, LAS unsigned char* vl, int lane, bool keep, int dd0, int kmin) {
    const int r32 = lane & 31, hi = lane >> 5, grp = lane >> 4, qq = (lane & 15) >> 2, pp = lane & 3;
    LAS unsigned char* kl = vl + 32768;
#pragma unroll
    for (int it = 0; it < 4; ++it) { const int row = it * 8 + (lane >> 3); *(LAS v4u*)(kl + row * 128 + (((lane & 7) ^ (row & 7)) << 4)) = R.kk[it]; }
#pragma unroll
    for (int it = 0; it < 4; ++it) *(LAS v4u*)(vl + (it * 2 + ((lane & 7) >> 2)) * 512 + (lane >> 3) * 64 + (lane & 3) * 16) = R.vv[it];
    f32x16 s = f32x16{};
#pragma unroll
    for (int d0 = 0; d0 < 4; ++d0) {
        const v4u kw = *(const LAS v4u*)(kl + r32 * 128 + (((2 * d0 + hi) ^ (r32 & 7)) << 4));
        s = __builtin_amdgcn_mfma_f32_32x32x16_bf16(__builtin_bit_cast(bf16x8, kw), qf[d0], s, 0, 0, 0);
    }
    if (MODE == 1) {
#pragma unroll
        for (int r = 0; r < 16; ++r) if (crow(r, hi) > r32) s[r] = -INFINITY;
    } else if (MODE == 2) {
#pragma unroll
        for (int r = 0; r < 16; ++r) s[r] = keep ? s[r] : -INFINITY;
    } else if (MODE == 3) {
        const int ddh = dd0 - 4 * hi, kmh = kmin - 4 * hi;
#pragma unroll
        for (int r = 0; r < 16; ++r) { const int c = (r & 3) + 8 * (r >> 2); if ((unsigned)(ddh - c) > 128u || c < kmh) s[r] = -INFINITY; }
    }
    float mt = s[0];
#pragma unroll
    for (int r = 1; r < 16; ++r) mt = fmaxf(mt, s[r]);
    mt = fmaxf(mt, __shfl_xor(mt, 32));
    if (__any(mt > st.m + RESCALE_THR)) {
        const float mn = fmaxf(st.m, mt);
        const float f = __builtin_amdgcn_exp2f(st.m - mn); st.l *= f; st.m = mn;
#pragma unroll
        for (int r = 0; r < 16; ++r) { st.o0[r] *= f; st.o1[r] *= f; }
    }
    float ps = 0.f;
#pragma unroll
    for (int r = 0; r < 16; ++r) { s[r] = __builtin_amdgcn_exp2f(s[r] - st.m); ps += s[r]; }
    st.l += ps;
    v4u pw0, pw1;
    pw0.x = cvtpk_s(s[0], s[1]); pw0.y = cvtpk_s(s[2], s[3]); pw0.z = cvtpk_s(s[4], s[5]); pw0.w = cvtpk_s(s[6], s[7]);
    pw1.x = cvtpk_s(s[8], s[9]); pw1.y = cvtpk_s(s[10], s[11]); pw1.z = cvtpk_s(s[12], s[13]); pw1.w = cvtpk_s(s[14], s[15]);
    const bf16x8 pf0 = __builtin_bit_cast(bf16x8, pw0), pf1 = __builtin_bit_cast(bf16x8, pw1);
    const LAS unsigned char* tb = vl + (4 * hi + qq) * 64 + (16 * (grp & 1) + 4 * pp) * 2;
#define VFRAG(ks, d0) ({ const s16x4 lo_ = vtr(tb + ((2 * (ks)) * 2 + (d0)) * 512), hi_ = vtr(tb + ((2 * (ks) + 1) * 2 + (d0)) * 512); (bf16x8){lo_[0], lo_[1], lo_[2], lo_[3], hi_[0], hi_[1], hi_[2], hi_[3]}; })
    st.o0 = __builtin_amdgcn_mfma_f32_32x32x16_bf16(VFRAG(0, 0), pf0, st.o0, 0, 0, 0);
    st.o1 = __builtin_amdgcn_mfma_f32_32x32x16_bf16(VFRAG(0, 1), pf0, st.o1, 0, 0, 0);
    st.o0 = __builtin_amdgcn_mfma_f32_32x32x16_bf16(VFRAG(1, 0), pf1, st.o0, 0, 0, 0);
    st.o1 = __builtin_amdgcn_mfma_f32_32x32x16_bf16(VFRAG(1, 1), pf1, st.o1, 0, 0, 0);
#undef VFRAG
}

template <class MaskF>
__device__ __forceinline__ void attn_subtile_lds(AttnSt& st, const bf16x8 (&qf)[4], const LAS unsigned char* kb, const LAS unsigned char* vl, int lane, bool domask, MaskF mask) {
    const int r32 = lane & 31, hi = lane >> 5, grp = lane >> 4, qq = (lane & 15) >> 2, pp = lane & 3;
    f32x16 s = f32x16{};
#pragma unroll
    for (int d0 = 0; d0 < 4; ++d0) {
        const bf16x8 kf = *(const LAS bf16x8*)(kb + r32 * 128 + (((2 * d0 + hi) ^ (r32 & 7)) << 4));
        s = __builtin_amdgcn_mfma_f32_32x32x16_bf16(kf, qf[d0], s, 0, 0, 0);
    }
    if (domask) {
#pragma unroll
        for (int r = 0; r < 16; ++r) if (!mask(crow(r, hi))) s[r] = -INFINITY;
    }
    float mt = s[0];
#pragma unroll
    for (int r = 1; r < 16; ++r) mt = fmaxf(mt, s[r]);
    mt = fmaxf(mt, __shfl_xor(mt, 32));
    if (__any(mt > st.m + RESCALE_THR)) {
        const float mn = fmaxf(st.m, mt);
        const float f = __builtin_amdgcn_exp2f(st.m - mn); st.l *= f; st.m = mn;
#pragma unroll
        for (int r = 0; r < 16; ++r) { st.o0[r] *= f; st.o1[r] *= f; }
    }
    float ps = 0.f;
#pragma unroll
    for (int r = 0; r < 16; ++r) { s[r] = __builtin_amdgcn_exp2f(s[r] - st.m); ps += s[r]; }
    st.l += ps;
    v4u pw0, pw1;
    pw0.x = cvtpk_s(s[0], s[1]); pw0.y = cvtpk_s(s[2], s[3]); pw0.z = cvtpk_s(s[4], s[5]); pw0.w = cvtpk_s(s[6], s[7]);
    pw1.x = cvtpk_s(s[8], s[9]); pw1.y = cvtpk_s(s[10], s[11]); pw1.z = cvtpk_s(s[12], s[13]); pw1.w = cvtpk_s(s[14], s[15]);
    const bf16x8 pf0 = __builtin_bit_cast(bf16x8, pw0), pf1 = __builtin_bit_cast(bf16x8, pw1);
    const LAS unsigned char* tb = vl + (4 * hi + qq) * 64 + (16 * (grp & 1) + 4 * pp) * 2;
#define VFRAG(ks, d0) ({ const s16x4 lo_ = vtr(tb + ((2 * (ks)) * 2 + (d0)) * 512), hi_ = vtr(tb + ((2 * (ks) + 1) * 2 + (d0)) * 512); (bf16x8){lo_[0], lo_[1], lo_[2], lo_[3], hi_[0], hi_[1], hi_[2], hi_[3]}; })
    st.o0 = __builtin_amdgcn_mfma_f32_32x32x16_bf16(VFRAG(0, 0), pf0, st.o0, 0, 0, 0);
    st.o1 = __builtin_amdgcn_mfma_f32_32x32x16_bf16(VFRAG(0, 1), pf0, st.o1, 0, 0, 0);
    st.o0 = __builtin_amdgcn_mfma_f32_32x32x16_bf16(VFRAG(1, 0), pf1, st.o0, 0, 0, 0);
    st.o1 = __builtin_amdgcn_mfma_f32_32x32x16_bf16(VFRAG(1, 1), pf1, st.o1, 0, 0, 0);
#undef VFRAG
}
template <int M0, int M1>
__device__ __forceinline__ void attn_tile64_lds(AttnSt& st, const bf16x8 (&qf)[4], const LAS unsigned char* kb, const LAS unsigned char* vb, int lane, bool keep) {
    const int r32 = lane & 31, hi = lane >> 5, grp = lane >> 4, qq = (lane & 15) >> 2, pp = lane & 3;
    f32x16 s0 = f32x16{}, s1 = f32x16{};
#pragma unroll
    for (int d0 = 0; d0 < 4; ++d0) {
        const int ko = r32 * 128 + (((2 * d0 + hi) ^ (r32 & 7)) << 4);
        const v4u k0 = *(const LAS v4u*)(kb + ko), k1 = *(const LAS v4u*)(kb + 4096 + ko);
        s0 = __builtin_amdgcn_mfma_f32_32x32x16_bf16(__builtin_bit_cast(bf16x8, k0), qf[d0], s0, 0, 0, 0);
        s1 = __builtin_amdgcn_mfma_f32_32x32x16_bf16(__builtin_bit_cast(bf16x8, k1), qf[d0], s1, 0, 0, 0);
    }
    if (M0 == 1 || M1 == 1) {
#pragma unroll
        for (int r = 0; r < 16; ++r) {
            if (M0 == 1) { if (crow(r, hi) > r32) s0[r] = -INFINITY; }
            if (M1 == 1) { if (crow(r, hi) > r32) s1[r] = -INFINITY; }
        }
    }
    float mt = fmaxf(s0[0], s1[0]);
#pragma unroll
    for (int r = 1; r < 16; ++r) mt = fmaxf(mt, fmaxf(s0[r], s1[r]));
    mt = fmaxf(mt, __shfl_xor(mt, 32));
    if (__any(mt > st.m + RESCALE_THR)) {
        const float mn = fmaxf(st.m, mt);
        const float f = __builtin_amdgcn_exp2f(st.m - mn); st.l *= f; st.m = mn;
#pragma unroll
        for (int r = 0; r < 16; ++r) { st.o0[r] *= f; st.o1[r] *= f; }
    }
    const float mo = (M0 == 2 && !keep) ? INFINITY : st.m;
    const f32x2_t mo2 = {mo, mo}; f32x2_t acc2 = {0.f, 0.f};
#pragma unroll
    for (int r = 0; r < 16; r += 2) {
        f32x2_t v0 = (f32x2_t){s0[r], s0[r + 1]} - mo2, v1 = (f32x2_t){s1[r], s1[r + 1]} - mo2;
        v0.x = __builtin_amdgcn_exp2f(v0.x); v0.y = __builtin_amdgcn_exp2f(v0.y); v1.x = __builtin_amdgcn_exp2f(v1.x); v1.y = __builtin_amdgcn_exp2f(v1.y);
        acc2 += v0; acc2 += v1;
        s0[r] = v0.x; s0[r + 1] = v0.y; s1[r] = v1.x; s1[r + 1] = v1.y;
    }
    st.l += acc2.x + acc2.y;
    v4u p00, p01, p10, p11;
    p00.x = cvtpk_s(s0[0], s0[1]); p00.y = cvtpk_s(s0[2], s0[3]); p00.z = cvtpk_s(s0[4], s0[5]); p00.w = cvtpk_s(s0[6], s0[7]);
    p01.x = cvtpk_s(s0[8], s0[9]); p01.y = cvtpk_s(s0[10], s0[11]); p01.z = cvtpk_s(s0[12], s0[13]); p01.w = cvtpk_s(s0[14], s0[15]);
    p10.x = cvtpk_s(s1[0], s1[1]); p10.y = cvtpk_s(s1[2], s1[3]); p10.z = cvtpk_s(s1[4], s1[5]); p10.w = cvtpk_s(s1[6], s1[7]);
    p11.x = cvtpk_s(s1[8], s1[9]); p11.y = cvtpk_s(s1[10], s1[11]); p11.z = cvtpk_s(s1[12], s1[13]); p11.w = cvtpk_s(s1[14], s1[15]);
    const bf16x8 f00 = __builtin_bit_cast(bf16x8, p00), f01 = __builtin_bit_cast(bf16x8, p01), f10 = __builtin_bit_cast(bf16x8, p10), f11 = __builtin_bit_cast(bf16x8, p11);
    const LAS unsigned char* tb = vb + (4 * hi + qq) * 64 + (16 * (grp & 1) + 4 * pp) * 2;
#define VFRAG(sub, ks, d0) ({ const s16x4 lo_ = vtr(tb + (sub) * 4096 + ((2 * (ks)) * 2 + (d0)) * 512), hi_ = vtr(tb + (sub) * 4096 + ((2 * (ks) + 1) * 2 + (d0)) * 512); (bf16x8){lo_[0], lo_[1], lo_[2], lo_[3], hi_[0], hi_[1], hi_[2], hi_[3]}; })
    st.o0 = __builtin_amdgcn_mfma_f32_32x32x16_bf16(VFRAG(0, 0, 0), f00, st.o0, 0, 0, 0);
    st.o1 = __builtin_amdgcn_mfma_f32_32x32x16_bf16(VFRAG(0, 0, 1), f00, st.o1, 0, 0, 0);
    st.o0 = __builtin_amdgcn_mfma_f32_32x32x16_bf16(VFRAG(0, 1, 0), f01, st.o0, 0, 0, 0);
    st.o1 = __builtin_amdgcn_mfma_f32_32x32x16_bf16(VFRAG(0, 1, 1), f01, st.o1, 0, 0, 0);
    st.o0 = __builtin_amdgcn_mfma_f32_32x32x16_bf16(VFRAG(1, 0, 0), f10, st.o0, 0, 0, 0);
    st.o1 = __builtin_amdgcn_mfma_f32_32x32x16_bf16(VFRAG(1, 0, 1), f10, st.o1, 0, 0, 0);
    st.o0 = __builtin_amdgcn_mfma_f32_32x32x16_bf16(VFRAG(1, 1, 0), f11, st.o0, 0, 0, 0);
    st.o1 = __builtin_amdgcn_mfma_f32_32x32x16_bf16(VFRAG(1, 1, 1), f11, st.o1, 0, 0, 0);
#undef VFRAG
}
__device__ __forceinline__ void phase_moba_s(const Args& A, LAS unsigned char* lds, int G, int vcu, int wave, int lane) {
    const bf16* Z = (const bf16*)(A.ws + WS_Z); bf16* Y = (bf16*)(A.ws + WS_Y); const float* kmp = (const float*)(A.ws + WS_KMP);
    const int r32 = lane & 31, hi = lane >> 5, tid = wave * 64 + lane;
    const int skey = tid >> 3, sch = tid & 7;
    const int kwoff = skey * 128 + ((sch ^ (skey & 7)) << 4);
    const int vwoff = ((skey >> 3) * 2 + (sch >> 2)) * 512 + (skey & 7) * 64 + (sch & 3) * 16;
    for (int U = vcu; U < 2048; U += G) {
        const int it8 = U >> 8, v = U & 255, j = v & 7;
        const int blk = (it8 & 1) ? 15 - j : j, bh = (v >> 3) * 4 + (it8 >> 1);
        const int b = bh >> 3, hh = bh & 7, q0 = blk * 256 + 32 * wave;
        const size_t rowbase = (size_t)b * SEQ;
        const bf16* zq = Z + (rowbase + q0 + r32) * EVEN_IN;
        const bf16* Kh = Z + rowbase * EVEN_IN + 2048 + hh * 64 + (size_t)skey * EVEN_IN + 8 * sch; const bf16* Vh = Kh + 512;
        v4u kreg = *(const v4u*)(Kh + (size_t)(blk * 256) * EVEN_IN), vreg = *(const v4u*)(Vh + (size_t)(blk * 256) * EVEN_IN);
        bf16x8 qf[4];
#pragma unroll
        for (int d0 = 0; d0 < 4; ++d0) qf[d0] = *(const bf16x8*)(zq + 1536 + hh * 64 + 16 * d0 + 8 * hi);
        v2u gg[2][4]; attn_gate_load(gg, zq + 3072 + hh * 64, lane);
        unsigned sel = 0u;
        if (blk > 0) {
            f32x16 gt = f32x16{};
#pragma unroll
            for (int d0 = 0; d0 < 4; ++d0) {
                bf16x8 kmf = bf16x8{};
                if (r32 < 16) {
                    const float* p0 = kmp + (((size_t)b * 16 + r32) * 2) * 512 + hh * 64 + 16 * d0 + 8 * hi;
                    const f32x4 a0 = *(const f32x4*)p0, a1 = *(const f32x4*)(p0 + 4), b0 = *(const f32x4*)(p0 + 512), b1 = *(const f32x4*)(p0 + 516);
                    const f32x4 s0 = a0 + b0, s1 = a1 + b1;
                    v4u w; w.x = pk2(s0[0], s0[1]); w.y = pk2(s0[2], s0[3]); w.z = pk2(s1[0], s1[1]); w.w = pk2(s1[2], s1[3]);
                    kmf = __builtin_bit_cast(bf16x8, w);
                }
                gt = __builtin_amdgcn_mfma_f32_32x32x16_bf16(kmf, qf[d0], gt, 0, 0, 0);
            }
            float gv[16];
#pragma unroll
            for (int r = 0; r < 8; ++r) {
                const float mine = gt[r], oth = __shfl_xor(mine, 32);
                const float vlo = hi ? oth : mine, vhi = hi ? mine : oth;
                gv[(r & 3) + 8 * (r >> 2)] = vlo; gv[(r & 3) + 8 * (r >> 2) + 4] = vhi;
            }
#pragma unroll
            for (int n = 0; n < 16; ++n) if (n >= blk) gv[n] = -INFINITY;
#pragma unroll
            for (int it = 0; it < 3; ++it) {
                float best = -INFINITY; int bi = -1;
#pragma unroll
                for (int n = 0; n < 16; ++n) { const bool ok = (gv[n] > best) && !((sel >> n) & 1u); best = ok ? gv[n] : best; bi = ok ? n : bi; }
                if (bi >= 0) sel |= 1u << bi;
            }
        }
        AttnSt st; st.o0 = f32x16{}; st.o1 = f32x16{}; st.m = -1e30f; st.l = 0.f;
#define MB_LOAD(key0_) do { kreg = *(const v4u*)(Kh + (size_t)(key0_) * EVEN_IN); vreg = *(const v4u*)(Vh + (size_t)(key0_) * EVEN_IN); } while (0)
#define MB_STORE(buf_) do { *(LAS v4u*)(lds + (buf_) * 8192 + kwoff) = kreg; *(LAS v4u*)(lds + 16384 + (buf_) * 8192 + vwoff) = vreg; } while (0)
        MB_STORE(0);
        __syncthreads();
#pragma unroll 1
        for (int t = 0; t < 4; ++t) {
            const int buf = t & 1;
            if (t < 3) MB_LOAD(blk * 256 + 64 * (t + 1)); else if (blk > 0) MB_LOAD(0);
            const LAS unsigned char* kb = lds + buf * 8192; const LAS unsigned char* vb = lds + 16384 + buf * 8192;
            if (2 * t + 1 < wave) attn_tile64_lds<0, 0>(st, qf, kb, vb, lane, true);
            else if (2 * t + 1 == wave) attn_tile64_lds<0, 1>(st, qf, kb, vb, lane, true);
            else if (2 * t == wave) attn_subtile_lds(st, qf, kb, vb, lane, true, [&](int kk) { return kk <= r32; });
            if (t < 3 || blk > 0) MB_STORE(buf ^ 1);
            __syncthreads();
        }
        const int P = 4 * blk;
#pragma unroll 1
        for (int p = 0; p < P; ++p) {
            const int buf = p & 1;
            if (p + 1 < P) MB_LOAD(64 * (p + 1));
            const LAS unsigned char* kb = lds + buf * 8192; const LAS unsigned char* vb = lds + 16384 + buf * 8192;
            const bool mysel = (sel >> (p >> 2)) & 1u;
            if (__any(mysel)) {
                attn_tile64_lds<2, 2>(st, qf, kb, vb, lane, mysel);
            }
            if (p + 1 < P) MB_STORE(buf ^ 1);
            __syncthreads();
        }
#undef MB_LOAD
#undef MB_STORE
        attn_store_g(st, gg, Y + (rowbase + q0 + r32) * D + 512 + hh * 64, lane);
    }
}

__device__ __forceinline__ void phase_moba_old(const Args& A, LAS unsigned char* lds, int gwv, int NGW, int wave, int lane) {
    const bf16* Z = (const bf16*)(A.ws + WS_Z); bf16* Y = (bf16*)(A.ws + WS_Y); const float* kmp = (const float*)(A.ws + WS_KMP);
    LAS unsigned char* vl = lds + wave * 4096;
    const int r32 = lane & 31, hi = lane >> 5;
#ifdef OLD_NEWMAP
    for (int U = gwv >> 3; U < 2048; U += NGW >> 3) {
        const int it8 = U >> 8, v = U & 255, j = v & 7;
        const int blk = (it8 & 1) ? 15 - j : j, bh = (v >> 3) * 4 + (it8 >> 1);
        const int b = bh >> 3, hh = bh & 7, q0 = blk * 256 + 32 * wave;
#else
    for (int U = gwv; U < 16384; U += NGW) {
        const int rd = U >> 11, g2 = U & 2047, X = g2 >> 8, lwv = g2 & 255;
        const int bh = 16 * X + 2 * rd + (lwv >> 7); int gi = lwv & 127; if (rd & 1) gi = 127 - gi;
        const int b = bh >> 3, hh = bh & 7, q0 = gi * 32, blk = q0 >> 8;
#endif
        const size_t rowbase = (size_t)b * SEQ;
        const bf16* zq = Z + (rowbase + q0 + r32) * EVEN_IN;
        bf16x8 qf[4];
#pragma unroll
        for (int d0 = 0; d0 < 4; ++d0) qf[d0] = *(const bf16x8*)(zq + 1536 + hh * 64 + 16 * d0 + 8 * hi);
        unsigned sel = 0u;
        if (blk > 0) {
            f32x16 gt = f32x16{};
#pragma unroll
            for (int d0 = 0; d0 < 4; ++d0) {
                bf16x8 kmf = bf16x8{};
                if (r32 < 16) {
                    const float* p0 = kmp + (((size_t)b * 16 + r32) * 2) * 512 + hh * 64 + 16 * d0 + 8 * hi;
                    const f32x4 a0 = *(const f32x4*)p0, a1 = *(const f32x4*)(p0 + 4), b0 = *(const f32x4*)(p0 + 512), b1 = *(const f32x4*)(p0 + 516);
                    const f32x4 s0 = a0 + b0, s1 = a1 + b1;
                    v4u w; w.x = pk2(s0[0], s0[1]); w.y = pk2(s0[2], s0[3]); w.z = pk2(s1[0], s1[1]); w.w = pk2(s1[2], s1[3]);
                    kmf = __builtin_bit_cast(bf16x8, w);
                }
                gt = __builtin_amdgcn_mfma_f32_32x32x16_bf16(kmf, qf[d0], gt, 0, 0, 0);
            }
            float gv[16];
#pragma unroll
            for (int r = 0; r < 8; ++r) {
                const float mine = gt[r], oth = __shfl_xor(mine, 32);
                const float vlo = hi ? oth : mine, vhi = hi ? mine : oth;
                gv[(r & 3) + 8 * (r >> 2)] = vlo; gv[(r & 3) + 8 * (r >> 2) + 4] = vhi;
            }
#pragma unroll
            for (int n = 0; n < 16; ++n) if (n >= blk) gv[n] = -INFINITY;
#pragma unroll
            for (int it = 0; it < 3; ++it) {
                float best = -INFINITY; int bi = -1;
#pragma unroll
                for (int n = 0; n < 16; ++n) { const bool ok = (gv[n] > best) && !((sel >> n) & 1u); best = ok ? gv[n] : best; bi = ok ? n : bi; }
                if (bi >= 0) sel |= 1u << bi;
            }
        }
        AttnSt st; st.o0 = f32x16{}; st.o1 = f32x16{}; st.m = -1e30f; st.l = 0.f;
        const bf16* Kh = Z + rowbase * EVEN_IN + 2048 + hh * 64; const bf16* Vh = Z + rowbase * EVEN_IN + 2560 + hh * 64;
        const size_t vrow8 = (size_t)8 * EVEN_IN;
        const int ndiag = (q0 & 255) >> 5;
        for (int kt = 0; kt <= ndiag; ++kt) {
            const size_t k0 = (size_t)blk * 256 + kt * 32;
            const bf16* vp = Vh + (k0 + (lane >> 3)) * EVEN_IN + 8 * (lane & 7);
            attn_tile(st, qf, Kh + (k0 + r32) * EVEN_IN + 8 * hi, vp, vp + vrow8, vp + 2 * vrow8, vp + 3 * vrow8, vl, lane, kt == ndiag, [&](int kk) { return kk <= r32; });
        }
        for (int n = 0; n < blk; ++n) {
            const bool mysel = (sel >> n) & 1u;
            if (!__any(mysel)) continue;
            for (int kt = 0; kt < 8; ++kt) {
                const size_t k0 = (size_t)n * 256 + kt * 32;
                const bf16* vp = Vh + (k0 + (lane >> 3)) * EVEN_IN + 8 * (lane & 7);
                attn_tile(st, qf, Kh + (k0 + r32) * EVEN_IN + 8 * hi, vp, vp + vrow8, vp + 2 * vrow8, vp + 3 * vrow8, vl, lane, true, [&](int) { return mysel; });
            }
        }
        attn_store(st, zq + 3072 + hh * 64, Y + (rowbase + q0 + r32) * D + 512 + hh * 64, lane);
    }
}


__device__ __forceinline__ void phase_moba_p(const Args& A, LAS unsigned char* lds, int gwv, int NGW, int wave, int lane) {
    const bf16* Z = (const bf16*)(A.ws + WS_Z); bf16* Y = (bf16*)(A.ws + WS_Y); const float* kmp = (const float*)(A.ws + WS_KMP);
    LAS unsigned char* vl = lds + wave * 4096;
    const int r32 = lane & 31, hi = lane >> 5;
    for (int U = gwv; U < 16384; U += NGW) {
        const int rd = U >> 11, g2 = U & 2047, X = g2 >> 8, lwv = g2 & 255;
        const int bh = 16 * X + 2 * rd + (lwv >> 7); int gi = lwv & 127; if (rd & 1) gi = 127 - gi;
        const int b = bh >> 3, hh = bh & 7, q0 = gi * 32, blk = q0 >> 8;
        const size_t rowbase = (size_t)b * SEQ;
        const bf16* zq = Z + (rowbase + q0 + r32) * EVEN_IN;
        bf16x8 qf[4];
#pragma unroll
        for (int d0 = 0; d0 < 4; ++d0) qf[d0] = *(const bf16x8*)(zq + 1536 + hh * 64 + 16 * d0 + 8 * hi);
        unsigned sel = 0u;
        if (blk > 0) {
            f32x16 gt = f32x16{};
#pragma unroll
            for (int d0 = 0; d0 < 4; ++d0) {
                bf16x8 kmf = bf16x8{};
                if (r32 < 16) {
                    const float* p0 = kmp + (((size_t)b * 16 + r32) * 2) * 512 + hh * 64 + 16 * d0 + 8 * hi;
                    const f32x4 a0 = *(const f32x4*)p0, a1 = *(const f32x4*)(p0 + 4), b0 = *(const f32x4*)(p0 + 512), b1 = *(const f32x4*)(p0 + 516);
                    const f32x4 s0 = a0 + b0, s1 = a1 + b1;
                    v4u w; w.x = pk2(s0[0], s0[1]); w.y = pk2(s0[2], s0[3]); w.z = pk2(s1[0], s1[1]); w.w = pk2(s1[2], s1[3]);
                    kmf = __builtin_bit_cast(bf16x8, w);
                }
                gt = __builtin_amdgcn_mfma_f32_32x32x16_bf16(kmf, qf[d0], gt, 0, 0, 0);
            }
            float gv[16];
#pragma unroll
            for (int r = 0; r < 8; ++r) {
                const float mine = gt[r], oth = __shfl_xor(mine, 32);
                const float vlo = hi ? oth : mine, vhi = hi ? mine : oth;
                gv[(r & 3) + 8 * (r >> 2)] = vlo; gv[(r & 3) + 8 * (r >> 2) + 4] = vhi;
            }
#pragma unroll
            for (int n = 0; n < 16; ++n) if (n >= blk) gv[n] = -INFINITY;
#pragma unroll
            for (int it = 0; it < 3; ++it) {
                float best = -INFINITY; int bi = -1;
#pragma unroll
                for (int n = 0; n < 16; ++n) { const bool ok = (gv[n] > best) && !((sel >> n) & 1u); best = ok ? gv[n] : best; bi = ok ? n : bi; }
                if (bi >= 0) sel |= 1u << bi;
            }
        }
        unsigned anym = 0u;
#pragma unroll
        for (int n = 0; n < 15; ++n) if (__any((sel >> n) & 1u)) anym |= 1u << n;
        anym = (unsigned)__builtin_amdgcn_readfirstlane((int)anym);
        AttnSt st; st.o0 = f32x16{}; st.o1 = f32x16{}; st.m = -1e30f; st.l = 0.f;
        const bf16* Kh = Z + rowbase * EVEN_IN + 2048 + hh * 64; const bf16* Vh = Z + rowbase * EVEN_IN + 2560 + hh * 64;
        const size_t vrow8 = (size_t)8 * EVEN_IN;
        const int ndiag = (q0 & 255) >> 5;
#define MB_LOADT(R, nn, kk_) do { const size_t k0_ = (size_t)((nn) < 0 ? blk : (nn)) * 256 + (kk_) * 32; const bf16* vp_ = Vh + (k0_ + (lane >> 3)) * EVEN_IN + 8 * (lane & 7); \
            attn_load(R, 512, vp_, vp_ + vrow8, vp_ + 2 * vrow8, vp_ + 3 * vrow8); } while (0)
#define MB_COMP(R, nn, kk_) do { if ((nn) < 0) { if ((kk_) == ndiag) attn_compute<1>(st, qf, R, vl, lane, true, 0, 0); else attn_compute<0>(st, qf, R, vl, lane, true, 0, 0); } \
            else attn_compute<2>(st, qf, R, vl, lane, ((sel >> (nn)) & 1u) != 0u, 0, 0); } while (0)
#define MB_ADV(nn, kk_, more) do { more = true; if ((nn) < 0) { if ((kk_) < ndiag) ++(kk_); else { (kk_) = 0; if (anym) (nn) = __builtin_ctz(anym); else more = false; } } \
            else if ((kk_) < 7) ++(kk_); else { (kk_) = 0; const unsigned rest_ = anym & ~((2u << (nn)) - 1u); if (rest_) (nn) = __builtin_ctz(rest_); else more = false; } } while (0)
        TileRegs RA, RB; int cn = -1, ck = 0;
        MB_LOADT(RA, cn, ck);
        for (;;) {
            int nn = cn, nk = ck; bool more; MB_ADV(nn, nk, more);
            if (more) MB_LOADT(RB, nn, nk);
            MB_COMP(RA, cn, ck);
            if (!more) break;
            cn = nn; ck = nk; MB_ADV(nn, nk, more);
            if (more) MB_LOADT(RA, nn, nk);
            MB_COMP(RB, cn, ck);
            if (!more) break;
            cn = nn; ck = nk;
        }
#undef MB_LOADT
#undef MB_COMP
#undef MB_ADV
        attn_store(st, zq + 3072 + hh * 64, Y + (rowbase + q0 + r32) * D + 512 + hh * 64, lane);
    }
}

__device__ __forceinline__ void phase_dilated_p(const Args& A, LAS unsigned char* lds, int gwv, int NGW, int wave, int lane) {
    const bf16* Z = (const bf16*)(A.ws + WS_Z); bf16* Y = (bf16*)(A.ws + WS_Y);
    LAS unsigned char* vl = lds + wave * 4096;
    const int r32 = lane & 31, hi = lane >> 5;
    for (int U = gwv; U < 32768; U += NGW) {
        const int rd = U >> 11, g2 = U & 2047, X = g2 >> 8, lwv = g2 & 255;
        const int bh = 32 * X + 2 * rd + (lwv >> 7), gi = lwv & 127, c = gi >> 4, r16 = gi & 15;
        const int b = bh >> 4, hh = bh & 15;
        const size_t rowbase = (size_t)b * SEQ;
        const int tq = 512 * c + r16 + 16 * r32;
        const bf16* zq = Z + (rowbase + tq) * ODD_IN;
        bf16x8 qf[4];
#pragma unroll
        for (int d0 = 0; d0 < 4; ++d0) qf[d0] = *(const bf16x8*)(zq + hh * 64 + 16 * d0 + 8 * hi);
        AttnSt st; st.o0 = f32x16{}; st.o1 = f32x16{}; st.m = -1e30f; st.l = 0.f;
        const bf16* Kh = Z + rowbase * ODD_IN + 1024 + hh * 64; const bf16* Vh = Z + rowbase * ODD_IN + 2048 + hh * 64;
#define DL_DIL(cfg) ((cfg) == 0 ? 16 : (cfg) == 1 ? 4 : 1)
#define DL_NT(cfg) ((cfg) == 0 ? 5 : (cfg) == 1 ? 8 : 20)
#define DL_MBASE(cfg) ((512 * c + r16 - (r16 & (DL_DIL(cfg) - 1))) / DL_DIL(cfg) - 128)
#define DL_TAU0(cfg) (DL_MBASE(cfg) < 0 ? (-DL_MBASE(cfg)) / 32 : 0)
#define DL_LOADT(R, cfg, tau) do { const int dil_ = DL_DIL(cfg), rdl_ = r16 & (dil_ - 1), m0_ = DL_MBASE(cfg) + 32 * (tau); \
            const int mv_ = m0_ + (lane >> 3); const int mv0_ = mv_ < 0 ? 0 : mv_, mv1_ = mv_ + 8 < 0 ? 0 : mv_ + 8, mv2_ = mv_ + 16 < 0 ? 0 : mv_ + 16, mv3_ = mv_ + 24 < 0 ? 0 : mv_ + 24; \
            const bf16* vb_ = Vh + (size_t)rdl_ * ODD_IN + 8 * (lane & 7); const size_t vst_ = (size_t)dil_ * ODD_IN; \
            attn_load(R, 1024, vb_ + mv0_ * vst_, vb_ + mv1_ * vst_, vb_ + mv2_ * vst_, vb_ + mv3_ * vst_); } while (0)
#define DL_COMP(R, cfg, tau) do { const int m0_ = DL_MBASE(cfg) + 32 * (tau); \
            if ((cfg) == 0 && (tau) >= 1 && (tau) <= 3 && m0_ >= 0) attn_compute<0>(st, qf, R, vl, lane, true, 0, 0); \
            else attn_compute<3>(st, qf, R, vl, lane, true, 128 + (16 / DL_DIL(cfg)) * r32 - 32 * (tau), -m0_); } while (0)
#define DL_ADV(cfg, tau, more) do { more = true; if ((tau) + 1 < DL_NT(cfg)) ++(tau); else if ((cfg) < 2) { ++(cfg); (tau) = DL_TAU0(cfg); } else more = false; } while (0)
        TileRegs RA, RB; int cc = 0, ct = DL_TAU0(0);
        DL_LOADT(RA, cc, ct);
        for (;;) {
            int nc = cc, nt = ct; bool more; DL_ADV(nc, nt, more);
            if (more) DL_LOADT(RB, nc, nt);
            DL_COMP(RA, cc, ct);
            if (!more) break;
            cc = nc; ct = nt; DL_ADV(nc, nt, more);
            if (more) DL_LOADT(RA, nc, nt);
            DL_COMP(RB, cc, ct);
            if (!more) break;
            cc = nc; ct = nt;
        }
#undef DL_DIL
#undef DL_NT
#undef DL_MBASE
#undef DL_TAU0
#undef DL_LOADT
#undef DL_COMP
#undef DL_ADV
        attn_store(st, zq + 3072 + hh * 64, Y + (rowbase + tq) * D + hh * 64, lane);
    }
}


__device__ __forceinline__ void attn_stage2(const TileRegs& RA, const TileRegs& RB, LAS unsigned char* wl, int lane) {
    LAS unsigned char* vla = wl; LAS unsigned char* vlb = wl + 4096; LAS unsigned char* kla = wl + 8192; LAS unsigned char* klb = wl + 12288;
#pragma unroll
    for (int it = 0; it < 4; ++it) { const int row = it * 8 + (lane >> 3); const int ko = row * 128 + (((lane & 7) ^ (row & 7)) << 4); *(LAS v4u*)(kla + ko) = RA.kk[it]; *(LAS v4u*)(klb + ko) = RB.kk[it]; }
#pragma unroll
    for (int it = 0; it < 4; ++it) { const int vo = (it * 2 + ((lane & 7) >> 2)) * 512 + (lane >> 3) * 64 + (lane & 3) * 16; *(LAS v4u*)(vla + vo) = RA.vv[it]; *(LAS v4u*)(vlb + vo) = RB.vv[it]; }
}
template <int MODE, class MidF>
__device__ __forceinline__ void attn_compute2_lds(AttnSt& a, AttnSt& b, const bf16x8 (&qa)[4], const bf16x8 (&qb)[4], LAS unsigned char* wl, int lane, int dd0, int kmina, int kminb, MidF mid) {
    const int r32 = lane & 31, hi = lane >> 5, grp = lane >> 4, qq = (lane & 15) >> 2, pp = lane & 3;
    LAS unsigned char* vla = wl; LAS unsigned char* vlb = wl + 4096; LAS unsigned char* kla = wl + 8192; LAS unsigned char* klb = wl + 12288;
    f32x16 sa = f32x16{}, sb = f32x16{};
#pragma unroll
    for (int d0 = 0; d0 < 4; ++d0) {
        const int ko = r32 * 128 + (((2 * d0 + hi) ^ (r32 & 7)) << 4);
        const v4u kwa = *(const LAS v4u*)(kla + ko), kwb = *(const LAS v4u*)(klb + ko);
        sa = __builtin_amdgcn_mfma_f32_32x32x16_bf16(__builtin_bit_cast(bf16x8, kwa), qa[d0], sa, 0, 0, 0);
        sb = __builtin_amdgcn_mfma_f32_32x32x16_bf16(__builtin_bit_cast(bf16x8, kwb), qb[d0], sb, 0, 0, 0);
    }
    if (MODE == 3) {
        const int ddh = dd0 - 4 * hi, kma = kmina - 4 * hi, kmb = kminb - 4 * hi;
#pragma unroll
        for (int r = 0; r < 16; ++r) { const int c = (r & 3) + 8 * (r >> 2); const bool band = (unsigned)(ddh - c) <= 128u; if (!band || c < kma) sa[r] = -INFINITY; if (!band || c < kmb) sb[r] = -INFINITY; }
    }
    float mta = sa[0], mtb = sb[0];
#pragma unroll
    for (int r = 1; r < 16; ++r) { mta = fmaxf(mta, sa[r]); mtb = fmaxf(mtb, sb[r]); }
    mta = fmaxf(mta, __shfl_xor(mta, 32)); mtb = fmaxf(mtb, __shfl_xor(mtb, 32));
    if (__any(mta > a.m + RESCALE_THR || mtb > b.m + RESCALE_THR)) {
        const float mna_ = fmaxf(a.m, mta), mnb_ = fmaxf(b.m, mtb);
        const float fa = __builtin_amdgcn_exp2f(a.m - mna_), fb = __builtin_amdgcn_exp2f(b.m - mnb_);
        a.l *= fa; a.m = mna_; b.l *= fb; b.m = mnb_;
#pragma unroll
        for (int r = 0; r < 16; ++r) { a.o0[r] *= fa; a.o1[r] *= fa; b.o0[r] *= fb; b.o1[r] *= fb; }
    }
    const float mna = a.m, mnb = b.m;
    float psa = 0.f, psb = 0.f;
#pragma unroll
    for (int r = 0; r < 16; ++r) { sa[r] = __builtin_amdgcn_exp2f(sa[r] - mna); sb[r] = __builtin_amdgcn_exp2f(sb[r] - mnb); psa += sa[r]; psb += sb[r]; }
    a.l += psa; b.l += psb;
    v4u pa0, pa1, pb0, pb1;
    pa0.x = cvtpk_s(sa[0], sa[1]); pa0.y = cvtpk_s(sa[2], sa[3]); pa0.z = cvtpk_s(sa[4], sa[5]); pa0.w = cvtpk_s(sa[6], sa[7]);
    pa1.x = cvtpk_s(sa[8], sa[9]); pa1.y = cvtpk_s(sa[10], sa[11]); pa1.z = cvtpk_s(sa[12], sa[13]); pa1.w = cvtpk_s(sa[14], sa[15]);
    pb0.x = cvtpk_s(sb[0], sb[1]); pb0.y = cvtpk_s(sb[2], sb[3]); pb0.z = cvtpk_s(sb[4], sb[5]); pb0.w = cvtpk_s(sb[6], sb[7]);
    pb1.x = cvtpk_s(sb[8], sb[9]); pb1.y = cvtpk_s(sb[10], sb[11]); pb1.z = cvtpk_s(sb[12], sb[13]); pb1.w = cvtpk_s(sb[14], sb[15]);
    const bf16x8 fa0 = __builtin_bit_cast(bf16x8, pa0), fa1 = __builtin_bit_cast(bf16x8, pa1), fb0 = __builtin_bit_cast(bf16x8, pb0), fb1 = __builtin_bit_cast(bf16x8, pb1);
    __builtin_amdgcn_sched_barrier(0); mid(); __builtin_amdgcn_sched_barrier(0);
    const int to = (4 * hi + qq) * 64 + (16 * (grp & 1) + 4 * pp) * 2;
#define VFRAG2(base, ks, d0) ({ const s16x4 lo_ = vtr((base) + to + ((2 * (ks)) * 2 + (d0)) * 512), hi_ = vtr((base) + to + ((2 * (ks) + 1) * 2 + (d0)) * 512); (bf16x8){lo_[0], lo_[1], lo_[2], lo_[3], hi_[0], hi_[1], hi_[2], hi_[3]}; })
    a.o0 = __builtin_amdgcn_mfma_f32_32x32x16_bf16(VFRAG2(vla, 0, 0), fa0, a.o0, 0, 0, 0);
    b.o0 = __builtin_amdgcn_mfma_f32_32x32x16_bf16(VFRAG2(vlb, 0, 0), fb0, b.o0, 0, 0, 0);
    a.o1 = __builtin_amdgcn_mfma_f32_32x32x16_bf16(VFRAG2(vla, 0, 1), fa0, a.o1, 0, 0, 0);
    b.o1 = __builtin_amdgcn_mfma_f32_32x32x16_bf16(VFRAG2(vlb, 0, 1), fb0, b.o1, 0, 0, 0);
    a.o0 = __builtin_amdgcn_mfma_f32_32x32x16_bf16(VFRAG2(vla, 1, 0), fa1, a.o0, 0, 0, 0);
    b.o0 = __builtin_amdgcn_mfma_f32_32x32x16_bf16(VFRAG2(vlb, 1, 0), fb1, b.o0, 0, 0, 0);
    a.o1 = __builtin_amdgcn_mfma_f32_32x32x16_bf16(VFRAG2(vla, 1, 1), fa1, a.o1, 0, 0, 0);
    b.o1 = __builtin_amdgcn_mfma_f32_32x32x16_bf16(VFRAG2(vlb, 1, 1), fb1, b.o1, 0, 0, 0);
#undef VFRAG2
}
template <int MODE, class PreF, class MidF>
__device__ __forceinline__ void attn_compute2_kv(AttnSt& a, AttnSt& b, const bf16x8 (&qa)[4], const bf16x8 (&qb)[4], TileRegs& RA, TileRegs& RB, LAS unsigned char* wl, int lane, int dd0, int kmina, int kminb, PreF pre, MidF mid) {
    const int r32 = lane & 31, hi = lane >> 5, grp = lane >> 4, qq = (lane & 15) >> 2, pp = lane & 3;
    LAS unsigned char* vla = wl; LAS unsigned char* vlb = wl + 4096; LAS unsigned char* kla = wl + 8192; LAS unsigned char* klb = wl + 12288;
#pragma unroll
    for (int it = 0; it < 4; ++it) { const int row = it * 8 + (lane >> 3); const int ko = row * 128 + (((lane & 7) ^ (row & 7)) << 4); *(LAS v4u*)(kla + ko) = RA.kk[it]; *(LAS v4u*)(klb + ko) = RB.kk[it]; }
    pre();
#pragma unroll
    for (int it = 0; it < 4; ++it) { const int vo = (it * 2 + ((lane & 7) >> 2)) * 512 + (lane >> 3) * 64 + (lane & 3) * 16; *(LAS v4u*)(vla + vo) = RA.vv[it]; *(LAS v4u*)(vlb + vo) = RB.vv[it]; }
    f32x16 sa = f32x16{}, sb = f32x16{};
#pragma unroll
    for (int d0 = 0; d0 < 4; ++d0) {
        const int ko = r32 * 128 + (((2 * d0 + hi) ^ (r32 & 7)) << 4);
        const v4u kwa = *(const LAS v4u*)(kla + ko), kwb = *(const LAS v4u*)(klb + ko);
        sa = __builtin_amdgcn_mfma_f32_32x32x16_bf16(__builtin_bit_cast(bf16x8, kwa), qa[d0], sa, 0, 0, 0);
        sb = __builtin_amdgcn_mfma_f32_32x32x16_bf16(__builtin_bit_cast(bf16x8, kwb), qb[d0], sb, 0, 0, 0);
    }
    if (MODE == 3) {
        const int ddh = dd0 - 4 * hi;
        if (kmina <= 0 && kminb <= 0) {
#pragma unroll
            for (int r = 0; r < 16; ++r) { const int c = (r & 3) + 8 * (r >> 2); const bool band = (unsigned)(ddh - c) <= 128u; sa[r] = band ? sa[r] : -INFINITY; sb[r] = band ? sb[r] : -INFINITY; }
        } else {
            const int kma = kmina - 4 * hi, kmb = kminb - 4 * hi;
#pragma unroll
            for (int r = 0; r < 16; ++r) { const int c = (r & 3) + 8 * (r >> 2); const bool band = (unsigned)(ddh - c) <= 128u; if (!band || c < kma) sa[r] = -INFINITY; if (!band || c < kmb) sb[r] = -INFINITY; }
        }
    }
    float mta = sa[0], mtb = sb[0];
#pragma unroll
    for (int r = 1; r < 16; ++r) { mta = fmaxf(mta, sa[r]); mtb = fmaxf(mtb, sb[r]); }
    mta = fmaxf(mta, __shfl_xor(mta, 32)); mtb = fmaxf(mtb, __shfl_xor(mtb, 32));
    if (__any(mta > a.m + RESCALE_THR || mtb > b.m + RESCALE_THR)) {
        const float mna_ = fmaxf(a.m, mta), mnb_ = fmaxf(b.m, mtb);
        const float fa = __builtin_amdgcn_exp2f(a.m - mna_), fb = __builtin_amdgcn_exp2f(b.m - mnb_);
        a.l *= fa; a.m = mna_; b.l *= fb; b.m = mnb_;
#pragma unroll
        for (int r = 0; r < 16; ++r) { a.o0[r] *= fa; a.o1[r] *= fa; b.o0[r] *= fb; b.o1[r] *= fb; }
    }
    const float mna = a.m, mnb = b.m;
    const f32x2_t ma2 = {mna, mna}, mb2 = {mnb, mnb}; f32x2_t acca = {0.f, 0.f}, accb = {0.f, 0.f};
#pragma unroll
    for (int r = 0; r < 16; r += 2) {
        f32x2_t va = (f32x2_t){sa[r], sa[r + 1]} - ma2, vb = (f32x2_t){sb[r], sb[r + 1]} - mb2;
        va.x = __builtin_amdgcn_exp2f(va.x); va.y = __builtin_amdgcn_exp2f(va.y); vb.x = __builtin_amdgcn_exp2f(vb.x); vb.y = __builtin_amdgcn_exp2f(vb.y);
        acca += va; accb += vb;
        sa[r] = va.x; sa[r + 1] = va.y; sb[r] = vb.x; sb[r + 1] = vb.y;
    }
    a.l += acca.x + acca.y; b.l += accb.x + accb.y;
    v4u pa0, pa1, pb0, pb1;
    pa0.x = cvtpk_s(sa[0], sa[1]); pa0.y = cvtpk_s(sa[2], sa[3]); pa0.z = cvtpk_s(sa[4], sa[5]); pa0.w = cvtpk_s(sa[6], sa[7]);
    pa1.x = cvtpk_s(sa[8], sa[9]); pa1.y = cvtpk_s(sa[10], sa[11]); pa1.z = cvtpk_s(sa[12], sa[13]); pa1.w = cvtpk_s(sa[14], sa[15]);
    pb0.x = cvtpk_s(sb[0], sb[1]); pb0.y = cvtpk_s(sb[2], sb[3]); pb0.z = cvtpk_s(sb[4], sb[5]); pb0.w = cvtpk_s(sb[6], sb[7]);
    pb1.x = cvtpk_s(sb[8], sb[9]); pb1.y = cvtpk_s(sb[10], sb[11]); pb1.z = cvtpk_s(sb[12], sb[13]); pb1.w = cvtpk_s(sb[14], sb[15]);
    const bf16x8 fa0 = __builtin_bit_cast(bf16x8, pa0), fa1 = __builtin_bit_cast(bf16x8, pa1), fb0 = __builtin_bit_cast(bf16x8, pb0), fb1 = __builtin_bit_cast(bf16x8, pb1);
    __builtin_amdgcn_sched_barrier(0); mid(); __builtin_amdgcn_sched_barrier(0);
    const int to = (4 * hi + qq) * 64 + (16 * (grp & 1) + 4 * pp) * 2;
#define VFRAG2(base, ks, d0) ({ const s16x4 lo_ = vtr((base) + to + ((2 * (ks)) * 2 + (d0)) * 512), hi_ = vtr((base) + to + ((2 * (ks) + 1) * 2 + (d0)) * 512); (bf16x8){lo_[0], lo_[1], lo_[2], lo_[3], hi_[0], hi_[1], hi_[2], hi_[3]}; })
    a.o0 = __builtin_amdgcn_mfma_f32_32x32x16_bf16(VFRAG2(vla, 0, 0), fa0, a.o0, 0, 0, 0);
    b.o0 = __builtin_amdgcn_mfma_f32_32x32x16_bf16(VFRAG2(vlb, 0, 0), fb0, b.o0, 0, 0, 0);
    a.o1 = __builtin_amdgcn_mfma_f32_32x32x16_bf16(VFRAG2(vla, 0, 1), fa0, a.o1, 0, 0, 0);
    b.o1 = __builtin_amdgcn_mfma_f32_32x32x16_bf16(VFRAG2(vlb, 0, 1), fb0, b.o1, 0, 0, 0);
    a.o0 = __builtin_amdgcn_mfma_f32_32x32x16_bf16(VFRAG2(vla, 1, 0), fa1, a.o0, 0, 0, 0);
    b.o0 = __builtin_amdgcn_mfma_f32_32x32x16_bf16(VFRAG2(vlb, 1, 0), fb1, b.o0, 0, 0, 0);
    a.o1 = __builtin_amdgcn_mfma_f32_32x32x16_bf16(VFRAG2(vla, 1, 1), fa1, a.o1, 0, 0, 0);
    b.o1 = __builtin_amdgcn_mfma_f32_32x32x16_bf16(VFRAG2(vlb, 1, 1), fb1, b.o1, 0, 0, 0);
#undef VFRAG2
}
template <int MODE>
__device__ __forceinline__ void attn_compute2(AttnSt& a, AttnSt& b, const bf16x8 (&qa)[4], const bf16x8 (&qb)[4], const TileRegs& RA, const TileRegs& RB, LAS unsigned char* wl, int lane, int dd0, int kmina, int kminb) {
    attn_stage2(RA, RB, wl, lane); attn_compute2_lds<MODE>(a, b, qa, qb, wl, lane, dd0, kmina, kminb, [] {});
}

__device__ __forceinline__ void phase_dilated_2(const Args& A, LAS unsigned char* lds, int gwv, int NGW, int wave, int lane) {
    const bf16* Z = (const bf16*)(A.ws + WS_Z); bf16* Y = (bf16*)(A.ws + WS_Y);
    LAS unsigned char* wl = lds + wave * 16384;
    const int r32 = lane & 31, hi = lane >> 5;
    for (int U = gwv; U < 16384; U += NGW) {
        const int rd = U >> 10, g2 = U & 1023, X = g2 >> 7, lp = g2 & 127;
        const int bh = 32 * X + 2 * rd + (lp >> 6), pi = lp & 63, c = pi >> 3, r16a = 2 * (pi & 7);
        const int b = bh >> 4, hh = bh & 15;
        const size_t rowbase = (size_t)b * SEQ;
        const int tqa = 512 * c + r16a + 16 * r32;
        const bf16* zqa = Z + (rowbase + tqa) * ODD_IN; const bf16* zqb = zqa + ODD_IN;
        bf16x8 qa[4], qb[4];
#pragma unroll
        for (int d0 = 0; d0 < 4; ++d0) { qa[d0] = *(const bf16x8*)(zqa + hh * 64 + 16 * d0 + 8 * hi); qb[d0] = *(const bf16x8*)(zqb + hh * 64 + 16 * d0 + 8 * hi); }
        AttnSt sa, sb; sa.o0 = f32x16{}; sa.o1 = f32x16{}; sa.m = -1e30f; sa.l = 0.f; sb.o0 = f32x16{}; sb.o1 = f32x16{}; sb.m = -1e30f; sb.l = 0.f;
        const bf16* Vh = Z + rowbase * ODD_IN + 2048 + hh * 64 + 8 * (lane & 7);
#pragma unroll 1
        for (int cfg = 0; cfg < 3; ++cfg) {
            const int dil = (cfg == 0) ? 16 : (cfg == 1) ? 4 : 1, sstep = 16 / dil, ntile = (cfg == 0) ? 5 : (cfg == 1) ? 8 : 20;
            const int rdla = r16a & (dil - 1), rdlb = (r16a + 1) & (dil - 1);
            const int mba = (512 * c + r16a - rdla) / dil - 128, mbb = (512 * c + r16a + 1 - rdlb) / dil - 128;
            const int tau0 = mbb < 0 ? (-mbb) / 32 : 0;
            const size_t vst = (size_t)dil * ODD_IN;
#pragma unroll 1
            for (int tau = tau0; tau < ntile; ++tau) {
                TileRegs RA, RB;
                { const int mv = mba + 32 * tau + (lane >> 3); const int m0_ = mv < 0 ? 0 : mv, m1_ = mv + 8 < 0 ? 0 : mv + 8, m2_ = mv + 16 < 0 ? 0 : mv + 16, m3_ = mv + 24 < 0 ? 0 : mv + 24;
                  const bf16* vb = Vh + (size_t)rdla * ODD_IN; attn_load(RA, 1024, vb + m0_ * vst, vb + m1_ * vst, vb + m2_ * vst, vb + m3_ * vst); }
                { const int mv = mbb + 32 * tau + (lane >> 3); const int m0_ = mv < 0 ? 0 : mv, m1_ = mv + 8 < 0 ? 0 : mv + 8, m2_ = mv + 16 < 0 ? 0 : mv + 16, m3_ = mv + 24 < 0 ? 0 : mv + 24;
                  const bf16* vb = Vh + (size_t)rdlb * ODD_IN; attn_load(RB, 1024, vb + m0_ * vst, vb + m1_ * vst, vb + m2_ * vst, vb + m3_ * vst); }
                attn_compute2<3>(sa, sb, qa, qb, RA, RB, wl, lane, 128 + sstep * r32 - 32 * tau, -(mba + 32 * tau), -(mbb + 32 * tau));
            }
        }
        attn_store(sa, zqa + 3072 + hh * 64, Y + (rowbase + tqa) * D + hh * 64, lane);
        attn_store(sb, zqb + 3072 + hh * 64, Y + (rowbase + tqa + 1) * D + hh * 64, lane);
    }
}


__device__ __forceinline__ void attn_state_store(const AttnSt& st, bf16* orow, float* lsep, int lane) {
    const int hi = lane >> 5;
    const float lt = st.l + __shfl_xor(st.l, 32), inv = 1.0f / lt;
#pragma unroll
    for (int d0 = 0; d0 < 2; ++d0)
#pragma unroll
        for (int rq = 0; rq < 4; ++rq) {
            const int d = 32 * d0 + 8 * rq + 4 * hi; const f32x16& o = d0 ? st.o1 : st.o0;
            v2u w; w.x = pk2(o[4 * rq + 0] * inv, o[4 * rq + 1] * inv); w.y = pk2(o[4 * rq + 2] * inv, o[4 * rq + 3] * inv);
            *(v2u*)(orow + d) = w;
        }
    if (hi == 0) *lsep = st.m + __builtin_amdgcn_logf(lt);
}
__device__ __forceinline__ void attn_state_load(AttnSt& st, const bf16* orow, const float* lsep, int lane) {
    const int hi = lane >> 5;
#pragma unroll
    for (int d0 = 0; d0 < 2; ++d0)
#pragma unroll
        for (int rq = 0; rq < 4; ++rq) {
            const int d = 32 * d0 + 8 * rq + 4 * hi; const v2u w = *(const v2u*)(orow + d);
            f32x16& o = d0 ? st.o1 : st.o0;
            o[4 * rq + 0] = bf_lo(w.x); o[4 * rq + 1] = bf_hi(w.x); o[4 * rq + 2] = bf_lo(w.y); o[4 * rq + 3] = bf_hi(w.y);
        }
    st.m = *lsep; st.l = hi ? 0.f : 1.f;
}

__device__ __forceinline__ void phase_dilated_3(const Args& A, LAS unsigned char* lds, int G, int vcu, int wave, int lane) {
    const bf16* Z = (const bf16*)(A.ws + WS_Z); bf16* Y = (bf16*)(A.ws + WS_Y);
    bf16* EX = (bf16*)A.out; float* LSE = A.out + (size_t)32 * 1024 * 1024;
    LAS unsigned char* wl = lds + wave * 16384;
    const int r32 = lane & 31, hi = lane >> 5;
    for (int U = vcu; U < 2048; U += G) {
        const int c = U >> 8, bh = U & 255, b = bh >> 4, hh = bh & 15, T0 = 512 * c;
        const size_t rowbase = (size_t)b * SEQ;
        const bf16* Vh = Z + rowbase * ODD_IN + 2048 + hh * 64 + 8 * (lane & 7);
        {
            const int r16a = 2 * wave, pa = r16a + 16 * r32;
            bf16x8 qa[4], qb[4];
            { const bf16* zqa = Z + (rowbase + T0 + pa) * ODD_IN + hh * 64 + 8 * hi;
#pragma unroll
              for (int d0 = 0; d0 < 4; ++d0) { qa[d0] = *(const bf16x8*)(zqa + 16 * d0); qb[d0] = *(const bf16x8*)(zqa + ODD_IN + 16 * d0); } }
            AttnSt sa, sb; sa.o0 = f32x16{}; sa.o1 = f32x16{}; sa.m = -1e30f; sa.l = 0.f; sb.o0 = f32x16{}; sb.o1 = f32x16{}; sb.m = -1e30f; sb.l = 0.f;
#define P1_PARAMS(ti) const int dil_ = (ti) < 5 ? 16 : 4, tau_ = (ti) < 5 ? (ti) : (ti) - 5; const int rdla_ = r16a & (dil_ - 1), rdlb_ = (r16a + 1) & (dil_ - 1); const int mba_ = (T0 + r16a - rdla_) / dil_ - 128 + 32 * tau_
#define P1_ADDR(ti) P1_PARAMS(ti); const size_t vst_ = (size_t)dil_ * ODD_IN; const int mv = mba_ + (lane >> 3); const int m0_ = mv < 0 ? 0 : mv, m1_ = mv + 8 < 0 ? 0 : mv + 8, m2_ = mv + 16 < 0 ? 0 : mv + 16, m3_ = mv + 24 < 0 ? 0 : mv + 24; \
                const bf16* va_ = Vh + (size_t)rdla_ * ODD_IN; const bf16* vb_ = Vh + (size_t)rdlb_ * ODD_IN
#define P1_LOADK(ti) do { P1_ADDR(ti); attn_load_k(RA, 1024, va_ + m0_ * vst_, va_ + m1_ * vst_, va_ + m2_ * vst_, va_ + m3_ * vst_); attn_load_k(RB, 1024, vb_ + m0_ * vst_, vb_ + m1_ * vst_, vb_ + m2_ * vst_, vb_ + m3_ * vst_); } while (0)
#define P1_LOADV(ti) do { P1_ADDR(ti); attn_load_v(RA, va_ + m0_ * vst_, va_ + m1_ * vst_, va_ + m2_ * vst_, va_ + m3_ * vst_); attn_load_v(RB, vb_ + m0_ * vst_, vb_ + m1_ * vst_, vb_ + m2_ * vst_, vb_ + m3_ * vst_); } while (0)
#pragma unroll 1
            for (int ti = 0; ti < 13; ++ti) {
                { P1_PARAMS(ti); if (mba_ + 31 < 0) continue; }
                TileRegs RA, RB;
                P1_LOADK(ti);
                P1_PARAMS(ti);
                attn_compute2_kv<3>(sa, sb, qa, qb, RA, RB, wl, lane, 128 + (16 / dil_) * r32 - 32 * tau_, -mba_, -mba_, [&] { P1_LOADV(ti); }, [] {});
            }
#undef P1_ADDR
#undef P1_LOADK
#undef P1_LOADV
#undef P1_PARAMS
            attn_state_store(sa, EX + ((size_t)U * 512 + pa) * 64, LSE + (size_t)U * 512 + pa, lane);
            attn_state_store(sb, EX + ((size_t)U * 512 + pa + 1) * 64, LSE + (size_t)U * 512 + pa + 1, lane);
        }
        {
            const int pa = 64 * wave + r32, pb = pa + 32;
            bf16x8 qa[4], qb[4];
            { const bf16* zqa = Z + (rowbase + T0 + pa) * ODD_IN + hh * 64 + 8 * hi;
#pragma unroll
              for (int d0 = 0; d0 < 4; ++d0) { qa[d0] = *(const bf16x8*)(zqa + 16 * d0); qb[d0] = *(const bf16x8*)(zqa + (size_t)32 * ODD_IN + 16 * d0); } }
            asm volatile("s_waitcnt vmcnt(0)" ::: "memory");
            __syncthreads();
            v2u gga[2][4], ggb[2][4];
            { const bf16* zg = Z + (rowbase + T0 + pa) * ODD_IN + 3072 + hh * 64; attn_gate_load(gga, zg, lane); attn_gate_load(ggb, zg + (size_t)32 * ODD_IN, lane); }
            AttnSt sa, sb;
            attn_state_load(sa, EX + ((size_t)U * 512 + pa) * 64, LSE + (size_t)U * 512 + pa, lane);
            attn_state_load(sb, EX + ((size_t)U * 512 + pb) * 64, LSE + (size_t)U * 512 + pb, lane);
            const int mba = T0 + 64 * wave - 128, mbb = mba + 32;
            const size_t vst = (size_t)ODD_IN;
#define P2_ADDR(tau) const int mva = mba + 32 * (tau) + (lane >> 3), mvb = mva + 32; \
                const int a0_ = mva < 0 ? 0 : mva, a1_ = mva + 8 < 0 ? 0 : mva + 8, a2_ = mva + 16 < 0 ? 0 : mva + 16, a3_ = mva + 24 < 0 ? 0 : mva + 24; \
                const int b0_ = mvb < 0 ? 0 : mvb, b1_ = mvb + 8 < 0 ? 0 : mvb + 8, b2_ = mvb + 16 < 0 ? 0 : mvb + 16, b3_ = mvb + 24 < 0 ? 0 : mvb + 24
#define P2_LOADK(tau) do { P2_ADDR(tau); attn_load_k(RA, 1024, Vh + a0_ * vst, Vh + a1_ * vst, Vh + a2_ * vst, Vh + a3_ * vst); attn_load_k(RB, 1024, Vh + b0_ * vst, Vh + b1_ * vst, Vh + b2_ * vst, Vh + b3_ * vst); } while (0)
#define P2_LOADV(tau) do { P2_ADDR(tau); attn_load_v(RA, Vh + a0_ * vst, Vh + a1_ * vst, Vh + a2_ * vst, Vh + a3_ * vst); attn_load_v(RB, Vh + b0_ * vst, Vh + b1_ * vst, Vh + b2_ * vst, Vh + b3_ * vst); } while (0)
#pragma unroll 1
            for (int tau = 0; tau < 5; ++tau) {
                if (mbb + 32 * tau + 31 < 0) continue;
                TileRegs RA, RB;
                P2_LOADK(tau);
                attn_compute2_kv<3>(sa, sb, qa, qb, RA, RB, wl, lane, 128 + r32 - 32 * tau, -(mba + 32 * tau), -(mbb + 32 * tau), [&] { P2_LOADV(tau); }, [] {});
            }
#undef P2_ADDR
#undef P2_LOADK
#undef P2_LOADV
            { int pa2 = pa; asm volatile("" : "+v"(pa2));
              bf16* yr = Y + (rowbase + T0 + pa2) * D + hh * 64;
              attn_store_g(sa, gga, yr, lane); attn_store_g(sb, ggb, yr + (size_t)32 * D, lane); }
        }
    }
}

__device__ __forceinline__ void phase_dilated(const Args& A, LAS unsigned char* lds, int gwv, int NGW, int wave, int lane) {
    const bf16* Z = (const bf16*)(A.ws + WS_Z); bf16* Y = (bf16*)(A.ws + WS_Y);
    LAS unsigned char* vl = lds + wave * 4096;
    const int r32 = lane & 31, hi = lane >> 5;
    for (int U = gwv; U < 32768; U += NGW) {
        const int rd = U >> 11, g2 = U & 2047, X = g2 >> 8, lwv = g2 & 255;
        const int bh = 32 * X + 2 * rd + (lwv >> 7), gi = lwv & 127, c = gi >> 4, r16 = gi & 15;
        const int b = bh >> 4, hh = bh & 15;
        const size_t rowbase = (size_t)b * SEQ;
        const int tq = 512 * c + r16 + 16 * r32;
        const bf16* zq = Z + (rowbase + tq) * ODD_IN;
        bf16x8 qf[4];
#pragma unroll
        for (int d0 = 0; d0 < 4; ++d0) qf[d0] = *(const bf16x8*)(zq + hh * 64 + 16 * d0 + 8 * hi);
        AttnSt st; st.o0 = f32x16{}; st.o1 = f32x16{}; st.m = -1e30f; st.l = 0.f;
        const bf16* Kh = Z + rowbase * ODD_IN + 1024 + hh * 64; const bf16* Vh = Z + rowbase * ODD_IN + 2048 + hh * 64;
#pragma unroll 1
        for (int cfg = 0; cfg < 3; ++cfg) {
            const int dil = (cfg == 0) ? 16 : (cfg == 1) ? 4 : 1, sstep = 16 / dil, ntile = (cfg == 0) ? 5 : (cfg == 1) ? 8 : 20;
            const int rdl = r16 & (dil - 1), mbase = (512 * c + r16 - rdl) / dil - 128;
            for (int tau = 0; tau < ntile; ++tau) {
                const int m0 = mbase + 32 * tau;
                if (m0 + 31 < 0) continue;
                const int mk = m0 + r32, mkc = mk < 0 ? 0 : mk;
                const bf16* kp = Kh + (size_t)(rdl + dil * mkc) * ODD_IN + 8 * hi;
                const int mv = m0 + (lane >> 3);
                const int mv0 = mv < 0 ? 0 : mv, mv1 = mv + 8 < 0 ? 0 : mv + 8, mv2 = mv + 16 < 0 ? 0 : mv + 16, mv3 = mv + 24 < 0 ? 0 : mv + 24;
                const bf16* vb = Vh + (size_t)rdl * ODD_IN + 8 * (lane & 7); const size_t vst = (size_t)dil * ODD_IN;
                const int dd0 = 128 + sstep * r32 - 32 * tau;
                attn_tile(st, qf, kp, vb + mv0 * vst, vb + mv1 * vst, vb + mv2 * vst, vb + mv3 * vst, vl, lane, true,
                          [&](int kk) { const int dd = dd0 - kk; return dd >= 0 && dd <= 128 && (m0 + kk) >= 0; });
            }
        }
        attn_store(st, zq + 3072 + hh * 64, Y + (rowbase + tq) * D + hh * 64, lane);
    }
}
#define XB_TMO      128
#define XB_XCNT(j)  (256  + 64 * (j))
#define XB_XSUB(j)  (1280 + 64 * (j))
#define XB_XGEN(j)  (2304 + 64 * (j))
#define XB_TOP      3328
#define XB_TOPGEN   3392
#define XCD_BAR_WORDS 3456
#define XB_SPIN_CAP (1u << 18)

__device__ __forceinline__ unsigned xb_ld(unsigned* p)              { return __hip_atomic_load(p, __ATOMIC_RELAXED, __HIP_MEMORY_SCOPE_AGENT); }
__device__ __forceinline__ unsigned xb_add(unsigned* p, unsigned v) { return __hip_atomic_fetch_add(p, v, __ATOMIC_RELAXED, __HIP_MEMORY_SCOPE_AGENT); }
__device__ __forceinline__ unsigned xb_xcc_id() { return (unsigned)__builtin_amdgcn_s_getreg((3 << 11) | 20) & 0xFu; }
#define XB_SPIN(cond, bar) do { unsigned _sp = 0; while (cond) { __builtin_amdgcn_s_sleep(1); \
    if ((++_sp & 255u) == 0u) { if (xb_ld(&(bar)[XB_TMO])) break; if (_sp > XB_SPIN_CAP) { atomicAdd(&(bar)[XB_TMO], 1u); break; } } } } while (0)

struct XcdBarrier {
    unsigned* bar; unsigned x;
    volatile LAS unsigned* st;
};

__device__ __forceinline__ XcdBarrier xcd_barrier_post(unsigned* bar, volatile LAS unsigned* st) {
    XcdBarrier b; b.bar = bar; b.x = xb_xcc_id(); b.st = st;
    if (threadIdx.x == 0) (void)xb_add(&bar[XB_XCNT(b.x)], 1u);
    return b;
}
__device__ __forceinline__ void xcd_barrier_complete(unsigned* bar, unsigned x, unsigned& nloc, unsigned& nx) {
    const unsigned G = gridDim.x * gridDim.y * gridDim.z;
    unsigned sum, cnt, mine, sp = 0u;
    for (;;) {
        sum = 0u; cnt = 0u; mine = 0u;
#pragma unroll
        for (unsigned j = 0; j < 16; ++j) { const unsigned c = xb_ld(&bar[XB_XCNT(j)]); sum += c; cnt += (c > 0u) ? 1u : 0u; mine = (j == x) ? c : mine; }
        if (sum == G) break;
        __builtin_amdgcn_s_sleep(1);
        if ((++sp & 255u) == 0u) { if (xb_ld(&bar[XB_TMO])) break; if (sp > XB_SPIN_CAP) { atomicAdd(&bar[XB_TMO], 1u); break; } }
    }
    nloc = mine > 0u ? mine : 1u; nx = cnt > 0u ? cnt : 1u;
}

__device__ __forceinline__ void xcd_barrier(const XcdBarrier& b) {
    asm volatile("s_waitcnt vmcnt(0)" ::: "memory");
    __syncthreads();
    if (threadIdx.x == 0) {
        unsigned* bar = b.bar;
        __builtin_amdgcn_s_waitcnt(0);
        unsigned nloc = b.st[0], nx = b.st[1];
        if (nloc == 0u) { xcd_barrier_complete(bar, b.x, nloc, nx); b.st[0] = nloc; b.st[1] = nx; }
        const unsigned old = xb_add(&bar[XB_XSUB(b.x)], 1u);
        const unsigned gen = old / nloc;
        if (old + 1u == (gen + 1u) * nloc) {
            __builtin_amdgcn_fence(__ATOMIC_RELEASE, "agent");
            asm volatile("s_waitcnt vmcnt(0)" ::: "memory");
            const unsigned og = xb_add(&bar[XB_TOP], 1u);
            const unsigned tg = og / nx;
            if (og + 1u == (tg + 1u) * nx) xb_add(&bar[XB_TOPGEN], 1u);
            else XB_SPIN(xb_ld(&bar[XB_TOPGEN]) == tg, bar);
            __builtin_amdgcn_fence(__ATOMIC_ACQUIRE, "agent");
            xb_add(&bar[XB_XGEN(b.x)], 1u);
            asm volatile("s_waitcnt vmcnt(0)" ::: "memory");
        } else {
            XB_SPIN(xb_ld(&bar[XB_XGEN(b.x)]) == gen, bar);
            __builtin_amdgcn_fence(__ATOMIC_ACQUIRE, "agent");
            asm volatile("s_waitcnt vmcnt(0)" ::: "memory");
        }
    }
    __syncthreads();
}
__device__ __forceinline__ void phase_final(const Args& A, int gwv, int NGW, int lane) {
    const float* ssqp = (const float*)(A.ws + WS_SSQ);
    f32x4 fg[4];
#pragma unroll
    for (int j = 0; j < 4; ++j) fg[j] = *((const f32x4*)A.final_g + lane + 64 * j);
    for (int m = gwv; m < M; m += 2 * NGW) {
        const int m2 = m + NGW;
        const f32x4* sp = (const f32x4*)(ssqp + (size_t)m * 16); const f32x4* sp2 = (const f32x4*)(ssqp + (size_t)m2 * 16);
        f32x4* hr = (f32x4*)(A.out + (size_t)m * D) + lane; f32x4* hr2 = (f32x4*)(A.out + (size_t)m2 * D) + lane;
        const f32x4 a = sp[0], b = sp[1], c = sp[2], d = sp[3], a2 = sp2[0], b2 = sp2[1], c2 = sp2[2], d2 = sp2[3];
        f32x4 v[4], w[4];
#pragma unroll
        for (int j = 0; j < 4; ++j) { v[j] = hr[64 * j]; w[j] = hr2[64 * j]; }
        const float ss = (((a[0] + a[1]) + (a[2] + a[3])) + ((b[0] + b[1]) + (b[2] + b[3]))) + (((c[0] + c[1]) + (c[2] + c[3])) + ((d[0] + d[1]) + (d[2] + d[3])));
        const float ss2 = (((a2[0] + a2[1]) + (a2[2] + a2[3])) + ((b2[0] + b2[1]) + (b2[2] + b2[3]))) + (((c2[0] + c2[1]) + (c2[2] + c2[3])) + ((d2[0] + d2[1]) + (d2[2] + d2[3])));
        const float rstd = __builtin_amdgcn_rsqf(ss * (1.0f / 1024.0f) + NORM_EPS), rstd2 = __builtin_amdgcn_rsqf(ss2 * (1.0f / 1024.0f) + NORM_EPS);
#pragma unroll
        for (int j = 0; j < 4; ++j) { hr[64 * j] = v[j] * rstd * fg[j]; hr2[64 * j] = w[j] * rstd2 * fg[j]; }
    }
}

#define CAS __attribute__((address_space(4)))
#define FRESH_IDS() int lane = lane_k, wave = wave_k, vcu = vcu_k; asm volatile("" : "+v"(lane), "+s"(wave), "+s"(vcu)); const int gwv = vcu * NWAVES + wave; (void)gwv;
#define GRID_SYNC() do { asm volatile("s_waitcnt vmcnt(0) lgkmcnt(0)" ::: "memory"); __syncthreads(); \
    if (wave_k == 0) { __builtin_amdgcn_fence(__ATOMIC_RELEASE, "agent"); asm volatile("s_waitcnt vmcnt(0)" ::: "memory"); } \
    grid.sync(); \
    if (wave_k == 0) { __builtin_amdgcn_fence(__ATOMIC_ACQUIRE, "agent"); asm volatile("s_waitcnt vmcnt(0)" ::: "memory"); } \
    __syncthreads(); } while (0)
#ifdef NO_XBAR
#define XBAR_SYNC() GRID_SYNC()
#else
#define XBAR_SYNC() xcd_barrier(xbar)
#endif
#define FRESH_ARGS() ({ const CAS Args* ap_ = (const CAS Args*)__builtin_amdgcn_kernarg_segment_ptr(); asm volatile("" : "+s"(ap_)); Args a_; a_ = *(const Args*)ap_; a_; })
__global__ void __launch_bounds__(NTHREADS, 2) mega_fwd(Args Akern) {
    extern __shared__ __attribute__((aligned(16))) unsigned char lds_raw[];
    cg::grid_group grid = cg::this_grid();
    LAS unsigned char* lds = (LAS unsigned char*)lds_raw;
    const int tid = threadIdx.x, lane_k = tid & 63, wave_k = __builtin_amdgcn_readfirstlane(tid >> 6);
    const int G = gridDim.x, bx = blockIdx.x;
    const int vcu_k = (G % 8 == 0) ? (bx % 8) * (G / 8) + bx / 8 : bx;
    const int NGW = G * NWAVES;
    if (tid < 2) ((volatile LAS unsigned*)(lds + 131072))[tid] = 0u;
    __syncthreads();
    const XcdBarrier xbar = xcd_barrier_post((unsigned*)(Akern.ws + WS_CTL), (volatile LAS unsigned*)(lds + 131072));

#ifndef NO_PRO
    { FRESH_IDS(); const Args A = FRESH_ARGS(); phase_prologue(A, lds, gwv, NGW, wave, lane); }
#endif
    GRID_SYNC();
#pragma unroll 1
    for (int layer = 0; layer < 4; ++layer) {
        const int li = layer >> 1; const int even = !(layer & 1);
        {
            const Args A = FRESH_ARGS(); bf16* hb = (bf16*)(A.ws + WS_HB); bf16* Zb = (bf16*)(A.ws + WS_Z); float* ssqp = (float*)(A.ws + WS_SSQ); float* kmp = (float*)(A.ws + WS_KMP);
            const int N = even ? EVEN_IN : ODD_IN;
            const bf16* Wt = even ? (const bf16*)(A.ws + WS_WE_IN) + (size_t)li * EVEN_IN * D : (const bf16*)(A.ws + WS_WO_IN) + (size_t)li * ODD_IN * D;
            pg8::Gemm g{hb, Wt, M, N, D}; pg8::StaticOrder S; S.init(M, N, G, bx);
            LAS float* rtab = (LAS float*)(lds + 131072 + 1024);
            {
                int tidl = tid; asm volatile("" : "+v"(tidl));
                const int rl = tidl & 255, half = tidl >> 8;
#pragma unroll 1
                for (int kb = 0; kb < 8; kb += 4) {
                    f32x4 pv[4][4]; int have[4];
#pragma unroll
                    for (int k = 0; k < 4; ++k) {
                        pg8::Unit uu; have[k] = S.next(2 * (kb + k) + half, uu) ? 1 : 0;
                        const float* sp = ssqp + ((size_t)(have[k] ? uu.pm : 0) * 256 + rl) * 16;
#pragma unroll
                        for (int q4 = 0; q4 < 4; ++q4) pv[k][q4] = *(const f32x4*)(sp + 4 * q4);
                    }
#pragma unroll
                    for (int k = 0; k < 4; ++k) {
                        const f32x4 a = pv[k][0], b = pv[k][1], c = pv[k][2], d = pv[k][3];
                        const float ss = (((a[0] + a[1]) + (a[2] + a[3])) + ((b[0] + b[1]) + (b[2] + b[3]))) + (((c[0] + c[1]) + (c[2] + c[3])) + ((d[0] + d[1]) + (d[2] + d[3])));
                        if (have[k]) rtab[(2 * (kb + k) + half) * 256 + rl] = __builtin_amdgcn_rsqf(ss * (1.0f / 1024.0f) + NORM_EPS);
                    }
                }
                __syncthreads();
            }
            int eseq = 0;
            pg8::EpiIn E{Zb, N, rtab, &eseq, kmp, even};
#ifdef PROBE_GIN2
            pg8::gemm_phase<pg8::EpiIn, pg8::StaticOrder, true, true>(lds, g, S, E);
#endif
#ifndef NO_GIN
            pg8::gemm_phase<pg8::EpiIn, pg8::StaticOrder, true, true>(lds, g, S, E);
#endif
        }
        XBAR_SYNC();
#ifdef PROBE_MIX2
        for (int rep = 0; rep < 2; ++rep)
#endif
#ifdef PROBE_MIX2_EVEN
        for (int rep = 0; rep < (even ? 2 : 1); ++rep)
#endif
        { __syncthreads(); FRESH_IDS(); const Args A = FRESH_ARGS();
        if (even) {
#ifndef NO_GMLP
            phase_gmlp(A, li, lds, vcu, G, wave, lane);
#endif
#ifdef PROBE_GMLP2
            phase_gmlp(A, li, lds, vcu, G, wave, lane);
#endif
#ifndef NO_MOBA
#if defined(NO_PIPE)
            phase_moba_old(A, lds, gwv, NGW, wave, lane);
#elif defined(MOBA_PIPE)
            phase_moba_p(A, lds, gwv, NGW, wave, lane);
#else
            phase_moba_s(A, lds, G, vcu, wave, lane);
#endif
#endif
        } else {
#ifndef NO_DIL
#if defined(NO_PIPE)
            phase_dilated(A, lds, gwv, NGW, wave, lane);
#elif defined(DIL_PIPE)
            phase_dilated_p(A, lds, gwv, NGW, wave, lane);
#elif defined(DIL_2)
            phase_dilated_2(A, lds, gwv, NGW, wave, lane);
#else
            phase_dilated_3(A, lds, G, vcu, wave, lane);
#endif
#endif
        } }
        XBAR_SYNC();
        {
            const Args A = FRESH_ARGS(); bf16* hb = (bf16*)(A.ws + WS_HB); bf16* Yb = (bf16*)(A.ws + WS_Y); float* ssqp = (float*)(A.ws + WS_SSQ);
            const bf16* Wt = even ? (const bf16*)(A.ws + WS_WE_OUT) + (size_t)li * D * D : (const bf16*)(A.ws + WS_WO_OUT) + (size_t)li * D * D;
            pg8::Gemm g{Yb, Wt, M, D, D}; pg8::StaticOrder S; S.init(M, D, G, bx);
            pg8::EpiOut E{layer == 0 ? A.x : nullptr, layer == 3 ? A.out : nullptr, hb, ssqp};
#ifndef NO_GOUT
            pg8::gemm_phase<pg8::EpiOut, pg8::StaticOrder, true, true>(lds, g, S, E);
#endif
        }
        XBAR_SYNC();
    }
#ifndef NO_FIN
    { FRESH_IDS(); const Args A = FRESH_ARGS(); phase_final(A, gwv, NGW, lane); }
#endif
}

extern "C" void kernel_launch(void* const* d_in, const int* in_sizes, int n_in, void* d_out, int out_size, void* d_ws, size_t ws_size, hipStream_t stream) {
    static int grid = 0;
    if (grid == 0) {
        if (n_in != 11 || in_sizes[0] != M * D || out_size != M * D || ws_size < WS_END) { fprintf(stderr, "kernel_launch: unexpected shapes (n_in %d, in0 %d, out %d, ws %zu)\n", n_in, n_in > 0 ? in_sizes[0] : -1, out_size, ws_size); grid = -1; return; }
        int dev = 0, cus = 0, per_cu = 0;
        if (hipGetDevice(&dev) != hipSuccess || hipDeviceGetAttribute(&cus, hipDeviceAttributeMultiprocessorCount, dev) != hipSuccess) { grid = -1; return; }
        if (hipFuncSetAttribute((const void*)mega_fwd, hipFuncAttributeMaxDynamicSharedMemorySize, LDS_BYTES) != hipSuccess) { fprintf(stderr, "kernel_launch: hipFuncSetAttribute failed\n"); grid = -1; return; }
        if (hipOccupancyMaxActiveBlocksPerMultiprocessor(&per_cu, (const void*)mega_fwd, NTHREADS, LDS_BYTES) != hipSuccess || per_cu < 1) { fprintf(stderr, "kernel_launch: occupancy query says %d\n", per_cu); per_cu = 1; }
        (void)hipGetLastError();
        grid = cus;
    }
    if (grid < 0) return;
    Args a{};
    a.x = (const float*)d_in[0]; a.norm_g = (const float*)d_in[1]; a.final_g = (const float*)d_in[2]; a.ab_w_in = (const float*)d_in[3]; a.ab_w_out = (const float*)d_in[4];
    a.ln_g = (const float*)d_in[5]; a.ln_b = (const float*)d_in[6]; a.w_s = (const float*)d_in[7]; a.b_s = (const float*)d_in[8]; a.c_w_in = (const float*)d_in[9]; a.c_w_out = (const float*)d_in[10];
    a.out = (float*)d_out; a.ws = (unsigned char*)d_ws;
    if (hipMemsetAsync((char*)d_ws + WS_CTL, 0, 16384, stream) != hipSuccess) { fprintf(stderr, "kernel_launch: hipMemsetAsync failed\n"); return; }
    void* args[] = {&a};
    const hipError_t e = hipLaunchCooperativeKernel((const void*)mega_fwd, dim3(grid), dim3(NTHREADS), args, LDS_BYTES, stream);
    if (e != hipSuccess) fprintf(stderr, "kernel_launch: cooperative launch failed: %s (grid %d)\n", hipGetErrorString(e), grid);
}
```

```cpp
#include <hip/hip_runtime.h>
#include <hip/hip_cooperative_groups.h>
#include <cstdio>
#include <cstdint>
#include <cmath>
namespace cg = cooperative_groups;
namespace pg8 {
#define PG8_LAS __attribute__((address_space(3)))
typedef unsigned short bf16_t;
typedef short bf16x8 __attribute__((ext_vector_type(8)));
typedef float f32x4 __attribute__((ext_vector_type(4)));
typedef unsigned u32x4 __attribute__((ext_vector_type(4)));
constexpr int BM = 256, BK = 64, HALF = 128, HTB = HALF * BK * 2  , STAGE_BYTES = 8 * HTB, NXCD = 8, WGM = 8;

__host__ __device__ __forceinline__ int lds_byte(int r, int c) { const int st = (r >> 4) * 2 + (c >> 5), rr = r & 15, cc = c & 31, ob = rr * 64 + cc * 2; return st * 1024 + (ob ^ (((ob >> 9) & 1) << 5)); }
__host__ __device__ __forceinline__ void stage_rc(int b, int& R, int& C) { const int st = b / 1024, sb = b % 1024, swz = sb ^ (((sb >> 9) & 1) << 5); R = (st >> 1) * 16 + swz / 64; C = (st & 1) * 32 + (swz % 64) / 2; }
__host__ __device__ __forceinline__ int perm32(int rho) { const int n = rho >> 4, i = rho & 15; return 8 * (i >> 2) + 4 * n + (i & 3); }

struct Unit { int pm, pn; };
struct Gemm { const bf16_t* A; const bf16_t* Bt; int M, N, K; };

struct StaticOrder {
    int nM, nN, nwg, G, c;
    __host__ __device__ void init(int M, int N, int G_, int c_) { nM = M / BM; nN = N / BM; nwg = nM * nN; G = G_; c = c_; }
    __host__ __device__ bool next(int i, Unit& u) const {
        const long L = (long)i * G + c; if (L >= nwg) return false;
        int wgid = (int)L; { const int q = nwg / NXCD, r = nwg % NXCD, xcd = wgid % NXCD, off = wgid / NXCD; wgid = (xcd < r ? xcd * (q + 1) : r * (q + 1) + (xcd - r) * q) + off; }
        const int nig = WGM * nN, gid = wgid / nig, fm = gid * WGM, gsz = (nM - fm) < WGM ? (nM - fm) : WGM;
        u.pm = fm + ((wgid % nig) % gsz); u.pn = (wgid % nig) / gsz; return true;
    }
    __device__ __forceinline__ void a_ready(const Unit&) const {}
    __device__ __forceinline__ void done(const Unit&) const {}
};

__device__ __forceinline__ unsigned cvt_pk_bf16(float lo, float hi) { unsigned r; asm volatile("v_cvt_pk_bf16_f32 %0, %1, %2" : "=v"(r) : "v"(lo), "v"(hi)); return r; }
typedef unsigned u32x2 __attribute__((ext_vector_type(2)));
__device__ __forceinline__ float act_gelu(float x) {
    const float t = x + 0.044715f * x * x * x;
    return x * __builtin_amdgcn_rcpf(1.f + __builtin_amdgcn_exp2f(-2.302208198f * t));
}
__device__ __forceinline__ float act_silu(float x) { return x * __builtin_amdgcn_rcpf(1.f + __builtin_amdgcn_exp2f(-1.4426950409f * x)); }
constexpr float QSCALE = 0.125f * 1.4426950408889634f;
constexpr float NORM_EPS = 1e-6f;

struct EpiIn {
    static constexpr bool PERM = true, AFTER_DRAIN = false;
    bf16_t* Z; int ldz; const PG8_LAS float* rtab; int* seq; float* kmp; int even;
    template <int ACT> __device__ __forceinline__ void body(const f32x4 (&acc)[2][2][4][2], const Unit& u, int wr, int wc, int fr, int fq, const PG8_LAS float* rt) const {
        const int row0 = u.pm * BM + wr * 64 + fr, col0 = u.pn * BM + wc * 32 + 8 * fq;
        float rs[2][4];
#pragma unroll
        for (int ai = 0; ai < 2; ++ai)
#pragma unroll
            for (int m = 0; m < 4; ++m) rs[ai][m] = rt[wr * 64 + fr + ai * HALF + m * 16];
        float cs[2][2][4];
        if (ACT == 4) {
#pragma unroll
            for (int bj = 0; bj < 2; ++bj)
#pragma unroll
                for (int n = 0; n < 2; ++n)
#pragma unroll
                    for (int e = 0; e < 4; ++e) cs[bj][n][e] = 0.f;
        }
#pragma unroll
        for (int ai = 0; ai < 2; ++ai)
#pragma unroll
            for (int m = 0; m < 4; ++m) {
                const int row = row0 + ai * HALF + m * 16;
                const float rstd = rs[ai][m];
                bf16_t* rowp = Z + (size_t)row * ldz + col0;
#pragma unroll
                for (int bj = 0; bj < 2; ++bj) {
                    f32x4 v[2];
#pragma unroll
                    for (int n = 0; n < 2; ++n) {
                        v[n] = acc[ai][bj][m][n] * rstd;
#pragma unroll
                        for (int e = 0; e < 4; ++e) {
                            if (ACT == 1) v[n][e] = act_gelu(v[n][e]);
                            if (ACT == 2) v[n][e] = act_silu(v[n][e]);
                            if (ACT == 3) v[n][e] = v[n][e] * QSCALE;
                            if (ACT == 4) cs[bj][n][e] += v[n][e];
                        }
                    }
                    u32x4 w; w.x = cvt_pk_bf16(v[0][0], v[0][1]); w.y = cvt_pk_bf16(v[0][2], v[0][3]); w.z = cvt_pk_bf16(v[1][0], v[1][1]); w.w = cvt_pk_bf16(v[1][2], v[1][3]);
                    *(u32x4*)(rowp + bj * HALF) = w;
                }
            }
        if (ACT == 4) {
#pragma unroll
            for (int bj = 0; bj < 2; ++bj)
#pragma unroll
                for (int n = 0; n < 2; ++n)
#pragma unroll
                    for (int e = 0; e < 4; ++e) {
                        float s = cs[bj][n][e];
                        s += __shfl_xor(s, 1); s += __shfl_xor(s, 2); s += __shfl_xor(s, 4); s += __shfl_xor(s, 8);
                        cs[bj][n][e] = s;
                    }
            if (fr == 0) {
                float* kp = kmp + ((size_t)u.pm * 2 + wr) * 512 + (col0 - 2048);
#pragma unroll
                for (int bj = 0; bj < 2; ++bj)
#pragma unroll
                    for (int n = 0; n < 2; ++n) *(f32x4*)(kp + bj * HALF + n * 4) = (f32x4){cs[bj][n][0], cs[bj][n][1], cs[bj][n][2], cs[bj][n][3]};
            }
        }
    }
    __device__ __forceinline__ void operator()(const f32x4 (&acc)[2][2][4][2], const Unit& u, int wr, int wc, int fr, int fq) const {
        int act;
        if (even) { const int seg = u.pn >> 1; act = (seg == 0 || seg == 1) ? 1 : (seg == 2 || seg == 6) ? 2 : (seg == 3) ? 3 : (seg == 4) ? 4 : 0; }
        else { const int seg = u.pn >> 2; act = (seg == 0) ? 3 : (seg == 3) ? 2 : 0; }
        const PG8_LAS float* rt = rtab + ((*seq)++) * 256;
        if (act == 0) body<0>(acc, u, wr, wc, fr, fq, rt);
        else if (act == 1) body<1>(acc, u, wr, wc, fr, fq, rt);
        else if (act == 2) body<2>(acc, u, wr, wc, fr, fq, rt);
        else if (act == 3) body<3>(acc, u, wr, wc, fr, fq, rt);
        else body<4>(acc, u, wr, wc, fr, fq, rt);
    }
};
struct EpiOut {
    static constexpr bool PERM = false, AFTER_DRAIN = false;
    const float* resid_f32; float* out_f32; bf16_t* hb; float* ssqp;
    template <bool RF32> __device__ __forceinline__ void body(const f32x4 (&acc)[2][2][4][2], const Unit& u, int wr, int wc, int fr, int fq) const {
        const int row0 = u.pm * BM + wr * 64 + fr, col0 = u.pn * BM + wc * 32 + 4 * fq;
        constexpr int MB = RF32 ? 2 : 4;
#pragma unroll
        for (int ai = 0; ai < 2; ++ai)
#pragma unroll
        for (int m0 = 0; m0 < 4; m0 += MB) {
            f32x4 rf[RF32 ? MB : 1][2][2]; u32x2 rb[RF32 ? 1 : MB][2][2];
#pragma unroll
            for (int mm = 0; mm < MB; ++mm)
#pragma unroll
                for (int bj = 0; bj < 2; ++bj)
#pragma unroll
                    for (int n = 0; n < 2; ++n) {
                        const size_t o2 = (size_t)(row0 + ai * HALF + (m0 + mm) * 16) * 1024 + col0 + bj * HALF + n * 16;
                        if (RF32) rf[RF32 ? mm : 0][bj][n] = *(const f32x4*)(resid_f32 + o2); else rb[RF32 ? 0 : mm][bj][n] = *(const u32x2*)(hb + o2);
                    }
#pragma unroll
            for (int mm = 0; mm < MB; ++mm) {
                const int m = m0 + mm;
                const int row = row0 + ai * HALF + m * 16; const size_t off = (size_t)row * 1024 + col0; float ss = 0.f;
#pragma unroll
                for (int bj = 0; bj < 2; ++bj)
#pragma unroll
                    for (int n = 0; n < 2; ++n) {
                        const size_t o2 = off + bj * HALF + n * 16;
                        f32x4 r;
                        if (RF32) r = rf[RF32 ? mm : 0][bj][n];
                        else { const u32x2 w = rb[RF32 ? 0 : mm][bj][n]; r[0] = __builtin_bit_cast(float, w.x << 16); r[1] = __builtin_bit_cast(float, w.x & 0xffff0000u); r[2] = __builtin_bit_cast(float, w.y << 16); r[3] = __builtin_bit_cast(float, w.y & 0xffff0000u); }
                        const f32x4 o = r + acc[ai][bj][m][n];
                        ss += (o[0] * o[0] + o[1] * o[1]) + (o[2] * o[2] + o[3] * o[3]);
                        if (out_f32) *(f32x4*)(out_f32 + o2) = o;
                        else { u32x2 w; w.x = cvt_pk_bf16(o[0], o[1]); w.y = cvt_pk_bf16(o[2], o[3]); *(u32x2*)(hb + o2) = w; }
                    }
                ss += __shfl_xor(ss, 16); ss += __shfl_xor(ss, 32);
                if (fq == 0) ssqp[(size_t)row * 16 + u.pn * 4 + wc] = ss;
            }
        }
    }
    __device__ __forceinline__ void operator()(const f32x4 (&acc)[2][2][4][2], const Unit& u, int wr, int wc, int fr, int fq) const {
        if (resid_f32) body<true>(acc, u, wr, wc, fr, fq); else body<false>(acc, u, wr, wc, fr, fq);
    }
};
template <class Epi, class Sched, bool ALIGN_EPI = false, bool SP2 = false>
__device__ __forceinline__ void gemm_phase(PG8_LAS unsigned char* lds, const Gemm g, const Sched& S, const Epi& E) {
    int tid_ = threadIdx.x; asm volatile("" : "+v"(tid_));
    const int tid = tid_, wid = __builtin_amdgcn_readfirstlane(tid >> 6), lane = tid & 63, wr = wid >> 2, wc = wid & 3, fr = lane & 15, fq = lane >> 4;
    const int K = g.K, nt = K / BK;
    unsigned voffA[2], voffB[2];
#pragma unroll
    for (int i = 0; i < 2; ++i) { int R, C; stage_rc(tid * 16 + i * 8192, R, C); const int Rb = Epi::PERM ? ((R & ~31) + perm32(R & 31)) : R;
        voffA[i] = (unsigned)(R * K + C) * 2u; voffB[i] = (unsigned)(Rb * K + C) * 2u; }
    const size_t kstep = (size_t)(BK * 2);
    const size_t hstep = (size_t)HALF * K * 2;
    const size_t tstep = 2 * hstep;
    const unsigned ldsw = (unsigned)wid * 1024u;
    const int aoff = lds_byte(wr * 64 + fr, fq * 8), boff = lds_byte(wc * 32 + fr, fq * 8);
#define PG8_SA(b, h) (((b) * 2 + (h)) * HTB)
#define PG8_SB(b, h) ((4 + (b) * 2 + (h)) * HTB)
#define PG8_STAGE(bufoff, gbase, voff) do { _Pragma("unroll") for (int _i = 0; _i < 2; ++_i) \
        __builtin_amdgcn_global_load_lds((const unsigned*)((const char*)(gbase) + (voff)[_i]), (PG8_LAS unsigned*)(lds + (bufoff) + ldsw + _i * 8192), 16, 0, 0); } while (0)
#define PG8_LDA(dst, b, h) do { _Pragma("unroll") for (int m = 0; m < 4; ++m) _Pragma("unroll") for (int k = 0; k < 2; ++k) dst[m][k] = *(const PG8_LAS bf16x8*)(lds + PG8_SA(b, h) + aoff + m * 2048 + k * 1024); } while (0)
#define PG8_LDB(dst, b, h) do { _Pragma("unroll") for (int n = 0; n < 2; ++n) _Pragma("unroll") for (int k = 0; k < 2; ++k) dst[n][k] = *(const PG8_LAS bf16x8*)(lds + PG8_SB(b, h) + boff + n * 2048 + k * 1024); } while (0)
#define PG8_MMA(ai, bj, At, Bt) do { __builtin_amdgcn_s_setprio(1); _Pragma("unroll") for (int m = 0; m < 4; ++m) _Pragma("unroll") for (int n = 0; n < 2; ++n) _Pragma("unroll") for (int k = 0; k < 2; ++k) \
        acc[ai][bj][m][n] = __builtin_amdgcn_mfma_f32_16x16x32_bf16(Bt[n][k], At[m][k], acc[ai][bj][m][n], 0, 0, 0); __builtin_amdgcn_s_setprio(0); } while (0)
#define PG8_WAIT_V(n) asm volatile("s_waitcnt vmcnt(" #n ")" ::: "memory")
#define PG8_WAIT_L(n) asm volatile("s_waitcnt lgkmcnt(" #n ")" ::: "memory")
#define PG8_BAR __builtin_amdgcn_s_barrier()
#define PG8_SCHED __builtin_amdgcn_sched_barrier(0)
    Unit cur, nxt; int ui = 0;
    if (!S.next(0, cur)) return;
    f32x4 acc[2][2][4][2];
#pragma unroll
    for (int a = 0; a < 2; ++a)
#pragma unroll
        for (int b = 0; b < 2; ++b)
#pragma unroll
            for (int m = 0; m < 4; ++m)
#pragma unroll
                for (int n = 0; n < 2; ++n) acc[a][b][m][n] = (f32x4){0.f, 0.f, 0.f, 0.f};
    bf16x8 At[4][2], B0[2][2], B1[2][2];
    const char* cA = (const char*)g.A + (size_t)cur.pm * tstep; const char* cB = (const char*)g.Bt + (size_t)cur.pn * tstep;
    S.a_ready(cur);
    if constexpr (SP2) {
        PG8_STAGE(PG8_SB(0, 0), cB, voffB); PG8_STAGE(PG8_SB(0, 1), cB + hstep, voffB); PG8_STAGE(PG8_SA(0, 0), cA, voffA); PG8_STAGE(PG8_SA(0, 1), cA + hstep, voffA);
        if (wr == 1) PG8_BAR;
        PG8_WAIT_V(2); PG8_BAR;
        PG8_STAGE(PG8_SB(1, 0), cB + kstep, voffB); PG8_STAGE(PG8_SA(1, 0), cA + kstep, voffA); PG8_STAGE(PG8_SB(1, 1), cB + hstep + kstep, voffB);
        PG8_WAIT_V(6); PG8_BAR;
    } else {
        PG8_STAGE(PG8_SB(0, 0), cB, voffB); PG8_STAGE(PG8_SA(0, 0), cA, voffA); PG8_STAGE(PG8_SB(0, 1), cB + hstep, voffB); PG8_STAGE(PG8_SA(0, 1), cA + hstep, voffA);
        if (wr == 1) PG8_BAR;
        PG8_WAIT_V(4); PG8_BAR;
        PG8_STAGE(PG8_SB(1, 0), cB + kstep, voffB); PG8_STAGE(PG8_SA(1, 0), cA + kstep, voffA); PG8_STAGE(PG8_SB(1, 1), cB + hstep + kstep, voffB);
        PG8_WAIT_V(6); PG8_BAR;
    }
    for (;;) {
        const bool has_next = S.next(ui + 1, nxt);
        const char* nA = has_next ? (const char*)g.A + (size_t)nxt.pm * tstep : cA; const char* nB = has_next ? (const char*)g.Bt + (size_t)nxt.pn * tstep : cB;
        for (int t = 0; t < nt; t += 2) {
            const bool last = (t == nt - 2);
            const char* a1 = cA + (size_t)(t + 1) * kstep;
            const char* a2 = last ? nA : cA + (size_t)(t + 2) * kstep; const char* b2 = last ? nB : cB + (size_t)(t + 2) * kstep;
            const char* a3 = a2 + kstep; const char* b3 = b2 + kstep;
            if (last && has_next) S.a_ready(nxt);
            if constexpr (SP2) {
            PG8_LDB(B0, 0, 0); PG8_LDB(B1, 0, 1); PG8_SCHED; PG8_LDA(At, 0, 0); PG8_STAGE(PG8_SA(1, 1), a1 + hstep, voffA);
            PG8_WAIT_V(8); PG8_WAIT_L(0); PG8_BAR; PG8_MMA(0, 0, At, B0); PG8_MMA(0, 1, At, B1); PG8_BAR; PG8_SCHED;
            PG8_LDA(At, 0, 1); PG8_STAGE(PG8_SB(0, 0), b2, voffB); PG8_STAGE(PG8_SB(0, 1), b2 + hstep, voffB); PG8_STAGE(PG8_SA(0, 0), a2, voffA);
            PG8_WAIT_V(8); PG8_WAIT_L(0); PG8_BAR; PG8_MMA(1, 0, At, B0); PG8_MMA(1, 1, At, B1); PG8_BAR; PG8_SCHED;
            PG8_LDB(B0, 1, 0); PG8_LDB(B1, 1, 1); PG8_SCHED; PG8_LDA(At, 1, 0); PG8_STAGE(PG8_SA(0, 1), a2 + hstep, voffA);
            PG8_WAIT_V(8); PG8_WAIT_L(0); PG8_BAR; PG8_MMA(0, 0, At, B0); PG8_MMA(0, 1, At, B1); PG8_BAR; PG8_SCHED;
            PG8_LDA(At, 1, 1); PG8_STAGE(PG8_SB(1, 0), b3, voffB); PG8_STAGE(PG8_SB(1, 1), b3 + hstep, voffB); PG8_STAGE(PG8_SA(1, 0), a3, voffA);
            PG8_WAIT_V(8); PG8_WAIT_L(0); PG8_BAR; PG8_MMA(1, 0, At, B0); PG8_MMA(1, 1, At, B1); PG8_BAR; PG8_SCHED;
            } else {
            PG8_LDB(B0, 0, 0); PG8_SCHED; PG8_LDA(At, 0, 0); PG8_STAGE(PG8_SA(1, 1), a1 + hstep, voffA);
            PG8_WAIT_L(8); PG8_BAR; PG8_WAIT_L(0); PG8_MMA(0, 0, At, B0); PG8_BAR; PG8_SCHED;
            PG8_LDB(B1, 0, 1); PG8_STAGE(PG8_SB(0, 0), b2, voffB);
            PG8_BAR; PG8_WAIT_L(0); PG8_MMA(0, 1, At, B1); PG8_BAR;
            PG8_LDA(At, 0, 1); PG8_STAGE(PG8_SA(0, 0), a2, voffA);
            PG8_BAR; PG8_WAIT_L(0); PG8_MMA(1, 0, At, B0); PG8_BAR; PG8_SCHED;
            PG8_STAGE(PG8_SB(0, 1), b2 + hstep, voffB);
            PG8_WAIT_V(6); PG8_BAR; PG8_MMA(1, 1, At, B1); PG8_BAR;
            PG8_LDB(B0, 1, 0); PG8_SCHED; PG8_LDA(At, 1, 0); PG8_STAGE(PG8_SA(0, 1), a2 + hstep, voffA);
            PG8_WAIT_L(8); PG8_BAR; PG8_WAIT_L(0); PG8_MMA(0, 0, At, B0); PG8_BAR; PG8_SCHED;
            PG8_LDB(B1, 1, 1); PG8_STAGE(PG8_SB(1, 0), b3, voffB);
            PG8_BAR; PG8_WAIT_L(0); PG8_MMA(0, 1, At, B1); PG8_BAR;
            PG8_LDA(At, 1, 1); PG8_STAGE(PG8_SA(1, 0), a3, voffA);
            PG8_BAR; PG8_WAIT_L(0); PG8_MMA(1, 0, At, B0); PG8_BAR; PG8_SCHED;
            PG8_STAGE(PG8_SB(1, 1), b3 + hstep, voffB);
            PG8_WAIT_V(6); PG8_BAR; PG8_MMA(1, 1, At, B1); PG8_BAR;
            }
        }
        if constexpr (ALIGN_EPI) { if (wr == 0) PG8_BAR; }
        if constexpr (!Epi::AFTER_DRAIN) { E(acc, cur, wr, wc, fr, fq); S.done(cur); }
        if (!has_next) break;
#pragma unroll
        for (int a = 0; a < 2; ++a)
#pragma unroll
            for (int b = 0; b < 2; ++b)
#pragma unroll
                for (int m = 0; m < 4; ++m)
#pragma unroll
                    for (int n = 0; n < 2; ++n) acc[a][b][m][n] = (f32x4){0.f, 0.f, 0.f, 0.f};
        cur = nxt; cA = nA; cB = nB; ++ui;
        if constexpr (ALIGN_EPI) { if (wr == 1) PG8_BAR; }
    }
    PG8_WAIT_V(0);
    if constexpr (!ALIGN_EPI) { if (wr == 0) PG8_BAR; }
    PG8_BAR;
    if constexpr (Epi::AFTER_DRAIN) { E.fused(acc, cur, wr, wc, fr, fq, lds, wid, lane); S.done(cur); }
#undef PG8_SA
#undef PG8_SB
#undef PG8_STAGE
#undef PG8_LDA
#undef PG8_LDB
#undef PG8_MMA
#undef PG8_WAIT_V
#undef PG8_WAIT_L
#undef PG8_BAR
#undef PG8_SCHED
}
}
#define GAS __attribute__((address_space(1)))
#define LAS __attribute__((address_space(3)))
typedef unsigned short bf16;
typedef unsigned v4u __attribute__((ext_vector_type(4)));
typedef unsigned v2u __attribute__((ext_vector_type(2)));
typedef float f32x4 __attribute__((ext_vector_type(4)));
typedef float f32x16 __attribute__((ext_vector_type(16)));
typedef short bf16x8 __attribute__((ext_vector_type(8)));
typedef short s16x4 __attribute__((ext_vector_type(4)));
#define LDS_WAIT() asm volatile("s_waitcnt lgkmcnt(0)" ::: "memory")
using pg8::cvt_pk_bf16; using pg8::NORM_EPS; using pg8::QSCALE;

constexpr int NWAVES = 8, NTHREADS = 512;
constexpr float RESCALE_THR = 8.0f;
constexpr int D = 1024, BATCH = 16, SEQ = 4096, M = BATCH * SEQ;
constexpr int EVEN_IN = 3584, ODD_IN = 4096;
constexpr size_t MiB = 1u << 20;
constexpr size_t WS_WE_IN = 0, WS_WE_OUT = 14 * MiB, WS_WO_IN = 18 * MiB, WS_WO_OUT = 34 * MiB, WS_WS = 38 * MiB, WS_SSQ = 39 * MiB, WS_KMP = 43 * MiB,
                 WS_HB = 44 * MiB, WS_Y = 172 * MiB, WS_Z = 300 * MiB, WS_CTL = 812 * MiB, WS_END = 813 * MiB;
constexpr int LDS_BYTES = 131072 + 1024 + 16384;

__device__ __forceinline__ unsigned f2bf(float f) { unsigned u = __builtin_bit_cast(unsigned, f); return (u + 0x7fffu + ((u >> 16) & 1u)) >> 16; }
__device__ __forceinline__ unsigned pk2(float lo, float hi) { return f2bf(lo) | (f2bf(hi) << 16); }
__device__ __forceinline__ float bf_lo(unsigned w) { return __builtin_bit_cast(float, w << 16); }
__device__ __forceinline__ float bf_hi(unsigned w) { return __builtin_bit_cast(float, w & 0xffff0000u); }
__device__ __forceinline__ float wave_sum(float v) {
#pragma unroll
    for (int o = 1; o < 64; o <<= 1) v += __shfl_xor(v, o);
    return v;
}
typedef float f32x2_t __attribute__((ext_vector_type(2))); typedef __bf16 bf16x2_t __attribute__((ext_vector_type(2)));
__device__ __forceinline__ unsigned cvtpk_s(float lo, float hi) { f32x2_t v = {lo, hi}; bf16x2_t b = __builtin_convertvector(v, bf16x2_t); return __builtin_bit_cast(unsigned, b); }
__device__ __forceinline__ int crow(int r, int hi) { return (r & 3) + 8 * (r >> 2) + 4 * hi; }
__device__ __forceinline__ s16x4 vtr(const LAS unsigned char* p) { return __builtin_bit_cast(s16x4, __builtin_amdgcn_ds_read_tr16_b64_v4i16((LAS s16x4*)p)); }

__device__ __forceinline__ void transpose_item(const float* W, const float* g, int K, int N, bf16* WT, LAS float* scr, int item, int lane) {
    const int nblk = N / 32, kb = item / nblk, nb = item % nblk, k0 = 64 * kb, n0 = 32 * nb;
#pragma unroll 8
    for (int i = 0; i < 32; ++i) { const int kk = 2 * i + (lane >> 5); const float sc = g ? g[k0 + kk] : 1.f; scr[kk * 33 + (lane & 31)] = W[(size_t)(k0 + kk) * N + n0 + (lane & 31)] * sc; }
    LDS_WAIT(); asm volatile("" ::: "memory");
    const int c = lane & 7;
#pragma unroll
    for (int j = 0; j < 4; ++j) { const int n = (lane >> 3) + 8 * j; const LAS float* s = scr + (8 * c) * 33 + n;
        v4u o; o.x = pk2(s[0 * 33], s[1 * 33]); o.y = pk2(s[2 * 33], s[3 * 33]); o.z = pk2(s[4 * 33], s[5 * 33]); o.w = pk2(s[6 * 33], s[7 * 33]);
        *(v4u*)(WT + (size_t)(n0 + n) * K + k0 + 8 * c) = o; }
    LDS_WAIT(); asm volatile("" ::: "memory");
}

struct Args {
    const float *x, *norm_g, *final_g, *ab_w_in, *ab_w_out, *ln_g, *ln_b, *w_s, *b_s, *c_w_in, *c_w_out;
    float* out; unsigned char* ws;
};

__device__ __forceinline__ void phase_prologue(const Args& A, LAS unsigned char* lds, int gwv, int NGW, int wave, int lane) {
    LAS float* scr = (LAS float*)(lds + wave * 16384);
    constexpr int I_EIN = 16 * (EVEN_IN / 32), I_OUT = 16 * 32, I_OIN = 16 * (ODD_IN / 32), I_PAIR = I_EIN + I_OUT + I_OIN + I_OUT;
    for (int it = gwv; it < 2 * I_PAIR; it += NGW) {
        const int i = it / I_PAIR; int r = it % I_PAIR;
        if (r < I_EIN) { transpose_item(A.ab_w_in + (size_t)i * D * EVEN_IN, A.norm_g + (2 * i) * D, D, EVEN_IN, (bf16*)(A.ws + WS_WE_IN) + (size_t)i * EVEN_IN * D, scr, r, lane); continue; } r -= I_EIN;
        if (r < I_OUT) { transpose_item(A.ab_w_out + (size_t)i * D * D, nullptr, D, D, (bf16*)(A.ws + WS_WE_OUT) + (size_t)i * D * D, scr, r, lane); continue; } r -= I_OUT;
        if (r < I_OIN) { transpose_item(A.c_w_in + (size_t)i * D * ODD_IN, A.norm_g + (2 * i + 1) * D, D, ODD_IN, (bf16*)(A.ws + WS_WO_IN) + (size_t)i * ODD_IN * D, scr, r, lane); continue; } r -= I_OIN;
        transpose_item(A.c_w_out + (size_t)i * D * D, nullptr, D, D, (bf16*)(A.ws + WS_WO_OUT) + (size_t)i * D * D, scr, r, lane);
    }
    { bf16* wst = (bf16*)(A.ws + WS_WS);
      for (int e = gwv * 64 + lane; e < 2 * 4 * 128 * 128; e += NGW * 64) { const int s = e & 127, t = (e >> 7) & 127; wst[e] = (bf16)f2bf(s <= t ? A.w_s[e] : 0.f); } }
    bf16* hb = (bf16*)(A.ws + WS_HB); float* ssqp = (float*)(A.ws + WS_SSQ);
    for (int m = gwv; m < M; m += 2 * NGW) {
        const int m2 = m + NGW;
        const f32x4* xr = (const f32x4*)(A.x + (size_t)m * D) + lane; const f32x4* xr2 = (const f32x4*)(A.x + (size_t)m2 * D) + lane;
        f32x4 v[4], w4[4];
#pragma unroll
        for (int j = 0; j < 4; ++j) { v[j] = xr[64 * j]; w4[j] = xr2[64 * j]; }
        float s = 0.f, s2 = 0.f;
#pragma unroll
        for (int j = 0; j < 4; ++j) { s += (v[j][0] * v[j][0] + v[j][1] * v[j][1]) + (v[j][2] * v[j][2] + v[j][3] * v[j][3]); s2 += (w4[j][0] * w4[j][0] + w4[j][1] * w4[j][1]) + (w4[j][2] * w4[j][2] + w4[j][3] * w4[j][3]); }
        s = wave_sum(s); s2 = wave_sum(s2);
        v2u* o8 = (v2u*)(hb + (size_t)m * D) + lane; v2u* o82 = (v2u*)(hb + (size_t)m2 * D) + lane;
#pragma unroll
        for (int j = 0; j < 4; ++j) { v2u w; w.x = cvtpk_s(v[j][0], v[j][1]); w.y = cvtpk_s(v[j][2], v[j][3]); o8[64 * j] = w; v2u w2; w2.x = cvtpk_s(w4[j][0], w4[j][1]); w2.y = cvtpk_s(w4[j][2], w4[j][3]); o82[64 * j] = w2; }
        if (lane < 16) { ssqp[(size_t)m * 16 + lane] = (lane == 0) ? s : 0.f; ssqp[(size_t)m2 * 16 + lane] = (lane == 0) ? s2 : 0.f; }
    }
}

__device__ __forceinline__ void phase_gmlp(const Args& A, int li, LAS unsigned char* lds, int vcu, int G, int wave, int lane) {
    const bf16* Z = (const bf16*)(A.ws + WS_Z); bf16* Y = (bf16*)(A.ws + WS_Y);
    const bf16* wst = (const bf16*)(A.ws + WS_WS) + (size_t)li * 4 * 128 * 128;
    const float* lng = A.ln_g + li * 512; const float* lnb = A.ln_b + li * 512; const float* bs = A.b_s + li * 4 * 128;
    const int r32 = lane & 31, hi = lane >> 5, grp = lane >> 4, qq = (lane & 15) >> 2, pp = lane & 3;
    float gg[8], gb[8];
#pragma unroll
    for (int j = 0; j < 8; ++j) { gg[j] = lng[8 * lane + j]; gb[j] = lnb[8 * lane + j]; }
    for (int u = vcu; u < M / 128; u += G) {
        const size_t row0 = (size_t)u * 128;
#pragma unroll 1
        for (int r4 = 0; r4 < 16; r4 += 8) {
            v4u wv[8];
#pragma unroll
            for (int k = 0; k < 8; ++k) wv[k] = *(const v4u*)(Z + (row0 + wave * 16 + r4 + k) * EVEN_IN + 512 + 8 * lane);
#pragma unroll
            for (int k = 0; k < 8; ++k) {
                const int s = wave * 16 + r4 + k; const v4u w = wv[k];
                float x[8] = {bf_lo(w.x), bf_hi(w.x), bf_lo(w.y), bf_hi(w.y), bf_lo(w.z), bf_hi(w.z), bf_lo(w.w), bf_hi(w.w)};
                float sm = 0.f;
#pragma unroll
                for (int j = 0; j < 8; ++j) sm += x[j];
                const float mean = wave_sum(sm) * (1.f / 512.f); float sq = 0.f;
#pragma unroll
                for (int j = 0; j < 8; ++j) { x[j] -= mean; sq += x[j] * x[j]; }
                const float rstd = __builtin_amdgcn_rsqf(wave_sum(sq) * (1.f / 512.f) + NORM_EPS);
#pragma unroll
                for (int j = 0; j < 8; ++j) x[j] = x[j] * rstd * gg[j] + gb[j];
                v4u o; o.x = cvtpk_s(x[0], x[1]); o.y = cvtpk_s(x[2], x[3]); o.z = cvtpk_s(x[4], x[5]); o.w = cvtpk_s(x[6], x[7]);
                *(LAS v4u*)(lds + ((s >> 3) * 16 + (lane >> 2)) * 512 + (s & 7) * 64 + (lane & 3) * 16) = o;
            }
        }
        __syncthreads();
        const int g = wave >> 1;
#pragma unroll 1
        for (int t2 = 0; t2 < 2; ++t2) {
            const int tt = (wave & 1) * 2 + t2;
            f32x16 acc[4];
#pragma unroll
            for (int ct = 0; ct < 4; ++ct) acc[ct] = f32x16{};
            const bf16* wrow = wst + ((size_t)g * 128 + 32 * tt + r32) * 128 + 8 * hi;
            bf16x8 bw[8];
#pragma unroll
            for (int ks = 0; ks < 8; ++ks) bw[ks] = *(const bf16x8*)(wrow + 16 * ks);
#pragma unroll
            for (int ks = 0; ks < 8; ++ks) {
                const bf16x8 bfrag = bw[ks];
#pragma unroll
                for (int ct = 0; ct < 4; ++ct) {
                    const LAS unsigned char* p = lds + ((2 * ks + hi) * 16 + 4 * g + ct) * 512 + qq * 64 + (16 * (grp & 1) + 4 * pp) * 2;
                    const s16x4 lo = vtr(p), hi4 = vtr(p + 256);
                    const bf16x8 afrag = (bf16x8){lo[0], lo[1], lo[2], lo[3], hi4[0], hi4[1], hi4[2], hi4[3]};
                    acc[ct] = __builtin_amdgcn_mfma_f32_32x32x16_bf16(afrag, bfrag, acc[ct], 0, 0, 0);
                }
            }
            const int t = 32 * tt + r32; const size_t row = row0 + t; const float bias = bs[g * 128 + t];
            v2u ub[4][4], gb2[4][4];
#pragma unroll
            for (int ct = 0; ct < 4; ++ct)
#pragma unroll
                for (int rq = 0; rq < 4; ++rq) { const int c = g * 128 + 32 * ct + 8 * rq + 4 * hi; ub[ct][rq] = *(const v2u*)(Z + row * EVEN_IN + c); gb2[ct][rq] = *(const v2u*)(Z + row * EVEN_IN + 1024 + c); }
#pragma unroll
            for (int ct = 0; ct < 4; ++ct)
#pragma unroll
                for (int rq = 0; rq < 4; ++rq) {
                    const int c = g * 128 + 32 * ct + 8 * rq + 4 * hi;
                    const v2u uu = ub[ct][rq], ga = gb2[ct][rq];
                    const float y0 = bf_lo(uu.x) * (acc[ct][4 * rq + 0] + bias) * bf_lo(ga.x), y1 = bf_hi(uu.x) * (acc[ct][4 * rq + 1] + bias) * bf_hi(ga.x);
                    const float y2 = bf_lo(uu.y) * (acc[ct][4 * rq + 2] + bias) * bf_lo(ga.y), y3 = bf_hi(uu.y) * (acc[ct][4 * rq + 3] + bias) * bf_hi(ga.y);
                    v2u o; o.x = cvtpk_s(y0, y1); o.y = cvtpk_s(y2, y3);
                    *(v2u*)(Y + row * D + c) = o;
                }
        }
        __syncthreads();
    }
}

struct AttnSt { f32x16 o0, o1; float m, l; };
template <class MaskF>
__device__ __forceinline__ void attn_tile(AttnSt& st, const bf16x8 (&qf)[4], const bf16* kp, const bf16* vp0, const bf16* vp1, const bf16* vp2, const bf16* vp3, LAS unsigned char* vl, int lane, bool domask, MaskF mask) {
    const int hi = lane >> 5, grp = lane >> 4, qq = (lane & 15) >> 2, pp = lane & 3;
    bf16x8 kf[4]; v4u vv[4];
#pragma unroll
    for (int d0 = 0; d0 < 4; ++d0) kf[d0] = *(const bf16x8*)(kp + 16 * d0);
    vv[0] = *(const v4u*)vp0; vv[1] = *(const v4u*)vp1; vv[2] = *(const v4u*)vp2; vv[3] = *(const v4u*)vp3;
    f32x16 s = f32x16{};
#pragma unroll
    for (int d0 = 0; d0 < 4; ++d0) s = __builtin_amdgcn_mfma_f32_32x32x16_bf16(kf[d0], qf[d0], s, 0, 0, 0);
#pragma unroll
    for (int it = 0; it < 4; ++it) *(LAS v4u*)(vl + (it * 2 + ((lane & 7) >> 2)) * 512 + (lane >> 3) * 64 + (lane & 3) * 16) = vv[it];
    if (domask) {
#pragma unroll
        for (int r = 0; r < 16; ++r) if (!mask(crow(r, hi))) s[r] = -INFINITY;
    }
    float mt = s[0];
#pragma unroll
    for (int r = 1; r < 16; ++r) mt = fmaxf(mt, s[r]);
    mt = fmaxf(mt, __shfl_xor(mt, 32));
    if (__any(mt > st.m + RESCALE_THR)) {
        const float mn = fmaxf(st.m, mt);
        const float f = __builtin_amdgcn_exp2f(st.m - mn); st.l *= f; st.m = mn;
#pragma unroll
        for (int r = 0; r < 16; ++r) { st.o0[r] *= f; st.o1[r] *= f; }
    }
    float ps = 0.f;
#pragma unroll
    for (int r = 0; r < 16; ++r) { s[r] = __builtin_amdgcn_exp2f(s[r] - st.m); ps += s[r]; }
    st.l += ps;
    v4u pw0, pw1;
    pw0.x = cvtpk_s(s[0], s[1]); pw0.y = cvtpk_s(s[2], s[3]); pw0.z = cvtpk_s(s[4], s[5]); pw0.w = cvtpk_s(s[6], s[7]);
    pw1.x = cvtpk_s(s[8], s[9]); pw1.y = cvtpk_s(s[10], s[11]); pw1.z = cvtpk_s(s[12], s[13]); pw1.w = cvtpk_s(s[14], s[15]);
    const bf16x8 pf0 = __builtin_bit_cast(bf16x8, pw0), pf1 = __builtin_bit_cast(bf16x8, pw1);
    const LAS unsigned char* tb = vl + (4 * hi + qq) * 64 + (16 * (grp & 1) + 4 * pp) * 2;
#define VFRAG(ks, d0) ({ const s16x4 lo_ = vtr(tb + ((2 * (ks)) * 2 + (d0)) * 512), hi_ = vtr(tb + ((2 * (ks) + 1) * 2 + (d0)) * 512); (bf16x8){lo_[0], lo_[1], lo_[2], lo_[3], hi_[0], hi_[1], hi_[2], hi_[3]}; })
    st.o0 = __builtin_amdgcn_mfma_f32_32x32x16_bf16(VFRAG(0, 0), pf0, st.o0, 0, 0, 0);
    st.o1 = __builtin_amdgcn_mfma_f32_32x32x16_bf16(VFRAG(0, 1), pf0, st.o1, 0, 0, 0);
    st.o0 = __builtin_amdgcn_mfma_f32_32x32x16_bf16(VFRAG(1, 0), pf1, st.o0, 0, 0, 0);
    st.o1 = __builtin_amdgcn_mfma_f32_32x32x16_bf16(VFRAG(1, 1), pf1, st.o1, 0, 0, 0);
#undef VFRAG
}
__device__ __forceinline__ v4u pair_to_wide(v2u gk, v2u gk1) {
    const auto sx = __builtin_amdgcn_permlane32_swap(gk.x, gk1.x, false, false), sy = __builtin_amdgcn_permlane32_swap(gk.y, gk1.y, false, false);
    return (v4u){sx[0], sy[0], sx[1], sy[1]};
}
__device__ __forceinline__ void wide_to_pair(v4u w, v2u& gk, v2u& gk1) {
    const auto sx = __builtin_amdgcn_permlane32_swap(w.x, w.z, false, false), sy = __builtin_amdgcn_permlane32_swap(w.y, w.w, false, false);
    gk.x = sx[0]; gk.y = sy[0]; gk1.x = sx[1]; gk1.y = sy[1];
}
__device__ __forceinline__ void attn_store(const AttnSt& st, const bf16* grow, bf16* yrow, int lane) {
    const int hi = lane >> 5;
    const float lt = st.l + __shfl_xor(st.l, 32), inv = 1.0f / lt;
    v2u ga[2][4];
#pragma unroll
    for (int d0 = 0; d0 < 2; ++d0)
#pragma unroll
        for (int rq = 0; rq < 4; ++rq) ga[d0][rq] = *(const v2u*)(grow + 32 * d0 + 8 * rq + 4 * hi);
#pragma unroll
    for (int d0 = 0; d0 < 2; ++d0)
#pragma unroll
        for (int rq = 0; rq < 4; ++rq) {
            const int d = 32 * d0 + 8 * rq + 4 * hi;
            const v2u g = ga[d0][rq];
            const f32x16& o = d0 ? st.o1 : st.o0;
            v2u w; w.x = cvtpk_s(o[4 * rq + 0] * inv * bf_lo(g.x), o[4 * rq + 1] * inv * bf_hi(g.x)); w.y = cvtpk_s(o[4 * rq + 2] * inv * bf_lo(g.y), o[4 * rq + 3] * inv * bf_hi(g.y));
            *(v2u*)(yrow + d) = w;
        }
}

__device__ __forceinline__ void attn_gate_load(v2u (&ga)[2][4], const bf16* grow, int lane) {
    const int hi = lane >> 5;
#pragma unroll
    for (int d0 = 0; d0 < 2; ++d0)
#pragma unroll
        for (int pr = 0; pr < 2; ++pr) { const v4u w = *(const v4u*)(grow + 32 * d0 + 16 * pr + 8 * hi); wide_to_pair(w, ga[d0][2 * pr], ga[d0][2 * pr + 1]); }
}
__device__ __forceinline__ void attn_store_g(const AttnSt& st, const v2u (&ga)[2][4], bf16* yrow, int lane) {
    const int hi = lane >> 5;
    const float lt = st.l + __shfl_xor(st.l, 32), inv = 1.0f / lt;
#pragma unroll
    for (int d0 = 0; d0 < 2; ++d0)
#pragma unroll
        for (int pr = 0; pr < 2; ++pr) {
            v2u w2[2];
#pragma unroll
            for (int k = 0; k < 2; ++k) {
                const int rq = 2 * pr + k; const v2u g = ga[d0][rq]; const f32x16& o = d0 ? st.o1 : st.o0;
                w2[k].x = cvtpk_s(o[4 * rq + 0] * inv * bf_lo(g.x), o[4 * rq + 1] * inv * bf_hi(g.x)); w2[k].y = cvtpk_s(o[4 * rq + 2] * inv * bf_lo(g.y), o[4 * rq + 3] * inv * bf_hi(g.y));
            }
            *(v4u*)(yrow + 32 * d0 + 16 * pr + 8 * hi) = pair_to_wide(w2[0], w2[1]);
        }
}

struct TileRegs { v4u kk[4]; v4u vv[4]; };
__device__ __forceinline__ void attn_load(TileRegs& R, int kvoff, const bf16* vp0, const bf16* vp1, const bf16* vp2, const bf16* vp3) {
    R.kk[0] = *(const v4u*)(vp0 - kvoff); R.kk[1] = *(const v4u*)(vp1 - kvoff); R.kk[2] = *(const v4u*)(vp2 - kvoff); R.kk[3] = *(const v4u*)(vp3 - kvoff);
    R.vv[0] = *(const v4u*)vp0; R.vv[1] = *(const v4u*)vp1; R.vv[2] = *(const v4u*)vp2; R.vv[3] = *(const v4u*)vp3;
}
__device__ __forceinline__ void attn_load_k(TileRegs& R, int kvoff, const bf16* vp0, const bf16* vp1, const bf16* vp2, const bf16* vp3) {
    R.kk[0] = *(const v4u*)(vp0 - kvoff); R.kk[1] = *(const v4u*)(vp1 - kvoff); R.kk[2] = *(const v4u*)(vp2 - kvoff); R.kk[3] = *(const v4u*)(vp3 - kvoff);
}
__device__ __forceinline__ void attn_load_v(TileRegs& R, const bf16* vp0, const bf16* vp1, const bf16* vp2, const bf16* vp3) {
    R.vv[0] = *(const v4u*)vp0; R.vv[1] = *(const v4u*)vp1; R.vv[2] = *(const v4u*)vp2; R.vv[3] = *(const v4u*)vp3;
}
template <int MODE>
__device__ __forceinline__ void attn_compute(AttnSt& st, const bf16x8 (&qf)[4], const TileRegs& R, LAS unsigned char* vl, int lane, bool keep, int dd0, int kmin) {
    const int r32 = lane & 31, hi = lane >> 5, grp = lane >> 4, qq = (lane & 15) >> 2, pp = lane & 3;
    LAS unsigned char* kl = vl + 32768;
#pragma unroll
    for (int it = 0; it < 4; ++it) { const int row = it * 8 + (lane >> 3); *(LAS v4u*)(kl + row * 128 + (((lane & 7) ^ (row & 7)) << 4)) = R.kk[it]; }
#pragma unroll
    for (int it = 0; it < 4; ++it) *(LAS v4u*)(vl + (it * 2 + ((lane & 7) >> 2)) * 512 + (lane >> 3) * 64 + (lane & 3) * 16) = R.vv[it];
    f32x16 s = f32x16{};
#pragma unroll
    for (int d0 = 0; d0 < 4; ++d0) {
        const v4u kw = *(const LAS v4u*)(kl + r32 * 128 + (((2 * d0 + hi) ^ (r32 & 7)) << 4));
        s = __builtin_amdgcn_mfma_f32_32x32x16_bf16(__builtin_bit_cast(bf16x8, kw), qf[d0], s, 0, 0, 0);
    }
    if (MODE == 1) {
#pragma unroll
        for (int r = 0; r < 16; ++r) if (crow(r, hi) > r32) s[r] = -INFINITY;
    } else if (MODE == 2) {
#pragma unroll
        for (int r = 0; r < 16; ++r) s[r] = keep ? s[r] : -INFINITY;
    } else if (MODE == 3) {
        const int ddh = dd0 - 4 * hi, kmh = kmin - 4 * hi;
#pragma unroll
        for (int r = 0; r < 16; ++r) { const int c = (r & 3) + 8 * (r >> 2); if ((unsigned)(ddh - c) > 128u || c < kmh) s[r] = -INFINITY; }
    }
    float mt = s[0];
#pragma unroll
    for (int r = 1; r < 16; ++r) mt = fmaxf(mt, s[r]);
    mt = fmaxf(mt, __shfl_xor(mt, 32));
    if (__any(mt > st.m + RESCALE_THR)) {
        const float mn = fmaxf(st.m, mt);
        const float f = __builtin_amdgcn_exp2f(st.m - mn); st.l *= f; st.m = mn;
#pragma unroll
        for (int r = 0; r < 16; ++r) { st.o0[r] *= f; st.o1[r] *= f; }
    }
    float ps = 0.f;
#pragma unroll
    for (int r = 0; r < 16; ++r) { s[r] = __builtin_amdgcn_exp2f(s[r] - st.m); ps += s[r]; }
    st.l += ps;
    v4u pw0, pw1;
    pw0.x = cvtpk_s(s[0], s[1]); pw0.y = cvtpk_s(s[2], s[3]); pw0.z = cvtpk_s(s[4], s[5]); pw0.w = cvtpk_s(s[6], s[7]);
    pw1.x = cvtpk_s(s[8], s[9]); pw1.y = cvtpk_s(s[10], s[11]); pw1.z = cvtpk_s(s[12], s[13]); pw1.w = cvtpk_s(s[14], s[15]);
    const bf16x8 pf0 = __builtin_bit_cast(bf16x8, pw0), pf1 = __builtin_bit_cast(bf16x8, pw1);
    const LAS unsigned char* tb = vl + (4 * hi + qq) * 64 + (16 * (grp & 1) + 4 * pp) * 2;
#define VFRAG(ks, d0) ({ const s16x4 lo_ = vtr(tb + ((2 * (ks)) * 2 + (d0)) * 512), hi_ = vtr(tb + ((2 * (ks) + 1) * 2 + (d0)) * 512); (bf16x8){lo_[0], lo_[1], lo_[2], lo_[3], hi_[0], hi_[1], hi_[2], hi_[3]}; })
    st.o0 = __builtin_amdgcn_mfma_f32_32x32x16_bf16(VFRAG(0, 0), pf0, st.o0, 0, 0, 0);
    st.o1 = __builtin_amdgcn_mfma_f32_32x32x16_bf16(VFRAG(0, 1), pf0, st.o1, 0, 0, 0);
    st.o0 = __builtin_amdgcn_mfma_f32_32x32x16_bf16(VFRAG(1, 0), pf1, st.o0, 0, 0, 0);
    st.o1 = __builtin_amdgcn_mfma_f32_32x32x16_bf16(VFRAG(1, 1), pf1, st.o1, 0, 0, 0);
#undef VFRAG
}

template <class MaskF>
__device__ __forceinline__ void attn_subtile_lds(AttnSt& st, const bf16x8 (&qf)[4], const LAS unsigned char* kb, const LAS unsigned char* vl, int lane, bool domask, MaskF mask) {
    const int r32 = lane & 31, hi = lane >> 5, grp = lane >> 4, qq = (lane & 15) >> 2, pp = lane & 3;
    f32x16 s = f32x16{};
#pragma unroll
    for (int d0 = 0; d0 < 4; ++d0) {
        const bf16x8 kf = *(const LAS bf16x8*)(kb + r32 * 128 + (((2 * d0 + hi) ^ (r32 & 7)) << 4));
        s = __builtin_amdgcn_mfma_f32_32x32x16_bf16(kf, qf[d0], s, 0, 0, 0);
    }
    if (domask) {
#pragma unroll
        for (int r = 0; r < 16; ++r) if (!mask(crow(r, hi))) s[r] = -INFINITY;
    }
    float mt = s[0];
#pragma unroll
    for (int r = 1; r < 16; ++r) mt = fmaxf(mt, s[r]);
    mt = fmaxf(mt, __shfl_xor(mt, 32));
    if (__any(mt > st.m + RESCALE_THR)) {
        const float mn = fmaxf(st.m, mt);
        const float f = __builtin_amdgcn_exp2f(st.m - mn); st.l *= f; st.m = mn;
#pragma unroll
        for (int r = 0; r < 16; ++r) { st.o0[r] *= f; st.o1[r] *= f; }
    }
    float ps = 0.f;
#pragma unroll
    for (int r = 0; r < 16; ++r) { s[r] = __builtin_amdgcn_exp2f(s[r] - st.m); ps += s[r]; }
    st.l += ps;
    v4u pw0, pw1;
    pw0.x = cvtpk_s(s[0], s[1]); pw0.y = cvtpk_s(s[2], s[3]); pw0.z = cvtpk_s(s[4], s[5]); pw0.w = cvtpk_s(s[6], s[7]);
    pw1.x = cvtpk_s(s[8], s[9]); pw1.y = cvtpk_s(s[10], s[11]); pw1.z = cvtpk_s(s[12], s[13]); pw1.w = cvtpk_s(s[14], s[15]);
    const bf16x8 pf0 = __builtin_bit_cast(bf16x8, pw0), pf1 = __builtin_bit_cast(bf16x8, pw1);
    const LAS unsigned char* tb = vl + (4 * hi + qq) * 64 + (16 * (grp & 1) + 4 * pp) * 2;
#define VFRAG(ks, d0) ({ const s16x4 lo_ = vtr(tb + ((2 * (ks)) * 2 + (d0)) * 512), hi_ = vtr(tb + ((2 * (ks) + 1) * 2 + (d0)) * 512); (bf16x8){lo_[0], lo_[1], lo_[2], lo_[3], hi_[0], hi_[1], hi_[2], hi_[3]}; })
    st.o0 = __builtin_amdgcn_mfma_f32_32x32x16_bf16(VFRAG(0, 0), pf0, st.o0, 0, 0, 0);
    st.o1 = __builtin_amdgcn_mfma_f32_32x32x16_bf16(VFRAG(0, 1), pf0, st.o1, 0, 0, 0);
    st.o0 = __builtin_amdgcn_mfma_f32_32x32x16_bf16(VFRAG(1, 0), pf1, st.o0, 0, 0, 0);
    st.o1 = __builtin_amdgcn_mfma_f32_32x32x16_bf16(VFRAG(1, 1), pf1, st.o1, 0, 0, 0);
#undef VFRAG
}
template <int M0, int M1>
__device__ __forceinline__ void attn_tile64_lds(AttnSt& st, const bf16x8 (&qf)[4], const LAS unsigned char* kb, const LAS unsigned char* vb, int lane, bool keep) {
    const int r32 = lane & 31, hi = lane >> 5, grp = lane >> 4, qq = (lane & 15) >> 2, pp = lane & 3;
    f32x16 s0 = f32x16{}, s1 = f32x16{};
#pragma unroll
    for (int d0 = 0; d0 < 4; ++d0) {
        const int ko = r32 * 128 + (((2 * d0 + hi) ^ (r32 & 7)) << 4);
        const v4u k0 = *(const LAS v4u*)(kb + ko), k1 = *(const LAS v4u*)(kb + 4096 + ko);
        s0 = __builtin_amdgcn_mfma_f32_32x32x16_bf16(__builtin_bit_cast(bf16x8, k0), qf[d0], s0, 0, 0, 0);
        s1 = __builtin_amdgcn_mfma_f32_32x32x16_bf16(__builtin_bit_cast(bf16x8, k1), qf[d0], s1, 0, 0, 0);
    }
    if (M0 == 1 || M1 == 1) {
#pragma unroll
        for (int r = 0; r < 16; ++r) {
            if (M0 == 1) { if (crow(r, hi) > r32) s0[r] = -INFINITY; }
            if (M1 == 1) { if (crow(r, hi) > r32) s1[r] = -INFINITY; }
        }
    }
    float mt = fmaxf(s0[0], s1[0]);
#pragma unroll
    for (int r = 1; r < 16; ++r) mt = fmaxf(mt, fmaxf(s0[r], s1[r]));
    mt = fmaxf(mt, __shfl_xor(mt, 32));
    if (__any(mt > st.m + RESCALE_THR)) {
        const float mn = fmaxf(st.m, mt);
        const float f = __builtin_amdgcn_exp2f(st.m - mn); st.l *= f; st.m = mn;
#pragma unroll
        for (int r = 0; r < 16; ++r) { st.o0[r] *= f; st.o1[r] *= f; }
    }
    const float mo = (M0 == 2 && !keep) ? INFINITY : st.m;
    const f32x2_t mo2 = {mo, mo}; f32x2_t acc2 = {0.f, 0.f};
#pragma unroll
    for (int r = 0; r < 16; r += 2) {
        f32x2_t v0 = (f32x2_t){s0[r], s0[r + 1]} - mo2, v1 = (f32x2_t){s1[r], s1[r + 1]} - mo2;
        v0.x = __builtin_amdgcn_exp2f(v0.x); v0.y = __builtin_amdgcn_exp2f(v0.y); v1.x = __builtin_amdgcn_exp2f(v1.x); v1.y = __builtin_amdgcn_exp2f(v1.y);
        acc2 += v0; acc2 += v1;
        s0[r] = v0.x; s0[r + 1] = v0.y; s1[r] = v1.x; s1[r + 1] = v1.y;
    }
    st.l += acc2.x + acc2.y;
    v4u p00, p01, p10, p11;
    p00.x = cvtpk_s(s0[0], s0[1]); p00.y = cvtpk_s(s0[2], s0[3]); p00.z = cvtpk_s(s0[4], s0[5]); p00.w = cvtpk_s(s0[6], s0[7]);
    p01.x = cvtpk_s(s0[8], s0[9]); p01.y = cvtpk_s(s0[10], s0[11]); p01.z = cvtpk_s(s0[12], s0[13]); p01.w = cvtpk_s(s0[14], s0[15]);
    p10.x = cvtpk_s(s1[0], s1[1]); p10.y = cvtpk_s(s1[2], s1[3]); p10.z = cvtpk_s(s1[4], s1[5]); p10.w = cvtpk_s(s1[6], s1[7]);
    p11.x = cvtpk_s(s1[8], s1[9]); p11.y = cvtpk_s(s1[10], s1[11]); p11.z = cvtpk_s(s1[12], s1[13]); p11.w = cvtpk_s(s1[14], s1[15]);
    const bf16x8 f00 = __builtin_bit_cast(bf16x8, p00), f01 = __builtin_bit_cast(bf16x8, p01), f10 = __builtin_bit_cast(bf16x8, p10), f11 = __builtin_bit_cast(bf16x8, p11);
    const LAS unsigned char* tb = vb + (4 * hi + qq) * 64 + (16 * (grp & 1) + 4 * pp) * 2;
#define VFRAG(sub, ks, d0) ({ const s16x4 lo_ = vtr(tb + (sub) * 4096 + ((2 * (ks)) * 2 + (d0)) * 512), hi_ = vtr(tb + (sub) * 4096 + ((2 * (ks) + 1) * 2 + (d0)) * 512); (bf16x8){lo_[0], lo_[1], lo_[2], lo_[3], hi_[0], hi_[1], hi_[2], hi_[3]}; })
    st.o0 = __builtin_amdgcn_mfma_f32_32x32x16_bf16(VFRAG(0, 0, 0), f00, st.o0, 0, 0, 0);
    st.o1 = __builtin_amdgcn_mfma_f32_32x32x16_bf16(VFRAG(0, 0, 1), f00, st.o1, 0, 0, 0);
    st.o0 = __builtin_amdgcn_mfma_f32_32x32x16_bf16(VFRAG(0, 1, 0), f01, st.o0, 0, 0, 0);
    st.o1 = __builtin_amdgcn_mfma_f32_32x32x16_bf16(VFRAG(0, 1, 1), f01, st.o1, 0, 0, 0);
    st.o0 = __builtin_amdgcn_mfma_f32_32x32x16_bf16(VFRAG(1, 0, 0), f10, st.o0, 0, 0, 0);
    st.o1 = __builtin_amdgcn_mfma_f32_32x32x16_bf16(VFRAG(1, 0, 1), f10, st.o1, 0, 0, 0);
    st.o0 = __builtin_amdgcn_mfma_f32_32x32x16_bf16(VFRAG(1, 1, 0), f11, st.o0, 0, 0, 0);
    st.o1 = __builtin_amdgcn_mfma_f32_32x32x16_bf16(VFRAG(1, 1, 1), f11, st.o1, 0, 0, 0);
#undef VFRAG
}
__device__ __forceinline__ void phase_moba_s(const Args& A, LAS unsigned char* lds, int G, int vcu, int wave, int lane) {
    const bf16* Z = (const bf16*)(A.ws + WS_Z); bf16* Y = (bf16*)(A.ws + WS_Y); const float* kmp = (const float*)(A.ws + WS_KMP);
    const int r32 = lane & 31, hi = lane >> 5, tid = wave * 64 + lane;
    const int skey = tid >> 3, sch = tid & 7;
    const int kwoff = skey * 128 + ((sch ^ (skey & 7)) << 4);
    const int vwoff = ((skey >> 3) * 2 + (sch >> 2)) * 512 + (skey & 7) * 64 + (sch & 3) * 16;
    for (int U = vcu; U < 2048; U += G) {
        const int it8 = U >> 8, v = U & 255, j = v & 7;
        const int blk = (it8 & 1) ? 15 - j : j, bh = (v >> 3) * 4 + (it8 >> 1);
        const int b = bh >> 3, hh = bh & 7, q0 = blk * 256 + 32 * wave;
        const size_t rowbase = (size_t)b * SEQ;
        const bf16* zq = Z + (rowbase + q0 + r32) * EVEN_IN;
        const bf16* Kh = Z + rowbase * EVEN_IN + 2048 + hh * 64 + (size_t)skey * EVEN_IN + 8 * sch; const bf16* Vh = Kh + 512;
        v4u kreg = *(const v4u*)(Kh + (size_t)(blk * 256) * EVEN_IN), vreg = *(const v4u*)(Vh + (size_t)(blk * 256) * EVEN_IN);
        bf16x8 qf[4];
#pragma unroll
        for (int d0 = 0; d0 < 4; ++d0) qf[d0] = *(const bf16x8*)(zq + 1536 + hh * 64 + 16 * d0 + 8 * hi);
        v2u gg[2][4]; attn_gate_load(gg, zq + 3072 + hh * 64, lane);
        unsigned sel = 0u;
        if (blk > 0) {
            f32x16 gt = f32x16{};
#pragma unroll
            for (int d0 = 0; d0 < 4; ++d0) {
                bf16x8 kmf = bf16x8{};
                if (r32 < 16) {
                    const float* p0 = kmp + (((size_t)b * 16 + r32) * 2) * 512 + hh * 64 + 16 * d0 + 8 * hi;
                    const f32x4 a0 = *(const f32x4*)p0, a1 = *(const f32x4*)(p0 + 4), b0 = *(const f32x4*)(p0 + 512), b1 = *(const f32x4*)(p0 + 516);
                    const f32x4 s0 = a0 + b0, s1 = a1 + b1;
                    v4u w; w.x = pk2(s0[0], s0[1]); w.y = pk2(s0[2], s0[3]); w.z = pk2(s1[0], s1[1]); w.w = pk2(s1[2], s1[3]);
                    kmf = __builtin_bit_cast(bf16x8, w);
                }
                gt = __builtin_amdgcn_mfma_f32_32x32x16_bf16(kmf, qf[d0], gt, 0, 0, 0);
            }
            float gv[16];
#pragma unroll
            for (int r = 0; r < 8; ++r) {
                const float mine = gt[r], oth = __shfl_xor(mine, 32);
                const float vlo = hi ? oth : mine, vhi = hi ? mine : oth;
                gv[(r & 3) + 8 * (r >> 2)] = vlo; gv[(r & 3) + 8 * (r >> 2) + 4] = vhi;
            }
#pragma unroll
            for (int n = 0; n < 16; ++n) if (n >= blk) gv[n] = -INFINITY;
#pragma unroll
            for (int it = 0; it < 3; ++it) {
                float best = -INFINITY; int bi = -1;
#pragma unroll
                for (int n = 0; n < 16; ++n) { const bool ok = (gv[n] > best) && !((sel >> n) & 1u); best = ok ? gv[n] : best; bi = ok ? n : bi; }
                if (bi >= 0) sel |= 1u << bi;
            }
        }
        AttnSt st; st.o0 = f32x16{}; st.o1 = f32x16{}; st.m = -1e30f; st.l = 0.f;
#define MB_LOAD(key0_) do { kreg = *(const v4u*)(Kh + (size_t)(key0_) * EVEN_IN); vreg = *(const v4u*)(Vh + (size_t)(key0_) * EVEN_IN); } while (0)
#define MB_STORE(buf_) do { *(LAS v4u*)(lds + (buf_) * 8192 + kwoff) = kreg; *(LAS v4u*)(lds + 16384 + (buf_) * 8192 + vwoff) = vreg; } while (0)
        MB_STORE(0);
        __syncthreads();
#pragma unroll 1
        for (int t = 0; t < 4; ++t) {
            const int buf = t & 1;
            if (t < 3) MB_LOAD(blk * 256 + 64 * (t + 1)); else if (blk > 0) MB_LOAD(0);
            const LAS unsigned char* kb = lds + buf * 8192; const LAS unsigned char* vb = lds + 16384 + buf * 8192;
            if (2 * t + 1 < wave) attn_tile64_lds<0, 0>(st, qf, kb, vb, lane, true);
            else if (2 * t + 1 == wave) attn_tile64_lds<0, 1>(st, qf, kb, vb, lane, true);
            else if (2 * t == wave) attn_subtile_lds(st, qf, kb, vb, lane, true, [&](int kk) { return kk <= r32; });
            if (t < 3 || blk > 0) MB_STORE(buf ^ 1);
            __syncthreads();
        }
        const int P = 4 * blk;
#pragma unroll 1
        for (int p = 0; p < P; ++p) {
            const int buf = p & 1;
            if (p + 1 < P) MB_LOAD(64 * (p + 1));
            const LAS unsigned char* kb = lds + buf * 8192; const LAS unsigned char* vb = lds + 16384 + buf * 8192;
            const bool mysel = (sel >> (p >> 2)) & 1u;
            if (__any(mysel)) {
                attn_tile64_lds<2, 2>(st, qf, kb, vb, lane, mysel);
            }
            if (p + 1 < P) MB_STORE(buf ^ 1);
            __syncthreads();
        }
#undef MB_LOAD
#undef MB_STORE
        attn_store_g(st, gg, Y + (rowbase + q0 + r32) * D + 512 + hh * 64, lane);
    }
}

__device__ __forceinline__ void phase_moba_old(const Args& A, LAS unsigned char* lds, int gwv, int NGW, int wave, int lane) {
    const bf16* Z = (const bf16*)(A.ws + WS_Z); bf16* Y = (bf16*)(A.ws + WS_Y); const float* kmp = (const float*)(A.ws + WS_KMP);
    LAS unsigned char* vl = lds + wave * 4096;
    const int r32 = lane & 31, hi = lane >> 5;
#ifdef OLD_NEWMAP
    for (int U = gwv >> 3; U < 2048; U += NGW >> 3) {
        const int it8 = U >> 8, v = U & 255, j = v & 7;
        const int blk = (it8 & 1) ? 15 - j : j, bh = (v >> 3) * 4 + (it8 >> 1);
        const int b = bh >> 3, hh = bh & 7, q0 = blk * 256 + 32 * wave;
#else
    for (int U = gwv; U < 16384; U += NGW) {
        const int rd = U >> 11, g2 = U & 2047, X = g2 >> 8, lwv = g2 & 255;
        const int bh = 16 * X + 2 * rd + (lwv >> 7); int gi = lwv & 127; if (rd & 1) gi = 127 - gi;
        const int b = bh >> 3, hh = bh & 7, q0 = gi * 32, blk = q0 >> 8;
#endif
        const size_t rowbase = (size_t)b * SEQ;
        const bf16* zq = Z + (rowbase + q0 + r32) * EVEN_IN;
        bf16x8 qf[4];
#pragma unroll
        for (int d0 = 0; d0 < 4; ++d0) qf[d0] = *(const bf16x8*)(zq + 1536 + hh * 64 + 16 * d0 + 8 * hi);
        unsigned sel = 0u;
        if (blk > 0) {
            f32x16 gt = f32x16{};
#pragma unroll
            for (int d0 = 0; d0 < 4; ++d0) {
                bf16x8 kmf = bf16x8{};
                if (r32 < 16) {
                    const float* p0 = kmp + (((size_t)b * 16 + r32) * 2) * 512 + hh * 64 + 16 * d0 + 8 * hi;
                    const f32x4 a0 = *(const f32x4*)p0, a1 = *(const f32x4*)(p0 + 4), b0 = *(const f32x4*)(p0 + 512), b1 = *(const f32x4*)(p0 + 516);
                    const f32x4 s0 = a0 + b0, s1 = a1 + b1;
                    v4u w; w.x = pk2(s0[0], s0[1]); w.y = pk2(s0[2], s0[3]); w.z = pk2(s1[0], s1[1]); w.w = pk2(s1[2], s1[3]);
                    kmf = __builtin_bit_cast(bf16x8, w);
                }
                gt = __builtin_amdgcn_mfma_f32_32x32x16_bf16(kmf, qf[d0], gt, 0, 0, 0);
            }
            float gv[16];
#pragma unroll
            for (int r = 0; r < 8; ++r) {
                const float mine = gt[r], oth = __shfl_xor(mine, 32);
                const float vlo = hi ? oth : mine, vhi = hi ? mine : oth;
                gv[(r & 3) + 8 * (r >> 2)] = vlo; gv[(r & 3) + 8 * (r >> 2) + 4] = vhi;
            }
#pragma unroll
            for (int n = 0; n < 16; ++n) if (n >= blk) gv[n] = -INFINITY;
#pragma unroll
            for (int it = 0; it < 3; ++it) {
                float best = -INFINITY; int bi = -1;
#pragma unroll
                for (int n = 0; n < 16; ++n) { const bool ok = (gv[n] > best) && !((sel >> n) & 1u); best = ok ? gv[n] : best; bi = ok ? n : bi; }
                if (bi >= 0) sel |= 1u << bi;
            }
        }
        AttnSt st; st.o0 = f32x16{}; st.o1 = f32x16{}; st.m = -1e30f; st.l = 0.f;
        const bf16* Kh = Z + rowbase * EVEN_IN + 2048 + hh * 64; const bf16* Vh = Z + rowbase * EVEN_IN + 2560 + hh * 64;
        const size_t vrow8 = (size_t)8 * EVEN_IN;
        const int ndiag = (q0 & 255) >> 5;
        for (int kt = 0; kt <= ndiag; ++kt) {
            const size_t k0 = (size_t)blk * 256 + kt * 32;
            const bf16* vp = Vh + (k0 + (lane >> 3)) * EVEN_IN + 8 * (lane & 7);
            attn_tile(st, qf, Kh + (k0 + r32) * EVEN_IN + 8 * hi, vp, vp + vrow8, vp + 2 * vrow8, vp + 3 * vrow8, vl, lane, kt == ndiag, [&](int kk) { return kk <= r32; });
        }
        for (int n = 0; n < blk; ++n) {
            const bool mysel = (sel >> n) & 1u;
            if (!__any(mysel)) continue;
            for (int kt = 0; kt < 8; ++kt) {
                const size_t k0 = (size_t)n * 256 + kt * 32;
                const bf16* vp = Vh + (k0 + (lane >> 3)) * EVEN_IN + 8 * (lane & 7);
                attn_tile(st, qf, Kh + (k0 + r32) * EVEN_IN + 8 * hi, vp, vp + vrow8, vp + 2 * vrow8, vp + 3 * vrow8, vl, lane, true, [&](int) { return mysel; });
            }
        }
        attn_store(st, zq + 3072 + hh * 64, Y + (rowbase + q0 + r32) * D + 512 + hh * 64, lane);
    }
}


__device__ __forceinline__ void phase_moba_p(const Args& A, LAS unsigned char* lds, int gwv, int NGW, int wave, int lane) {
    const bf16* Z = (const bf16*)(A.ws + WS_Z); bf16* Y = (bf16*)(A.ws + WS_Y); const float* kmp = (const float*)(A.ws + WS_KMP);
    LAS unsigned char* vl = lds + wave * 4096;
    const int r32 = lane & 31, hi = lane >> 5;
    for (int U = gwv; U < 16384; U += NGW) {
        const int rd = U >> 11, g2 = U & 2047, X = g2 >> 8, lwv = g2 & 255;
        const int bh = 16 * X + 2 * rd + (lwv >> 7); int gi = lwv & 127; if (rd & 1) gi = 127 - gi;
        const int b = bh >> 3, hh = bh & 7, q0 = gi * 32, blk = q0 >> 8;
        const size_t rowbase = (size_t)b * SEQ;
        const bf16* zq = Z + (rowbase + q0 + r32) * EVEN_IN;
        bf16x8 qf[4];
#pragma unroll
        for (int d0 = 0; d0 < 4; ++d0) qf[d0] = *(const bf16x8*)(zq + 1536 + hh * 64 + 16 * d0 + 8 * hi);
        unsigned sel = 0u;
        if (blk > 0) {
            f32x16 gt = f32x16{};
#pragma unroll
            for (int d0 = 0; d0 < 4; ++d0) {
                bf16x8 kmf = bf16x8{};
                if (r32 < 16) {
                    const float* p0 = kmp + (((size_t)b * 16 + r32) * 2) * 512 + hh * 64 + 16 * d0 + 8 * hi;
                    const f32x4 a0 = *(const f32x4*)p0, a1 = *(const f32x4*)(p0 + 4), b0 = *(const f32x4*)(p0 + 512), b1 = *(const f32x4*)(p0 + 516);
                    const f32x4 s0 = a0 + b0, s1 = a1 + b1;
                    v4u w; w.x = pk2(s0[0], s0[1]); w.y = pk2(s0[2], s0[3]); w.z = pk2(s1[0], s1[1]); w.w = pk2(s1[2], s1[3]);
                    kmf = __builtin_bit_cast(bf16x8, w);
                }
                gt = __builtin_amdgcn_mfma_f32_32x32x16_bf16(kmf, qf[d0], gt, 0, 0, 0);
            }
            float gv[16];
#pragma unroll
            for (int r = 0; r < 8; ++r) {
                const float mine = gt[r], oth = __shfl_xor(mine, 32);
                const float vlo = hi ? oth : mine, vhi = hi ? mine : oth;
                gv[(r & 3) + 8 * (r >> 2)] = vlo; gv[(r & 3) + 8 * (r >> 2) + 4] = vhi;
            }
#pragma unroll
            for (int n = 0; n < 16; ++n) if (n >= blk) gv[n] = -INFINITY;
#pragma unroll
            for (int it = 0; it < 3; ++it) {
                float best = -INFINITY; int bi = -1;
#pragma unroll
                for (int n = 0; n < 16; ++n) { const bool ok = (gv[n] > best) && !((sel >> n) & 1u); best = ok ? gv[n] : best; bi = ok ? n : bi; }
                if (bi >= 0) sel |= 1u << bi;
            }
        }
        unsigned anym = 0u;
#pragma unroll
        for (int n = 0; n < 15; ++n) if (__any((sel >> n) & 1u)) anym |= 1u << n;
        anym = (unsigned)__builtin_amdgcn_readfirstlane((int)anym);
        AttnSt st; st.o0 = f32x16{}; st.o1 = f32x16{}; st.m = -1e30f; st.l = 0.f;
        const bf16* Kh = Z + rowbase * EVEN_IN + 2048 + hh * 64; const bf16* Vh = Z + rowbase * EVEN_IN + 2560 + hh * 64;
        const size_t vrow8 = (size_t)8 * EVEN_IN;
        const int ndiag = (q0 & 255) >> 5;
#define MB_LOADT(R, nn, kk_) do { const size_t k0_ = (size_t)((nn) < 0 ? blk : (nn)) * 256 + (kk_) * 32; const bf16* vp_ = Vh + (k0_ + (lane >> 3)) * EVEN_IN + 8 * (lane & 7); \
            attn_load(R, 512, vp_, vp_ + vrow8, vp_ + 2 * vrow8, vp_ + 3 * vrow8); } while (0)
#define MB_COMP(R, nn, kk_) do { if ((nn) < 0) { if ((kk_) == ndiag) attn_compute<1>(st, qf, R, vl, lane, true, 0, 0); else attn_compute<0>(st, qf, R, vl, lane, true, 0, 0); } \
            else attn_compute<2>(st, qf, R, vl, lane, ((sel >> (nn)) & 1u) != 0u, 0, 0); } while (0)
#define MB_ADV(nn, kk_, more) do { more = true; if ((nn) < 0) { if ((kk_) < ndiag) ++(kk_); else { (kk_) = 0; if (anym) (nn) = __builtin_ctz(anym); else more = false; } } \
            else if ((kk_) < 7) ++(kk_); else { (kk_) = 0; const unsigned rest_ = anym & ~((2u << (nn)) - 1u); if (rest_) (nn) = __builtin_ctz(rest_); else more = false; } } while (0)
        TileRegs RA, RB; int cn = -1, ck = 0;
        MB_LOADT(RA, cn, ck);
        for (;;) {
            int nn = cn, nk = ck; bool more; MB_ADV(nn, nk, more);
            if (more) MB_LOADT(RB, nn, nk);
            MB_COMP(RA, cn, ck);
            if (!more) break;
            cn = nn; ck = nk; MB_ADV(nn, nk, more);
            if (more) MB_LOADT(RA, nn, nk);
            MB_COMP(RB, cn, ck);
            if (!more) break;
            cn = nn; ck = nk;
        }
#undef MB_LOADT
#undef MB_COMP
#undef MB_ADV
        attn_store(st, zq + 3072 + hh * 64, Y + (rowbase + q0 + r32) * D + 512 + hh * 64, lane);
    }
}

__device__ __forceinline__ void phase_dilated_p(const Args& A, LAS unsigned char* lds, int gwv, int NGW, int wave, int lane) {
    const bf16* Z = (const bf16*)(A.ws + WS_Z); bf16* Y = (bf16*)(A.ws + WS_Y);
    LAS unsigned char* vl = lds + wave * 4096;
    const int r32 = lane & 31, hi = lane >> 5;
    for (int U = gwv; U < 32768; U += NGW) {
        const int rd = U >> 11, g2 = U & 2047, X = g2 >> 8, lwv = g2 & 255;
        const int bh = 32 * X + 2 * rd + (lwv >> 7), gi = lwv & 127, c = gi >> 4, r16 = gi & 15;
        const int b = bh >> 4, hh = bh & 15;
        const size_t rowbase = (size_t)b * SEQ;
        const int tq = 512 * c + r16 + 16 * r32;
        const bf16* zq = Z + (rowbase + tq) * ODD_IN;
        bf16x8 qf[4];
#pragma unroll
        for (int d0 = 0; d0 < 4; ++d0) qf[d0] = *(const bf16x8*)(zq + hh * 64 + 16 * d0 + 8 * hi);
        AttnSt st; st.o0 = f32x16{}; st.o1 = f32x16{}; st.m = -1e30f; st.l = 0.f;
        const bf16* Kh = Z + rowbase * ODD_IN + 1024 + hh * 64; const bf16* Vh = Z + rowbase * ODD_IN + 2048 + hh * 64;
#define DL_DIL(cfg) ((cfg) == 0 ? 16 : (cfg) == 1 ? 4 : 1)
#define DL_NT(cfg) ((cfg) == 0 ? 5 : (cfg) == 1 ? 8 : 20)
#define DL_MBASE(cfg) ((512 * c + r16 - (r16 & (DL_DIL(cfg) - 1))) / DL_DIL(cfg) - 128)
#define DL_TAU0(cfg) (DL_MBASE(cfg) < 0 ? (-DL_MBASE(cfg)) / 32 : 0)
#define DL_LOADT(R, cfg, tau) do { const int dil_ = DL_DIL(cfg), rdl_ = r16 & (dil_ - 1), m0_ = DL_MBASE(cfg) + 32 * (tau); \
            const int mv_ = m0_ + (lane >> 3); const int mv0_ = mv_ < 0 ? 0 : mv_, mv1_ = mv_ + 8 < 0 ? 0 : mv_ + 8, mv2_ = mv_ + 16 < 0 ? 0 : mv_ + 16, mv3_ = mv_ + 24 < 0 ? 0 : mv_ + 24; \
            const bf16* vb_ = Vh + (size_t)rdl_ * ODD_IN + 8 * (lane & 7); const size_t vst_ = (size_t)dil_ * ODD_IN; \
            attn_load(R, 1024, vb_ + mv0_ * vst_, vb_ + mv1_ * vst_, vb_ + mv2_ * vst_, vb_ + mv3_ * vst_); } while (0)
#define DL_COMP(R, cfg, tau) do { const int m0_ = DL_MBASE(cfg) + 32 * (tau); \
            if ((cfg) == 0 && (tau) >= 1 && (tau) <= 3 && m0_ >= 0) attn_compute<0>(st, qf, R, vl, lane, true, 0, 0); \
            else attn_compute<3>(st, qf, R, vl, lane, true, 128 + (16 / DL_DIL(cfg)) * r32 - 32 * (tau), -m0_); } while (0)
#define DL_ADV(cfg, tau, more) do { more = true; if ((tau) + 1 < DL_NT(cfg)) ++(tau); else if ((cfg) < 2) { ++(cfg); (tau) = DL_TAU0(cfg); } else more = false; } while (0)
        TileRegs RA, RB; int cc = 0, ct = DL_TAU0(0);
        DL_LOADT(RA, cc, ct);
        for (;;) {
            int nc = cc, nt = ct; bool more; DL_ADV(nc, nt, more);
            if (more) DL_LOADT(RB, nc, nt);
            DL_COMP(RA, cc, ct);
            if (!more) break;
            cc = nc; ct = nt; DL_ADV(nc, nt, more);
            if (more) DL_LOADT(RA, nc, nt);
            DL_COMP(RB, cc, ct);
            if (!more) break;
            cc = nc; ct = nt;
        }
#undef DL_DIL
#undef DL_NT
#undef DL_MBASE
#undef DL_TAU0
#undef DL_LOADT
#undef DL_COMP
#undef DL_ADV
        attn_store(st, zq + 3072 + hh * 64, Y + (rowbase + tq) * D + hh * 64, lane);
    }
}


__device__ __forceinline__ void attn_stage2(const TileRegs& RA, const TileRegs& RB, LAS unsigned char* wl, int lane) {
    LAS unsigned char* vla = wl; LAS unsigned char* vlb = wl + 4096; LAS unsigned char* kla = wl + 8192; LAS unsigned char* klb = wl + 12288;
#pragma unroll
    for (int it = 0; it < 4; ++it) { const int row = it * 8 + (lane >> 3); const int ko = row * 128 + (((lane & 7) ^ (row & 7)) << 4); *(LAS v4u*)(kla + ko) = RA.kk[it]; *(LAS v4u*)(klb + ko) = RB.kk[it]; }
#pragma unroll
    for (int it = 0; it < 4; ++it) { const int vo = (it * 2 + ((lane & 7) >> 2)) * 512 + (lane >> 3) * 64 + (lane & 3) * 16; *(LAS v4u*)(vla + vo) = RA.vv[it]; *(LAS v4u*)(vlb + vo) = RB.vv[it]; }
}
template <int MODE, class MidF>
__device__ __forceinline__ void attn_compute2_lds(AttnSt& a, AttnSt& b, const bf16x8 (&qa)[4], const bf16x8 (&qb)[4], LAS unsigned char* wl, int lane, int dd0, int kmina, int kminb, MidF mid) {
    const int r32 = lane & 31, hi = lane >> 5, grp = lane >> 4, qq = (lane & 15) >> 2, pp = lane & 3;
    LAS unsigned char* vla = wl; LAS unsigned char* vlb = wl + 4096; LAS unsigned char* kla = wl + 8192; LAS unsigned char* klb = wl + 12288;
    f32x16 sa = f32x16{}, sb = f32x16{};
#pragma unroll
    for (int d0 = 0; d0 < 4; ++d0) {
        const int ko = r32 * 128 + (((2 * d0 + hi) ^ (r32 & 7)) << 4);
        const v4u kwa = *(const LAS v4u*)(kla + ko), kwb = *(const LAS v4u*)(klb + ko);
        sa = __builtin_amdgcn_mfma_f32_32x32x16_bf16(__builtin_bit_cast(bf16x8, kwa), qa[d0], sa, 0, 0, 0);
        sb = __builtin_amdgcn_mfma_f32_32x32x16_bf16(__builtin_bit_cast(bf16x8, kwb), qb[d0], sb, 0, 0, 0);
    }
    if (MODE == 3) {
        const int ddh = dd0 - 4 * hi, kma = kmina - 4 * hi, kmb = kminb - 4 * hi;
#pragma unroll
        for (int r = 0; r < 16; ++r) { const int c = (r & 3) + 8 * (r >> 2); const bool band = (unsigned)(ddh - c) <= 128u; if (!band || c < kma) sa[r] = -INFINITY; if (!band || c < kmb) sb[r] = -INFINITY; }
    }
    float mta = sa[0], mtb = sb[0];
#pragma unroll
    for (int r = 1; r < 16; ++r) { mta = fmaxf(mta, sa[r]); mtb = fmaxf(mtb, sb[r]); }
    mta = fmaxf(mta, __shfl_xor(mta, 32)); mtb = fmaxf(mtb, __shfl_xor(mtb, 32));
    if (__any(mta > a.m + RESCALE_THR || mtb > b.m + RESCALE_THR)) {
        const float mna_ = fmaxf(a.m, mta), mnb_ = fmaxf(b.m, mtb);
        const float fa = __builtin_amdgcn_exp2f(a.m - mna_), fb = __builtin_amdgcn_exp2f(b.m - mnb_);
        a.l *= fa; a.m = mna_; b.l *= fb; b.m = mnb_;
#pragma unroll
        for (int r = 0; r < 16; ++r) { a.o0[r] *= fa; a.o1[r] *= fa; b.o0[r] *= fb; b.o1[r] *= fb; }
    }
    const float mna = a.m, mnb = b.m;
    float psa = 0.f, psb = 0.f;
#pragma unroll
    for (int r = 0; r < 16; ++r) { sa[r] = __builtin_amdgcn_exp2f(sa[r] - mna); sb[r] = __builtin_amdgcn_exp2f(sb[r] - mnb); psa += sa[r]; psb += sb[r]; }
    a.l += psa; b.l += psb;
    v4u pa0, pa1, pb0, pb1;
    pa0.x = cvtpk_s(sa[0], sa[1]); pa0.y = cvtpk_s(sa[2], sa[3]); pa0.z = cvtpk_s(sa[4], sa[5]); pa0.w = cvtpk_s(sa[6], sa[7]);
    pa1.x = cvtpk_s(sa[8], sa[9]); pa1.y = cvtpk_s(sa[10], sa[11]); pa1.z = cvtpk_s(sa[12], sa[13]); pa1.w = cvtpk_s(sa[14], sa[15]);
    pb0.x = cvtpk_s(sb[0], sb[1]); pb0.y = cvtpk_s(sb[2], sb[3]); pb0.z = cvtpk_s(sb[4], sb[5]); pb0.w = cvtpk_s(sb[6], sb[7]);
    pb1.x = cvtpk_s(sb[8], sb[9]); pb1.y = cvtpk_s(sb[10], sb[11]); pb1.z = cvtpk_s(sb[12], sb[13]); pb1.w = cvtpk_s(sb[14], sb[15]);
    const bf16x8 fa0 = __builtin_bit_cast(bf16x8, pa0), fa1 = __builtin_bit_cast(bf16x8, pa1), fb0 = __builtin_bit_cast(bf16x8, pb0), fb1 = __builtin_bit_cast(bf16x8, pb1);
    __builtin_amdgcn_sched_barrier(0); mid(); __builtin_amdgcn_sched_barrier(0);
    const int to = (4 * hi + qq) * 64 + (16 * (grp & 1) + 4 * pp) * 2;
#define VFRAG2(base, ks, d0) ({ const s16x4 lo_ = vtr((base) + to + ((2 * (ks)) * 2 + (d0)) * 512), hi_ = vtr((base) + to + ((2 * (ks) + 1) * 2 + (d0)) * 512); (bf16x8){lo_[0], lo_[1], lo_[2], lo_[3], hi_[0], hi_[1], hi_[2], hi_[3]}; })
    a.o0 = __builtin_amdgcn_mfma_f32_32x32x16_bf16(VFRAG2(vla, 0, 0), fa0, a.o0, 0, 0, 0);
    b.o0 = __builtin_amdgcn_mfma_f32_32x32x16_bf16(VFRAG2(vlb, 0, 0), fb0, b.o0, 0, 0, 0);
    a.o1 = __builtin_amdgcn_mfma_f32_32x32x16_bf16(VFRAG2(vla, 0, 1), fa0, a.o1, 0, 0, 0);
    b.o1 = __builtin_amdgcn_mfma_f32_32x32x16_bf16(VFRAG2(vlb, 0, 1), fb0, b.o1, 0, 0, 0);
    a.o0 = __builtin_amdgcn_mfma_f32_32x32x16_bf16(VFRAG2(vla, 1, 0), fa1, a.o0, 0, 0, 0);
    b.o0 = __builtin_amdgcn_mfma_f32_32x32x16_bf16(VFRAG2(vlb, 1, 0), fb1, b.o0, 0, 0, 0);
    a.o1 = __builtin_amdgcn_mfma_f32_32x32x16_bf16(VFRAG2(vla, 1, 1), fa1, a.o1, 0, 0, 0);
    b.o1 = __builtin_amdgcn_mfma_f32_32x32x16_bf16(VFRAG2(vlb, 1, 1), fb1, b.o1, 0, 0, 0);
#undef VFRAG2
}
template <int MODE, class PreF, class MidF>
__device__ __forceinline__ void attn_compute2_kv(AttnSt& a, AttnSt& b, const bf16x8 (&qa)[4], const bf16x8 (&qb)[4], TileRegs& RA, TileRegs& RB, LAS unsigned char* wl, int lane, int dd0, int kmina, int kminb, PreF pre, MidF mid) {
    const int r32 = lane & 31, hi = lane >> 5, grp = lane >> 4, qq = (lane & 15) >> 2, pp = lane & 3;
    LAS unsigned char* vla = wl; LAS unsigned char* vlb = wl + 4096; LAS unsigned char* kla = wl + 8192; LAS unsigned char* klb = wl + 12288;
#pragma unroll
    for (int it = 0; it < 4; ++it) { const int row = it * 8 + (lane >> 3); const int ko = row * 128 + (((lane & 7) ^ (row & 7)) << 4); *(LAS v4u*)(kla + ko) = RA.kk[it]; *(LAS v4u*)(klb + ko) = RB.kk[it]; }
    pre();
#pragma unroll
    for (int it = 0; it < 4; ++it) { const int vo = (it * 2 + ((lane & 7) >> 2)) * 512 + (lane >> 3) * 64 + (lane & 3) * 16; *(LAS v4u*)(vla + vo) = RA.vv[it]; *(LAS v4u*)(vlb + vo) = RB.vv[it]; }
    f32x16 sa = f32x16{}, sb = f32x16{};
#pragma unroll
    for (int d0 = 0; d0 < 4; ++d0) {
        const int ko = r32 * 128 + (((2 * d0 + hi) ^ (r32 & 7)) << 4);
        const v4u kwa = *(const LAS v4u*)(kla + ko), kwb = *(const LAS v4u*)(klb + ko);
        sa = __builtin_amdgcn_mfma_f32_32x32x16_bf16(__builtin_bit_cast(bf16x8, kwa), qa[d0], sa, 0, 0, 0);
        sb = __builtin_amdgcn_mfma_f32_32x32x16_bf16(__builtin_bit_cast(bf16x8, kwb), qb[d0], sb, 0, 0, 0);
    }
    if (MODE == 3) {
        const int ddh = dd0 - 4 * hi;
        if (kmina <= 0 && kminb <= 0) {
#pragma unroll
            for (int r = 0; r < 16; ++r) { const int c = (r & 3) + 8 * (r >> 2); const bool band = (unsigned)(ddh - c) <= 128u; sa[r] = band ? sa[r] : -INFINITY; sb[r] = band ? sb[r] : -INFINITY; }
        } else {
            const int kma = kmina - 4 * hi, kmb = kminb - 4 * hi;
#pragma unroll
            for (int r = 0; r < 16; ++r) { const int c = (r & 3) + 8 * (r >> 2); const bool band = (unsigned)(ddh - c) <= 128u; if (!band || c < kma) sa[r] = -INFINITY; if (!band || c < kmb) sb[r] = -INFINITY; }
        }
    }
    float mta = sa[0], mtb = sb[0];
#pragma unroll
    for (int r = 1; r < 16; ++r) { mta = fmaxf(mta, sa[r]); mtb = fmaxf(mtb, sb[r]); }
    mta = fmaxf(mta, __shfl_xor(mta, 32)); mtb = fmaxf(mtb, __shfl_xor(mtb, 32));
    if (__any(mta > a.m + RESCALE_THR || mtb > b.m + RESCALE_THR)) {
        const float mna_ = fmaxf(a.m, mta), mnb_ = fmaxf(b.m, mtb);
        const float fa = __builtin_amdgcn_exp2f(a.m - mna_), fb = __builtin_amdgcn_exp2f(b.m - mnb_);
        a.l *= fa; a.m = mna_; b.l *= fb; b.m = mnb_;
#pragma unroll
        for (int r = 0; r < 16; ++r) { a.o0[r] *= fa; a.o1[r] *= fa; b.o0[r] *= fb; b.o1[r] *= fb; }
    }
    const float mna = a.m, mnb = b.m;
    const f32x2_t ma2 = {mna, mna}, mb2 = {mnb, mnb}; f32x2_t acca = {0.f, 0.f}, accb = {0.f, 0.f};
#pragma unroll
    for (int r = 0; r < 16; r += 2) {
        f32x2_t va = (f32x2_t){sa[r], sa[r + 1]} - ma2, vb = (f32x2_t){sb[r], sb[r + 1]} - mb2;
        va.x = __builtin_amdgcn_exp2f(va.x); va.y = __builtin_amdgcn_exp2f(va.y); vb.x = __builtin_amdgcn_exp2f(vb.x); vb.y = __builtin_amdgcn_exp2f(vb.y);
        acca += va; accb += vb;
        sa[r] = va.x; sa[r + 1] = va.y; sb[r] = vb.x; sb[r + 1] = vb.y;
    }
    a.l += acca.x + acca.y; b.l += accb.x + accb.y;
    v4u pa0, pa1, pb0, pb1;
    pa0.x = cvtpk_s(sa[0], sa[1]); pa0.y = cvtpk_s(sa[2], sa[3]); pa0.z = cvtpk_s(sa[4], sa[5]); pa0.w = cvtpk_s(sa[6], sa[7]);
    pa1.x = cvtpk_s(sa[8], sa[9]); pa1.y = cvtpk_s(sa[10], sa[11]); pa1.z = cvtpk_s(sa[12], sa[13]); pa1.w = cvtpk_s(sa[14], sa[15]);
    pb0.x = cvtpk_s(sb[0], sb[1]); pb0.y = cvtpk_s(sb[2], sb[3]); pb0.z = cvtpk_s(sb[4], sb[5]); pb0.w = cvtpk_s(sb[6], sb[7]);
    pb1.x = cvtpk_s(sb[8], sb[9]); pb1.y = cvtpk_s(sb[10], sb[11]); pb1.z = cvtpk_s(sb[12], sb[13]); pb1.w = cvtpk_s(sb[14], sb[15]);
    const bf16x8 fa0 = __builtin_bit_cast(bf16x8, pa0), fa1 = __builtin_bit_cast(bf16x8, pa1), fb0 = __builtin_bit_cast(bf16x8, pb0), fb1 = __builtin_bit_cast(bf16x8, pb1);
    __builtin_amdgcn_sched_barrier(0); mid(); __builtin_amdgcn_sched_barrier(0);
    const int to = (4 * hi + qq) * 64 + (16 * (grp & 1) + 4 * pp) * 2;
#define VFRAG2(base, ks, d0) ({ const s16x4 lo_ = vtr((base) + to + ((2 * (ks)) * 2 + (d0)) * 512), hi_ = vtr((base) + to + ((2 * (ks) + 1) * 2 + (d0)) * 512); (bf16x8){lo_[0], lo_[1], lo_[2], lo_[3], hi_[0], hi_[1], hi_[2], hi_[3]}; })
    a.o0 = __builtin_amdgcn_mfma_f32_32x32x16_bf16(VFRAG2(vla, 0, 0), fa0, a.o0, 0, 0, 0);
    b.o0 = __builtin_amdgcn_mfma_f32_32x32x16_bf16(VFRAG2(vlb, 0, 0), fb0, b.o0, 0, 0, 0);
    a.o1 = __builtin_amdgcn_mfma_f32_32x32x16_bf16(VFRAG2(vla, 0, 1), fa0, a.o1, 0, 0, 0);
    b.o1 = __builtin_amdgcn_mfma_f32_32x32x16_bf16(VFRAG2(vlb, 0, 1), fb0, b.o1, 0, 0, 0);
    a.o0 = __builtin_amdgcn_mfma_f32_32x32x16_bf16(VFRAG2(vla, 1, 0), fa1, a.o0, 0, 0, 0);
    b.o0 = __builtin_amdgcn_mfma_f32_32x32x16_bf16(VFRAG2(vlb, 1, 0), fb1, b.o0, 0, 0, 0);
    a.o1 = __builtin_amdgcn_mfma_f32_32x32x16_bf16(VFRAG2(vla, 1, 1), fa1, a.o1, 0, 0, 0);
    b.o1 = __builtin_amdgcn_mfma_f32_32x32x16_bf16(VFRAG2(vlb, 1, 1), fb1, b.o1, 0, 0, 0);
#undef VFRAG2
}
template <int MODE>
__device__ __forceinline__ void attn_compute2(AttnSt& a, AttnSt& b, const bf16x8 (&qa)[4], const bf16x8 (&qb)[4], const TileRegs& RA, const TileRegs& RB, LAS unsigned char* wl, int lane, int dd0, int kmina, int kminb) {
    attn_stage2(RA, RB, wl, lane); attn_compute2_lds<MODE>(a, b, qa, qb, wl, lane, dd0, kmina, kminb, [] {});
}

__device__ __forceinline__ void phase_dilated_2(const Args& A, LAS unsigned char* lds, int gwv, int NGW, int wave, int lane) {
    const bf16* Z = (const bf16*)(A.ws + WS_Z); bf16* Y = (bf16*)(A.ws + WS_Y);
    LAS unsigned char* wl = lds + wave * 16384;
    const int r32 = lane & 31, hi = lane >> 5;
    for (int U = gwv; U < 16384; U += NGW) {
        const int rd = U >> 10, g2 = U & 1023, X = g2 >> 7, lp = g2 & 127;
        const int bh = 32 * X + 2 * rd + (lp >> 6), pi = lp & 63, c = pi >> 3, r16a = 2 * (pi & 7);
        const int b = bh >> 4, hh = bh & 15;
        const size_t rowbase = (size_t)b * SEQ;
        const int tqa = 512 * c + r16a + 16 * r32;
        const bf16* zqa = Z + (rowbase + tqa) * ODD_IN; const bf16* zqb = zqa + ODD_IN;
        bf16x8 qa[4], qb[4];
#pragma unroll
        for (int d0 = 0; d0 < 4; ++d0) { qa[d0] = *(const bf16x8*)(zqa + hh * 64 + 16 * d0 + 8 * hi); qb[d0] = *(const bf16x8*)(zqb + hh * 64 + 16 * d0 + 8 * hi); }
        AttnSt sa, sb; sa.o0 = f32x16{}; sa.o1 = f32x16{}; sa.m = -1e30f; sa.l = 0.f; sb.o0 = f32x16{}; sb.o1 = f32x16{}; sb.m = -1e30f; sb.l = 0.f;
        const bf16* Vh = Z + rowbase * ODD_IN + 2048 + hh * 64 + 8 * (lane & 7);
#pragma unroll 1
        for (int cfg = 0; cfg < 3; ++cfg) {
            const int dil = (cfg == 0) ? 16 : (cfg == 1) ? 4 : 1, sstep = 16 / dil, ntile = (cfg == 0) ? 5 : (cfg == 1) ? 8 : 20;
            const int rdla = r16a & (dil - 1), rdlb = (r16a + 1) & (dil - 1);
            const int mba = (512 * c + r16a - rdla) / dil - 128, mbb = (512 * c + r16a + 1 - rdlb) / dil - 128;
            const int tau0 = mbb < 0 ? (-mbb) / 32 : 0;
            const size_t vst = (size_t)dil * ODD_IN;
#pragma unroll 1
            for (int tau = tau0; tau < ntile; ++tau) {
                TileRegs RA, RB;
                { const int mv = mba + 32 * tau + (lane >> 3); const int m0_ = mv < 0 ? 0 : mv, m1_ = mv + 8 < 0 ? 0 : mv + 8, m2_ = mv + 16 < 0 ? 0 : mv + 16, m3_ = mv + 24 < 0 ? 0 : mv + 24;
                  const bf16* vb = Vh + (size_t)rdla * ODD_IN; attn_load(RA, 1024, vb + m0_ * vst, vb + m1_ * vst, vb + m2_ * vst, vb + m3_ * vst); }
                { const int mv = mbb + 32 * tau + (lane >> 3); const int m0_ = mv < 0 ? 0 : mv, m1_ = mv + 8 < 0 ? 0 : mv + 8, m2_ = mv + 16 < 0 ? 0 : mv + 16, m3_ = mv + 24 < 0 ? 0 : mv + 24;
                  const bf16* vb = Vh + (size_t)rdlb * ODD_IN; attn_load(RB, 1024, vb + m0_ * vst, vb + m1_ * vst, vb + m2_ * vst, vb + m3_ * vst); }
                attn_compute2<3>(sa, sb, qa, qb, RA, RB, wl, lane, 128 + sstep * r32 - 32 * tau, -(mba + 32 * tau), -(mbb + 32 * tau));
            }
        }
        attn_store(sa, zqa + 3072 + hh * 64, Y + (rowbase + tqa) * D + hh * 64, lane);
        attn_store(sb, zqb + 3072 + hh * 64, Y + (rowbase + tqa + 1) * D + hh * 64, lane);
    }
}


__device__ __forceinline__ void attn_state_store(const AttnSt& st, bf16* orow, float* lsep, int lane) {
    const int hi = lane >> 5;
    const float lt = st.l + __shfl_xor(st.l, 32), inv = 1.0f / lt;
#pragma unroll
    for (int d0 = 0; d0 < 2; ++d0)
#pragma unroll
        for (int pr = 0; pr < 2; ++pr) {
            v2u w2[2];
#pragma unroll
            for (int k = 0; k < 2; ++k) { const int rq = 2 * pr + k; const f32x16& o = d0 ? st.o1 : st.o0; w2[k].x = cvtpk_s(o[4 * rq + 0] * inv, o[4 * rq + 1] * inv); w2[k].y = cvtpk_s(o[4 * rq + 2] * inv, o[4 * rq + 3] * inv); }
            *(v4u*)(orow + 32 * d0 + 16 * pr + 8 * hi) = pair_to_wide(w2[0], w2[1]);
        }
    if (hi == 0) *lsep = st.m + __builtin_amdgcn_logf(lt);
}
__device__ __forceinline__ void attn_state_load(AttnSt& st, const bf16* orow, const float* lsep, int lane) {
    const int hi = lane >> 5;
#pragma unroll
    for (int d0 = 0; d0 < 2; ++d0)
#pragma unroll
        for (int pr = 0; pr < 2; ++pr) {
            const v4u w = *(const v4u*)(orow + 32 * d0 + 16 * pr + 8 * hi); v2u g2[2]; wide_to_pair(w, g2[0], g2[1]);
            f32x16& o = d0 ? st.o1 : st.o0;
#pragma unroll
            for (int k = 0; k < 2; ++k) { const int rq = 2 * pr + k; o[4 * rq + 0] = bf_lo(g2[k].x); o[4 * rq + 1] = bf_hi(g2[k].x); o[4 * rq + 2] = bf_lo(g2[k].y); o[4 * rq + 3] = bf_hi(g2[k].y); }
        }
    st.m = *lsep; st.l = hi ? 0.f : 1.f;
}

__device__ __forceinline__ void phase_dilated_3(const Args& A, LAS unsigned char* lds, int G, int vcu, int wave, int lane) {
    const bf16* Z = (const bf16*)(A.ws + WS_Z); bf16* Y = (bf16*)(A.ws + WS_Y);
    bf16* EX = (bf16*)A.out; float* LSE = A.out + (size_t)32 * 1024 * 1024;
    LAS unsigned char* wl = lds + wave * 16384;
    const int r32 = lane & 31, hi = lane >> 5;
    for (int U = vcu; U < 2048; U += G) {
        const int c = U >> 8, bh = U & 255, b = bh >> 4, hh = bh & 15, T0 = 512 * c;
        const size_t rowbase = (size_t)b * SEQ;
        const bf16* Vh = Z + rowbase * ODD_IN + 2048 + hh * 64 + 8 * (lane & 7);
        {
            const int r16a = 2 * wave, pa = r16a + 16 * r32;
            bf16x8 qa[4], qb[4];
            { const bf16* zqa = Z + (rowbase + T0 + pa) * ODD_IN + hh * 64 + 8 * hi;
#pragma unroll
              for (int d0 = 0; d0 < 4; ++d0) { qa[d0] = *(const bf16x8*)(zqa + 16 * d0); qb[d0] = *(const bf16x8*)(zqa + ODD_IN + 16 * d0); } }
            AttnSt sa, sb; sa.o0 = f32x16{}; sa.o1 = f32x16{}; sa.m = -1e30f; sa.l = 0.f; sb.o0 = f32x16{}; sb.o1 = f32x16{}; sb.m = -1e30f; sb.l = 0.f;
#define P1_PARAMS(ti) const int dil_ = (ti) < 5 ? 16 : 4, tau_ = (ti) < 5 ? (ti) : (ti) - 5; const int rdla_ = r16a & (dil_ - 1), rdlb_ = (r16a + 1) & (dil_ - 1); const int mba_ = (T0 + r16a - rdla_) / dil_ - 128 + 32 * tau_
#define P1_ADDR(ti) P1_PARAMS(ti); const size_t vst_ = (size_t)dil_ * ODD_IN; const int mv = mba_ + (lane >> 3); const int m0_ = mv < 0 ? 0 : mv, m1_ = mv + 8 < 0 ? 0 : mv + 8, m2_ = mv + 16 < 0 ? 0 : mv + 16, m3_ = mv + 24 < 0 ? 0 : mv + 24; \
                const bf16* va_ = Vh + (size_t)rdla_ * ODD_IN; const bf16* vb_ = Vh + (size_t)rdlb_ * ODD_IN
#define P1_LOADK(ti) do { P1_ADDR(ti); attn_load_k(RA, 1024, va_ + m0_ * vst_, va_ + m1_ * vst_, va_ + m2_ * vst_, va_ + m3_ * vst_); attn_load_k(RB, 1024, vb_ + m0_ * vst_, vb_ + m1_ * vst_, vb_ + m2_ * vst_, vb_ + m3_ * vst_); } while (0)
#define P1_LOADV(ti) do { P1_ADDR(ti); attn_load_v(RA, va_ + m0_ * vst_, va_ + m1_ * vst_, va_ + m2_ * vst_, va_ + m3_ * vst_); attn_load_v(RB, vb_ + m0_ * vst_, vb_ + m1_ * vst_, vb_ + m2_ * vst_, vb_ + m3_ * vst_); } while (0)
#pragma unroll 1
            for (int ti = 0; ti < 13; ++ti) {
                { P1_PARAMS(ti); if (mba_ + 31 < 0) continue; }
                TileRegs RA, RB;
                P1_LOADK(ti);
                P1_PARAMS(ti);
                attn_compute2_kv<3>(sa, sb, qa, qb, RA, RB, wl, lane, 128 + (16 / dil_) * r32 - 32 * tau_, -mba_, -mba_, [&] { P1_LOADV(ti); }, [] {});
            }
#undef P1_ADDR
#undef P1_LOADK
#undef P1_LOADV
#undef P1_PARAMS
            attn_state_store(sa, EX + ((size_t)U * 512 + pa) * 64, LSE + (size_t)U * 512 + pa, lane);
            attn_state_store(sb, EX + ((size_t)U * 512 + pa + 1) * 64, LSE + (size_t)U * 512 + pa + 1, lane);
        }
        {
            const int pa = 64 * wave + r32, pb = pa + 32;
            bf16x8 qa[4], qb[4];
            { const bf16* zqa = Z + (rowbase + T0 + pa) * ODD_IN + hh * 64 + 8 * hi;
#pragma unroll
              for (int d0 = 0; d0 < 4; ++d0) { qa[d0] = *(const bf16x8*)(zqa + 16 * d0); qb[d0] = *(const bf16x8*)(zqa + (size_t)32 * ODD_IN + 16 * d0); } }
            asm volatile("s_waitcnt vmcnt(0)" ::: "memory");
            __syncthreads();
            v2u gga[2][4], ggb[2][4];
            { const bf16* zg = Z + (rowbase + T0 + pa) * ODD_IN + 3072 + hh * 64; attn_gate_load(gga, zg, lane); attn_gate_load(ggb, zg + (size_t)32 * ODD_IN, lane); }
            AttnSt sa, sb;
            attn_state_load(sa, EX + ((size_t)U * 512 + pa) * 64, LSE + (size_t)U * 512 + pa, lane);
            attn_state_load(sb, EX + ((size_t)U * 512 + pb) * 64, LSE + (size_t)U * 512 + pb, lane);
            const int mba = T0 + 64 * wave - 128, mbb = mba + 32;
            const size_t vst = (size_t)ODD_IN;
#define P2_ADDR(tau) const int mva = mba + 32 * (tau) + (lane >> 3), mvb = mva + 32; \
                const int a0_ = mva < 0 ? 0 : mva, a1_ = mva + 8 < 0 ? 0 : mva + 8, a2_ = mva + 16 < 0 ? 0 : mva + 16, a3_ = mva + 24 < 0 ? 0 : mva + 24; \
                const int b0_ = mvb < 0 ? 0 : mvb, b1_ = mvb + 8 < 0 ? 0 : mvb + 8, b2_ = mvb + 16 < 0 ? 0 : mvb + 16, b3_ = mvb + 24 < 0 ? 0 : mvb + 24
#define P2_LOADK(tau) do { P2_ADDR(tau); attn_load_k(RA, 1024, Vh + a0_ * vst, Vh + a1_ * vst, Vh + a2_ * vst, Vh + a3_ * vst); attn_load_k(RB, 1024, Vh + b0_ * vst, Vh + b1_ * vst, Vh + b2_ * vst, Vh + b3_ * vst); } while (0)
#define P2_LOADV(tau) do { P2_ADDR(tau); attn_load_v(RA, Vh + a0_ * vst, Vh + a1_ * vst, Vh + a2_ * vst, Vh + a3_ * vst); attn_load_v(RB, Vh + b0_ * vst, Vh + b1_ * vst, Vh + b2_ * vst, Vh + b3_ * vst); } while (0)
#pragma unroll 1
            for (int tau = 0; tau < 5; ++tau) {
                if (mbb + 32 * tau + 31 < 0) continue;
                TileRegs RA, RB;
                P2_LOADK(tau);
                attn_compute2_kv<3>(sa, sb, qa, qb, RA, RB, wl, lane, 128 + r32 - 32 * tau, -(mba + 32 * tau), -(mbb + 32 * tau), [&] { P2_LOADV(tau); }, [] {});
            }
#undef P2_ADDR
#undef P2_LOADK
#undef P2_LOADV
            { int pa2 = pa; asm volatile("" : "+v"(pa2));
              bf16* yr = Y + (rowbase + T0 + pa2) * D + hh * 64;
              attn_store_g(sa, gga, yr, lane); attn_store_g(sb, ggb, yr + (size_t)32 * D, lane); }
        }
    }
}

__device__ __forceinline__ void phase_dilated(const Args& A, LAS unsigned char* lds, int gwv, int NGW, int wave, int lane) {
    const bf16* Z = (const bf16*)(A.ws + WS_Z); bf16* Y = (bf16*)(A.ws + WS_Y);
    LAS unsigned char* vl = lds + wave * 4096;
    const int r32 = lane & 31, hi = lane >> 5;
    for (int U = gwv; U < 32768; U += NGW) {
        const int rd = U >> 11, g2 = U & 2047, X = g2 >> 8, lwv = g2 & 255;
        const int bh = 32 * X + 2 * rd + (lwv >> 7), gi = lwv & 127, c = gi >> 4, r16 = gi & 15;
        const int b = bh >> 4, hh = bh & 15;
        const size_t rowbase = (size_t)b * SEQ;
        const int tq = 512 * c + r16 + 16 * r32;
        const bf16* zq = Z + (rowbase + tq) * ODD_IN;
        bf16x8 qf[4];
#pragma unroll
        for (int d0 = 0; d0 < 4; ++d0) qf[d0] = *(const bf16x8*)(zq + hh * 64 + 16 * d0 + 8 * hi);
        AttnSt st; st.o0 = f32x16{}; st.o1 = f32x16{}; st.m = -1e30f; st.l = 0.f;
        const bf16* Kh = Z + rowbase * ODD_IN + 1024 + hh * 64; const bf16* Vh = Z + rowbase * ODD_IN + 2048 + hh * 64;
#pragma unroll 1
        for (int cfg = 0; cfg < 3; ++cfg) {
            const int dil = (cfg == 0) ? 16 : (cfg == 1) ? 4 : 1, sstep = 16 / dil, ntile = (cfg == 0) ? 5 : (cfg == 1) ? 8 : 20;
            const int rdl = r16 & (dil - 1), mbase = (512 * c + r16 - rdl) / dil - 128;
            for (int tau = 0; tau < ntile; ++tau) {
                const int m0 = mbase + 32 * tau;
                if (m0 + 31 < 0) continue;
                const int mk = m0 + r32, mkc = mk < 0 ? 0 : mk;
                const bf16* kp = Kh + (size_t)(rdl + dil * mkc) * ODD_IN + 8 * hi;
                const int mv = m0 + (lane >> 3);
                const int mv0 = mv < 0 ? 0 : mv, mv1 = mv + 8 < 0 ? 0 : mv + 8, mv2 = mv + 16 < 0 ? 0 : mv + 16, mv3 = mv + 24 < 0 ? 0 : mv + 24;
                const bf16* vb = Vh + (size_t)rdl * ODD_IN + 8 * (lane & 7); const size_t vst = (size_t)dil * ODD_IN;
                const int dd0 = 128 + sstep * r32 - 32 * tau;
                attn_tile(st, qf, kp, vb + mv0 * vst, vb + mv1 * vst, vb + mv2 * vst, vb + mv3 * vst, vl, lane, true,
                          [&](int kk) { const int dd = dd0 - kk; return dd >= 0 && dd <= 128 && (m0 + kk) >= 0; });
            }
        }
        attn_store(st, zq + 3072 + hh * 64, Y + (rowbase + tq) * D + hh * 64, lane);
    }
}
#define XB_TMO      128
#define XB_XCNT(j)  (256  + 64 * (j))
#define XB_XSUB(j)  (1280 + 64 * (j))
#define XB_XGEN(j)  (2304 + 64 * (j))
#define XB_TOP      3328
#define XB_TOPGEN   3392
#define XCD_BAR_WORDS 3456
#define XB_SPIN_CAP (1u << 18)

__device__ __forceinline__ unsigned xb_ld(unsigned* p)              { return __hip_atomic_load(p, __ATOMIC_RELAXED, __HIP_MEMORY_SCOPE_AGENT); }
__device__ __forceinline__ unsigned xb_add(unsigned* p, unsigned v) { return __hip_atomic_fetch_add(p, v, __ATOMIC_RELAXED, __HIP_MEMORY_SCOPE_AGENT); }
__device__ __forceinline__ unsigned xb_xcc_id() { return (unsigned)__builtin_amdgcn_s_getreg((3 << 11) | 20) & 0xFu; }
#define XB_SPIN(cond, bar) do { unsigned _sp = 0; while (cond) { __builtin_amdgcn_s_sleep(1); \
    if ((++_sp & 255u) == 0u) { if (xb_ld(&(bar)[XB_TMO])) break; if (_sp > XB_SPIN_CAP) { atomicAdd(&(bar)[XB_TMO], 1u); break; } } } } while (0)

struct XcdBarrier {
    unsigned* bar; unsigned x;
    volatile LAS unsigned* st;
};

__device__ __forceinline__ XcdBarrier xcd_barrier_post(unsigned* bar, volatile LAS unsigned* st) {
    XcdBarrier b; b.bar = bar; b.x = xb_xcc_id(); b.st = st;
    if (threadIdx.x == 0) (void)xb_add(&bar[XB_XCNT(b.x)], 1u);
    return b;
}
__device__ __forceinline__ void xcd_barrier_complete(unsigned* bar, unsigned x, unsigned& nloc, unsigned& nx) {
    const unsigned G = gridDim.x * gridDim.y * gridDim.z;
    unsigned sum, cnt, mine, sp = 0u;
    for (;;) {
        sum = 0u; cnt = 0u; mine = 0u;
#pragma unroll
        for (unsigned j = 0; j < 16; ++j) { const unsigned c = xb_ld(&bar[XB_XCNT(j)]); sum += c; cnt += (c > 0u) ? 1u : 0u; mine = (j == x) ? c : mine; }
        if (sum == G) break;
        __builtin_amdgcn_s_sleep(1);
        if ((++sp & 255u) == 0u) { if (xb_ld(&bar[XB_TMO])) break; if (sp > XB_SPIN_CAP) { atomicAdd(&bar[XB_TMO], 1u); break; } }
    }
    nloc = mine > 0u ? mine : 1u; nx = cnt > 0u ? cnt : 1u;
}

__device__ __forceinline__ void xcd_barrier(const XcdBarrier& b) {
    asm volatile("s_waitcnt vmcnt(0)" ::: "memory");
    __syncthreads();
    if (threadIdx.x == 0) {
        unsigned* bar = b.bar;
        __builtin_amdgcn_s_waitcnt(0);
        unsigned nloc = b.st[0], nx = b.st[1];
        if (nloc == 0u) { xcd_barrier_complete(bar, b.x, nloc, nx); b.st[0] = nloc; b.st[1] = nx; }
        const unsigned old = xb_add(&bar[XB_XSUB(b.x)], 1u);
        const unsigned gen = old / nloc;
        if (old + 1u == (gen + 1u) * nloc) {
            __builtin_amdgcn_fence(__ATOMIC_RELEASE, "agent");
            asm volatile("s_waitcnt vmcnt(0)" ::: "memory");
            const unsigned og = xb_add(&bar[XB_TOP], 1u);
            const unsigned tg = og / nx;
            if (og + 1u == (tg + 1u) * nx) xb_add(&bar[XB_TOPGEN], 1u);
            else XB_SPIN(xb_ld(&bar[XB_TOPGEN]) == tg, bar);
            __builtin_amdgcn_fence(__ATOMIC_ACQUIRE, "agent");
            xb_add(&bar[XB_XGEN(b.x)], 1u);
            asm volatile("s_waitcnt vmcnt(0)" ::: "memory");
        } else {
            XB_SPIN(xb_ld(&bar[XB_XGEN(b.x)]) == gen, bar);
            __builtin_amdgcn_fence(__ATOMIC_ACQUIRE, "agent");
            asm volatile("s_waitcnt vmcnt(0)" ::: "memory");
        }
    }
    __syncthreads();
}
__device__ __forceinline__ void phase_final(const Args& A, int gwv, int NGW, int lane) {
    const float* ssqp = (const float*)(A.ws + WS_SSQ);
    f32x4 fg[4];
#pragma unroll
    for (int j = 0; j < 4; ++j) fg[j] = *((const f32x4*)A.final_g + lane + 64 * j);
    for (int m = gwv; m < M; m += 2 * NGW) {
        const int m2 = m + NGW;
        const f32x4* sp = (const f32x4*)(ssqp + (size_t)m * 16); const f32x4* sp2 = (const f32x4*)(ssqp + (size_t)m2 * 16);
        f32x4* hr = (f32x4*)(A.out + (size_t)m * D) + lane; f32x4* hr2 = (f32x4*)(A.out + (size_t)m2 * D) + lane;
        const f32x4 a = sp[0], b = sp[1], c = sp[2], d = sp[3], a2 = sp2[0], b2 = sp2[1], c2 = sp2[2], d2 = sp2[3];
        f32x4 v[4], w[4];
#pragma unroll
        for (int j = 0; j < 4; ++j) { v[j] = hr[64 * j]; w[j] = hr2[64 * j]; }
        const float ss = (((a[0] + a[1]) + (a[2] + a[3])) + ((b[0] + b[1]) + (b[2] + b[3]))) + (((c[0] + c[1]) + (c[2] + c[3])) + ((d[0] + d[1]) + (d[2] + d[3])));
        const float ss2 = (((a2[0] + a2[1]) + (a2[2] + a2[3])) + ((b2[0] + b2[1]) + (b2[2] + b2[3]))) + (((c2[0] + c2[1]) + (c2[2] + c2[3])) + ((d2[0] + d2[1]) + (d2[2] + d2[3])));
        const float rstd = __builtin_amdgcn_rsqf(ss * (1.0f / 1024.0f) + NORM_EPS), rstd2 = __builtin_amdgcn_rsqf(ss2 * (1.0f / 1024.0f) + NORM_EPS);
#pragma unroll
        for (int j = 0; j < 4; ++j) { hr[64 * j] = v[j] * rstd * fg[j]; hr2[64 * j] = w[j] * rstd2 * fg[j]; }
    }
}

#define CAS __attribute__((address_space(4)))
#define FRESH_IDS() int lane = lane_k, wave = wave_k, vcu = vcu_k; asm volatile("" : "+v"(lane), "+s"(wave), "+s"(vcu)); const int gwv = vcu * NWAVES + wave; (void)gwv;
#define GRID_SYNC() do { asm volatile("s_waitcnt vmcnt(0) lgkmcnt(0)" ::: "memory"); __syncthreads(); \
    if (wave_k == 0) { __builtin_amdgcn_fence(__ATOMIC_RELEASE, "agent"); asm volatile("s_waitcnt vmcnt(0)" ::: "memory"); } \
    grid.sync(); \
    if (wave_k == 0) { __builtin_amdgcn_fence(__ATOMIC_ACQUIRE, "agent"); asm volatile("s_waitcnt vmcnt(0)" ::: "memory"); } \
    __syncthreads(); } while (0)
#ifdef NO_XBAR
#define XBAR_SYNC() GRID_SYNC()
#else
#define XBAR_SYNC() xcd_barrier(xbar)
#endif
#define FRESH_ARGS() ({ const CAS Args* ap_ = (const CAS Args*)__builtin_amdgcn_kernarg_segment_ptr(); asm volatile("" : "+s"(ap_)); Args a_; a_ = *(const Args*)ap_; a_; })
__global__ void __launch_bounds__(NTHREADS, 2) mega_fwd(Args Akern) {
    extern __shared__ __attribute__((aligned(16))) unsigned char lds_raw[];
    cg::grid_group grid = cg::this_grid();
    LAS unsigned char* lds = (LAS unsigned char*)lds_raw;
    const int tid = threadIdx.x, lane_k = tid & 63, wave_k = __builtin_amdgcn_readfirstlane(tid >> 6);
    const int G = gridDim.x, bx = blockIdx.x;
    const int vcu_k = (G % 8 == 0) ? (bx % 8) * (G / 8) + bx / 8 : bx;
    const int NGW = G * NWAVES;
    if (tid < 2) ((volatile LAS unsigned*)(lds + 131072))[tid] = 0u;
    __syncthreads();
    const XcdBarrier xbar = xcd_barrier_post((unsigned*)(Akern.ws + WS_CTL), (volatile LAS unsigned*)(lds + 131072));

#ifndef NO_PRO
    { FRESH_IDS(); const Args A = FRESH_ARGS(); phase_prologue(A, lds, gwv, NGW, wave, lane); }
#endif
    GRID_SYNC();
#pragma unroll 1
    for (int layer = 0; layer < 4; ++layer) {
        const int li = layer >> 1; const int even = !(layer & 1);
        {
            const Args A = FRESH_ARGS(); bf16* hb = (bf16*)(A.ws + WS_HB); bf16* Zb = (bf16*)(A.ws + WS_Z); float* ssqp = (float*)(A.ws + WS_SSQ); float* kmp = (float*)(A.ws + WS_KMP);
            const int N = even ? EVEN_IN : ODD_IN;
            const bf16* Wt = even ? (const bf16*)(A.ws + WS_WE_IN) + (size_t)li * EVEN_IN * D : (const bf16*)(A.ws + WS_WO_IN) + (size_t)li * ODD_IN * D;
            pg8::Gemm g{hb, Wt, M, N, D}; pg8::StaticOrder S; S.init(M, N, G, bx);
            LAS float* rtab = (LAS float*)(lds + 131072 + 1024);
            {
                int tidl = tid; asm volatile("" : "+v"(tidl));
                const int rl = tidl & 255, half = tidl >> 8;
#pragma unroll 1
                for (int kb = 0; kb < 8; kb += 4) {
                    f32x4 pv[4][4]; int have[4];
#pragma unroll
                    for (int k = 0; k < 4; ++k) {
                        pg8::Unit uu; have[k] = S.next(2 * (kb + k) + half, uu) ? 1 : 0;
                        const float* sp = ssqp + ((size_t)(have[k] ? uu.pm : 0) * 256 + rl) * 16;
#pragma unroll
                        for (int q4 = 0; q4 < 4; ++q4) pv[k][q4] = *(const f32x4*)(sp + 4 * q4);
                    }
#pragma unroll
                    for (int k = 0; k < 4; ++k) {
                        const f32x4 a = pv[k][0], b = pv[k][1], c = pv[k][2], d = pv[k][3];
                        const float ss = (((a[0] + a[1]) + (a[2] + a[3])) + ((b[0] + b[1]) + (b[2] + b[3]))) + (((c[0] + c[1]) + (c[2] + c[3])) + ((d[0] + d[1]) + (d[2] + d[3])));
                        if (have[k]) rtab[(2 * (kb + k) + half) * 256 + rl] = __builtin_amdgcn_rsqf(ss * (1.0f / 1024.0f) + NORM_EPS);
                    }
                }
                __syncthreads();
            }
            int eseq = 0;
            pg8::EpiIn E{Zb, N, rtab, &eseq, kmp, even};
#ifdef PROBE_GIN2
            pg8::gemm_phase<pg8::EpiIn, pg8::StaticOrder, true, true>(lds, g, S, E);
#endif
#ifndef NO_GIN
            pg8::gemm_phase<pg8::EpiIn, pg8::StaticOrder, true, true>(lds, g, S, E);
#endif
        }
        XBAR_SYNC();
#ifdef PROBE_MIX2
        for (int rep = 0; rep < 2; ++rep)
#endif
#ifdef PROBE_MIX2_EVEN
        for (int rep = 0; rep < (even ? 2 : 1); ++rep)
#endif
        { __syncthreads(); FRESH_IDS(); const Args A = FRESH_ARGS();
        if (even) {
#ifndef NO_GMLP
            phase_gmlp(A, li, lds, vcu, G, wave, lane);
#endif
#ifdef PROBE_GMLP2
            phase_gmlp(A, li, lds, vcu, G, wave, lane);
#endif
#ifndef NO_MOBA
#if defined(NO_PIPE)
            phase_moba_old(A, lds, gwv, NGW, wave, lane);
#elif defined(MOBA_PIPE)
            phase_moba_p(A, lds, gwv, NGW, wave, lane);
#else
            phase_moba_s(A, lds, G, vcu, wave, lane);
#endif
#endif
        } else {
#ifndef NO_DIL
#if defined(NO_PIPE)
            phase_dilated(A, lds, gwv, NGW, wave, lane);
#elif defined(DIL_PIPE)
            phase_dilated_p(A, lds, gwv, NGW, wave, lane);
#elif defined(DIL_2)
            phase_dilated_2(A, lds, gwv, NGW, wave, lane);
#else
            phase_dilated_3(A, lds, G, vcu, wave, lane);
#endif
#endif
        } }
        XBAR_SYNC();
        {
            const Args A = FRESH_ARGS(); bf16* hb = (bf16*)(A.ws + WS_HB); bf16* Yb = (bf16*)(A.ws + WS_Y); float* ssqp = (float*)(A.ws + WS_SSQ);
            const bf16* Wt = even ? (const bf16*)(A.ws + WS_WE_OUT) + (size_t)li * D * D : (const bf16*)(A.ws + WS_WO_OUT) + (size_t)li * D * D;
            pg8::Gemm g{Yb, Wt, M, D, D}; pg8::StaticOrder S; S.init(M, D, G, bx);
            pg8::EpiOut E{layer == 0 ? A.x : nullptr, layer == 3 ? A.out : nullptr, hb, ssqp};
#ifndef NO_GOUT
            pg8::gemm_phase<pg8::EpiOut, pg8::StaticOrder, true, true>(lds, g, S, E);
#endif
        }
        XBAR_SYNC();
    }
#ifndef NO_FIN
    { FRESH_IDS(); const Args A = FRESH_ARGS(); phase_final(A, gwv, NGW, lane); }
#endif
}

extern "C" void kernel_launch(void* const* d_in, const int* in_sizes, int n_in, void* d_out, int out_size, void* d_ws, size_t ws_size, hipStream_t stream) {
    static int grid = 0;
    if (grid == 0) {
        if (n_in != 11 || in_sizes[0] != M * D || out_size != M * D || ws_size < WS_END) { fprintf(stderr, "kernel_launch: unexpected shapes (n_in %d, in0 %d, out %d, ws %zu)\n", n_in, n_in > 0 ? in_sizes[0] : -1, out_size, ws_size); grid = -1; return; }
        int dev = 0, cus = 0, per_cu = 0;
        if (hipGetDevice(&dev) != hipSuccess || hipDeviceGetAttribute(&cus, hipDeviceAttributeMultiprocessorCount, dev) != hipSuccess) { grid = -1; return; }
        if (hipFuncSetAttribute((const void*)mega_fwd, hipFuncAttributeMaxDynamicSharedMemorySize, LDS_BYTES) != hipSuccess) { fprintf(stderr, "kernel_launch: hipFuncSetAttribute failed\n"); grid = -1; return; }
        if (hipOccupancyMaxActiveBlocksPerMultiprocessor(&per_cu, (const void*)mega_fwd, NTHREADS, LDS_BYTES) != hipSuccess || per_cu < 1) { fprintf(stderr, "kernel_launch: occupancy query says %d\n", per_cu); per_cu = 1; }
        (void)hipGetLastError();
        grid = cus;
    }
    if (grid < 0) return;
    Args a{};
    a.x = (const float*)d_in[0]; a.norm_g = (const float*)d_in[1]; a.final_g = (const float*)d_in[2]; a.ab_w_in = (const float*)d_in[3]; a.ab_w_out = (const float*)d_in[4];
    a.ln_g = (const float*)d_in[5]; a.ln_b = (const float*)d_in[6]; a.w_s = (const float*)d_in[7]; a.b_s = (const float*)d_in[8]; a.c_w_in = (const float*)d_in[9]; a.c_w_out = (const float*)d_in[10];
    a.out = (float*)d_out; a.ws = (unsigned char*)d_ws;
    if (hipMemsetAsync((char*)d_ws + WS_CTL, 0, 16384, stream) != hipSuccess) { fprintf(stderr, "kernel_launch: hipMemsetAsync failed\n"); return; }
    void* args[] = {&a};
    const hipError_t e = hipLaunchCooperativeKernel((const void*)mega_fwd, dim3(grid), dim3(NTHREADS), args, LDS_BYTES, stream);
    if (e != hipSuccess) fprintf(stderr, "kernel_launch: cooperative launch failed: %s (grid %d)\n", hipGetErrorString(e), grid);
}
```

```cpp
#include <hip/hip_runtime.h>
#include <hip/hip_cooperative_groups.h>
#include <cstdio>
#include <cstdint>
#include <cmath>
namespace cg = cooperative_groups;
namespace pg8 {
#define PG8_LAS __attribute__((address_space(3)))
typedef unsigned short bf16_t;
typedef short bf16x8 __attribute__((ext_vector_type(8)));
typedef float f32x4 __attribute__((ext_vector_type(4)));
typedef unsigned u32x4 __attribute__((ext_vector_type(4)));
constexpr int BM = 256, BK = 64, HALF = 128, HTB = HALF * BK * 2  , STAGE_BYTES = 8 * HTB, NXCD = 8, WGM = 8;

__host__ __device__ __forceinline__ int lds_byte(int r, int c) { const int st = (r >> 4) * 2 + (c >> 5), rr = r & 15, cc = c & 31, ob = rr * 64 + cc * 2; return st * 1024 + (ob ^ (((ob >> 9) & 1) << 5)); }
__host__ __device__ __forceinline__ void stage_rc(int b, int& R, int& C) { const int st = b / 1024, sb = b % 1024, swz = sb ^ (((sb >> 9) & 1) << 5); R = (st >> 1) * 16 + swz / 64; C = (st & 1) * 32 + (swz % 64) / 2; }
__host__ __device__ __forceinline__ int perm32(int rho) { const int n = rho >> 4, i = rho & 15; return 8 * (i >> 2) + 4 * n + (i & 3); }

struct Unit { int pm, pn; };
struct Gemm { const bf16_t* A; const bf16_t* Bt; int M, N, K; };

struct StaticOrder {
    int nM, nN, nwg, G, c;
    __host__ __device__ void init(int M, int N, int G_, int c_) { nM = M / BM; nN = N / BM; nwg = nM * nN; G = G_; c = c_; }
    __host__ __device__ bool next(int i, Unit& u) const {
        const long L = (long)i * G + c; if (L >= nwg) return false;
        int wgid = (int)L; { const int q = nwg / NXCD, r = nwg % NXCD, xcd = wgid % NXCD, off = wgid / NXCD; wgid = (xcd < r ? xcd * (q + 1) : r * (q + 1) + (xcd - r) * q) + off; }
        const int nig = WGM * nN, gid = wgid / nig, fm = gid * WGM, gsz = (nM - fm) < WGM ? (nM - fm) : WGM;
        u.pm = fm + ((wgid % nig) % gsz); u.pn = (wgid % nig) / gsz; return true;
    }
    __device__ __forceinline__ void a_ready(const Unit&) const {}
    __device__ __forceinline__ void done(const Unit&) const {}
};

__device__ __forceinline__ unsigned cvt_pk_bf16(float lo, float hi) { unsigned r; asm volatile("v_cvt_pk_bf16_f32 %0, %1, %2" : "=v"(r) : "v"(lo), "v"(hi)); return r; }
typedef unsigned u32x2 __attribute__((ext_vector_type(2)));
__device__ __forceinline__ float act_gelu(float x) {
    const float t = x + 0.044715f * x * x * x;
    return x * __builtin_amdgcn_rcpf(1.f + __builtin_amdgcn_exp2f(-2.302208198f * t));
}
__device__ __forceinline__ float act_silu(float x) { return x * __builtin_amdgcn_rcpf(1.f + __builtin_amdgcn_exp2f(-1.4426950409f * x)); }
constexpr float QSCALE = 0.125f * 1.4426950408889634f;
constexpr float NORM_EPS = 1e-6f;

struct EpiIn {
    static constexpr bool PERM = true, AFTER_DRAIN = false;
    bf16_t* Z; int ldz; const PG8_LAS float* rtab; int* seq; float* kmp; int even;
    template <int ACT> __device__ __forceinline__ void body(const f32x4 (&acc)[2][2][4][2], const Unit& u, int wr, int wc, int fr, int fq, const PG8_LAS float* rt) const {
        const int row0 = u.pm * BM + wr * 64 + fr, col0 = u.pn * BM + wc * 32 + 8 * fq;
        float rs[2][4];
#pragma unroll
        for (int ai = 0; ai < 2; ++ai)
#pragma unroll
            for (int m = 0; m < 4; ++m) rs[ai][m] = rt[wr * 64 + fr + ai * HALF + m * 16];
        float cs[2][2][4];
        if (ACT == 4) {
#pragma unroll
            for (int bj = 0; bj < 2; ++bj)
#pragma unroll
                for (int n = 0; n < 2; ++n)
#pragma unroll
                    for (int e = 0; e < 4; ++e) cs[bj][n][e] = 0.f;
        }
#pragma unroll
        for (int ai = 0; ai < 2; ++ai)
#pragma unroll
            for (int m = 0; m < 4; ++m) {
                const int row = row0 + ai * HALF + m * 16;
                const float rstd = rs[ai][m];
                bf16_t* rowp = Z + (size_t)row * ldz + col0;
#pragma unroll
                for (int bj = 0; bj < 2; ++bj) {
                    f32x4 v[2];
#pragma unroll
                    for (int n = 0; n < 2; ++n) {
                        v[n] = acc[ai][bj][m][n] * rstd;
#pragma unroll
                        for (int e = 0; e < 4; ++e) {
                            if (ACT == 1) v[n][e] = act_gelu(v[n][e]);
                            if (ACT == 2) v[n][e] = act_silu(v[n][e]);
                            if (ACT == 3) v[n][e] = v[n][e] * QSCALE;
                            if (ACT == 4) cs[bj][n][e] += v[n][e];
                        }
                    }
                    u32x4 w; w.x = cvt_pk_bf16(v[0][0], v[0][1]); w.y = cvt_pk_bf16(v[0][2], v[0][3]); w.z = cvt_pk_bf16(v[1][0], v[1][1]); w.w = cvt_pk_bf16(v[1][2], v[1][3]);
                    *(u32x4*)(rowp + bj * HALF) = w;
                }
            }
        if (ACT == 4) {
#pragma unroll
            for (int bj = 0; bj < 2; ++bj)
#pragma unroll
                for (int n = 0; n < 2; ++n)
#pragma unroll
                    for (int e = 0; e < 4; ++e) {
                        float s = cs[bj][n][e];
                        s += __shfl_xor(s, 1); s += __shfl_xor(s, 2); s += __shfl_xor(s, 4); s += __shfl_xor(s, 8);
                        cs[bj][n][e] = s;
                    }
            if (fr == 0) {
                float* kp = kmp + ((size_t)u.pm * 2 + wr) * 512 + (col0 - 2048);
#pragma unroll
                for (int bj = 0; bj < 2; ++bj)
#pragma unroll
                    for (int n = 0; n < 2; ++n) *(f32x4*)(kp + bj * HALF + n * 4) = (f32x4){cs[bj][n][0], cs[bj][n][1], cs[bj][n][2], cs[bj][n][3]};
            }
        }
    }
    __device__ __forceinline__ void operator()(const f32x4 (&acc)[2][2][4][2], const Unit& u, int wr, int wc, int fr, int fq) const {
        int act;
        if (even) { const int seg = u.pn >> 1; act = (seg == 0 || seg == 1) ? 1 : (seg == 2 || seg == 6) ? 2 : (seg == 3) ? 3 : (seg == 4) ? 4 : 0; }
        else { const int seg = u.pn >> 2; act = (seg == 0) ? 3 : (seg == 3) ? 2 : 0; }
        const PG8_LAS float* rt = rtab + ((*seq)++) * 256;
        if (act == 0) body<0>(acc, u, wr, wc, fr, fq, rt);
        else if (act == 1) body<1>(acc, u, wr, wc, fr, fq, rt);
        else if (act == 2) body<2>(acc, u, wr, wc, fr, fq, rt);
        else if (act == 3) body<3>(acc, u, wr, wc, fr, fq, rt);
        else body<4>(acc, u, wr, wc, fr, fq, rt);
    }
};
struct EpiOut {
    static constexpr bool PERM = true, AFTER_DRAIN = false;
    const float* resid_f32; float* out_f32; bf16_t* hb; float* ssqp;
    template <bool RF32> __device__ __forceinline__ void body(const f32x4 (&acc)[2][2][4][2], const Unit& u, int wr, int wc, int fr, int fq) const {
        const int row0 = u.pm * BM + wr * 64 + fr, col0 = u.pn * BM + wc * 32 + 8 * fq;
        constexpr int MB = RF32 ? 2 : 4;
#pragma unroll
        for (int ai = 0; ai < 2; ++ai)
#pragma unroll
        for (int m0 = 0; m0 < 4; m0 += MB) {
            f32x4 rf[RF32 ? MB : 1][2][2]; u32x4 rb[RF32 ? 1 : MB][2];
#pragma unroll
            for (int mm = 0; mm < MB; ++mm)
#pragma unroll
                for (int bj = 0; bj < 2; ++bj) {
                    const size_t o2 = (size_t)(row0 + ai * HALF + (m0 + mm) * 16) * 1024 + col0 + bj * HALF;
                    if (RF32) { rf[RF32 ? mm : 0][bj][0] = *(const f32x4*)(resid_f32 + o2); rf[RF32 ? mm : 0][bj][1] = *(const f32x4*)(resid_f32 + o2 + 4); }
                    else rb[RF32 ? 0 : mm][bj] = *(const u32x4*)(hb + o2);
                }
#pragma unroll
            for (int mm = 0; mm < MB; ++mm) {
                const int m = m0 + mm;
                const int row = row0 + ai * HALF + m * 16; const size_t off = (size_t)row * 1024 + col0; float ss = 0.f;
#pragma unroll
                for (int bj = 0; bj < 2; ++bj) {
                    const size_t o2 = off + bj * HALF;
                    f32x4 r0, r1;
                    if (RF32) { r0 = rf[RF32 ? mm : 0][bj][0]; r1 = rf[RF32 ? mm : 0][bj][1]; }
                    else { const u32x4 w = rb[RF32 ? 0 : mm][bj];
                        r0[0] = __builtin_bit_cast(float, w.x << 16); r0[1] = __builtin_bit_cast(float, w.x & 0xffff0000u); r0[2] = __builtin_bit_cast(float, w.y << 16); r0[3] = __builtin_bit_cast(float, w.y & 0xffff0000u);
                        r1[0] = __builtin_bit_cast(float, w.z << 16); r1[1] = __builtin_bit_cast(float, w.z & 0xffff0000u); r1[2] = __builtin_bit_cast(float, w.w << 16); r1[3] = __builtin_bit_cast(float, w.w & 0xffff0000u); }
                    const f32x4 o0 = r0 + acc[ai][bj][m][0], o1 = r1 + acc[ai][bj][m][1];
                    ss += ((o0[0] * o0[0] + o0[1] * o0[1]) + (o0[2] * o0[2] + o0[3] * o0[3])) + ((o1[0] * o1[0] + o1[1] * o1[1]) + (o1[2] * o1[2] + o1[3] * o1[3]));
                    if (out_f32) { *(f32x4*)(out_f32 + o2) = o0; *(f32x4*)(out_f32 + o2 + 4) = o1; }
                    else { u32x4 w; w.x = cvt_pk_bf16(o0[0], o0[1]); w.y = cvt_pk_bf16(o0[2], o0[3]); w.z = cvt_pk_bf16(o1[0], o1[1]); w.w = cvt_pk_bf16(o1[2], o1[3]); *(u32x4*)(hb + o2) = w; }
                }
                ss += __shfl_xor(ss, 16); ss += __shfl_xor(ss, 32);
                if (fq == 0) ssqp[(size_t)row * 16 + u.pn * 4 + wc] = ss;
            }
        }
    }
    __device__ __forceinline__ void operator()(const f32x4 (&acc)[2][2][4][2], const Unit& u, int wr, int wc, int fr, int fq) const {
        if (resid_f32) body<true>(acc, u, wr, wc, fr, fq); else body<false>(acc, u, wr, wc, fr, fq);
    }
};
template <class Epi, class Sched, bool ALIGN_EPI = false, bool SP2 = false>
__device__ __forceinline__ void gemm_phase(PG8_LAS unsigned char* lds, const Gemm g, const Sched& S, const Epi& E) {
    int tid_ = threadIdx.x; asm volatile("" : "+v"(tid_));
    const int tid = tid_, wid = __builtin_amdgcn_readfirstlane(tid >> 6), lane = tid & 63, wr = wid >> 2, wc = wid & 3, fr = lane & 15, fq = lane >> 4;
    const int K = g.K, nt = K / BK;
    unsigned voffA[2], voffB[2];
#pragma unroll
    for (int i = 0; i < 2; ++i) { int R, C; stage_rc(tid * 16 + i * 8192, R, C); const int Rb = Epi::PERM ? ((R & ~31) + perm32(R & 31)) : R;
        voffA[i] = (unsigned)(R * K + C) * 2u; voffB[i] = (unsigned)(Rb * K + C) * 2u; }
    const size_t kstep = (size_t)(BK * 2);
    const size_t hstep = (size_t)HALF * K * 2;
    const size_t tstep = 2 * hstep;
    const unsigned ldsw = (unsigned)wid * 1024u;
    const int aoff = lds_byte(wr * 64 + fr, fq * 8), boff = lds_byte(wc * 32 + fr, fq * 8);
#define PG8_SA(b, h) (((b) * 2 + (h)) * HTB)
#define PG8_SB(b, h) ((4 + (b) * 2 + (h)) * HTB)
#define PG8_STAGE(bufoff, gbase, voff) do { _Pragma("unroll") for (int _i = 0; _i < 2; ++_i) \
        __builtin_amdgcn_global_load_lds((const unsigned*)((const char*)(gbase) + (voff)[_i]), (PG8_LAS unsigned*)(lds + (bufoff) + ldsw + _i * 8192), 16, 0, 0); } while (0)
#define PG8_LDA(dst, b, h) do { _Pragma("unroll") for (int m = 0; m < 4; ++m) _Pragma("unroll") for (int k = 0; k < 2; ++k) dst[m][k] = *(const PG8_LAS bf16x8*)(lds + PG8_SA(b, h) + aoff + m * 2048 + k * 1024); } while (0)
#define PG8_LDB(dst, b, h) do { _Pragma("unroll") for (int n = 0; n < 2; ++n) _Pragma("unroll") for (int k = 0; k < 2; ++k) dst[n][k] = *(const PG8_LAS bf16x8*)(lds + PG8_SB(b, h) + boff + n * 2048 + k * 1024); } while (0)
#define PG8_MMA(ai, bj, At, Bt) do { __builtin_amdgcn_s_setprio(1); _Pragma("unroll") for (int m = 0; m < 4; ++m) _Pragma("unroll") for (int n = 0; n < 2; ++n) _Pragma("unroll") for (int k = 0; k < 2; ++k) \
        acc[ai][bj][m][n] = __builtin_amdgcn_mfma_f32_16x16x32_bf16(Bt[n][k], At[m][k], acc[ai][bj][m][n], 0, 0, 0); __builtin_amdgcn_s_setprio(0); } while (0)
#define PG8_WAIT_V(n) asm volatile("s_waitcnt vmcnt(" #n ")" ::: "memory")
#define PG8_WAIT_L(n) asm volatile("s_waitcnt lgkmcnt(" #n ")" ::: "memory")
#define PG8_BAR __builtin_amdgcn_s_barrier()
#define PG8_SCHED __builtin_amdgcn_sched_barrier(0)
    Unit cur, nxt; int ui = 0;
    if (!S.next(0, cur)) return;
    f32x4 acc[2][2][4][2];
#pragma unroll
    for (int a = 0; a < 2; ++a)
#pragma unroll
        for (int b = 0; b < 2; ++b)
#pragma unroll
            for (int m = 0; m < 4; ++m)
#pragma unroll
                for (int n = 0; n < 2; ++n) acc[a][b][m][n] = (f32x4){0.f, 0.f, 0.f, 0.f};
    bf16x8 At[4][2], B0[2][2], B1[2][2];
    const char* cA = (const char*)g.A + (size_t)cur.pm * tstep; const char* cB = (const char*)g.Bt + (size_t)cur.pn * tstep;
    S.a_ready(cur);
    if constexpr (SP2) {
        PG8_STAGE(PG8_SB(0, 0), cB, voffB); PG8_STAGE(PG8_SB(0, 1), cB + hstep, voffB); PG8_STAGE(PG8_SA(0, 0), cA, voffA); PG8_STAGE(PG8_SA(0, 1), cA + hstep, voffA);
        if (wr == 1) PG8_BAR;
        PG8_WAIT_V(2); PG8_BAR;
        PG8_STAGE(PG8_SB(1, 0), cB + kstep, voffB); PG8_STAGE(PG8_SA(1, 0), cA + kstep, voffA); PG8_STAGE(PG8_SB(1, 1), cB + hstep + kstep, voffB);
        PG8_WAIT_V(6); PG8_BAR;
    } else {
        PG8_STAGE(PG8_SB(0, 0), cB, voffB); PG8_STAGE(PG8_SA(0, 0), cA, voffA); PG8_STAGE(PG8_SB(0, 1), cB + hstep, voffB); PG8_STAGE(PG8_SA(0, 1), cA + hstep, voffA);
        if (wr == 1) PG8_BAR;
        PG8_WAIT_V(4); PG8_BAR;
        PG8_STAGE(PG8_SB(1, 0), cB + kstep, voffB); PG8_STAGE(PG8_SA(1, 0), cA + kstep, voffA); PG8_STAGE(PG8_SB(1, 1), cB + hstep + kstep, voffB);
        PG8_WAIT_V(6); PG8_BAR;
    }
    for (;;) {
        const bool has_next = S.next(ui + 1, nxt);
        const char* nA = has_next ? (const char*)g.A + (size_t)nxt.pm * tstep : cA; const char* nB = has_next ? (const char*)g.Bt + (size_t)nxt.pn * tstep : cB;
        for (int t = 0; t < nt; t += 2) {
            const bool last = (t == nt - 2);
            const char* a1 = cA + (size_t)(t + 1) * kstep;
            const char* a2 = last ? nA : cA + (size_t)(t + 2) * kstep; const char* b2 = last ? nB : cB + (size_t)(t + 2) * kstep;
            const char* a3 = a2 + kstep; const char* b3 = b2 + kstep;
            if (last && has_next) S.a_ready(nxt);
            if constexpr (SP2) {
            PG8_LDB(B0, 0, 0); PG8_LDB(B1, 0, 1); PG8_SCHED; PG8_LDA(At, 0, 0); PG8_STAGE(PG8_SA(1, 1), a1 + hstep, voffA);
            PG8_WAIT_V(8); PG8_WAIT_L(0); PG8_BAR; PG8_MMA(0, 0, At, B0); PG8_MMA(0, 1, At, B1); PG8_BAR; PG8_SCHED;
            PG8_LDA(At, 0, 1); PG8_STAGE(PG8_SB(0, 0), b2, voffB); PG8_STAGE(PG8_SB(0, 1), b2 + hstep, voffB); PG8_STAGE(PG8_SA(0, 0), a2, voffA);
            PG8_WAIT_V(8); PG8_WAIT_L(0); PG8_BAR; PG8_MMA(1, 0, At, B0); PG8_MMA(1, 1, At, B1); PG8_BAR; PG8_SCHED;
            PG8_LDB(B0, 1, 0); PG8_LDB(B1, 1, 1); PG8_SCHED; PG8_LDA(At, 1, 0); PG8_STAGE(PG8_SA(0, 1), a2 + hstep, voffA);
            PG8_WAIT_V(8); PG8_WAIT_L(0); PG8_BAR; PG8_MMA(0, 0, At, B0); PG8_MMA(0, 1, At, B1); PG8_BAR; PG8_SCHED;
            PG8_LDA(At, 1, 1); PG8_STAGE(PG8_SB(1, 0), b3, voffB); PG8_STAGE(PG8_SB(1, 1), b3 + hstep, voffB); PG8_STAGE(PG8_SA(1, 0), a3, voffA);
            PG8_WAIT_V(8); PG8_WAIT_L(0); PG8_BAR; PG8_MMA(1, 0, At, B0); PG8_MMA(1, 1, At, B1); PG8_BAR; PG8_SCHED;
            } else {
            PG8_LDB(B0, 0, 0); PG8_SCHED; PG8_LDA(At, 0, 0); PG8_STAGE(PG8_SA(1, 1), a1 + hstep, voffA);
            PG8_WAIT_L(8); PG8_BAR; PG8_WAIT_L(0); PG8_MMA(0, 0, At, B0); PG8_BAR; PG8_SCHED;
            PG8_LDB(B1, 0, 1); PG8_STAGE(PG8_SB(0, 0), b2, voffB);
            PG8_BAR; PG8_WAIT_L(0); PG8_MMA(0, 1, At, B1); PG8_BAR;
            PG8_LDA(At, 0, 1); PG8_STAGE(PG8_SA(0, 0), a2, voffA);
            PG8_BAR; PG8_WAIT_L(0); PG8_MMA(1, 0, At, B0); PG8_BAR; PG8_SCHED;
            PG8_STAGE(PG8_SB(0, 1), b2 + hstep, voffB);
            PG8_WAIT_V(6); PG8_BAR; PG8_MMA(1, 1, At, B1); PG8_BAR;
            PG8_LDB(B0, 1, 0); PG8_SCHED; PG8_LDA(At, 1, 0); PG8_STAGE(PG8_SA(0, 1), a2 + hstep, voffA);
            PG8_WAIT_L(8); PG8_BAR; PG8_WAIT_L(0); PG8_MMA(0, 0, At, B0); PG8_BAR; PG8_SCHED;
            PG8_LDB(B1, 1, 1); PG8_STAGE(PG8_SB(1, 0), b3, voffB);
            PG8_BAR; PG8_WAIT_L(0); PG8_MMA(0, 1, At, B1); PG8_BAR;
            PG8_LDA(At, 1, 1); PG8_STAGE(PG8_SA(1, 0), a3, voffA);
            PG8_BAR; PG8_WAIT_L(0); PG8_MMA(1, 0, At, B0); PG8_BAR; PG8_SCHED;
            PG8_STAGE(PG8_SB(1, 1), b3 + hstep, voffB);
            PG8_WAIT_V(6); PG8_BAR; PG8_MMA(1, 1, At, B1); PG8_BAR;
            }
        }
        if constexpr (ALIGN_EPI) { if (wr == 0) PG8_BAR; }
        if constexpr (!Epi::AFTER_DRAIN) { E(acc, cur, wr, wc, fr, fq); S.done(cur); }
        if (!has_next) break;
#pragma unroll
        for (int a = 0; a < 2; ++a)
#pragma unroll
            for (int b = 0; b < 2; ++b)
#pragma unroll
                for (int m = 0; m < 4; ++m)
#pragma unroll
                    for (int n = 0; n < 2; ++n) acc[a][b][m][n] = (f32x4){0.f, 0.f, 0.f, 0.f};
        cur = nxt; cA = nA; cB = nB; ++ui;
        if constexpr (ALIGN_EPI) { if (wr == 1) PG8_BAR; }
    }
    PG8_WAIT_V(0);
    if constexpr (!ALIGN_EPI) { if (wr == 0) PG8_BAR; }
    PG8_BAR;
    if constexpr (Epi::AFTER_DRAIN) { E.fused(acc, cur, wr, wc, fr, fq, lds, wid, lane); S.done(cur); }
#undef PG8_SA
#undef PG8_SB
#undef PG8_STAGE
#undef PG8_LDA
#undef PG8_LDB
#undef PG8_MMA
#undef PG8_WAIT_V
#undef PG8_WAIT_L
#undef PG8_BAR
#undef PG8_SCHED
}
}
#define GAS __attribute__((address_space(1)))
#define LAS __attribute__((address_space(3)))
typedef unsigned short bf16;
typedef unsigned v4u __attribute__((ext_vector_type(4)));
typedef unsigned v2u __attribute__((ext_vector_type(2)));
typedef float f32x4 __attribute__((ext_vector_type(4)));
typedef float f32x16 __attribute__((ext_vector_type(16)));
typedef short bf16x8 __attribute__((ext_vector_type(8)));
typedef short s16x4 __attribute__((ext_vector_type(4)));
#define LDS_WAIT() asm volatile("s_waitcnt lgkmcnt(0)" ::: "memory")
using pg8::cvt_pk_bf16; using pg8::NORM_EPS; using pg8::QSCALE;

constexpr int NWAVES = 8, NTHREADS = 512;
constexpr float RESCALE_THR = 8.0f;
constexpr int D = 1024, BATCH = 16, SEQ = 4096, M = BATCH * SEQ;
constexpr int EVEN_IN = 3584, ODD_IN = 4096;
constexpr size_t MiB = 1u << 20;
constexpr size_t WS_WE_IN = 0, WS_WE_OUT = 14 * MiB, WS_WO_IN = 18 * MiB, WS_WO_OUT = 34 * MiB, WS_WS = 38 * MiB, WS_SSQ = 39 * MiB, WS_KMP = 43 * MiB,
                 WS_HB = 44 * MiB, WS_Y = 172 * MiB, WS_Z = 300 * MiB, WS_CTL = 812 * MiB, WS_END = 813 * MiB;
constexpr int LDS_BYTES = 131072 + 1024 + 16384;

__device__ __forceinline__ unsigned f2bf(float f) { unsigned u = __builtin_bit_cast(unsigned, f); return (u + 0x7fffu + ((u >> 16) & 1u)) >> 16; }
__device__ __forceinline__ unsigned pk2(float lo, float hi) { return f2bf(lo) | (f2bf(hi) << 16); }
__device__ __forceinline__ float bf_lo(unsigned w) { return __builtin_bit_cast(float, w << 16); }
__device__ __forceinline__ float bf_hi(unsigned w) { return __builtin_bit_cast(float, w & 0xffff0000u); }
__device__ __forceinline__ float wave_sum(float v) {
#pragma unroll
    for (int o = 1; o < 64; o <<= 1) v += __shfl_xor(v, o);
    return v;
}
typedef float f32x2_t __attribute__((ext_vector_type(2))); typedef __bf16 bf16x2_t __attribute__((ext_vector_type(2)));
__device__ __forceinline__ unsigned cvtpk_s(float lo, float hi) { f32x2_t v = {lo, hi}; bf16x2_t b = __builtin_convertvector(v, bf16x2_t); return __builtin_bit_cast(unsigned, b); }
__device__ __forceinline__ int crow(int r, int hi) { return (r & 3) + 8 * (r >> 2) + 4 * hi; }
__device__ __forceinline__ s16x4 vtr(const LAS unsigned char* p) { return __builtin_bit_cast(s16x4, __builtin_amdgcn_ds_read_tr16_b64_v4i16((LAS s16x4*)p)); }

__device__ __forceinline__ void transpose_item(const float* W, const float* g, int K, int N, bf16* WT, LAS float* scr, int item, int lane) {
    const int nblk = N / 32, kb = item / nblk, nb = item % nblk, k0 = 64 * kb, n0 = 32 * nb;
#pragma unroll 8
    for (int i = 0; i < 32; ++i) { const int kk = 2 * i + (lane >> 5); const float sc = g ? g[k0 + kk] : 1.f; scr[kk * 33 + (lane & 31)] = W[(size_t)(k0 + kk) * N + n0 + (lane & 31)] * sc; }
    LDS_WAIT(); asm volatile("" ::: "memory");
    const int c = lane & 7;
#pragma unroll
    for (int j = 0; j < 4; ++j) { const int n = (lane >> 3) + 8 * j; const LAS float* s = scr + (8 * c) * 33 + n;
        v4u o; o.x = pk2(s[0 * 33], s[1 * 33]); o.y = pk2(s[2 * 33], s[3 * 33]); o.z = pk2(s[4 * 33], s[5 * 33]); o.w = pk2(s[6 * 33], s[7 * 33]);
        *(v4u*)(WT + (size_t)(n0 + n) * K + k0 + 8 * c) = o; }
    LDS_WAIT(); asm volatile("" ::: "memory");
}

struct Args {
    const float *x, *norm_g, *final_g, *ab_w_in, *ab_w_out, *ln_g, *ln_b, *w_s, *b_s, *c_w_in, *c_w_out;
    float* out; unsigned char* ws;
};

__device__ __forceinline__ void phase_prologue(const Args& A, LAS unsigned char* lds, int gwv, int NGW, int wave, int lane) {
    LAS float* scr = (LAS float*)(lds + wave * 16384);
    constexpr int I_EIN = 16 * (EVEN_IN / 32), I_OUT = 16 * 32, I_OIN = 16 * (ODD_IN / 32), I_PAIR = I_EIN + I_OUT + I_OIN + I_OUT;
    for (int it = gwv; it < 2 * I_PAIR; it += NGW) {
        const int i = it / I_PAIR; int r = it % I_PAIR;
        if (r < I_EIN) { transpose_item(A.ab_w_in + (size_t)i * D * EVEN_IN, A.norm_g + (2 * i) * D, D, EVEN_IN, (bf16*)(A.ws + WS_WE_IN) + (size_t)i * EVEN_IN * D, scr, r, lane); continue; } r -= I_EIN;
        if (r < I_OUT) { transpose_item(A.ab_w_out + (size_t)i * D * D, nullptr, D, D, (bf16*)(A.ws + WS_WE_OUT) + (size_t)i * D * D, scr, r, lane); continue; } r -= I_OUT;
        if (r < I_OIN) { transpose_item(A.c_w_in + (size_t)i * D * ODD_IN, A.norm_g + (2 * i + 1) * D, D, ODD_IN, (bf16*)(A.ws + WS_WO_IN) + (size_t)i * ODD_IN * D, scr, r, lane); continue; } r -= I_OIN;
        transpose_item(A.c_w_out + (size_t)i * D * D, nullptr, D, D, (bf16*)(A.ws + WS_WO_OUT) + (size_t)i * D * D, scr, r, lane);
    }
    { bf16* wst = (bf16*)(A.ws + WS_WS);
      for (int e = gwv * 64 + lane; e < 2 * 4 * 128 * 128; e += NGW * 64) { const int s = e & 127, t = (e >> 7) & 127; wst[e] = (bf16)f2bf(s <= t ? A.w_s[e] : 0.f); } }
    bf16* hb = (bf16*)(A.ws + WS_HB); float* ssqp = (float*)(A.ws + WS_SSQ);
    for (int m = gwv; m < M; m += 2 * NGW) {
        const int m2 = m + NGW;
        const f32x4* xr = (const f32x4*)(A.x + (size_t)m * D) + lane; const f32x4* xr2 = (const f32x4*)(A.x + (size_t)m2 * D) + lane;
        f32x4 v[4], w4[4];
#pragma unroll
        for (int j = 0; j < 4; ++j) { v[j] = xr[64 * j]; w4[j] = xr2[64 * j]; }
        float s = 0.f, s2 = 0.f;
#pragma unroll
        for (int j = 0; j < 4; ++j) { s += (v[j][0] * v[j][0] + v[j][1] * v[j][1]) + (v[j][2] * v[j][2] + v[j][3] * v[j][3]); s2 += (w4[j][0] * w4[j][0] + w4[j][1] * w4[j][1]) + (w4[j][2] * w4[j][2] + w4[j][3] * w4[j][3]); }
        s = wave_sum(s); s2 = wave_sum(s2);
        v2u* o8 = (v2u*)(hb + (size_t)m * D) + lane; v2u* o82 = (v2u*)(hb + (size_t)m2 * D) + lane;
#pragma unroll
        for (int j = 0; j < 4; ++j) { v2u w; w.x = cvtpk_s(v[j][0], v[j][1]); w.y = cvtpk_s(v[j][2], v[j][3]); o8[64 * j] = w; v2u w2; w2.x = cvtpk_s(w4[j][0], w4[j][1]); w2.y = cvtpk_s(w4[j][2], w4[j][3]); o82[64 * j] = w2; }
        if (lane < 16) { ssqp[(size_t)m * 16 + lane] = (lane == 0) ? s : 0.f; ssqp[(size_t)m2 * 16 + lane] = (lane == 0) ? s2 : 0.f; }
    }
}

__device__ __forceinline__ v4u pair_to_wide(v2u gk, v2u gk1) {
    const auto sx = __builtin_amdgcn_permlane32_swap(gk.x, gk1.x, false, false), sy = __builtin_amdgcn_permlane32_swap(gk.y, gk1.y, false, false);
    return (v4u){sx[0], sy[0], sx[1], sy[1]};
}
__device__ __forceinline__ void wide_to_pair(v4u w, v2u& gk, v2u& gk1) {
    const auto sx = __builtin_amdgcn_permlane32_swap(w.x, w.z, false, false), sy = __builtin_amdgcn_permlane32_swap(w.y, w.w, false, false);
    gk.x = sx[0]; gk.y = sy[0]; gk1.x = sx[1]; gk1.y = sy[1];
}
__device__ __forceinline__ void phase_gmlp(const Args& A, int li, LAS unsigned char* lds, int vcu, int G, int wave, int lane) {
    const bf16* Z = (const bf16*)(A.ws + WS_Z); bf16* Y = (bf16*)(A.ws + WS_Y);
    const bf16* wst = (const bf16*)(A.ws + WS_WS) + (size_t)li * 4 * 128 * 128;
    const float* lng = A.ln_g + li * 512; const float* lnb = A.ln_b + li * 512; const float* bs = A.b_s + li * 4 * 128;
    const int r32 = lane & 31, hi = lane >> 5, grp = lane >> 4, qq = (lane & 15) >> 2, pp = lane & 3;
    float gg[8], gb[8];
#pragma unroll
    for (int j = 0; j < 8; ++j) { gg[j] = lng[8 * lane + j]; gb[j] = lnb[8 * lane + j]; }
    for (int u = vcu; u < M / 128; u += G) {
        const size_t row0 = (size_t)u * 128;
#pragma unroll 1
        for (int r4 = 0; r4 < 16; r4 += 8) {
            v4u wv[8];
#pragma unroll
            for (int k = 0; k < 8; ++k) wv[k] = *(const v4u*)(Z + (row0 + wave * 16 + r4 + k) * EVEN_IN + 512 + 8 * lane);
#pragma unroll
            for (int k = 0; k < 8; ++k) {
                const int s = wave * 16 + r4 + k; const v4u w = wv[k];
                float x[8] = {bf_lo(w.x), bf_hi(w.x), bf_lo(w.y), bf_hi(w.y), bf_lo(w.z), bf_hi(w.z), bf_lo(w.w), bf_hi(w.w)};
                float sm = 0.f;
#pragma unroll
                for (int j = 0; j < 8; ++j) sm += x[j];
                const float mean = wave_sum(sm) * (1.f / 512.f); float sq = 0.f;
#pragma unroll
                for (int j = 0; j < 8; ++j) { x[j] -= mean; sq += x[j] * x[j]; }
                const float rstd = __builtin_amdgcn_rsqf(wave_sum(sq) * (1.f / 512.f) + NORM_EPS);
#pragma unroll
                for (int j = 0; j < 8; ++j) x[j] = x[j] * rstd * gg[j] + gb[j];
                v4u o; o.x = cvtpk_s(x[0], x[1]); o.y = cvtpk_s(x[2], x[3]); o.z = cvtpk_s(x[4], x[5]); o.w = cvtpk_s(x[6], x[7]);
                *(LAS v4u*)(lds + ((s >> 3) * 16 + (lane >> 2)) * 512 + (s & 7) * 64 + (lane & 3) * 16) = o;
            }
        }
        __syncthreads();
        const int g = wave >> 1;
#pragma unroll 1
        for (int t2 = 0; t2 < 2; ++t2) {
            const int tt = (wave & 1) * 2 + t2;
            f32x16 acc[4];
#pragma unroll
            for (int ct = 0; ct < 4; ++ct) acc[ct] = f32x16{};
            const bf16* wrow = wst + ((size_t)g * 128 + 32 * tt + r32) * 128 + 8 * hi;
            bf16x8 bw[8];
#pragma unroll
            for (int ks = 0; ks < 8; ++ks) bw[ks] = *(const bf16x8*)(wrow + 16 * ks);
#pragma unroll
            for (int ks = 0; ks < 8; ++ks) {
                const bf16x8 bfrag = bw[ks];
#pragma unroll
                for (int ct = 0; ct < 4; ++ct) {
                    const LAS unsigned char* p = lds + ((2 * ks + hi) * 16 + 4 * g + ct) * 512 + qq * 64 + (16 * (grp & 1) + 4 * pp) * 2;
                    const s16x4 lo = vtr(p), hi4 = vtr(p + 256);
                    const bf16x8 afrag = (bf16x8){lo[0], lo[1], lo[2], lo[3], hi4[0], hi4[1], hi4[2], hi4[3]};
                    acc[ct] = __builtin_amdgcn_mfma_f32_32x32x16_bf16(afrag, bfrag, acc[ct], 0, 0, 0);
                }
            }
            const int t = 32 * tt + r32; const size_t row = row0 + t; const float bias = bs[g * 128 + t];
            v2u ub[4][4], gb2[4][4];
#pragma unroll
            for (int ct = 0; ct < 4; ++ct)
#pragma unroll
                for (int pr = 0; pr < 2; ++pr) {
                    const int c = g * 128 + 32 * ct + 16 * pr + 8 * hi;
                    const v4u wu = *(const v4u*)(Z + row * EVEN_IN + c), wg = *(const v4u*)(Z + row * EVEN_IN + 1024 + c);
                    wide_to_pair(wu, ub[ct][2 * pr], ub[ct][2 * pr + 1]); wide_to_pair(wg, gb2[ct][2 * pr], gb2[ct][2 * pr + 1]);
                }
#pragma unroll
            for (int ct = 0; ct < 4; ++ct)
#pragma unroll
                for (int pr = 0; pr < 2; ++pr) {
                    v2u o2[2];
#pragma unroll
                    for (int k = 0; k < 2; ++k) {
                        const int rq = 2 * pr + k; const v2u uu = ub[ct][rq], ga = gb2[ct][rq];
                        const float y0 = bf_lo(uu.x) * (acc[ct][4 * rq + 0] + bias) * bf_lo(ga.x), y1 = bf_hi(uu.x) * (acc[ct][4 * rq + 1] + bias) * bf_hi(ga.x);
                        const float y2 = bf_lo(uu.y) * (acc[ct][4 * rq + 2] + bias) * bf_lo(ga.y), y3 = bf_hi(uu.y) * (acc[ct][4 * rq + 3] + bias) * bf_hi(ga.y);
                        o2[k].x = cvtpk_s(y0, y1); o2[k].y = cvtpk_s(y2, y3);
                    }
                    *(v4u*)(Y + row * D + g * 128 + 32 * ct + 16 * pr + 8 * hi) = pair_to_wide(o2[0], o2[1]);
                }
        }
        __syncthreads();
    }
}

struct AttnSt { f32x16 o0, o1; float m, l; };
template <class MaskF>
__device__ __forceinline__ void attn_tile(AttnSt& st, const bf16x8 (&qf)[4], const bf16* kp, const bf16* vp0, const bf16* vp1, const bf16* vp2, const bf16* vp3, LAS unsigned char* vl, int lane, bool domask, MaskF mask) {
    const int hi = lane >> 5, grp = lane >> 4, qq = (lane & 15) >> 2, pp = lane & 3;
    bf16x8 kf[4]; v4u vv[4];
#pragma unroll
    for (int d0 = 0; d0 < 4; ++d0) kf[d0] = *(const bf16x8*)(kp + 16 * d0);
    vv[0] = *(const v4u*)vp0; vv[1] = *(const v4u*)vp1; vv[2] = *(const v4u*)vp2; vv[3] = *(const v4u*)vp3;
    f32x16 s = f32x16{};
#pragma unroll
    for (int d0 = 0; d0 < 4; ++d0) s = __builtin_amdgcn_mfma_f32_32x32x16_bf16(kf[d0], qf[d0], s, 0, 0, 0);
#pragma unroll
    for (int it = 0; it < 4; ++it) *(LAS v4u*)(vl + (it * 2 + ((lane & 7) >> 2)) * 512 + (lane >> 3) * 64 + (lane & 3) * 16) = vv[it];
    if (domask) {
#pragma unroll
        for (int r = 0; r < 16; ++r) if (!mask(crow(r, hi))) s[r] = -INFINITY;
    }
    float mt = s[0];
#pragma unroll
    for (int r = 1; r < 16; ++r) mt = fmaxf(mt, s[r]);
    mt = fmaxf(mt, __shfl_xor(mt, 32));
    if (__any(mt > st.m + RESCALE_THR)) {
        const float mn = fmaxf(st.m, mt);
        const float f = __builtin_amdgcn_exp2f(st.m - mn); st.l *= f; st.m = mn;
#pragma unroll
        for (int r = 0; r < 16; ++r) { st.o0[r] *= f; st.o1[r] *= f; }
    }
    float ps = 0.f;
#pragma unroll
    for (int r = 0; r < 16; ++r) { s[r] = __builtin_amdgcn_exp2f(s[r] - st.m); ps += s[r]; }
    st.l += ps;
    v4u pw0, pw1;
    pw0.x = cvtpk_s(s[0], s[1]); pw0.y = cvtpk_s(s[2], s[3]); pw0.z = cvtpk_s(s[4], s[5]); pw0.w = cvtpk_s(s[6], s[7]);
    pw1.x = cvtpk_s(s[8], s[9]); pw1.y = cvtpk_s(s[10], s[11]); pw1.z = cvtpk_s(s[12], s[13]); pw1.w = cvtpk_s(s[14], s[15]);
    const bf16x8 pf0 = __builtin_bit_cast(bf16x8, pw0), pf1 = __builtin_bit_cast(bf16x8, pw1);
    const LAS unsigned char* tb = vl + (4 * hi + qq) * 64 + (16 * (grp & 1) + 4 * pp) * 2;
#define VFRAG(ks, d0) ({ const s16x4 lo_ = vtr(tb + ((2 * (ks)) * 2 + (d0)) * 512), hi_ = vtr(tb + ((2 * (ks) + 1) * 2 + (d0)) * 512); (bf16x8){lo_[0], lo_[1], lo_[2], lo_[3], hi_[0], hi_[1], hi_[2], hi_[3]}; })
    st.o0 = __builtin_amdgcn_mfma_f32_32x32x16_bf16(VFRAG(0, 0), pf0, st.o0, 0, 0, 0);
    st.o1 = __builtin_amdgcn_mfma_f32_32x32x16_bf16(VFRAG(0, 1), pf0, st.o1, 0, 0, 0);
    st.o0 = __builtin_amdgcn_mfma_f32_32x32x16_bf16(VFRAG(1, 0), pf1, st.o0, 0, 0, 0);
    st.o1 = __builtin_amdgcn_mfma_f32_32x32x16_bf16(VFRAG(1, 1), pf1, st.o1, 0, 0, 0);
#undef VFRAG
}
__device__ __forceinline__ void attn_store(const AttnSt& st, const bf16* grow, bf16* yrow, int lane) {
    const int hi = lane >> 5;
    const float lt = st.l + __shfl_xor(st.l, 32), inv = 1.0f / lt;
    v2u ga[2][4];
#pragma unroll
    for (int d0 = 0; d0 < 2; ++d0)
#pragma unroll
        for (int rq = 0; rq < 4; ++rq) ga[d0][rq] = *(const v2u*)(grow + 32 * d0 + 8 * rq + 4 * hi);
#pragma unroll
    for (int d0 = 0; d0 < 2; ++d0)
#pragma unroll
        for (int rq = 0; rq < 4; ++rq) {
            const int d = 32 * d0 + 8 * rq + 4 * hi;
            const v2u g = ga[d0][rq];
            const f32x16& o = d0 ? st.o1 : st.o0;
            v2u w; w.x = cvtpk_s(o[4 * rq + 0] * inv * bf_lo(g.x), o[4 * rq + 1] * inv * bf_hi(g.x)); w.y = cvtpk_s(o[4 * rq + 2] * inv * bf_lo(g.y), o[4 * rq + 3] * inv * bf_hi(g.y));
            *(v2u*)(yrow + d) = w;
        }
}

__device__ __forceinline__ void attn_gate_load(v2u (&ga)[2][4], const bf16* grow, int lane) {
    const int hi = lane >> 5;
#pragma unroll
    for (int d0 = 0; d0 < 2; ++d0)
#pragma unroll
        for (int pr = 0; pr < 2; ++pr) { const v4u w = *(const v4u*)(grow + 32 * d0 + 16 * pr + 8 * hi); wide_to_pair(w, ga[d0][2 * pr], ga[d0][2 * pr + 1]); }
}
__device__ __forceinline__ void attn_store_g(const AttnSt& st, const v2u (&ga)[2][4], bf16* yrow, int lane) {
    const int hi = lane >> 5;
    const float lt = st.l + __shfl_xor(st.l, 32), inv = 1.0f / lt;
#pragma unroll
    for (int d0 = 0; d0 < 2; ++d0)
#pragma unroll
        for (int pr = 0; pr < 2; ++pr) {
            v2u w2[2];
#pragma unroll
            for (int k = 0; k < 2; ++k) {
                const int rq = 2 * pr + k; const v2u g = ga[d0][rq]; const f32x16& o = d0 ? st.o1 : st.o0;
                w2[k].x = cvtpk_s(o[4 * rq + 0] * inv * bf_lo(g.x), o[4 * rq + 1] * inv * bf_hi(g.x)); w2[k].y = cvtpk_s(o[4 * rq + 2] * inv * bf_lo(g.y), o[4 * rq + 3] * inv * bf_hi(g.y));
            }
            *(v4u*)(yrow + 32 * d0 + 16 * pr + 8 * hi) = pair_to_wide(w2[0], w2[1]);
        }
}

struct TileRegs { v4u kk[4]; v4u vv[4]; };
__device__ __forceinline__ void attn_load(TileRegs& R, int kvoff, const bf16* vp0, const bf16* vp1, const bf16* vp2, const bf16* vp3) {
    R.kk[0] = *(const v4u*)(vp0 - kvoff); R.kk[1] = *(const v4u*)(vp1 - kvoff); R.kk[2] = *(const v4u*)(vp2 - kvoff); R.kk[3] = *(const v4u*)(vp3 - kvoff);
    R.vv[0] = *(const v4u*)vp0; R.vv[1] = *(const v4u*)vp1; R.vv[2] = *(const v4u*)vp2; R.vv[3] = *(const v4u*)vp3;
}
__device__ __forceinline__ void attn_load_k(TileRegs& R, int kvoff, const bf16* vp0, const bf16* vp1, const bf16* vp2, const bf16* vp3) {
    R.kk[0] = *(const v4u*)(vp0 - kvoff); R.kk[1] = *(const v4u*)(vp1 - kvoff); R.kk[2] = *(const v4u*)(vp2 - kvoff); R.kk[3] = *(const v4u*)(vp3 - kvoff);
}
__device__ __forceinline__ void attn_load_v(TileRegs& R, const bf16* vp0, const bf16* vp1, const bf16* vp2, const bf16* vp3) {
    R.vv[0] = *(const v4u*)vp0; R.vv[1] = *(const v4u*)vp1; R.vv[2] = *(const v4u*)vp2; R.vv[3] = *(const v4u*)vp3;
}
template <int MODE>
__device__ __forceinline__ void attn_compute(AttnSt& st, const bf16x8 (&qf)[4], const TileRegs& R, LAS unsigned char* vl, int lane, bool keep, int dd0, int kmin) {
    const int r32 = lane & 31, hi = lane >> 5, grp = lane >> 4, qq = (lane & 15) >> 2, pp = lane & 3;
    LAS unsigned char* kl = vl + 32768;
#pragma unroll
    for (int it = 0; it < 4; ++it) { const int row = it * 8 + (lane >> 3); *(LAS v4u*)(kl + row * 128 + (((lane & 7) ^ (row & 7)) << 4)) = R.kk[it]; }
#pragma unroll
    for (int it = 0; it < 4; ++it) *(LAS v4u*)(vl + (it * 2 + ((lane & 7) >> 2)) * 512 + (lane >> 3) * 64 + (lane & 3) * 16) = R.vv[it];
    f32x16 s = f32x16{};
#pragma unroll
    for (int d0 = 0; d0 < 4; ++d0) {
        const v4u kw = *(const LAS v4u*)(kl + r32 * 128 + (((2 * d0 + hi) ^ (r32 & 7)) << 4));
        s = __builtin_amdgcn_mfma_f32_32x32x16_bf16(__builtin_bit_cast(bf16x8, kw), qf[d0], s, 0, 0, 0);
    }
    if (MODE == 1) {
#pragma unroll
        for (int r = 0; r < 16; ++r) if (crow(r, hi) > r32) s[r] = -INFINITY;
    } else if (MODE == 2) {
#pragma unroll
        for (int r = 0; r < 16; ++r) s[r] = keep ? s[r] : -INFINITY;
    } else if (MODE == 3) {
        const int ddh = dd0 - 4 * hi, kmh = kmin - 4 * hi;
#pragma unroll
        for (int r = 0; r < 16; ++r) { const int c = (r & 3) + 8 * (r >> 2); if ((unsigned)(ddh - c) > 128u || c < kmh) s[r] = -INFINITY; }
    }
    float mt = s[0];
#pragma unroll
    for (int r = 1; r < 16; ++r) mt = fmaxf(mt, s[r]);
    mt = fmaxf(mt, __shfl_xor(mt, 32));
    if (__any(mt > st.m + RESCALE_THR)) {
        const float mn = fmaxf(st.m, mt);
        const float f = __builtin_amdgcn_exp2f(st.m - mn); st.l *= f; st.m = mn;
#pragma unroll
        for (int r = 0; r < 16; ++r) { st.o0[r] *= f; st.o1[r] *= f; }
    }
    float ps = 0.f;
#pragma unroll
    for (int r = 0; r < 16; ++r) { s[r] = __builtin_amdgcn_exp2f(s[r] - st.m); ps += s[r]; }
    st.l += ps;
    v4u pw0, pw1;
    pw0.x = cvtpk_s(s[0], s[1]); pw0.y = cvtpk_s(s[2], s[3]); pw0.z = cvtpk_s(s[4], s[5]); pw0.w = cvtpk_s(s[6], s[7]);
    pw1.x = cvtpk_s(s[8], s[9]); pw1.y = cvtpk_s(s[10], s[11]); pw1.z = cvtpk_s(s[12], s[13]); pw1.w = cvtpk_s(s[14], s[15]);
    const bf16x8 pf0 = __builtin_bit_cast(bf16x8, pw0), pf1 = __builtin_bit_cast(bf16x8, pw1);
    const LAS unsigned char* tb = vl + (4 * hi + qq) * 64 + (16 * (grp & 1) + 4 * pp) * 2;
#define VFRAG(ks, d0) ({ const s16x4 lo_ = vtr(tb + ((2 * (ks)) * 2 + (d0)) * 512), hi_ = vtr(tb + ((2 * (ks) + 1) * 2 + (d0)) * 512); (bf16x8){lo_[0], lo_[1], lo_[2], lo_[3], hi_[0], hi_[1], hi_[2], hi_[3]}; })
    st.o0 = __builtin_amdgcn_mfma_f32_32x32x16_bf16(VFRAG(0, 0), pf0, st.o0, 0, 0, 0);
    st.o1 = __builtin_amdgcn_mfma_f32_32x32x16_bf16(VFRAG(0, 1), pf0, st.o1, 0, 0, 0);
    st.o0 = __builtin_amdgcn_mfma_f32_32x32x16_bf16(VFRAG(1, 0), pf1, st.o0, 0, 0, 0);
    st.o1 = __builtin_amdgcn_mfma_f32_32x32x16_bf16(VFRAG(1, 1), pf1, st.o1, 0, 0, 0);
#undef VFRAG
}

template <class MaskF>
__device__ __forceinline__ void attn_subtile_lds(AttnSt& st, const bf16x8 (&qf)[4], const LAS unsigned char* kb, const LAS unsigned char* vl, int lane, bool domask, MaskF mask) {
    const int r32 = lane & 31, hi = lane >> 5, grp = lane >> 4, qq = (lane & 15) >> 2, pp = lane & 3;
    f32x16 s = f32x16{};
#pragma unroll
    for (int d0 = 0; d0 < 4; ++d0) {
        const bf16x8 kf = *(const LAS bf16x8*)(kb + r32 * 128 + (((2 * d0 + hi) ^ (r32 & 7)) << 4));
        s = __builtin_amdgcn_mfma_f32_32x32x16_bf16(kf, qf[d0], s, 0, 0, 0);
    }
    if (domask) {
#pragma unroll
        for (int r = 0; r < 16; ++r) if (!mask(crow(r, hi))) s[r] = -INFINITY;
    }
    float mt = s[0];
#pragma unroll
    for (int r = 1; r < 16; ++r) mt = fmaxf(mt, s[r]);
    mt = fmaxf(mt, __shfl_xor(mt, 32));
    if (__any(mt > st.m + RESCALE_THR)) {
        const float mn = fmaxf(st.m, mt);
        const float f = __builtin_amdgcn_exp2f(st.m - mn); st.l *= f; st.m = mn;
#pragma unroll
        for (int r = 0; r < 16; ++r) { st.o0[r] *= f; st.o1[r] *= f; }
    }
    float ps = 0.f;
#pragma unroll
    for (int r = 0; r < 16; ++r) { s[r] = __builtin_amdgcn_exp2f(s[r] - st.m); ps += s[r]; }
    st.l += ps;
    v4u pw0, pw1;
    pw0.x = cvtpk_s(s[0], s[1]); pw0.y = cvtpk_s(s[2], s[3]); pw0.z = cvtpk_s(s[4], s[5]); pw0.w = cvtpk_s(s[6], s[7]);
    pw1.x = cvtpk_s(s[8], s[9]); pw1.y = cvtpk_s(s[10], s[11]); pw1.z = cvtpk_s(s[12], s[13]); pw1.w = cvtpk_s(s[14], s[15]);
    const bf16x8 pf0 = __builtin_bit_cast(bf16x8, pw0), pf1 = __builtin_bit_cast(bf16x8, pw1);
    const LAS unsigned char* tb = vl + (4 * hi + qq) * 64 + (16 * (grp & 1) + 4 * pp) * 2;
#define VFRAG(ks, d0) ({ const s16x4 lo_ = vtr(tb + ((2 * (ks)) * 2 + (d0)) * 512), hi_ = vtr(tb + ((2 * (ks) + 1) * 2 + (d0)) * 512); (bf16x8){lo_[0], lo_[1], lo_[2], lo_[3], hi_[0], hi_[1], hi_[2], hi_[3]}; })
    st.o0 = __builtin_amdgcn_mfma_f32_32x32x16_bf16(VFRAG(0, 0), pf0, st.o0, 0, 0, 0);
    st.o1 = __builtin_amdgcn_mfma_f32_32x32x16_bf16(VFRAG(0, 1), pf0, st.o1, 0, 0, 0);
    st.o0 = __builtin_amdgcn_mfma_f32_32x32x16_bf16(VFRAG(1, 0), pf1, st.o0, 0, 0, 0);
    st.o1 = __builtin_amdgcn_mfma_f32_32x32x16_bf16(VFRAG(1, 1), pf1, st.o1, 0, 0, 0);
#undef VFRAG
}
template <int M0, int M1>
__device__ __forceinline__ void attn_tile64_lds(AttnSt& st, const bf16x8 (&qf)[4], const LAS unsigned char* kb, const LAS unsigned char* vb, int lane, bool keep) {
    const int r32 = lane & 31, hi = lane >> 5, grp = lane >> 4, qq = (lane & 15) >> 2, pp = lane & 3;
    f32x16 s0 = f32x16{}, s1 = f32x16{};
#pragma unroll
    for (int d0 = 0; d0 < 4; ++d0) {
        const int ko = r32 * 128 + (((2 * d0 + hi) ^ (r32 & 7)) << 4);
        const v4u k0 = *(const LAS v4u*)(kb + ko), k1 = *(const LAS v4u*)(kb + 4096 + ko);
        s0 = __builtin_amdgcn_mfma_f32_32x32x16_bf16(__builtin_bit_cast(bf16x8, k0), qf[d0], s0, 0, 0, 0);
        s1 = __builtin_amdgcn_mfma_f32_32x32x16_bf16(__builtin_bit_cast(bf16x8, k1), qf[d0], s1, 0, 0, 0);
    }
    if (M0 == 1 || M1 == 1) {
#pragma unroll
        for (int r = 0; r < 16; ++r) {
            if (M0 == 1) { if (crow(r, hi) > r32) s0[r] = -INFINITY; }
            if (M1 == 1) { if (crow(r, hi) > r32) s1[r] = -INFINITY; }
        }
    }
    float mt = fmaxf(s0[0], s1[0]);
#pragma unroll
    for (int r = 1; r < 16; ++r) mt = fmaxf(mt, fmaxf(s0[r], s1[r]));
    mt = fmaxf(mt, __shfl_xor(mt, 32));
    if (__any(mt > st.m + RESCALE_THR)) {
        const float mn = fmaxf(st.m, mt);
        const float f = __builtin_amdgcn_exp2f(st.m - mn); st.l *= f; st.m = mn;
#pragma unroll
        for (int r = 0; r < 16; ++r) { st.o0[r] *= f; st.o1[r] *= f; }
    }
    const float mo = (M0 == 2 && !keep) ? INFINITY : st.m;
    const f32x2_t mo2 = {mo, mo}; f32x2_t acc2 = {0.f, 0.f};
#pragma unroll
    for (int r = 0; r < 16; r += 2) {
        f32x2_t v0 = (f32x2_t){s0[r], s0[r + 1]} - mo2, v1 = (f32x2_t){s1[r], s1[r + 1]} - mo2;
        v0.x = __builtin_amdgcn_exp2f(v0.x); v0.y = __builtin_amdgcn_exp2f(v0.y); v1.x = __builtin_amdgcn_exp2f(v1.x); v1.y = __builtin_amdgcn_exp2f(v1.y);
        acc2 += v0; acc2 += v1;
        s0[r] = v0.x; s0[r + 1] = v0.y; s1[r] = v1.x; s1[r + 1] = v1.y;
    }
    st.l += acc2.x + acc2.y;
    v4u p00, p01, p10, p11;
    p00.x = cvtpk_s(s0[0], s0[1]); p00.y = cvtpk_s(s0[2], s0[3]); p00.z = cvtpk_s(s0[4], s0[5]); p00.w = cvtpk_s(s0[6], s0[7]);
    p01.x = cvtpk_s(s0[8], s0[9]); p01.y = cvtpk_s(s0[10], s0[11]); p01.z = cvtpk_s(s0[12], s0[13]); p01.w = cvtpk_s(s0[14], s0[15]);
    p10.x = cvtpk_s(s1[0], s1[1]); p10.y = cvtpk_s(s1[2], s1[3]); p10.z = cvtpk_s(s1[4], s1[5]); p10.w = cvtpk_s(s1[6], s1[7]);
    p11.x = cvtpk_s(s1[8], s1[9]); p11.y = cvtpk_s(s1[10], s1[11]); p11.z = cvtpk_s(s1[12], s1[13]); p11.w = cvtpk_s(s1[14], s1[15]);
    const bf16x8 f00 = __builtin_bit_cast(bf16x8, p00), f01 = __builtin_bit_cast(bf16x8, p01), f10 = __builtin_bit_cast(bf16x8, p10), f11 = __builtin_bit_cast(bf16x8, p11);
    const LAS unsigned char* tb = vb + (4 * hi + qq) * 64 + (16 * (grp & 1) + 4 * pp) * 2;
#define VFRAG(sub, ks, d0) ({ const s16x4 lo_ = vtr(tb + (sub) * 4096 + ((2 * (ks)) * 2 + (d0)) * 512), hi_ = vtr(tb + (sub) * 4096 + ((2 * (ks) + 1) * 2 + (d0)) * 512); (bf16x8){lo_[0], lo_[1], lo_[2], lo_[3], hi_[0], hi_[1], hi_[2], hi_[3]}; })
    st.o0 = __builtin_amdgcn_mfma_f32_32x32x16_bf16(VFRAG(0, 0, 0), f00, st.o0, 0, 0, 0);
    st.o1 = __builtin_amdgcn_mfma_f32_32x32x16_bf16(VFRAG(0, 0, 1), f00, st.o1, 0, 0, 0);
    st.o0 = __builtin_amdgcn_mfma_f32_32x32x16_bf16(VFRAG(0, 1, 0), f01, st.o0, 0, 0, 0);
    st.o1 = __builtin_amdgcn_mfma_f32_32x32x16_bf16(VFRAG(0, 1, 1), f01, st.o1, 0, 0, 0);
    st.o0 = __builtin_amdgcn_mfma_f32_32x32x16_bf16(VFRAG(1, 0, 0), f10, st.o0, 0, 0, 0);
    st.o1 = __builtin_amdgcn_mfma_f32_32x32x16_bf16(VFRAG(1, 0, 1), f10, st.o1, 0, 0, 0);
    st.o0 = __builtin_amdgcn_mfma_f32_32x32x16_bf16(VFRAG(1, 1, 0), f11, st.o0, 0, 0, 0);
    st.o1 = __builtin_amdgcn_mfma_f32_32x32x16_bf16(VFRAG(1, 1, 1), f11, st.o1, 0, 0, 0);
#undef VFRAG
}
__device__ __forceinline__ void phase_moba_s(const Args& A, LAS unsigned char* lds, int G, int vcu, int wave, int lane) {
    const bf16* Z = (const bf16*)(A.ws + WS_Z); bf16* Y = (bf16*)(A.ws + WS_Y); const float* kmp = (const float*)(A.ws + WS_KMP);
    const int r32 = lane & 31, hi = lane >> 5, tid = wave * 64 + lane;
    const int skey = tid >> 3, sch = tid & 7;
    const int kwoff = skey * 128 + ((sch ^ (skey & 7)) << 4);
    const int vwoff = ((skey >> 3) * 2 + (sch >> 2)) * 512 + (skey & 7) * 64 + (sch & 3) * 16;
    for (int U = vcu; U < 2048; U += G) {
        const int it8 = U >> 8, v = U & 255, j = v & 7;
        const int blk = (it8 & 1) ? 15 - j : j, bh = (v >> 3) * 4 + (it8 >> 1);
        const int b = bh >> 3, hh = bh & 7, q0 = blk * 256 + 32 * wave;
        const size_t rowbase = (size_t)b * SEQ;
        const bf16* zq = Z + (rowbase + q0 + r32) * EVEN_IN;
        const bf16* Kh = Z + rowbase * EVEN_IN + 2048 + hh * 64 + (size_t)skey * EVEN_IN + 8 * sch; const bf16* Vh = Kh + 512;
        v4u kreg = *(const v4u*)(Kh + (size_t)(blk * 256) * EVEN_IN), vreg = *(const v4u*)(Vh + (size_t)(blk * 256) * EVEN_IN);
        bf16x8 qf[4];
#pragma unroll
        for (int d0 = 0; d0 < 4; ++d0) qf[d0] = *(const bf16x8*)(zq + 1536 + hh * 64 + 16 * d0 + 8 * hi);
        v2u gg[2][4]; attn_gate_load(gg, zq + 3072 + hh * 64, lane);
        unsigned sel = 0u;
        if (blk > 0) {
            f32x16 gt = f32x16{};
#pragma unroll
            for (int d0 = 0; d0 < 4; ++d0) {
                bf16x8 kmf = bf16x8{};
                if (r32 < 16) {
                    const float* p0 = kmp + (((size_t)b * 16 + r32) * 2) * 512 + hh * 64 + 16 * d0 + 8 * hi;
                    const f32x4 a0 = *(const f32x4*)p0, a1 = *(const f32x4*)(p0 + 4), b0 = *(const f32x4*)(p0 + 512), b1 = *(const f32x4*)(p0 + 516);
                    const f32x4 s0 = a0 + b0, s1 = a1 + b1;
                    v4u w; w.x = pk2(s0[0], s0[1]); w.y = pk2(s0[2], s0[3]); w.z = pk2(s1[0], s1[1]); w.w = pk2(s1[2], s1[3]);
                    kmf = __builtin_bit_cast(bf16x8, w);
                }
                gt = __builtin_amdgcn_mfma_f32_32x32x16_bf16(kmf, qf[d0], gt, 0, 0, 0);
            }
            float gv[16];
#pragma unroll
            for (int r = 0; r < 8; ++r) {
                const float mine = gt[r], oth = __shfl_xor(mine, 32);
                const float vlo = hi ? oth : mine, vhi = hi ? mine : oth;
                gv[(r & 3) + 8 * (r >> 2)] = vlo; gv[(r & 3) + 8 * (r >> 2) + 4] = vhi;
            }
#pragma unroll
            for (int n = 0; n < 16; ++n) if (n >= blk) gv[n] = -INFINITY;
#pragma unroll
            for (int it = 0; it < 3; ++it) {
                float best = -INFINITY; int bi = -1;
#pragma unroll
                for (int n = 0; n < 16; ++n) { const bool ok = (gv[n] > best) && !((sel >> n) & 1u); best = ok ? gv[n] : best; bi = ok ? n : bi; }
                if (bi >= 0) sel |= 1u << bi;
            }
        }
        AttnSt st; st.o0 = f32x16{}; st.o1 = f32x16{}; st.m = -1e30f; st.l = 0.f;
#define MB_LOAD(key0_) do { kreg = *(const v4u*)(Kh + (size_t)(key0_) * EVEN_IN); vreg = *(const v4u*)(Vh + (size_t)(key0_) * EVEN_IN); } while (0)
#define MB_STORE(buf_) do { *(LAS v4u*)(lds + (buf_) * 8192 + kwoff) = kreg; *(LAS v4u*)(lds + 16384 + (buf_) * 8192 + vwoff) = vreg; } while (0)
        MB_STORE(0);
        __syncthreads();
#pragma unroll 1
        for (int t = 0; t < 4; ++t) {
            const int buf = t & 1;
            if (t < 3) MB_LOAD(blk * 256 + 64 * (t + 1)); else if (blk > 0) MB_LOAD(0);
            const LAS unsigned char* kb = lds + buf * 8192; const LAS unsigned char* vb = lds + 16384 + buf * 8192;
            if (2 * t + 1 < wave) attn_tile64_lds<0, 0>(st, qf, kb, vb, lane, true);
            else if (2 * t + 1 == wave) attn_tile64_lds<0, 1>(st, qf, kb, vb, lane, true);
            else if (2 * t == wave) attn_subtile_lds(st, qf, kb, vb, lane, true, [&](int kk) { return kk <= r32; });
            if (t < 3 || blk > 0) MB_STORE(buf ^ 1);
            __syncthreads();
        }
        const int P = 4 * blk;
#pragma unroll 1
        for (int p = 0; p < P; ++p) {
            const int buf = p & 1;
            if (p + 1 < P) MB_LOAD(64 * (p + 1));
            const LAS unsigned char* kb = lds + buf * 8192; const LAS unsigned char* vb = lds + 16384 + buf * 8192;
            const bool mysel = (sel >> (p >> 2)) & 1u;
            if (__any(mysel)) {
                attn_tile64_lds<2, 2>(st, qf, kb, vb, lane, mysel);
            }
            if (p + 1 < P) MB_STORE(buf ^ 1);
            __syncthreads();
        }
#undef MB_LOAD
#undef MB_STORE
        attn_store_g(st, gg, Y + (rowbase + q0 + r32) * D + 512 + hh * 64, lane);
    }
}

__device__ __forceinline__ void phase_moba_old(const Args& A, LAS unsigned char* lds, int gwv, int NGW, int wave, int lane) {
    const bf16* Z = (const bf16*)(A.ws + WS_Z); bf16* Y = (bf16*)(A.ws + WS_Y); const float* kmp = (const float*)(A.ws + WS_KMP);
    LAS unsigned char* vl = lds + wave * 4096;
    const int r32 = lane & 31, hi = lane >> 5;
#ifdef OLD_NEWMAP
    for (int U = gwv >> 3; U < 2048; U += NGW >> 3) {
        const int it8 = U >> 8, v = U & 255, j = v & 7;
        const int blk = (it8 & 1) ? 15 - j : j, bh = (v >> 3) * 4 + (it8 >> 1);
        const int b = bh >> 3, hh = bh & 7, q0 = blk * 256 + 32 * wave;
#else
    for (int U = gwv; U < 16384; U += NGW) {
        const int rd = U >> 11, g2 = U & 2047, X = g2 >> 8, lwv = g2 & 255;
        const int bh = 16 * X + 2 * rd + (lwv >> 7); int gi = lwv & 127; if (rd & 1) gi = 127 - gi;
        const int b = bh >> 3, hh = bh & 7, q0 = gi * 32, blk = q0 >> 8;
#endif
        const size_t rowbase = (size_t)b * SEQ;
        const bf16* zq = Z + (rowbase + q0 + r32) * EVEN_IN;
        bf16x8 qf[4];
#pragma unroll
        for (int d0 = 0; d0 < 4; ++d0) qf[d0] = *(const bf16x8*)(zq + 1536 + hh * 64 + 16 * d0 + 8 * hi);
        unsigned sel = 0u;
        if (blk > 0) {
            f32x16 gt = f32x16{};
#pragma unroll
            for (int d0 = 0; d0 < 4; ++d0) {
                bf16x8 kmf = bf16x8{};
                if (r32 < 16) {
                    const float* p0 = kmp + (((size_t)b * 16 + r32) * 2) * 512 + hh * 64 + 16 * d0 + 8 * hi;
                    const f32x4 a0 = *(const f32x4*)p0, a1 = *(const f32x4*)(p0 + 4), b0 = *(const f32x4*)(p0 + 512), b1 = *(const f32x4*)(p0 + 516);
                    const f32x4 s0 = a0 + b0, s1 = a1 + b1;
                    v4u w; w.x = pk2(s0[0], s0[1]); w.y = pk2(s0[2], s0[3]); w.z = pk2(s1[0], s1[1]); w.w = pk2(s1[2], s1[3]);
                    kmf = __builtin_bit_cast(bf16x8, w);
                }
                gt = __builtin_amdgcn_mfma_f32_32x32x16_bf16(kmf, qf[d0], gt, 0, 0, 0);
            }
            float gv[16];
#pragma unroll
            for (int r = 0; r < 8; ++r) {
                const float mine = gt[r], oth = __shfl_xor(mine, 32);
                const float vlo = hi ? oth : mine, vhi = hi ? mine : oth;
                gv[(r & 3) + 8 * (r >> 2)] = vlo; gv[(r & 3) + 8 * (r >> 2) + 4] = vhi;
            }
#pragma unroll
            for (int n = 0; n < 16; ++n) if (n >= blk) gv[n] = -INFINITY;
#pragma unroll
            for (int it = 0; it < 3; ++it) {
                float best = -INFINITY; int bi = -1;
#pragma unroll
                for (int n = 0; n < 16; ++n) { const bool ok = (gv[n] > best) && !((sel >> n) & 1u); best = ok ? gv[n] : best; bi = ok ? n : bi; }
                if (bi >= 0) sel |= 1u << bi;
            }
        }
        AttnSt st; st.o0 = f32x16{}; st.o1 = f32x16{}; st.m = -1e30f; st.l = 0.f;
        const bf16* Kh = Z + rowbase * EVEN_IN + 2048 + hh * 64; const bf16* Vh = Z + rowbase * EVEN_IN + 2560 + hh * 64;
        const size_t vrow8 = (size_t)8 * EVEN_IN;
        const int ndiag = (q0 & 255) >> 5;
        for (int kt = 0; kt <= ndiag; ++kt) {
            const size_t k0 = (size_t)blk * 256 + kt * 32;
            const bf16* vp = Vh + (k0 + (lane >> 3)) * EVEN_IN + 8 * (lane & 7);
            attn_tile(st, qf, Kh + (k0 + r32) * EVEN_IN + 8 * hi, vp, vp + vrow8, vp + 2 * vrow8, vp + 3 * vrow8, vl, lane, kt == ndiag, [&](int kk) { return kk <= r32; });
        }
        for (int n = 0; n < blk; ++n) {
            const bool mysel = (sel >> n) & 1u;
            if (!__any(mysel)) continue;
            for (int kt = 0; kt < 8; ++kt) {
                const size_t k0 = (size_t)n * 256 + kt * 32;
                const bf16* vp = Vh + (k0 + (lane >> 3)) * EVEN_IN + 8 * (lane & 7);
                attn_tile(st, qf, Kh + (k0 + r32) * EVEN_IN + 8 * hi, vp, vp + vrow8, vp + 2 * vrow8, vp + 3 * vrow8, vl, lane, true, [&](int) { return mysel; });
            }
        }
        attn_store(st, zq + 3072 + hh * 64, Y + (rowbase + q0 + r32) * D + 512 + hh * 64, lane);
    }
}


__device__ __forceinline__ void phase_moba_p(const Args& A, LAS unsigned char* lds, int gwv, int NGW, int wave, int lane) {
    const bf16* Z = (const bf16*)(A.ws + WS_Z); bf16* Y = (bf16*)(A.ws + WS_Y); const float* kmp = (const float*)(A.ws + WS_KMP);
    LAS unsigned char* vl = lds + wave * 4096;
    const int r32 = lane & 31, hi = lane >> 5;
    for (int U = gwv; U < 16384; U += NGW) {
        const int rd = U >> 11, g2 = U & 2047, X = g2 >> 8, lwv = g2 & 255;
        const int bh = 16 * X + 2 * rd + (lwv >> 7); int gi = lwv & 127; if (rd & 1) gi = 127 - gi;
        const int b = bh >> 3, hh = bh & 7, q0 = gi * 32, blk = q0 >> 8;
        const size_t rowbase = (size_t)b * SEQ;
        const bf16* zq = Z + (rowbase + q0 + r32) * EVEN_IN;
        bf16x8 qf[4];
#pragma unroll
        for (int d0 = 0; d0 < 4; ++d0) qf[d0] = *(const bf16x8*)(zq + 1536 + hh * 64 + 16 * d0 + 8 * hi);
        unsigned sel = 0u;
        if (blk > 0) {
            f32x16 gt = f32x16{};
#pragma unroll
            for (int d0 = 0; d0 < 4; ++d0) {
                bf16x8 kmf = bf16x8{};
                if (r32 < 16) {
                    const float* p0 = kmp + (((size_t)b * 16 + r32) * 2) * 512 + hh * 64 + 16 * d0 + 8 * hi;
                    const f32x4 a0 = *(const f32x4*)p0, a1 = *(const f32x4*)(p0 + 4), b0 = *(const f32x4*)(p0 + 512), b1 = *(const f32x4*)(p0 + 516);
                    const f32x4 s0 = a0 + b0, s1 = a1 + b1;
                    v4u w; w.x = pk2(s0[0], s0[1]); w.y = pk2(s0[2], s0[3]); w.z = pk2(s1[0], s1[1]); w.w = pk2(s1[2], s1[3]);
                    kmf = __builtin_bit_cast(bf16x8, w);
                }
                gt = __builtin_amdgcn_mfma_f32_32x32x16_bf16(kmf, qf[d0], gt, 0, 0, 0);
            }
            float gv[16];
#pragma unroll
            for (int r = 0; r < 8; ++r) {
                const float mine = gt[r], oth = __shfl_xor(mine, 32);
                const float vlo = hi ? oth : mine, vhi = hi ? mine : oth;
                gv[(r & 3) + 8 * (r >> 2)] = vlo; gv[(r & 3) + 8 * (r >> 2) + 4] = vhi;
            }
#pragma unroll
            for (int n = 0; n < 16; ++n) if (n >= blk) gv[n] = -INFINITY;
#pragma unroll
            for (int it = 0; it < 3; ++it) {
                float best = -INFINITY; int bi = -1;
#pragma unroll
                for (int n = 0; n < 16; ++n) { const bool ok = (gv[n] > best) && !((sel >> n) & 1u); best = ok ? gv[n] : best; bi = ok ? n : bi; }
                if (bi >= 0) sel |= 1u << bi;
            }
        }
        unsigned anym = 0u;
#pragma unroll
        for (int n = 0; n < 15; ++n) if (__any((sel >> n) & 1u)) anym |= 1u << n;
        anym = (unsigned)__builtin_amdgcn_readfirstlane((int)anym);
        AttnSt st; st.o0 = f32x16{}; st.o1 = f32x16{}; st.m = -1e30f; st.l = 0.f;
        const bf16* Kh = Z + rowbase * EVEN_IN + 2048 + hh * 64; const bf16* Vh = Z + rowbase * EVEN_IN + 2560 + hh * 64;
        const size_t vrow8 = (size_t)8 * EVEN_IN;
        const int ndiag = (q0 & 255) >> 5;
#define MB_LOADT(R, nn, kk_) do { const size_t k0_ = (size_t)((nn) < 0 ? blk : (nn)) * 256 + (kk_) * 32; const bf16* vp_ = Vh + (k0_ + (lane >> 3)) * EVEN_IN + 8 * (lane & 7); \
            attn_load(R, 512, vp_, vp_ + vrow8, vp_ + 2 * vrow8, vp_ + 3 * vrow8); } while (0)
#define MB_COMP(R, nn, kk_) do { if ((nn) < 0) { if ((kk_) == ndiag) attn_compute<1>(st, qf, R, vl, lane, true, 0, 0); else attn_compute<0>(st, qf, R, vl, lane, true, 0, 0); } \
            else attn_compute<2>(st, qf, R, vl, lane, ((sel >> (nn)) & 1u) != 0u, 0, 0); } while (0)
#define MB_ADV(nn, kk_, more) do { more = true; if ((nn) < 0) { if ((kk_) < ndiag) ++(kk_); else { (kk_) = 0; if (anym) (nn) = __builtin_ctz(anym); else more = false; } } \
            else if ((kk_) < 7) ++(kk_); else { (kk_) = 0; const unsigned rest_ = anym & ~((2u << (nn)) - 1u); if (rest_) (nn) = __builtin_ctz(rest_); else more = false; } } while (0)
        TileRegs RA, RB; int cn = -1, ck = 0;
        MB_LOADT(RA, cn, ck);
        for (;;) {
            int nn = cn, nk = ck; bool more; MB_ADV(nn, nk, more);
            if (more) MB_LOADT(RB, nn, nk);
            MB_COMP(RA, cn, ck);
            if (!more) break;
            cn = nn; ck = nk; MB_ADV(nn, nk, more);
            if (more) MB_LOADT(RA, nn, nk);
            MB_COMP(RB, cn, ck);
            if (!more) break;
            cn = nn; ck = nk;
        }
#undef MB_LOADT
#undef MB_COMP
#undef MB_ADV
        attn_store(st, zq + 3072 + hh * 64, Y + (rowbase + q0 + r32) * D + 512 + hh * 64, lane);
    }
}

__device__ __forceinline__ void phase_dilated_p(const Args& A, LAS unsigned char* lds, int gwv, int NGW, int wave, int lane) {
    const bf16* Z = (const bf16*)(A.ws + WS_Z); bf16* Y = (bf16*)(A.ws + WS_Y);
    LAS unsigned char* vl = lds + wave * 4096;
    const int r32 = lane & 31, hi = lane >> 5;
    for (int U = gwv; U < 32768; U += NGW) {
        const int rd = U >> 11, g2 = U & 2047, X = g2 >> 8, lwv = g2 & 255;
        const int bh = 32 * X + 2 * rd + (lwv >> 7), gi = lwv & 127, c = gi >> 4, r16 = gi & 15;
        const int b = bh >> 4, hh = bh & 15;
        const size_t rowbase = (size_t)b * SEQ;
        const int tq = 512 * c + r16 + 16 * r32;
        const bf16* zq = Z + (rowbase + tq) * ODD_IN;
        bf16x8 qf[4];
#pragma unroll
        for (int d0 = 0; d0 < 4; ++d0) qf[d0] = *(const bf16x8*)(zq + hh * 64 + 16 * d0 + 8 * hi);
        AttnSt st; st.o0 = f32x16{}; st.o1 = f32x16{}; st.m = -1e30f; st.l = 0.f;
        const bf16* Kh = Z + rowbase * ODD_IN + 1024 + hh * 64; const bf16* Vh = Z + rowbase * ODD_IN + 2048 + hh * 64;
#define DL_DIL(cfg) ((cfg) == 0 ? 16 : (cfg) == 1 ? 4 : 1)
#define DL_NT(cfg) ((cfg) == 0 ? 5 : (cfg) == 1 ? 8 : 20)
#define DL_MBASE(cfg) ((512 * c + r16 - (r16 & (DL_DIL(cfg) - 1))) / DL_DIL(cfg) - 128)
#define DL_TAU0(cfg) (DL_MBASE(cfg) < 0 ? (-DL_MBASE(cfg)) / 32 : 0)
#define DL_LOADT(R, cfg, tau) do { const int dil_ = DL_DIL(cfg), rdl_ = r16 & (dil_ - 1), m0_ = DL_MBASE(cfg) + 32 * (tau); \
            const int mv_ = m0_ + (lane >> 3); const int mv0_ = mv_ < 0 ? 0 : mv_, mv1_ = mv_ + 8 < 0 ? 0 : mv_ + 8, mv2_ = mv_ + 16 < 0 ? 0 : mv_ + 16, mv3_ = mv_ + 24 < 0 ? 0 : mv_ + 24; \
            const bf16* vb_ = Vh + (size_t)rdl_ * ODD_IN + 8 * (lane & 7); const size_t vst_ = (size_t)dil_ * ODD_IN; \
            attn_load(R, 1024, vb_ + mv0_ * vst_, vb_ + mv1_ * vst_, vb_ + mv2_ * vst_, vb_ + mv3_ * vst_); } while (0)
#define DL_COMP(R, cfg, tau) do { const int m0_ = DL_MBASE(cfg) + 32 * (tau); \
            if ((cfg) == 0 && (tau) >= 1 && (tau) <= 3 && m0_ >= 0) attn_compute<0>(st, qf, R, vl, lane, true, 0, 0); \
            else attn_compute<3>(st, qf, R, vl, lane, true, 128 + (16 / DL_DIL(cfg)) * r32 - 32 * (tau), -m0_); } while (0)
#define DL_ADV(cfg, tau, more) do { more = true; if ((tau) + 1 < DL_NT(cfg)) ++(tau); else if ((cfg) < 2) { ++(cfg); (tau) = DL_TAU0(cfg); } else more = false; } while (0)
        TileRegs RA, RB; int cc = 0, ct = DL_TAU0(0);
        DL_LOADT(RA, cc, ct);
        for (;;) {
            int nc = cc, nt = ct; bool more; DL_ADV(nc, nt, more);
            if (more) DL_LOADT(RB, nc, nt);
            DL_COMP(RA, cc, ct);
            if (!more) break;
            cc = nc; ct = nt; DL_ADV(nc, nt, more);
            if (more) DL_LOADT(RA, nc, nt);
            DL_COMP(RB, cc, ct);
            if (!more) break;
            cc = nc; ct = nt;
        }
#undef DL_DIL
#undef DL_NT
#undef DL_MBASE
#undef DL_TAU0
#undef DL_LOADT
#undef DL_COMP
#undef DL_ADV
        attn_store(st, zq + 3072 + hh * 64, Y + (rowbase + tq) * D + hh * 64, lane);
    }
}


__device__ __forceinline__ void attn_stage2(const TileRegs& RA, const TileRegs& RB, LAS unsigned char* wl, int lane) {
    LAS unsigned char* vla = wl; LAS unsigned char* vlb = wl + 4096; LAS unsigned char* kla = wl + 8192; LAS unsigned char* klb = wl + 12288;
#pragma unroll
    for (int it = 0; it < 4; ++it) { const int row = it * 8 + (lane >> 3); const int ko = row * 128 + (((lane & 7) ^ (row & 7)) << 4); *(LAS v4u*)(kla + ko) = RA.kk[it]; *(LAS v4u*)(klb + ko) = RB.kk[it]; }
#pragma unroll
    for (int it = 0; it < 4; ++it) { const int vo = (it * 2 + ((lane & 7) >> 2)) * 512 + (lane >> 3) * 64 + (lane & 3) * 16; *(LAS v4u*)(vla + vo) = RA.vv[it]; *(LAS v4u*)(vlb + vo) = RB.vv[it]; }
}
template <int MODE, class MidF>
__device__ __forceinline__ void attn_compute2_lds(AttnSt& a, AttnSt& b, const bf16x8 (&qa)[4], const bf16x8 (&qb)[4], LAS unsigned char* wl, int lane, int dd0, int kmina, int kminb, MidF mid) {
    const int r32 = lane & 31, hi = lane >> 5, grp = lane >> 4, qq = (lane & 15) >> 2, pp = lane & 3;
    LAS unsigned char* vla = wl; LAS unsigned char* vlb = wl + 4096; LAS unsigned char* kla = wl + 8192; LAS unsigned char* klb = wl + 12288;
    f32x16 sa = f32x16{}, sb = f32x16{};
#pragma unroll
    for (int d0 = 0; d0 < 4; ++d0) {
        const int ko = r32 * 128 + (((2 * d0 + hi) ^ (r32 & 7)) << 4);
        const v4u kwa = *(const LAS v4u*)(kla + ko), kwb = *(const LAS v4u*)(klb + ko);
        sa = __builtin_amdgcn_mfma_f32_32x32x16_bf16(__builtin_bit_cast(bf16x8, kwa), qa[d0], sa, 0, 0, 0);
        sb = __builtin_amdgcn_mfma_f32_32x32x16_bf16(__builtin_bit_cast(bf16x8, kwb), qb[d0], sb, 0, 0, 0);
    }
    if (MODE == 3) {
        const int ddh = dd0 - 4 * hi, kma = kmina - 4 * hi, kmb = kminb - 4 * hi;
#pragma unroll
        for (int r = 0; r < 16; ++r) { const int c = (r & 3) + 8 * (r >> 2); const bool band = (unsigned)(ddh - c) <= 128u; if (!band || c < kma) sa[r] = -INFINITY; if (!band || c < kmb) sb[r] = -INFINITY; }
    }
    float mta = sa[0], mtb = sb[0];
#pragma unroll
    for (int r = 1; r < 16; ++r) { mta = fmaxf(mta, sa[r]); mtb = fmaxf(mtb, sb[r]); }
    mta = fmaxf(mta, __shfl_xor(mta, 32)); mtb = fmaxf(mtb, __shfl_xor(mtb, 32));
    if (__any(mta > a.m + RESCALE_THR || mtb > b.m + RESCALE_THR)) {
        const float mna_ = fmaxf(a.m, mta), mnb_ = fmaxf(b.m, mtb);
        const float fa = __builtin_amdgcn_exp2f(a.m - mna_), fb = __builtin_amdgcn_exp2f(b.m - mnb_);
        a.l *= fa; a.m = mna_; b.l *= fb; b.m = mnb_;
#pragma unroll
        for (int r = 0; r < 16; ++r) { a.o0[r] *= fa; a.o1[r] *= fa; b.o0[r] *= fb; b.o1[r] *= fb; }
    }
    const float mna = a.m, mnb = b.m;
    float psa = 0.f, psb = 0.f;
#pragma unroll
    for (int r = 0; r < 16; ++r) { sa[r] = __builtin_amdgcn_exp2f(sa[r] - mna); sb[r] = __builtin_amdgcn_exp2f(sb[r] - mnb); psa += sa[r]; psb += sb[r]; }
    a.l += psa; b.l += psb;
    v4u pa0, pa1, pb0, pb1;
    pa0.x = cvtpk_s(sa[0], sa[1]); pa0.y = cvtpk_s(sa[2], sa[3]); pa0.z = cvtpk_s(sa[4], sa[5]); pa0.w = cvtpk_s(sa[6], sa[7]);
    pa1.x = cvtpk_s(sa[8], sa[9]); pa1.y = cvtpk_s(sa[10], sa[11]); pa1.z = cvtpk_s(sa[12], sa[13]); pa1.w = cvtpk_s(sa[14], sa[15]);
    pb0.x = cvtpk_s(sb[0], sb[1]); pb0.y = cvtpk_s(sb[2], sb[3]); pb0.z = cvtpk_s(sb[4], sb[5]); pb0.w = cvtpk_s(sb[6], sb[7]);
    pb1.x = cvtpk_s(sb[8], sb[9]); pb1.y = cvtpk_s(sb[10], sb[11]); pb1.z = cvtpk_s(sb[12], sb[13]); pb1.w = cvtpk_s(sb[14], sb[15]);
    const bf16x8 fa0 = __builtin_bit_cast(bf16x8, pa0), fa1 = __builtin_bit_cast(bf16x8, pa1), fb0 = __builtin_bit_cast(bf16x8, pb0), fb1 = __builtin_bit_cast(bf16x8, pb1);
    __builtin_amdgcn_sched_barrier(0); mid(); __builtin_amdgcn_sched_barrier(0);
    const int to = (4 * hi + qq) * 64 + (16 * (grp & 1) + 4 * pp) * 2;
#define VFRAG2(base, ks, d0) ({ const s16x4 lo_ = vtr((base) + to + ((2 * (ks)) * 2 + (d0)) * 512), hi_ = vtr((base) + to + ((2 * (ks) + 1) * 2 + (d0)) * 512); (bf16x8){lo_[0], lo_[1], lo_[2], lo_[3], hi_[0], hi_[1], hi_[2], hi_[3]}; })
    a.o0 = __builtin_amdgcn_mfma_f32_32x32x16_bf16(VFRAG2(vla, 0, 0), fa0, a.o0, 0, 0, 0);
    b.o0 = __builtin_amdgcn_mfma_f32_32x32x16_bf16(VFRAG2(vlb, 0, 0), fb0, b.o0, 0, 0, 0);
    a.o1 = __builtin_amdgcn_mfma_f32_32x32x16_bf16(VFRAG2(vla, 0, 1), fa0, a.o1, 0, 0, 0);
    b.o1 = __builtin_amdgcn_mfma_f32_32x32x16_bf16(VFRAG2(vlb, 0, 1), fb0, b.o1, 0, 0, 0);
    a.o0 = __builtin_amdgcn_mfma_f32_32x32x16_bf16(VFRAG2(vla, 1, 0), fa1, a.o0, 0, 0, 0);
    b.o0 = __builtin_amdgcn_mfma_f32_32x32x16_bf16(VFRAG2(vlb, 1, 0), fb1, b.o0, 0, 0, 0);
    a.o1 = __builtin_amdgcn_mfma_f32_32x32x16_bf16(VFRAG2(vla, 1, 1), fa1, a.o1, 0, 0, 0);
    b.o1 = __builtin_amdgcn_mfma_f32_32x32x16_bf16(VFRAG2(vlb, 1, 1), fb1, b.o1, 0, 0, 0);
#undef VFRAG2
}
template <int MODE, class PreF, class MidF>
__device__ __forceinline__ void attn_compute2_kv(AttnSt& a, AttnSt& b, const bf16x8 (&qa)[4], const bf16x8 (&qb)[4], TileRegs& RA, TileRegs& RB, LAS unsigned char* wl, int lane, int dd0, int kmina, int kminb, PreF pre, MidF mid) {
    const int r32 = lane & 31, hi = lane >> 5, grp = lane >> 4, qq = (lane & 15) >> 2, pp = lane & 3;
    LAS unsigned char* vla = wl; LAS unsigned char* vlb = wl + 4096; LAS unsigned char* kla = wl + 8192; LAS unsigned char* klb = wl + 12288;
#pragma unroll
    for (int it = 0; it < 4; ++it) { const int row = it * 8 + (lane >> 3); const int ko = row * 128 + (((lane & 7) ^ (row & 7)) << 4); *(LAS v4u*)(kla + ko) = RA.kk[it]; *(LAS v4u*)(klb + ko) = RB.kk[it]; }
    pre();
#pragma unroll
    for (int it = 0; it < 4; ++it) { const int vo = (it * 2 + ((lane & 7) >> 2)) * 512 + (lane >> 3) * 64 + (lane & 3) * 16; *(LAS v4u*)(vla + vo) = RA.vv[it]; *(LAS v4u*)(vlb + vo) = RB.vv[it]; }
    f32x16 sa = f32x16{}, sb = f32x16{};
#pragma unroll
    for (int d0 = 0; d0 < 4; ++d0) {
        const int ko = r32 * 128 + (((2 * d0 + hi) ^ (r32 & 7)) << 4);
        const v4u kwa = *(const LAS v4u*)(kla + ko), kwb = *(const LAS v4u*)(klb + ko);
        sa = __builtin_amdgcn_mfma_f32_32x32x16_bf16(__builtin_bit_cast(bf16x8, kwa), qa[d0], sa, 0, 0, 0);
        sb = __builtin_amdgcn_mfma_f32_32x32x16_bf16(__builtin_bit_cast(bf16x8, kwb), qb[d0], sb, 0, 0, 0);
    }
    if (MODE == 3) {
        const int ddh = dd0 - 4 * hi;
        if (kmina <= 0 && kminb <= 0) {
#pragma unroll
            for (int r = 0; r < 16; ++r) { const int c = (r & 3) + 8 * (r >> 2); const bool band = (unsigned)(ddh - c) <= 128u; sa[r] = band ? sa[r] : -INFINITY; sb[r] = band ? sb[r] : -INFINITY; }
        } else {
            const int kma = kmina - 4 * hi, kmb = kminb - 4 * hi;
#pragma unroll
            for (int r = 0; r < 16; ++r) { const int c = (r & 3) + 8 * (r >> 2); const bool band = (unsigned)(ddh - c) <= 128u; if (!band || c < kma) sa[r] = -INFINITY; if (!band || c < kmb) sb[r] = -INFINITY; }
        }
    }
    float mta = sa[0], mtb = sb[0];
#pragma unroll
    for (int r = 1; r < 16; ++r) { mta = fmaxf(mta, sa[r]); mtb = fmaxf(mtb, sb[r]); }
    mta = fmaxf(mta, __shfl_xor(mta, 32)); mtb = fmaxf(mtb, __shfl_xor(mtb, 32));
    if (__any(mta > a.m + RESCALE_THR || mtb > b.m + RESCALE_THR)) {
        const float mna_ = fmaxf(a.m, mta), mnb_ = fmaxf(b.m, mtb);
        const float fa = __builtin_amdgcn_exp2f(a.m - mna_), fb = __builtin_amdgcn_exp2f(b.m - mnb_);
        a.l *= fa; a.m = mna_; b.l *= fb; b.m = mnb_;
#pragma unroll
        for (int r = 0; r < 16; ++r) { a.o0[r] *= fa; a.o1[r] *= fa; b.o0[r] *= fb; b.o1[r] *= fb; }
    }
    const float mna = a.m, mnb = b.m;
    const f32x2_t ma2 = {mna, mna}, mb2 = {mnb, mnb}; f32x2_t acca = {0.f, 0.f}, accb = {0.f, 0.f};
#pragma unroll
    for (int r = 0; r < 16; r += 2) {
        f32x2_t va = (f32x2_t){sa[r], sa[r + 1]} - ma2, vb = (f32x2_t){sb[r], sb[r + 1]} - mb2;
        va.x = __builtin_amdgcn_exp2f(va.x); va.y = __builtin_amdgcn_exp2f(va.y); vb.x = __builtin_amdgcn_exp2f(vb.x); vb.y = __builtin_amdgcn_exp2f(vb.y);
        acca += va; accb += vb;
        sa[r] = va.x; sa[r + 1] = va.y; sb[r] = vb.x; sb[r + 1] = vb.y;
    }
    a.l += acca.x + acca.y; b.l += accb.x + accb.y;
    v4u pa0, pa1, pb0, pb1;
    pa0.x = cvtpk_s(sa[0], sa[1]); pa0.y = cvtpk_s(sa[2], sa[3]); pa0.z = cvtpk_s(sa[4], sa[5]); pa0.w = cvtpk_s(sa[6], sa[7]);
    pa1.x = cvtpk_s(sa[8], sa[9]); pa1.y = cvtpk_s(sa[10], sa[11]); pa1.z = cvtpk_s(sa[12], sa[13]); pa1.w = cvtpk_s(sa[14], sa[15]);
    pb0.x = cvtpk_s(sb[0], sb[1]); pb0.y = cvtpk_s(sb[2], sb[3]); pb0.z = cvtpk_s(sb[4], sb[5]); pb0.w = cvtpk_s(sb[6], sb[7]);
    pb1.x = cvtpk_s(sb[8], sb[9]); pb1.y = cvtpk_s(sb[10], sb[11]); pb1.z = cvtpk_s(sb[12], sb[13]); pb1.w = cvtpk_s(sb[14], sb[15]);
    const bf16x8 fa0 = __builtin_bit_cast(bf16x8, pa0), fa1 = __builtin_bit_cast(bf16x8, pa1), fb0 = __builtin_bit_cast(bf16x8, pb0), fb1 = __builtin_bit_cast(bf16x8, pb1);
    __builtin_amdgcn_sched_barrier(0); mid(); __builtin_amdgcn_sched_barrier(0);
    const int to = (4 * hi + qq) * 64 + (16 * (grp & 1) + 4 * pp) * 2;
#define VFRAG2(base, ks, d0) ({ const s16x4 lo_ = vtr((base) + to + ((2 * (ks)) * 2 + (d0)) * 512), hi_ = vtr((base) + to + ((2 * (ks) + 1) * 2 + (d0)) * 512); (bf16x8){lo_[0], lo_[1], lo_[2], lo_[3], hi_[0], hi_[1], hi_[2], hi_[3]}; })
    a.o0 = __builtin_amdgcn_mfma_f32_32x32x16_bf16(VFRAG2(vla, 0, 0), fa0, a.o0, 0, 0, 0);
    b.o0 = __builtin_amdgcn_mfma_f32_32x32x16_bf16(VFRAG2(vlb, 0, 0), fb0, b.o0, 0, 0, 0);
    a.o1 = __builtin_amdgcn_mfma_f32_32x32x16_bf16(VFRAG2(vla, 0, 1), fa0, a.o1, 0, 0, 0);
    b.o1 = __builtin_amdgcn_mfma_f32_32x32x16_bf16(VFRAG2(vlb, 0, 1), fb0, b.o1, 0, 0, 0);
    a.o0 = __builtin_amdgcn_mfma_f32_32x32x16_bf16(VFRAG2(vla, 1, 0), fa1, a.o0, 0, 0, 0);
    b.o0 = __builtin_amdgcn_mfma_f32_32x32x16_bf16(VFRAG2(vlb, 1, 0), fb1, b.o0, 0, 0, 0);
    a.o1 = __builtin_amdgcn_mfma_f32_32x32x16_bf16(VFRAG2(vla, 1, 1), fa1, a.o1, 0, 0, 0);
    b.o1 = __builtin_amdgcn_mfma_f32_32x32x16_bf16(VFRAG2(vlb, 1, 1), fb1, b.o1, 0, 0, 0);
#undef VFRAG2
}
template <int MODE>
__device__ __forceinline__ void attn_compute2(AttnSt& a, AttnSt& b, const bf16x8 (&qa)[4], const bf16x8 (&qb)[4], const TileRegs& RA, const TileRegs& RB, LAS unsigned char* wl, int lane, int dd0, int kmina, int kminb) {
    attn_stage2(RA, RB, wl, lane); attn_compute2_lds<MODE>(a, b, qa, qb, wl, lane, dd0, kmina, kminb, [] {});
}

__device__ __forceinline__ void phase_dilated_2(const Args& A, LAS unsigned char* lds, int gwv, int NGW, int wave, int lane) {
    const bf16* Z = (const bf16*)(A.ws + WS_Z); bf16* Y = (bf16*)(A.ws + WS_Y);
    LAS unsigned char* wl = lds + wave * 16384;
    const int r32 = lane & 31, hi = lane >> 5;
    for (int U = gwv; U < 16384; U += NGW) {
        const int rd = U >> 10, g2 = U & 1023, X = g2 >> 7, lp = g2 & 127;
        const int bh = 32 * X + 2 * rd + (lp >> 6), pi = lp & 63, c = pi >> 3, r16a = 2 * (pi & 7);
        const int b = bh >> 4, hh = bh & 15;
        const size_t rowbase = (size_t)b * SEQ;
        const int tqa = 512 * c + r16a + 16 * r32;
        const bf16* zqa = Z + (rowbase + tqa) * ODD_IN; const bf16* zqb = zqa + ODD_IN;
        bf16x8 qa[4], qb[4];
#pragma unroll
        for (int d0 = 0; d0 < 4; ++d0) { qa[d0] = *(const bf16x8*)(zqa + hh * 64 + 16 * d0 + 8 * hi); qb[d0] = *(const bf16x8*)(zqb + hh * 64 + 16 * d0 + 8 * hi); }
        AttnSt sa, sb; sa.o0 = f32x16{}; sa.o1 = f32x16{}; sa.m = -1e30f; sa.l = 0.f; sb.o0 = f32x16{}; sb.o1 = f32x16{}; sb.m = -1e30f; sb.l = 0.f;
        const bf16* Vh = Z + rowbase * ODD_IN + 2048 + hh * 64 + 8 * (lane & 7);
#pragma unroll 1
        for (int cfg = 0; cfg < 3; ++cfg) {
            const int dil = (cfg == 0) ? 16 : (cfg == 1) ? 4 : 1, sstep = 16 / dil, ntile = (cfg == 0) ? 5 : (cfg == 1) ? 8 : 20;
            const int rdla = r16a & (dil - 1), rdlb = (r16a + 1) & (dil - 1);
            const int mba = (512 * c + r16a - rdla) / dil - 128, mbb = (512 * c + r16a + 1 - rdlb) / dil - 128;
            const int tau0 = mbb < 0 ? (-mbb) / 32 : 0;
            const size_t vst = (size_t)dil * ODD_IN;
#pragma unroll 1
            for (int tau = tau0; tau < ntile; ++tau) {
                TileRegs RA, RB;
                { const int mv = mba + 32 * tau + (lane >> 3); const int m0_ = mv < 0 ? 0 : mv, m1_ = mv + 8 < 0 ? 0 : mv + 8, m2_ = mv + 16 < 0 ? 0 : mv + 16, m3_ = mv + 24 < 0 ? 0 : mv + 24;
                  const bf16* vb = Vh + (size_t)rdla * ODD_IN; attn_load(RA, 1024, vb + m0_ * vst, vb + m1_ * vst, vb + m2_ * vst, vb + m3_ * vst); }
                { const int mv = mbb + 32 * tau + (lane >> 3); const int m0_ = mv < 0 ? 0 : mv, m1_ = mv + 8 < 0 ? 0 : mv + 8, m2_ = mv + 16 < 0 ? 0 : mv + 16, m3_ = mv + 24 < 0 ? 0 : mv + 24;
                  const bf16* vb = Vh + (size_t)rdlb * ODD_IN; attn_load(RB, 1024, vb + m0_ * vst, vb + m1_ * vst, vb + m2_ * vst, vb + m3_ * vst); }
                attn_compute2<3>(sa, sb, qa, qb, RA, RB, wl, lane, 128 + sstep * r32 - 32 * tau, -(mba + 32 * tau), -(mbb + 32 * tau));
            }
        }
        attn_store(sa, zqa + 3072 + hh * 64, Y + (rowbase + tqa) * D + hh * 64, lane);
        attn_store(sb, zqb + 3072 + hh * 64, Y + (rowbase + tqa + 1) * D + hh * 64, lane);
    }
}


__device__ __forceinline__ void attn_state_store(const AttnSt& st, bf16* orow, float* lsep, int lane) {
    const int hi = lane >> 5;
    const float lt = st.l + __shfl_xor(st.l, 32), inv = 1.0f / lt;
#pragma unroll
    for (int d0 = 0; d0 < 2; ++d0)
#pragma unroll
        for (int pr = 0; pr < 2; ++pr) {
            v2u w2[2];
#pragma unroll
            for (int k = 0; k < 2; ++k) { const int rq = 2 * pr + k; const f32x16& o = d0 ? st.o1 : st.o0; w2[k].x = cvtpk_s(o[4 * rq + 0] * inv, o[4 * rq + 1] * inv); w2[k].y = cvtpk_s(o[4 * rq + 2] * inv, o[4 * rq + 3] * inv); }
            *(v4u*)(orow + 32 * d0 + 16 * pr + 8 * hi) = pair_to_wide(w2[0], w2[1]);
        }
    if (hi == 0) *lsep = st.m + __builtin_amdgcn_logf(lt);
}
__device__ __forceinline__ void attn_state_load(AttnSt& st, const bf16* orow, const float* lsep, int lane) {
    const int hi = lane >> 5;
#pragma unroll
    for (int d0 = 0; d0 < 2; ++d0)
#pragma unroll
        for (int pr = 0; pr < 2; ++pr) {
            const v4u w = *(const v4u*)(orow + 32 * d0 + 16 * pr + 8 * hi); v2u g2[2]; wide_to_pair(w, g2[0], g2[1]);
            f32x16& o = d0 ? st.o1 : st.o0;
#pragma unroll
            for (int k = 0; k < 2; ++k) { const int rq = 2 * pr + k; o[4 * rq + 0] = bf_lo(g2[k].x); o[4 * rq + 1] = bf_hi(g2[k].x); o[4 * rq + 2] = bf_lo(g2[k].y); o[4 * rq + 3] = bf_hi(g2[k].y); }
        }
    st.m = *lsep; st.l = hi ? 0.f : 1.f;
}

__device__ __forceinline__ void phase_dilated_3(const Args& A, LAS unsigned char* lds, int G, int vcu, int wave, int lane) {
    const bf16* Z = (const bf16*)(A.ws + WS_Z); bf16* Y = (bf16*)(A.ws + WS_Y);
    bf16* EX = (bf16*)A.out; float* LSE = A.out + (size_t)32 * 1024 * 1024;
    LAS unsigned char* wl = lds + wave * 16384;
    const int r32 = lane & 31, hi = lane >> 5;
    for (int U = vcu; U < 2048; U += G) {
        const int c = U >> 8, bh = U & 255, b = bh >> 4, hh = bh & 15, T0 = 512 * c;
        const size_t rowbase = (size_t)b * SEQ;
        const bf16* Vh = Z + rowbase * ODD_IN + 2048 + hh * 64 + 8 * (lane & 7);
        {
            const int r16a = 2 * wave, pa = r16a + 16 * r32;
            bf16x8 qa[4], qb[4];
            { const bf16* zqa = Z + (rowbase + T0 + pa) * ODD_IN + hh * 64 + 8 * hi;
#pragma unroll
              for (int d0 = 0; d0 < 4; ++d0) { qa[d0] = *(const bf16x8*)(zqa + 16 * d0); qb[d0] = *(const bf16x8*)(zqa + ODD_IN + 16 * d0); } }
            AttnSt sa, sb; sa.o0 = f32x16{}; sa.o1 = f32x16{}; sa.m = -1e30f; sa.l = 0.f; sb.o0 = f32x16{}; sb.o1 = f32x16{}; sb.m = -1e30f; sb.l = 0.f;
#define P1_PARAMS(ti) const int dil_ = (ti) < 5 ? 16 : 4, tau_ = (ti) < 5 ? (ti) : (ti) - 5; const int rdla_ = r16a & (dil_ - 1), rdlb_ = (r16a + 1) & (dil_ - 1); const int mba_ = (T0 + r16a - rdla_) / dil_ - 128 + 32 * tau_
#define P1_ADDR(ti) P1_PARAMS(ti); const size_t vst_ = (size_t)dil_ * ODD_IN; const int mv = mba_ + (lane >> 3); const int m0_ = mv < 0 ? 0 : mv, m1_ = mv + 8 < 0 ? 0 : mv + 8, m2_ = mv + 16 < 0 ? 0 : mv + 16, m3_ = mv + 24 < 0 ? 0 : mv + 24; \
                const bf16* va_ = Vh + (size_t)rdla_ * ODD_IN; const bf16* vb_ = Vh + (size_t)rdlb_ * ODD_IN
#define P1_LOADK(ti) do { P1_ADDR(ti); attn_load_k(RA, 1024, va_ + m0_ * vst_, va_ + m1_ * vst_, va_ + m2_ * vst_, va_ + m3_ * vst_); attn_load_k(RB, 1024, vb_ + m0_ * vst_, vb_ + m1_ * vst_, vb_ + m2_ * vst_, vb_ + m3_ * vst_); } while (0)
#define P1_LOADV(ti) do { P1_ADDR(ti); attn_load_v(RA, va_ + m0_ * vst_, va_ + m1_ * vst_, va_ + m2_ * vst_, va_ + m3_ * vst_); attn_load_v(RB, vb_ + m0_ * vst_, vb_ + m1_ * vst_, vb_ + m2_ * vst_, vb_ + m3_ * vst_); } while (0)
#pragma unroll 1
            for (int ti = 0; ti < 13; ++ti) {
                { P1_PARAMS(ti); if (mba_ + 31 < 0) continue; }
                TileRegs RA, RB;
                P1_LOADK(ti);
                P1_PARAMS(ti);
                attn_compute2_kv<3>(sa, sb, qa, qb, RA, RB, wl, lane, 128 + (16 / dil_) * r32 - 32 * tau_, -mba_, -mba_, [&] { P1_LOADV(ti); }, [] {});
            }
#undef P1_ADDR
#undef P1_LOADK
#undef P1_LOADV
#undef P1_PARAMS
            attn_state_store(sa, EX + ((size_t)U * 512 + pa) * 64, LSE + (size_t)U * 512 + pa, lane);
            attn_state_store(sb, EX + ((size_t)U * 512 + pa + 1) * 64, LSE + (size_t)U * 512 + pa + 1, lane);
        }
        {
            const int pa = 64 * wave + r32, pb = pa + 32;
            bf16x8 qa[4], qb[4];
            { const bf16* zqa = Z + (rowbase + T0 + pa) * ODD_IN + hh * 64 + 8 * hi;
#pragma unroll
              for (int d0 = 0; d0 < 4; ++d0) { qa[d0] = *(const bf16x8*)(zqa + 16 * d0); qb[d0] = *(const bf16x8*)(zqa + (size_t)32 * ODD_IN + 16 * d0); } }
            asm volatile("s_waitcnt vmcnt(0)" ::: "memory");
            __syncthreads();
            v2u gga[2][4], ggb[2][4];
            { const bf16* zg = Z + (rowbase + T0 + pa) * ODD_IN + 3072 + hh * 64; attn_gate_load(gga, zg, lane); attn_gate_load(ggb, zg + (size_t)32 * ODD_IN, lane); }
            AttnSt sa, sb;
            attn_state_load(sa, EX + ((size_t)U * 512 + pa) * 64, LSE + (size_t)U * 512 + pa, lane);
            attn_state_load(sb, EX + ((size_t)U * 512 + pb) * 64, LSE + (size_t)U * 512 + pb, lane);
            const int mba = T0 + 64 * wave - 128, mbb = mba + 32;
            const size_t vst = (size_t)ODD_IN;
#define P2_ADDR(tau) const int mva = mba + 32 * (tau) + (lane >> 3), mvb = mva + 32; \
                const int a0_ = mva < 0 ? 0 : mva, a1_ = mva + 8 < 0 ? 0 : mva + 8, a2_ = mva + 16 < 0 ? 0 : mva + 16, a3_ = mva + 24 < 0 ? 0 : mva + 24; \
                const int b0_ = mvb < 0 ? 0 : mvb, b1_ = mvb + 8 < 0 ? 0 : mvb + 8, b2_ = mvb + 16 < 0 ? 0 : mvb + 16, b3_ = mvb + 24 < 0 ? 0 : mvb + 24
#define P2_LOADK(tau) do { P2_ADDR(tau); attn_load_k(RA, 1024, Vh + a0_ * vst, Vh + a1_ * vst, Vh + a2_ * vst, Vh + a3_ * vst); attn_load_k(RB, 1024, Vh + b0_ * vst, Vh + b1_ * vst, Vh + b2_ * vst, Vh + b3_ * vst); } while (0)
#define P2_LOADV(tau) do { P2_ADDR(tau); attn_load_v(RA, Vh + a0_ * vst, Vh + a1_ * vst, Vh + a2_ * vst, Vh + a3_ * vst); attn_load_v(RB, Vh + b0_ * vst, Vh + b1_ * vst, Vh + b2_ * vst, Vh + b3_ * vst); } while (0)
#pragma unroll 1
            for (int tau = 0; tau < 5; ++tau) {
                if (mbb + 32 * tau + 31 < 0) continue;
                TileRegs RA, RB;
                P2_LOADK(tau);
                attn_compute2_kv<3>(sa, sb, qa, qb, RA, RB, wl, lane, 128 + r32 - 32 * tau, -(mba + 32 * tau), -(mbb + 32 * tau), [&] { P2_LOADV(tau); }, [] {});
            }
#undef P2_ADDR
#undef P2_LOADK
#undef P2_LOADV
            { int pa2 = pa; asm volatile("" : "+v"(pa2));
              bf16* yr = Y + (rowbase + T0 + pa2) * D + hh * 64;
              attn_store_g(sa, gga, yr, lane); attn_store_g(sb, ggb, yr + (size_t)32 * D, lane); }
        }
    }
}

__device__ __forceinline__ void phase_dilated(const Args& A, LAS unsigned char* lds, int gwv, int NGW, int wave, int lane) {
    const bf16* Z = (const bf16*)(A.ws + WS_Z); bf16* Y = (bf16*)(A.ws + WS_Y);
    LAS unsigned char* vl = lds + wave * 4096;
    const int r32 = lane & 31, hi = lane >> 5;
    for (int U = gwv; U < 32768; U += NGW) {
        const int rd = U >> 11, g2 = U & 2047, X = g2 >> 8, lwv = g2 & 255;
        const int bh = 32 * X + 2 * rd + (lwv >> 7), gi = lwv & 127, c = gi >> 4, r16 = gi & 15;
        const int b = bh >> 4, hh = bh & 15;
        const size_t rowbase = (size_t)b * SEQ;
        const int tq = 512 * c + r16 + 16 * r32;
        const bf16* zq = Z + (rowbase + tq) * ODD_IN;
        bf16x8 qf[4];
#pragma unroll
        for (int d0 = 0; d0 < 4; ++d0) qf[d0] = *(const bf16x8*)(zq + hh * 64 + 16 * d0 + 8 * hi);
        AttnSt st; st.o0 = f32x16{}; st.o1 = f32x16{}; st.m = -1e30f; st.l = 0.f;
        const bf16* Kh = Z + rowbase * ODD_IN + 1024 + hh * 64; const bf16* Vh = Z + rowbase * ODD_IN + 2048 + hh * 64;
#pragma unroll 1
        for (int cfg = 0; cfg < 3; ++cfg) {
            const int dil = (cfg == 0) ? 16 : (cfg == 1) ? 4 : 1, sstep = 16 / dil, ntile = (cfg == 0) ? 5 : (cfg == 1) ? 8 : 20;
            const int rdl = r16 & (dil - 1), mbase = (512 * c + r16 - rdl) / dil - 128;
            for (int tau = 0; tau < ntile; ++tau) {
                const int m0 = mbase + 32 * tau;
                if (m0 + 31 < 0) continue;
                const int mk = m0 + r32, mkc = mk < 0 ? 0 : mk;
                const bf16* kp = Kh + (size_t)(rdl + dil * mkc) * ODD_IN + 8 * hi;
                const int mv = m0 + (lane >> 3);
                const int mv0 = mv < 0 ? 0 : mv, mv1 = mv + 8 < 0 ? 0 : mv + 8, mv2 = mv + 16 < 0 ? 0 : mv + 16, mv3 = mv + 24 < 0 ? 0 : mv + 24;
                const bf16* vb = Vh + (size_t)rdl * ODD_IN + 8 * (lane & 7); const size_t vst = (size_t)dil * ODD_IN;
                const int dd0 = 128 + sstep * r32 - 32 * tau;
                attn_tile(st, qf, kp, vb + mv0 * vst, vb + mv1 * vst, vb + mv2 * vst, vb + mv3 * vst, vl, lane, true,
                          [&](int kk) { const int dd = dd0 - kk; return dd >= 0 && dd <= 128 && (m0 + kk) >= 0; });
            }
        }
        attn_store(st, zq + 3072 + hh * 64, Y + (rowbase + tq) * D + hh * 64, lane);
    }
}
#define XB_TMO      128
#define XB_XCNT(j)  (256  + 64 * (j))
#define XB_XSUB(j)  (1280 + 64 * (j))
#define XB_XGEN(j)  (2304 + 64 * (j))
#define XB_TOP      3328
#define XB_TOPGEN   3392
#define XCD_BAR_WORDS 3456
#define XB_SPIN_CAP (1u << 18)

__device__ __forceinline__ unsigned xb_ld(unsigned* p)              { return __hip_atomic_load(p, __ATOMIC_RELAXED, __HIP_MEMORY_SCOPE_AGENT); }
__device__ __forceinline__ unsigned xb_add(unsigned* p, unsigned v) { return __hip_atomic_fetch_add(p, v, __ATOMIC_RELAXED, __HIP_MEMORY_SCOPE_AGENT); }
__device__ __forceinline__ unsigned xb_xcc_id() { return (unsigned)__builtin_amdgcn_s_getreg((3 << 11) | 20) & 0xFu; }
#define XB_SPIN(cond, bar) do { unsigned _sp = 0; while (cond) { __builtin_amdgcn_s_sleep(1); \
    if ((++_sp & 255u) == 0u) { if (xb_ld(&(bar)[XB_TMO])) break; if (_sp > XB_SPIN_CAP) { atomicAdd(&(bar)[XB_TMO], 1u); break; } } } } while (0)

struct XcdBarrier {
    unsigned* bar; unsigned x;
    volatile LAS unsigned* st;
};

__device__ __forceinline__ XcdBarrier xcd_barrier_post(unsigned* bar, volatile LAS unsigned* st) {
    XcdBarrier b; b.bar = bar; b.x = xb_xcc_id(); b.st = st;
    if (threadIdx.x == 0) (void)xb_add(&bar[XB_XCNT(b.x)], 1u);
    return b;
}
__device__ __forceinline__ void xcd_barrier_complete(unsigned* bar, unsigned x, unsigned& nloc, unsigned& nx) {
    const unsigned G = gridDim.x * gridDim.y * gridDim.z;
    unsigned sum, cnt, mine, sp = 0u;
    for (;;) {
        sum = 0u; cnt = 0u; mine = 0u;
#pragma unroll
        for (unsigned j = 0; j < 16; ++j) { const unsigned c = xb_ld(&bar[XB_XCNT(j)]); sum += c; cnt += (c > 0u) ? 1u : 0u; mine = (j == x) ? c : mine; }
        if (sum == G) break;
        __builtin_amdgcn_s_sleep(1);
        if ((++sp & 255u) == 0u) { if (xb_ld(&bar[XB_TMO])) break; if (sp > XB_SPIN_CAP) { atomicAdd(&bar[XB_TMO], 1u); break; } }
    }
    nloc = mine > 0u ? mine : 1u; nx = cnt > 0u ? cnt : 1u;
}

__device__ __forceinline__ void xcd_barrier(const XcdBarrier& b) {
    asm volatile("s_waitcnt vmcnt(0)" ::: "memory");
    __syncthreads();
    if (threadIdx.x == 0) {
        unsigned* bar = b.bar;
        __builtin_amdgcn_s_waitcnt(0);
        unsigned nloc = b.st[0], nx = b.st[1];
        if (nloc == 0u) { xcd_barrier_complete(bar, b.x, nloc, nx); b.st[0] = nloc; b.st[1] = nx; }
        const unsigned old = xb_add(&bar[XB_XSUB(b.x)], 1u);
        const unsigned gen = old / nloc;
        if (old + 1u == (gen + 1u) * nloc) {
            __builtin_amdgcn_fence(__ATOMIC_RELEASE, "agent");
            asm volatile("s_waitcnt vmcnt(0)" ::: "memory");
            const unsigned og = xb_add(&bar[XB_TOP], 1u);
            const unsigned tg = og / nx;
            if (og + 1u == (tg + 1u) * nx) xb_add(&bar[XB_TOPGEN], 1u);
            else XB_SPIN(xb_ld(&bar[XB_TOPGEN]) == tg, bar);
            __builtin_amdgcn_fence(__ATOMIC_ACQUIRE, "agent");
            xb_add(&bar[XB_XGEN(b.x)], 1u);
            asm volatile("s_waitcnt vmcnt(0)" ::: "memory");
        } else {
            XB_SPIN(xb_ld(&bar[XB_XGEN(b.x)]) == gen, bar);
            __builtin_amdgcn_fence(__ATOMIC_ACQUIRE, "agent");
            asm volatile("s_waitcnt vmcnt(0)" ::: "memory");
        }
    }
    __syncthreads();
}
__device__ __forceinline__ void phase_final(const Args& A, int gwv, int NGW, int lane) {
    const float* ssqp = (const float*)(A.ws + WS_SSQ);
    f32x4 fg[4];
#pragma unroll
    for (int j = 0; j < 4; ++j) fg[j] = *((const f32x4*)A.final_g + lane + 64 * j);
    for (int m = gwv; m < M; m += 2 * NGW) {
        const int m2 = m + NGW;
        const f32x4* sp = (const f32x4*)(ssqp + (size_t)m * 16); const f32x4* sp2 = (const f32x4*)(ssqp + (size_t)m2 * 16);
        f32x4* hr = (f32x4*)(A.out + (size_t)m * D) + lane; f32x4* hr2 = (f32x4*)(A.out + (size_t)m2 * D) + lane;
        const f32x4 a = sp[0], b = sp[1], c = sp[2], d = sp[3], a2 = sp2[0], b2 = sp2[1], c2 = sp2[2], d2 = sp2[3];
        f32x4 v[4], w[4];
#pragma unroll
        for (int j = 0; j < 4; ++j) { v[j] = hr[64 * j]; w[j] = hr2[64 * j]; }
        const float ss = (((a[0] + a[1]) + (a[2] + a[3])) + ((b[0] + b[1]) + (b[2] + b[3]))) + (((c[0] + c[1]) + (c[2] + c[3])) + ((d[0] + d[1]) + (d[2] + d[3])));
        const float ss2 = (((a2[0] + a2[1]) + (a2[2] + a2[3])) + ((b2[0] + b2[1]) + (b2[2] + b2[3]))) + (((c2[0] + c2[1]) + (c2[2] + c2[3])) + ((d2[0] + d2[1]) + (d2[2] + d2[3])));
        const float rstd = __builtin_amdgcn_rsqf(ss * (1.0f / 1024.0f) + NORM_EPS), rstd2 = __builtin_amdgcn_rsqf(ss2 * (1.0f / 1024.0f) + NORM_EPS);
#pragma unroll
        for (int j = 0; j < 4; ++j) { hr[64 * j] = v[j] * rstd * fg[j]; hr2[64 * j] = w[j] * rstd2 * fg[j]; }
    }
}

#define CAS __attribute__((address_space(4)))
#define FRESH_IDS() int lane = lane_k, wave = wave_k, vcu = vcu_k; asm volatile("" : "+v"(lane), "+s"(wave), "+s"(vcu)); const int gwv = vcu * NWAVES + wave; (void)gwv;
#define GRID_SYNC() do { asm volatile("s_waitcnt vmcnt(0) lgkmcnt(0)" ::: "memory"); __syncthreads(); \
    if (wave_k == 0) { __builtin_amdgcn_fence(__ATOMIC_RELEASE, "agent"); asm volatile("s_waitcnt vmcnt(0)" ::: "memory"); } \
    grid.sync(); \
    if (wave_k == 0) { __builtin_amdgcn_fence(__ATOMIC_ACQUIRE, "agent"); asm volatile("s_waitcnt vmcnt(0)" ::: "memory"); } \
    __syncthreads(); } while (0)
#ifdef NO_XBAR
#define XBAR_SYNC() GRID_SYNC()
#else
#define XBAR_SYNC() xcd_barrier(xbar)
#endif
#define FRESH_ARGS() ({ const CAS Args* ap_ = (const CAS Args*)__builtin_amdgcn_kernarg_segment_ptr(); asm volatile("" : "+s"(ap_)); Args a_; a_ = *(const Args*)ap_; a_; })
__global__ void __launch_bounds__(NTHREADS, 2) mega_fwd(Args Akern) {
    extern __shared__ __attribute__((aligned(16))) unsigned char lds_raw[];
    cg::grid_group grid = cg::this_grid();
    LAS unsigned char* lds = (LAS unsigned char*)lds_raw;
    const int tid = threadIdx.x, lane_k = tid & 63, wave_k = __builtin_amdgcn_readfirstlane(tid >> 6);
    const int G = gridDim.x, bx = blockIdx.x;
    const int vcu_k = (G % 8 == 0) ? (bx % 8) * (G / 8) + bx / 8 : bx;
    const int NGW = G * NWAVES;
    if (tid < 2) ((volatile LAS unsigned*)(lds + 131072))[tid] = 0u;
    __syncthreads();
    const XcdBarrier xbar = xcd_barrier_post((unsigned*)(Akern.ws + WS_CTL), (volatile LAS unsigned*)(lds + 131072));

#ifndef NO_PRO
    { FRESH_IDS(); const Args A = FRESH_ARGS(); phase_prologue(A, lds, gwv, NGW, wave, lane); }
#endif
    GRID_SYNC();
#pragma unroll 1
    for (int layer = 0; layer < 4; ++layer) {
        const int li = layer >> 1; const int even = !(layer & 1);
        {
            const Args A = FRESH_ARGS(); bf16* hb = (bf16*)(A.ws + WS_HB); bf16* Zb = (bf16*)(A.ws + WS_Z); float* ssqp = (float*)(A.ws + WS_SSQ); float* kmp = (float*)(A.ws + WS_KMP);
            const int N = even ? EVEN_IN : ODD_IN;
            const bf16* Wt = even ? (const bf16*)(A.ws + WS_WE_IN) + (size_t)li * EVEN_IN * D : (const bf16*)(A.ws + WS_WO_IN) + (size_t)li * ODD_IN * D;
            pg8::Gemm g{hb, Wt, M, N, D}; pg8::StaticOrder S; S.init(M, N, G, bx);
            LAS float* rtab = (LAS float*)(lds + 131072 + 1024);
            {
                int tidl = tid; asm volatile("" : "+v"(tidl));
                const int rl = tidl & 255, half = tidl >> 8;
#pragma unroll 1
                for (int kb = 0; kb < 8; kb += 4) {
                    f32x4 pv[4][4]; int have[4];
#pragma unroll
                    for (int k = 0; k < 4; ++k) {
                        pg8::Unit uu; have[k] = S.next(2 * (kb + k) + half, uu) ? 1 : 0;
                        const float* sp = ssqp + ((size_t)(have[k] ? uu.pm : 0) * 256 + rl) * 16;
#pragma unroll
                        for (int q4 = 0; q4 < 4; ++q4) pv[k][q4] = *(const f32x4*)(sp + 4 * q4);
                    }
#pragma unroll
                    for (int k = 0; k < 4; ++k) {
                        const f32x4 a = pv[k][0], b = pv[k][1], c = pv[k][2], d = pv[k][3];
                        const float ss = (((a[0] + a[1]) + (a[2] + a[3])) + ((b[0] + b[1]) + (b[2] + b[3]))) + (((c[0] + c[1]) + (c[2] + c[3])) + ((d[0] + d[1]) + (d[2] + d[3])));
                        if (have[k]) rtab[(2 * (kb + k) + half) * 256 + rl] = __builtin_amdgcn_rsqf(ss * (1.0f / 1024.0f) + NORM_EPS);
                    }
                }
                __syncthreads();
            }
            int eseq = 0;
            pg8::EpiIn E{Zb, N, rtab, &eseq, kmp, even};
#ifdef PROBE_GIN2
            pg8::gemm_phase<pg8::EpiIn, pg8::StaticOrder, true, true>(lds, g, S, E);
#endif
#ifndef NO_GIN
            pg8::gemm_phase<pg8::EpiIn, pg8::StaticOrder, true, true>(lds, g, S, E);
#endif
        }
        XBAR_SYNC();
#ifdef PROBE_MIX2
        for (int rep = 0; rep < 2; ++rep)
#endif
#ifdef PROBE_MIX2_EVEN
        for (int rep = 0; rep < (even ? 2 : 1); ++rep)
#endif
        { __syncthreads(); FRESH_IDS(); const Args A = FRESH_ARGS();
        if (even) {
#ifndef NO_GMLP
            phase_gmlp(A, li, lds, vcu, G, wave, lane);
#endif
#ifdef PROBE_GMLP2
            phase_gmlp(A, li, lds, vcu, G, wave, lane);
#endif
#ifndef NO_MOBA
#if defined(NO_PIPE)
            phase_moba_old(A, lds, gwv, NGW, wave, lane);
#elif defined(MOBA_PIPE)
            phase_moba_p(A, lds, gwv, NGW, wave, lane);
#else
            phase_moba_s(A, lds, G, vcu, wave, lane);
#endif
#endif
        } else {
#ifndef NO_DIL
#if defined(NO_PIPE)
            phase_dilated(A, lds, gwv, NGW, wave, lane);
#elif defined(DIL_PIPE)
            phase_dilated_p(A, lds, gwv, NGW, wave, lane);
#elif defined(DIL_2)
            phase_dilated_2(A, lds, gwv, NGW, wave, lane);
#else
            phase_dilated_3(A, lds, G, vcu, wave, lane);
#endif
#endif
        } }
        XBAR_SYNC();
        {
            const Args A = FRESH_ARGS(); bf16* hb = (bf16*)(A.ws + WS_HB); bf16* Yb = (bf16*)(A.ws + WS_Y); float* ssqp = (float*)(A.ws + WS_SSQ);
            const bf16* Wt = even ? (const bf16*)(A.ws + WS_WE_OUT) + (size_t)li * D * D : (const bf16*)(A.ws + WS_WO_OUT) + (size_t)li * D * D;
            pg8::Gemm g{Yb, Wt, M, D, D}; pg8::StaticOrder S; S.init(M, D, G, bx);
            pg8::EpiOut E{layer == 0 ? A.x : nullptr, layer == 3 ? A.out : nullptr, hb, ssqp};
#ifndef NO_GOUT
            pg8::gemm_phase<pg8::EpiOut, pg8::StaticOrder, true, true>(lds, g, S, E);
#endif
        }
        XBAR_SYNC();
    }
#ifndef NO_FIN
    { FRESH_IDS(); const Args A = FRESH_ARGS(); phase_final(A, gwv, NGW, lane); }
#endif
}

extern "C" void kernel_launch(void* const* d_in, const int* in_sizes, int n_in, void* d_out, int out_size, void* d_ws, size_t ws_size, hipStream_t stream) {
    static int grid = 0;
    if (grid == 0) {
        if (n_in != 11 || in_sizes[0] != M * D || out_size != M * D || ws_size < WS_END) { fprintf(stderr, "kernel_launch: unexpected shapes (n_in %d, in0 %d, out %d, ws %zu)\n", n_in, n_in > 0 ? in_sizes[0] : -1, out_size, ws_size); grid = -1; return; }
        int dev = 0, cus = 0, per_cu = 0;
        if (hipGetDevice(&dev) != hipSuccess || hipDeviceGetAttribute(&cus, hipDeviceAttributeMultiprocessorCount, dev) != hipSuccess) { grid = -1; return; }
        if (hipFuncSetAttribute((const void*)mega_fwd, hipFuncAttributeMaxDynamicSharedMemorySize, LDS_BYTES) != hipSuccess) { fprintf(stderr, "kernel_launch: hipFuncSetAttribute failed\n"); grid = -1; return; }
        if (hipOccupancyMaxActiveBlocksPerMultiprocessor(&per_cu, (const void*)mega_fwd, NTHREADS, LDS_BYTES) != hipSuccess || per_cu < 1) { fprintf(stderr, "kernel_launch: occupancy query says %d\n", per_cu); per_cu = 1; }
        (void)hipGetLastError();
        grid = cus;
    }
    if (grid < 0) return;
    Args a{};
    a.x = (const float*)d_in[0]; a.norm_g = (const float*)d_in[1]; a.final_g = (const float*)d_in[2]; a.ab_w_in = (const float*)d_in[3]; a.ab_w_out = (const float*)d_in[4];
    a.ln_g = (const float*)d_in[5]; a.ln_b = (const float*)d_in[6]; a.w_s = (const float*)d_in[7]; a.b_s = (const float*)d_in[8]; a.c_w_in = (const float*)d_in[9]; a.c_w_out = (const float*)d_in[10];
    a.out = (float*)d_out; a.ws = (unsigned char*)d_ws;
    if (hipMemsetAsync((char*)d_ws + WS_CTL, 0, 16384, stream) != hipSuccess) { fprintf(stderr, "kernel_launch: hipMemsetAsync failed\n"); return; }
    void* args[] = {&a};
    const hipError_t e = hipLaunchCooperativeKernel((const void*)mega_fwd, dim3(grid), dim3(NTHREADS), args, LDS_BYTES, stream);
    if (e != hipSuccess) fprintf(stderr, "kernel_launch: cooperative launch failed: %s (grid %d)\n", hipGetErrorString(e), grid);
}
```

```cpp
#include <hip/hip_runtime.h>
#include <hip/hip_cooperative_groups.h>
#include <cstdio>
#include <cstdint>
#include <cmath>
namespace cg = cooperative_groups;
namespace pg8 {
#define PG8_LAS __attribute__((address_space(3)))
typedef unsigned short bf16_t;
typedef short bf16x8 __attribute__((ext_vector_type(8)));
typedef float f32x4 __attribute__((ext_vector_type(4)));
typedef unsigned u32x4 __attribute__((ext_vector_type(4)));
constexpr int BM = 256, BK = 64, HALF = 128, HTB = HALF * BK * 2  , STAGE_BYTES = 8 * HTB, NXCD = 8, WGM = 8;

__host__ __device__ __forceinline__ int lds_byte(int r, int c) { const int st = (r >> 4) * 2 + (c >> 5), rr = r & 15, cc = c & 31, ob = rr * 64 + cc * 2; return st * 1024 + (ob ^ (((ob >> 9) & 1) << 5)); }
__host__ __device__ __forceinline__ void stage_rc(int b, int& R, int& C) { const int st = b / 1024, sb = b % 1024, swz = sb ^ (((sb >> 9) & 1) << 5); R = (st >> 1) * 16 + swz / 64; C = (st & 1) * 32 + (swz % 64) / 2; }
__host__ __device__ __forceinline__ int perm32(int rho) { const int n = rho >> 4, i = rho & 15; return 8 * (i >> 2) + 4 * n + (i & 3); }

struct Unit { int pm, pn; };
struct Gemm { const bf16_t* A; const bf16_t* Bt; int M, N, K; };

struct StaticOrder {
    int nM, nN, nwg, G, c;
    __host__ __device__ void init(int M, int N, int G_, int c_) { nM = M / BM; nN = N / BM; nwg = nM * nN; G = G_; c = c_; }
    __host__ __device__ bool next(int i, Unit& u) const {
        const long L = (long)i * G + c; if (L >= nwg) return false;
        int wgid = (int)L; { const int q = nwg / NXCD, r = nwg % NXCD, xcd = wgid % NXCD, off = wgid / NXCD; wgid = (xcd < r ? xcd * (q + 1) : r * (q + 1) + (xcd - r) * q) + off; }
        const int nig = WGM * nN, gid = wgid / nig, fm = gid * WGM, gsz = (nM - fm) < WGM ? (nM - fm) : WGM;
        u.pm = fm + ((wgid % nig) % gsz); u.pn = (wgid % nig) / gsz; return true;
    }
    __device__ __forceinline__ void a_ready(const Unit&) const {}
    __device__ __forceinline__ void done(const Unit&) const {}
};

__device__ __forceinline__ unsigned cvt_pk_bf16(float lo, float hi) { unsigned r; asm volatile("v_cvt_pk_bf16_f32 %0, %1, %2" : "=v"(r) : "v"(lo), "v"(hi)); return r; }
typedef unsigned u32x2 __attribute__((ext_vector_type(2)));
__device__ __forceinline__ float act_gelu(float x) {
    const float t = x + 0.044715f * x * x * x;
    return x * __builtin_amdgcn_rcpf(1.f + __builtin_amdgcn_exp2f(-2.302208198f * t));
}
__device__ __forceinline__ float act_silu(float x) { return x * __builtin_amdgcn_rcpf(1.f + __builtin_amdgcn_exp2f(-1.4426950409f * x)); }
constexpr float QSCALE = 0.125f * 1.4426950408889634f;
constexpr float NORM_EPS = 1e-6f;

struct EpiIn {
    static constexpr bool PERM = true, AFTER_DRAIN = false;
    bf16_t* Z; int ldz; const PG8_LAS float* rtab; int* seq; float* kmp; int even;
    template <int ACT> __device__ __forceinline__ void body(const f32x4 (&acc)[2][2][4][2], const Unit& u, int wr, int wc, int fr, int fq, const PG8_LAS float* rt) const {
        const int row0 = u.pm * BM + wr * 64 + fr, col0 = u.pn * BM + wc * 32 + 8 * fq;
        float rs[2][4];
#pragma unroll
        for (int ai = 0; ai < 2; ++ai)
#pragma unroll
            for (int m = 0; m < 4; ++m) rs[ai][m] = rt[wr * 64 + fr + ai * HALF + m * 16];
        float cs[2][2][4];
        if (ACT == 4) {
#pragma unroll
            for (int bj = 0; bj < 2; ++bj)
#pragma unroll
                for (int n = 0; n < 2; ++n)
#pragma unroll
                    for (int e = 0; e < 4; ++e) cs[bj][n][e] = 0.f;
        }
#pragma unroll
        for (int ai = 0; ai < 2; ++ai)
#pragma unroll
            for (int m = 0; m < 4; ++m) {
                const int row = row0 + ai * HALF + m * 16;
                const float rstd = rs[ai][m];
                bf16_t* rowp = Z + (size_t)row * ldz + col0;
#pragma unroll
                for (int bj = 0; bj < 2; ++bj) {
                    f32x4 v[2];
#pragma unroll
                    for (int n = 0; n < 2; ++n) {
                        v[n] = acc[ai][bj][m][n] * rstd;
#pragma unroll
                        for (int e = 0; e < 4; ++e) {
                            if (ACT == 1) v[n][e] = act_gelu(v[n][e]);
                            if (ACT == 2) v[n][e] = act_silu(v[n][e]);
                            if (ACT == 3) v[n][e] = v[n][e] * QSCALE;
                            if (ACT == 4) cs[bj][n][e] += v[n][e];
                        }
                    }
                    u32x4 w; w.x = cvt_pk_bf16(v[0][0], v[0][1]); w.y = cvt_pk_bf16(v[0][2], v[0][3]); w.z = cvt_pk_bf16(v[1][0], v[1][1]); w.w = cvt_pk_bf16(v[1][2], v[1][3]);
                    *(u32x4*)(rowp + bj * HALF) = w;
                }
            }
        if (ACT == 4) {
#pragma unroll
            for (int bj = 0; bj < 2; ++bj)
#pragma unroll
                for (int n = 0; n < 2; ++n)
#pragma unroll
                    for (int e = 0; e < 4; ++e) {
                        float s = cs[bj][n][e];
                        s += __shfl_xor(s, 1); s += __shfl_xor(s, 2); s += __shfl_xor(s, 4); s += __shfl_xor(s, 8);
                        cs[bj][n][e] = s;
                    }
            if (fr == 0) {
                float* kp = kmp + ((size_t)u.pm * 2 + wr) * 512 + (col0 - 2048);
#pragma unroll
                for (int bj = 0; bj < 2; ++bj)
#pragma unroll
                    for (int n = 0; n < 2; ++n) *(f32x4*)(kp + bj * HALF + n * 4) = (f32x4){cs[bj][n][0], cs[bj][n][1], cs[bj][n][2], cs[bj][n][3]};
            }
        }
    }
    __device__ __forceinline__ void operator()(const f32x4 (&acc)[2][2][4][2], const Unit& u, int wr, int wc, int fr, int fq) const {
        int act;
        if (even) { const int seg = u.pn >> 1; act = (seg == 0 || seg == 1) ? 1 : (seg == 2 || seg == 6) ? 2 : (seg == 3) ? 3 : (seg == 4) ? 4 : 0; }
        else { const int seg = u.pn >> 2; act = (seg == 0) ? 3 : (seg == 3) ? 2 : 0; }
        const PG8_LAS float* rt = rtab + ((*seq)++) * 256;
        if (act == 0) body<0>(acc, u, wr, wc, fr, fq, rt);
        else if (act == 1) body<1>(acc, u, wr, wc, fr, fq, rt);
        else if (act == 2) body<2>(acc, u, wr, wc, fr, fq, rt);
        else if (act == 3) body<3>(acc, u, wr, wc, fr, fq, rt);
        else body<4>(acc, u, wr, wc, fr, fq, rt);
    }
};
struct EpiOut {
    static constexpr bool PERM = true, AFTER_DRAIN = false;
    const float* resid_f32; float* out_f32; bf16_t* hb; float* ssqp;
    template <bool RF32> __device__ __forceinline__ void body(const f32x4 (&acc)[2][2][4][2], const Unit& u, int wr, int wc, int fr, int fq) const {
        const int row0 = u.pm * BM + wr * 64 + fr, col0 = u.pn * BM + wc * 32 + 8 * fq;
        constexpr int MB = RF32 ? 2 : 4;
#pragma unroll
        for (int ai = 0; ai < 2; ++ai)
#pragma unroll
        for (int m0 = 0; m0 < 4; m0 += MB) {
            f32x4 rf[RF32 ? MB : 1][2][2]; u32x4 rb[RF32 ? 1 : MB][2];
#pragma unroll
            for (int mm = 0; mm < MB; ++mm)
#pragma unroll
                for (int bj = 0; bj < 2; ++bj) {
                    const size_t o2 = (size_t)(row0 + ai * HALF + (m0 + mm) * 16) * 1024 + col0 + bj * HALF;
                    if (RF32) { rf[RF32 ? mm : 0][bj][0] = *(const f32x4*)(resid_f32 + o2); rf[RF32 ? mm : 0][bj][1] = *(const f32x4*)(resid_f32 + o2 + 4); }
                    else rb[RF32 ? 0 : mm][bj] = *(const u32x4*)(hb + o2);
                }
#pragma unroll
            for (int mm = 0; mm < MB; ++mm) {
                const int m = m0 + mm;
                const int row = row0 + ai * HALF + m * 16; const size_t off = (size_t)row * 1024 + col0; float ss = 0.f;
#pragma unroll
                for (int bj = 0; bj < 2; ++bj) {
                    const size_t o2 = off + bj * HALF;
                    f32x4 r0, r1;
                    if (RF32) { r0 = rf[RF32 ? mm : 0][bj][0]; r1 = rf[RF32 ? mm : 0][bj][1]; }
                    else { const u32x4 w = rb[RF32 ? 0 : mm][bj];
                        r0[0] = __builtin_bit_cast(float, w.x << 16); r0[1] = __builtin_bit_cast(float, w.x & 0xffff0000u); r0[2] = __builtin_bit_cast(float, w.y << 16); r0[3] = __builtin_bit_cast(float, w.y & 0xffff0000u);
                        r1[0] = __builtin_bit_cast(float, w.z << 16); r1[1] = __builtin_bit_cast(float, w.z & 0xffff0000u); r1[2] = __builtin_bit_cast(float, w.w << 16); r1[3] = __builtin_bit_cast(float, w.w & 0xffff0000u); }
                    const f32x4 o0 = r0 + acc[ai][bj][m][0], o1 = r1 + acc[ai][bj][m][1];
                    ss += ((o0[0] * o0[0] + o0[1] * o0[1]) + (o0[2] * o0[2] + o0[3] * o0[3])) + ((o1[0] * o1[0] + o1[1] * o1[1]) + (o1[2] * o1[2] + o1[3] * o1[3]));
                    if (out_f32) { *(f32x4*)(out_f32 + o2) = o0; *(f32x4*)(out_f32 + o2 + 4) = o1; }
                    else { u32x4 w; w.x = cvt_pk_bf16(o0[0], o0[1]); w.y = cvt_pk_bf16(o0[2], o0[3]); w.z = cvt_pk_bf16(o1[0], o1[1]); w.w = cvt_pk_bf16(o1[2], o1[3]); *(u32x4*)(hb + o2) = w; }
                }
                ss += __shfl_xor(ss, 16); ss += __shfl_xor(ss, 32);
                if (fq == 0) ssqp[(size_t)row * 16 + u.pn * 4 + wc] = ss;
            }
        }
    }
    __device__ __forceinline__ void operator()(const f32x4 (&acc)[2][2][4][2], const Unit& u, int wr, int wc, int fr, int fq) const {
        if (resid_f32) body<true>(acc, u, wr, wc, fr, fq); else body<false>(acc, u, wr, wc, fr, fq);
    }
};
template <class Epi, class Sched, bool ALIGN_EPI = false, bool SP2 = false>
__device__ __forceinline__ void gemm_phase(PG8_LAS unsigned char* lds, const Gemm g, const Sched& S, const Epi& E) {
    int tid_ = threadIdx.x; asm volatile("" : "+v"(tid_));
    const int tid = tid_, wid = __builtin_amdgcn_readfirstlane(tid >> 6), lane = tid & 63, wr = wid >> 2, wc = wid & 3, fr = lane & 15, fq = lane >> 4;
    const int K = g.K, nt = K / BK;
    unsigned voffA[2], voffB[2];
#pragma unroll
    for (int i = 0; i < 2; ++i) { int R, C; stage_rc(tid * 16 + i * 8192, R, C); const int Rb = Epi::PERM ? ((R & ~31) + perm32(R & 31)) : R;
        voffA[i] = (unsigned)(R * K + C) * 2u; voffB[i] = (unsigned)(Rb * K + C) * 2u; }
    const size_t kstep = (size_t)(BK * 2);
    const size_t hstep = (size_t)HALF * K * 2;
    const size_t tstep = 2 * hstep;
    const unsigned ldsw = (unsigned)wid * 1024u;
    const int aoff = lds_byte(wr * 64 + fr, fq * 8), boff = lds_byte(wc * 32 + fr, fq * 8);
#define PG8_SA(b, h) (((b) * 2 + (h)) * HTB)
#define PG8_SB(b, h) ((4 + (b) * 2 + (h)) * HTB)
#define PG8_STAGE(bufoff, gbase, voff) do { _Pragma("unroll") for (int _i = 0; _i < 2; ++_i) \
        __builtin_amdgcn_global_load_lds((const unsigned*)((const char*)(gbase) + (voff)[_i]), (PG8_LAS unsigned*)(lds + (bufoff) + ldsw + _i * 8192), 16, 0, 0); } while (0)
#define PG8_LDA(dst, b, h) do { _Pragma("unroll") for (int m = 0; m < 4; ++m) _Pragma("unroll") for (int k = 0; k < 2; ++k) dst[m][k] = *(const PG8_LAS bf16x8*)(lds + PG8_SA(b, h) + aoff + m * 2048 + k * 1024); } while (0)
#define PG8_LDB(dst, b, h) do { _Pragma("unroll") for (int n = 0; n < 2; ++n) _Pragma("unroll") for (int k = 0; k < 2; ++k) dst[n][k] = *(const PG8_LAS bf16x8*)(lds + PG8_SB(b, h) + boff + n * 2048 + k * 1024); } while (0)
#define PG8_MMA(ai, bj, At, Bt) do { __builtin_amdgcn_s_setprio(1); _Pragma("unroll") for (int m = 0; m < 4; ++m) _Pragma("unroll") for (int n = 0; n < 2; ++n) _Pragma("unroll") for (int k = 0; k < 2; ++k) \
        acc[ai][bj][m][n] = __builtin_amdgcn_mfma_f32_16x16x32_bf16(Bt[n][k], At[m][k], acc[ai][bj][m][n], 0, 0, 0); __builtin_amdgcn_s_setprio(0); } while (0)
#define PG8_WAIT_V(n) asm volatile("s_waitcnt vmcnt(" #n ")" ::: "memory")
#define PG8_WAIT_L(n) asm volatile("s_waitcnt lgkmcnt(" #n ")" ::: "memory")
#define PG8_BAR __builtin_amdgcn_s_barrier()
#define PG8_SCHED __builtin_amdgcn_sched_barrier(0)
    Unit cur, nxt; int ui = 0;
    if (!S.next(0, cur)) return;
    f32x4 acc[2][2][4][2];
#pragma unroll
    for (int a = 0; a < 2; ++a)
#pragma unroll
        for (int b = 0; b < 2; ++b)
#pragma unroll
            for (int m = 0; m < 4; ++m)
#pragma unroll
                for (int n = 0; n < 2; ++n) acc[a][b][m][n] = (f32x4){0.f, 0.f, 0.f, 0.f};
    bf16x8 At[4][2], B0[2][2], B1[2][2];
    const char* cA = (const char*)g.A + (size_t)cur.pm * tstep; const char* cB = (const char*)g.Bt + (size_t)cur.pn * tstep;
    S.a_ready(cur);
    if constexpr (SP2) {
        PG8_STAGE(PG8_SB(0, 0), cB, voffB); PG8_STAGE(PG8_SB(0, 1), cB + hstep, voffB); PG8_STAGE(PG8_SA(0, 0), cA, voffA); PG8_STAGE(PG8_SA(0, 1), cA + hstep, voffA);
        if (wr == 1) PG8_BAR;
        PG8_WAIT_V(2); PG8_BAR;
        PG8_STAGE(PG8_SB(1, 0), cB + kstep, voffB); PG8_STAGE(PG8_SA(1, 0), cA + kstep, voffA); PG8_STAGE(PG8_SB(1, 1), cB + hstep + kstep, voffB);
        PG8_WAIT_V(6); PG8_BAR;
    } else {
        PG8_STAGE(PG8_SB(0, 0), cB, voffB); PG8_STAGE(PG8_SA(0, 0), cA, voffA); PG8_STAGE(PG8_SB(0, 1), cB + hstep, voffB); PG8_STAGE(PG8_SA(0, 1), cA + hstep, voffA);
        if (wr == 1) PG8_BAR;
        PG8_WAIT_V(4); PG8_BAR;
        PG8_STAGE(PG8_SB(1, 0), cB + kstep, voffB); PG8_STAGE(PG8_SA(1, 0), cA + kstep, voffA); PG8_STAGE(PG8_SB(1, 1), cB + hstep + kstep, voffB);
        PG8_WAIT_V(6); PG8_BAR;
    }
    for (;;) {
        const bool has_next = S.next(ui + 1, nxt);
        const char* nA = has_next ? (const char*)g.A + (size_t)nxt.pm * tstep : cA; const char* nB = has_next ? (const char*)g.Bt + (size_t)nxt.pn * tstep : cB;
        for (int t = 0; t < nt; t += 2) {
            const bool last = (t == nt - 2);
            const char* a1 = cA + (size_t)(t + 1) * kstep;
            const char* a2 = last ? nA : cA + (size_t)(t + 2) * kstep; const char* b2 = last ? nB : cB + (size_t)(t + 2) * kstep;
            const char* a3 = a2 + kstep; const char* b3 = b2 + kstep;
            if (last && has_next) S.a_ready(nxt);
            if constexpr (SP2) {
            PG8_LDB(B0, 0, 0); PG8_LDB(B1, 0, 1); PG8_SCHED; PG8_LDA(At, 0, 0); PG8_STAGE(PG8_SA(1, 1), a1 + hstep, voffA);
            PG8_WAIT_V(8); PG8_WAIT_L(0); PG8_BAR; PG8_MMA(0, 0, At, B0); PG8_MMA(0, 1, At, B1); PG8_BAR; PG8_SCHED;
            PG8_LDA(At, 0, 1); PG8_STAGE(PG8_SB(0, 0), b2, voffB); PG8_STAGE(PG8_SB(0, 1), b2 + hstep, voffB); PG8_STAGE(PG8_SA(0, 0), a2, voffA);
            PG8_WAIT_V(8); PG8_WAIT_L(0); PG8_BAR; PG8_MMA(1, 0, At, B0); PG8_MMA(1, 1, At, B1); PG8_BAR; PG8_SCHED;
            PG8_LDB(B0, 1, 0); PG8_LDB(B1, 1, 1); PG8_SCHED; PG8_LDA(At, 1, 0); PG8_STAGE(PG8_SA(0, 1), a2 + hstep, voffA);
            PG8_WAIT_V(8); PG8_WAIT_L(0); PG8_BAR; PG8_MMA(0, 0, At, B0); PG8_MMA(0, 1, At, B1); PG8_BAR; PG8_SCHED;
            PG8_LDA(At, 1, 1); PG8_STAGE(PG8_SB(1, 0), b3, voffB); PG8_STAGE(PG8_SB(1, 1), b3 + hstep, voffB); PG8_STAGE(PG8_SA(1, 0), a3, voffA);
            PG8_WAIT_V(8); PG8_WAIT_L(0); PG8_BAR; PG8_MMA(1, 0, At, B0); PG8_MMA(1, 1, At, B1); PG8_BAR; PG8_SCHED;
            } else {
            PG8_LDB(B0, 0, 0); PG8_SCHED; PG8_LDA(At, 0, 0); PG8_STAGE(PG8_SA(1, 1), a1 + hstep, voffA);
            PG8_WAIT_L(8); PG8_BAR; PG8_WAIT_L(0); PG8_MMA(0, 0, At, B0); PG8_BAR; PG8_SCHED;
            PG8_LDB(B1, 0, 1); PG8_STAGE(PG8_SB(0, 0), b2, voffB);
            PG8_BAR; PG8_WAIT_L(0); PG8_MMA(0, 1, At, B1); PG8_BAR;
            PG8_LDA(At, 0, 1); PG8_STAGE(PG8_SA(0, 0), a2, voffA);
            PG8_BAR; PG8_WAIT_L(0); PG8_MMA(1, 0, At, B0); PG8_BAR; PG8_SCHED;
            PG8_STAGE(PG8_SB(0, 1), b2 + hstep, voffB);
            PG8_WAIT_V(6); PG8_BAR; PG8_MMA(1, 1, At, B1); PG8_BAR;
            PG8_LDB(B0, 1, 0); PG8_SCHED; PG8_LDA(At, 1, 0); PG8_STAGE(PG8_SA(0, 1), a2 + hstep, voffA);
            PG8_WAIT_L(8); PG8_BAR; PG8_WAIT_L(0); PG8_MMA(0, 0, At, B0); PG8_BAR; PG8_SCHED;
            PG8_LDB(B1, 1, 1); PG8_STAGE(PG8_SB(1, 0), b3, voffB);
            PG8_BAR; PG8_WAIT_L(0); PG8_MMA(0, 1, At, B1); PG8_BAR;
            PG8_LDA(At, 1, 1); PG8_STAGE(PG8_SA(1, 0), a3, voffA);
            PG8_BAR; PG8_WAIT_L(0); PG8_MMA(1, 0, At, B0); PG8_BAR; PG8_SCHED;
            PG8_STAGE(PG8_SB(1, 1), b3 + hstep, voffB);
            PG8_WAIT_V(6); PG8_BAR; PG8_MMA(1, 1, At, B1); PG8_BAR;
            }
        }
        if constexpr (ALIGN_EPI) { if (wr == 0) PG8_BAR; }
        if constexpr (!Epi::AFTER_DRAIN) { E(acc, cur, wr, wc, fr, fq); S.done(cur); }
        if (!has_next) break;
#pragma unroll
        for (int a = 0; a < 2; ++a)
#pragma unroll
            for (int b = 0; b < 2; ++b)
#pragma unroll
                for (int m = 0; m < 4; ++m)
#pragma unroll
                    for (int n = 0; n < 2; ++n) acc[a][b][m][n] = (f32x4){0.f, 0.f, 0.f, 0.f};
        cur = nxt; cA = nA; cB = nB; ++ui;
        if constexpr (ALIGN_EPI) { if (wr == 1) PG8_BAR; }
    }
    PG8_WAIT_V(0);
    if constexpr (!ALIGN_EPI) { if (wr == 0) PG8_BAR; }
    PG8_BAR;
    if constexpr (Epi::AFTER_DRAIN) { E.fused(acc, cur, wr, wc, fr, fq, lds, wid, lane); S.done(cur); }
#undef PG8_SA
#undef PG8_SB
#undef PG8_STAGE
#undef PG8_LDA
#undef PG8_LDB
#undef PG8_MMA
#undef PG8_WAIT_V
#undef PG8_WAIT_L
#undef PG8_BAR
#undef PG8_SCHED
}
}
#define GAS __attribute__((address_space(1)))
#define LAS __attribute__((address_space(3)))
typedef unsigned short bf16;
typedef unsigned v4u __attribute__((ext_vector_type(4)));
typedef unsigned v2u __attribute__((ext_vector_type(2)));
typedef float f32x4 __attribute__((ext_vector_type(4)));
typedef float f32x16 __attribute__((ext_vector_type(16)));
typedef short bf16x8 __attribute__((ext_vector_type(8)));
typedef short s16x4 __attribute__((ext_vector_type(4)));
#define LDS_WAIT() asm volatile("s_waitcnt lgkmcnt(0)" ::: "memory")
using pg8::cvt_pk_bf16; using pg8::NORM_EPS; using pg8::QSCALE;

constexpr int NWAVES = 8, NTHREADS = 512;
constexpr float RESCALE_THR = 8.0f;
constexpr int D = 1024, BATCH = 16, SEQ = 4096, M = BATCH * SEQ;
constexpr int EVEN_IN = 3584, ODD_IN = 4096;
constexpr size_t MiB = 1u << 20;
constexpr size_t WS_WE_IN = 0, WS_WE_OUT = 14 * MiB, WS_WO_IN = 18 * MiB, WS_WO_OUT = 34 * MiB, WS_WS = 38 * MiB, WS_SSQ = 39 * MiB, WS_KMP = 43 * MiB,
                 WS_HB = 44 * MiB, WS_Y = 172 * MiB, WS_Z = 300 * MiB, WS_CTL = 812 * MiB, WS_END = 813 * MiB;
constexpr int LDS_BYTES = 131072 + 1024 + 16384;

__device__ __forceinline__ unsigned f2bf(float f) { unsigned u = __builtin_bit_cast(unsigned, f); return (u + 0x7fffu + ((u >> 16) & 1u)) >> 16; }
__device__ __forceinline__ unsigned pk2(float lo, float hi) { return f2bf(lo) | (f2bf(hi) << 16); }
__device__ __forceinline__ float bf_lo(unsigned w) { return __builtin_bit_cast(float, w << 16); }
__device__ __forceinline__ float bf_hi(unsigned w) { return __builtin_bit_cast(float, w & 0xffff0000u); }
__device__ __forceinline__ float wave_sum(float v) {
#pragma unroll
    for (int o = 1; o < 64; o <<= 1) v += __shfl_xor(v, o);
    return v;
}
typedef float f32x2_t __attribute__((ext_vector_type(2))); typedef __bf16 bf16x2_t __attribute__((ext_vector_type(2)));
__device__ __forceinline__ unsigned cvtpk_s(float lo, float hi) { f32x2_t v = {lo, hi}; bf16x2_t b = __builtin_convertvector(v, bf16x2_t); return __builtin_bit_cast(unsigned, b); }
__device__ __forceinline__ int crow(int r, int hi) { return (r & 3) + 8 * (r >> 2) + 4 * hi; }
__device__ __forceinline__ s16x4 vtr(const LAS unsigned char* p) { return __builtin_bit_cast(s16x4, __builtin_amdgcn_ds_read_tr16_b64_v4i16((LAS s16x4*)p)); }

__device__ __forceinline__ void transpose_item(const float* W, const float* g, int K, int N, bf16* WT, LAS float* scr, int item, int lane) {
    const int nblk = N / 32, kb = item / nblk, nb = item % nblk, k0 = 64 * kb, n0 = 32 * nb;
#pragma unroll 8
    for (int i = 0; i < 32; ++i) { const int kk = 2 * i + (lane >> 5); const float sc = g ? g[k0 + kk] : 1.f; scr[kk * 33 + (lane & 31)] = W[(size_t)(k0 + kk) * N + n0 + (lane & 31)] * sc; }
    LDS_WAIT(); asm volatile("" ::: "memory");
    const int c = lane & 7;
#pragma unroll
    for (int j = 0; j < 4; ++j) { const int n = (lane >> 3) + 8 * j; const LAS float* s = scr + (8 * c) * 33 + n;
        v4u o; o.x = pk2(s[0 * 33], s[1 * 33]); o.y = pk2(s[2 * 33], s[3 * 33]); o.z = pk2(s[4 * 33], s[5 * 33]); o.w = pk2(s[6 * 33], s[7 * 33]);
        *(v4u*)(WT + (size_t)(n0 + n) * K + k0 + 8 * c) = o; }
    LDS_WAIT(); asm volatile("" ::: "memory");
}

struct Args {
    const float *x, *norm_g, *final_g, *ab_w_in, *ab_w_out, *ln_g, *ln_b, *w_s, *b_s, *c_w_in, *c_w_out;
    float* out; unsigned char* ws;
};

__device__ __forceinline__ void phase_prologue(const Args& A, LAS unsigned char* lds, int gwv, int NGW, int wave, int lane) {
    LAS float* scr = (LAS float*)(lds + wave * 16384);
    constexpr int I_EIN = 16 * (EVEN_IN / 32), I_OUT = 16 * 32, I_OIN = 16 * (ODD_IN / 32), I_PAIR = I_EIN + I_OUT + I_OIN + I_OUT;
    for (int it = gwv; it < 2 * I_PAIR; it += NGW) {
        const int i = it / I_PAIR; int r = it % I_PAIR;
        if (r < I_EIN) { transpose_item(A.ab_w_in + (size_t)i * D * EVEN_IN, A.norm_g + (2 * i) * D, D, EVEN_IN, (bf16*)(A.ws + WS_WE_IN) + (size_t)i * EVEN_IN * D, scr, r, lane); continue; } r -= I_EIN;
        if (r < I_OUT) { transpose_item(A.ab_w_out + (size_t)i * D * D, nullptr, D, D, (bf16*)(A.ws + WS_WE_OUT) + (size_t)i * D * D, scr, r, lane); continue; } r -= I_OUT;
        if (r < I_OIN) { transpose_item(A.c_w_in + (size_t)i * D * ODD_IN, A.norm_g + (2 * i + 1) * D, D, ODD_IN, (bf16*)(A.ws + WS_WO_IN) + (size_t)i * ODD_IN * D, scr, r, lane); continue; } r -= I_OIN;
        transpose_item(A.c_w_out + (size_t)i * D * D, nullptr, D, D, (bf16*)(A.ws + WS_WO_OUT) + (size_t)i * D * D, scr, r, lane);
    }
    { bf16* wst = (bf16*)(A.ws + WS_WS);
      for (int e = gwv * 64 + lane; e < 2 * 4 * 128 * 128; e += NGW * 64) { const int s = e & 127, t = (e >> 7) & 127; wst[e] = (bf16)f2bf(s <= t ? A.w_s[e] : 0.f); } }
    bf16* hb = (bf16*)(A.ws + WS_HB); float* ssqp = (float*)(A.ws + WS_SSQ);
    for (int m = gwv; m < M; m += 2 * NGW) {
        const int m2 = m + NGW;
        const f32x4* xr = (const f32x4*)(A.x + (size_t)m * D) + lane; const f32x4* xr2 = (const f32x4*)(A.x + (size_t)m2 * D) + lane;
        f32x4 v[4], w4[4];
#pragma unroll
        for (int j = 0; j < 4; ++j) { v[j] = xr[64 * j]; w4[j] = xr2[64 * j]; }
        float s = 0.f, s2 = 0.f;
#pragma unroll
        for (int j = 0; j < 4; ++j) { s += (v[j][0] * v[j][0] + v[j][1] * v[j][1]) + (v[j][2] * v[j][2] + v[j][3] * v[j][3]); s2 += (w4[j][0] * w4[j][0] + w4[j][1] * w4[j][1]) + (w4[j][2] * w4[j][2] + w4[j][3] * w4[j][3]); }
        s = wave_sum(s); s2 = wave_sum(s2);
        v2u* o8 = (v2u*)(hb + (size_t)m * D) + lane; v2u* o82 = (v2u*)(hb + (size_t)m2 * D) + lane;
#pragma unroll
        for (int j = 0; j < 4; ++j) { v2u w; w.x = cvtpk_s(v[j][0], v[j][1]); w.y = cvtpk_s(v[j][2], v[j][3]); o8[64 * j] = w; v2u w2; w2.x = cvtpk_s(w4[j][0], w4[j][1]); w2.y = cvtpk_s(w4[j][2], w4[j][3]); o82[64 * j] = w2; }
        if (lane < 16) { ssqp[(size_t)m * 16 + lane] = (lane == 0) ? s : 0.f; ssqp[(size_t)m2 * 16 + lane] = (lane == 0) ? s2 : 0.f; }
    }
}

__device__ __forceinline__ v4u pair_to_wide(v2u gk, v2u gk1) {
    const auto sx = __builtin_amdgcn_permlane32_swap(gk.x, gk1.x, false, false), sy = __builtin_amdgcn_permlane32_swap(gk.y, gk1.y, false, false);
    return (v4u){sx[0], sy[0], sx[1], sy[1]};
}
__device__ __forceinline__ void wide_to_pair(v4u w, v2u& gk, v2u& gk1) {
    const auto sx = __builtin_amdgcn_permlane32_swap(w.x, w.z, false, false), sy = __builtin_amdgcn_permlane32_swap(w.y, w.w, false, false);
    gk.x = sx[0]; gk.y = sy[0]; gk1.x = sx[1]; gk1.y = sy[1];
}
__device__ __forceinline__ void phase_gmlp(const Args& A, int li, LAS unsigned char* lds, int vcu, int G, int wave, int lane) {
    const bf16* Z = (const bf16*)(A.ws + WS_Z); bf16* Y = (bf16*)(A.ws + WS_Y);
    const bf16* wst = (const bf16*)(A.ws + WS_WS) + (size_t)li * 4 * 128 * 128;
    const float* lng = A.ln_g + li * 512; const float* lnb = A.ln_b + li * 512; const float* bs = A.b_s + li * 4 * 128;
    const int r32 = lane & 31, hi = lane >> 5, grp = lane >> 4, qq = (lane & 15) >> 2, pp = lane & 3;
    float gg[8], gb[8];
#pragma unroll
    for (int j = 0; j < 8; ++j) { gg[j] = lng[8 * lane + j]; gb[j] = lnb[8 * lane + j]; }
    for (int u = vcu; u < M / 128; u += G) {
        const size_t row0 = (size_t)u * 128;
#pragma unroll 1
        for (int r4 = 0; r4 < 16; r4 += 8) {
            v4u wv[8];
#pragma unroll
            for (int k = 0; k < 8; ++k) wv[k] = *(const v4u*)(Z + (row0 + wave * 16 + r4 + k) * EVEN_IN + 512 + 8 * lane);
#pragma unroll
            for (int k = 0; k < 8; ++k) {
                const int s = wave * 16 + r4 + k; const v4u w = wv[k];
                float x[8] = {bf_lo(w.x), bf_hi(w.x), bf_lo(w.y), bf_hi(w.y), bf_lo(w.z), bf_hi(w.z), bf_lo(w.w), bf_hi(w.w)};
                float sm = 0.f;
#pragma unroll
                for (int j = 0; j < 8; ++j) sm += x[j];
                const float mean = wave_sum(sm) * (1.f / 512.f); float sq = 0.f;
#pragma unroll
                for (int j = 0; j < 8; ++j) { x[j] -= mean; sq += x[j] * x[j]; }
                const float rstd = __builtin_amdgcn_rsqf(wave_sum(sq) * (1.f / 512.f) + NORM_EPS);
#pragma unroll
                for (int j = 0; j < 8; ++j) x[j] = x[j] * rstd * gg[j] + gb[j];
                v4u o; o.x = cvtpk_s(x[0], x[1]); o.y = cvtpk_s(x[2], x[3]); o.z = cvtpk_s(x[4], x[5]); o.w = cvtpk_s(x[6], x[7]);
                *(LAS v4u*)(lds + ((s >> 3) * 16 + (lane >> 2)) * 512 + (s & 7) * 64 + (lane & 3) * 16) = o;
            }
        }
        __syncthreads();
        const int g = wave >> 1;
#pragma unroll 1
        for (int t2 = 0; t2 < 2; ++t2) {
            const int tt = (wave & 1) * 2 + t2;
            f32x16 acc[4];
#pragma unroll
            for (int ct = 0; ct < 4; ++ct) acc[ct] = f32x16{};
            const bf16* wrow = wst + ((size_t)g * 128 + 32 * tt + r32) * 128 + 8 * hi;
            bf16x8 bw[8];
#pragma unroll
            for (int ks = 0; ks < 8; ++ks) bw[ks] = *(const bf16x8*)(wrow + 16 * ks);
#pragma unroll
            for (int ks = 0; ks < 8; ++ks) {
                const bf16x8 bfrag = bw[ks];
#pragma unroll
                for (int ct = 0; ct < 4; ++ct) {
                    const LAS unsigned char* p = lds + ((2 * ks + hi) * 16 + 4 * g + ct) * 512 + qq * 64 + (16 * (grp & 1) + 4 * pp) * 2;
                    const s16x4 lo = vtr(p), hi4 = vtr(p + 256);
                    const bf16x8 afrag = (bf16x8){lo[0], lo[1], lo[2], lo[3], hi4[0], hi4[1], hi4[2], hi4[3]};
                    acc[ct] = __builtin_amdgcn_mfma_f32_32x32x16_bf16(afrag, bfrag, acc[ct], 0, 0, 0);
                }
            }
            const int t = 32 * tt + r32; const size_t row = row0 + t; const float bias = bs[g * 128 + t];
            v2u ub[4][4], gb2[4][4];
#pragma unroll
            for (int ct = 0; ct < 4; ++ct)
#pragma unroll
                for (int pr = 0; pr < 2; ++pr) {
                    const int c = g * 128 + 32 * ct + 16 * pr + 8 * hi;
                    const v4u wu = *(const v4u*)(Z + row * EVEN_IN + c), wg = *(const v4u*)(Z + row * EVEN_IN + 1024 + c);
                    wide_to_pair(wu, ub[ct][2 * pr], ub[ct][2 * pr + 1]); wide_to_pair(wg, gb2[ct][2 * pr], gb2[ct][2 * pr + 1]);
                }
#pragma unroll
            for (int ct = 0; ct < 4; ++ct)
#pragma unroll
                for (int pr = 0; pr < 2; ++pr) {
                    v2u o2[2];
#pragma unroll
                    for (int k = 0; k < 2; ++k) {
                        const int rq = 2 * pr + k; const v2u uu = ub[ct][rq], ga = gb2[ct][rq];
                        const float y0 = bf_lo(uu.x) * (acc[ct][4 * rq + 0] + bias) * bf_lo(ga.x), y1 = bf_hi(uu.x) * (acc[ct][4 * rq + 1] + bias) * bf_hi(ga.x);
                        const float y2 = bf_lo(uu.y) * (acc[ct][4 * rq + 2] + bias) * bf_lo(ga.y), y3 = bf_hi(uu.y) * (acc[ct][4 * rq + 3] + bias) * bf_hi(ga.y);
                        o2[k].x = cvtpk_s(y0, y1); o2[k].y = cvtpk_s(y2, y3);
                    }
                    *(v4u*)(Y + row * D + g * 128 + 32 * ct + 16 * pr + 8 * hi) = pair_to_wide(o2[0], o2[1]);
                }
        }
        __syncthreads();
    }
}

struct AttnSt { f32x16 o0, o1; float m, l; };
template <class MaskF>
__device__ __forceinline__ void attn_tile(AttnSt& st, const bf16x8 (&qf)[4], const bf16* kp, const bf16* vp0, const bf16* vp1, const bf16* vp2, const bf16* vp3, LAS unsigned char* vl, int lane, bool domask, MaskF mask) {
    const int hi = lane >> 5, grp = lane >> 4, qq = (lane & 15) >> 2, pp = lane & 3;
    bf16x8 kf[4]; v4u vv[4];
#pragma unroll
    for (int d0 = 0; d0 < 4; ++d0) kf[d0] = *(const bf16x8*)(kp + 16 * d0);
    vv[0] = *(const v4u*)vp0; vv[1] = *(const v4u*)vp1; vv[2] = *(const v4u*)vp2; vv[3] = *(const v4u*)vp3;
    f32x16 s = f32x16{};
#pragma unroll
    for (int d0 = 0; d0 < 4; ++d0) s = __builtin_amdgcn_mfma_f32_32x32x16_bf16(kf[d0], qf[d0], s, 0, 0, 0);
#pragma unroll
    for (int it = 0; it < 4; ++it) *(LAS v4u*)(vl + (it * 2 + ((lane & 7) >> 2)) * 512 + (lane >> 3) * 64 + (lane & 3) * 16) = vv[it];
    if (domask) {
#pragma unroll
        for (int r = 0; r < 16; ++r) if (!mask(crow(r, hi))) s[r] = -INFINITY;
    }
    float mt = s[0];
#pragma unroll
    for (int r = 1; r < 16; ++r) mt = fmaxf(mt, s[r]);
    mt = fmaxf(mt, __shfl_xor(mt, 32));
    if (__any(mt > st.m + RESCALE_THR)) {
        const float mn = fmaxf(st.m, mt);
        const float f = __builtin_amdgcn_exp2f(st.m - mn); st.l *= f; st.m = mn;
#pragma unroll
        for (int r = 0; r < 16; ++r) { st.o0[r] *= f; st.o1[r] *= f; }
    }
    float ps = 0.f;
#pragma unroll
    for (int r = 0; r < 16; ++r) { s[r] = __builtin_amdgcn_exp2f(s[r] - st.m); ps += s[r]; }
    st.l += ps;
    v4u pw0, pw1;
    pw0.x = cvtpk_s(s[0], s[1]); pw0.y = cvtpk_s(s[2], s[3]); pw0.z = cvtpk_s(s[4], s[5]); pw0.w = cvtpk_s(s[6], s[7]);
    pw1.x = cvtpk_s(s[8], s[9]); pw1.y = cvtpk_s(s[10], s[11]); pw1.z = cvtpk_s(s[12], s[13]); pw1.w = cvtpk_s(s[14], s[15]);
    const bf16x8 pf0 = __builtin_bit_cast(bf16x8, pw0), pf1 = __builtin_bit_cast(bf16x8, pw1);
    const LAS unsigned char* tb = vl + (4 * hi + qq) * 64 + (16 * (grp & 1) + 4 * pp) * 2;
#define VFRAG(ks, d0) ({ const s16x4 lo_ = vtr(tb + ((2 * (ks)) * 2 + (d0)) * 512), hi_ = vtr(tb + ((2 * (ks) + 1) * 2 + (d0)) * 512); (bf16x8){lo_[0], lo_[1], lo_[2], lo_[3], hi_[0], hi_[1], hi_[2], hi_[3]}; })
    st.o0 = __builtin_amdgcn_mfma_f32_32x32x16_bf16(VFRAG(0, 0), pf0, st.o0, 0, 0, 0);
    st.o1 = __builtin_amdgcn_mfma_f32_32x32x16_bf16(VFRAG(0, 1), pf0, st.o1, 0, 0, 0);
    st.o0 = __builtin_amdgcn_mfma_f32_32x32x16_bf16(VFRAG(1, 0), pf1, st.o0, 0, 0, 0);
    st.o1 = __builtin_amdgcn_mfma_f32_32x32x16_bf16(VFRAG(1, 1), pf1, st.o1, 0, 0, 0);
#undef VFRAG
}
__device__ __forceinline__ void attn_store(const AttnSt& st, const bf16* grow, bf16* yrow, int lane) {
    const int hi = lane >> 5;
    const float lt = st.l + __shfl_xor(st.l, 32), inv = 1.0f / lt;
    v2u ga[2][4];
#pragma unroll
    for (int d0 = 0; d0 < 2; ++d0)
#pragma unroll
        for (int rq = 0; rq < 4; ++rq) ga[d0][rq] = *(const v2u*)(grow + 32 * d0 + 8 * rq + 4 * hi);
#pragma unroll
    for (int d0 = 0; d0 < 2; ++d0)
#pragma unroll
        for (int rq = 0; rq < 4; ++rq) {
            const int d = 32 * d0 + 8 * rq + 4 * hi;
            const v2u g = ga[d0][rq];
            const f32x16& o = d0 ? st.o1 : st.o0;
            v2u w; w.x = cvtpk_s(o[4 * rq + 0] * inv * bf_lo(g.x), o[4 * rq + 1] * inv * bf_hi(g.x)); w.y = cvtpk_s(o[4 * rq + 2] * inv * bf_lo(g.y), o[4 * rq + 3] * inv * bf_hi(g.y));
            *(v2u*)(yrow + d) = w;
        }
}

__device__ __forceinline__ void attn_gate_load(v2u (&ga)[2][4], const bf16* grow, int lane) {
    const int hi = lane >> 5;
#pragma unroll
    for (int d0 = 0; d0 < 2; ++d0)
#pragma unroll
        for (int pr = 0; pr < 2; ++pr) { const v4u w = *(const v4u*)(grow + 32 * d0 + 16 * pr + 8 * hi); wide_to_pair(w, ga[d0][2 * pr], ga[d0][2 * pr + 1]); }
}
__device__ __forceinline__ void attn_store_g(const AttnSt& st, const v2u (&ga)[2][4], bf16* yrow, int lane) {
    const int hi = lane >> 5;
    const float lt = st.l + __shfl_xor(st.l, 32), inv = 1.0f / lt;
#pragma unroll
    for (int d0 = 0; d0 < 2; ++d0)
#pragma unroll
        for (int pr = 0; pr < 2; ++pr) {
            v2u w2[2];
#pragma unroll
            for (int k = 0; k < 2; ++k) {
                const int rq = 2 * pr + k; const v2u g = ga[d0][rq]; const f32x16& o = d0 ? st.o1 : st.o0;
                w2[k].x = cvtpk_s(o[4 * rq + 0] * inv * bf_lo(g.x), o[4 * rq + 1] * inv * bf_hi(g.x)); w2[k].y = cvtpk_s(o[4 * rq + 2] * inv * bf_lo(g.y), o[4 * rq + 3] * inv * bf_hi(g.y));
            }
            *(v4u*)(yrow + 32 * d0 + 16 * pr + 8 * hi) = pair_to_wide(w2[0], w2[1]);
        }
}

struct TileRegs { v4u kk[4]; v4u vv[4]; };
__device__ __forceinline__ void attn_load(TileRegs& R, int kvoff, const bf16* vp0, const bf16* vp1, const bf16* vp2, const bf16* vp3) {
    R.kk[0] = *(const v4u*)(vp0 - kvoff); R.kk[1] = *(const v4u*)(vp1 - kvoff); R.kk[2] = *(const v4u*)(vp2 - kvoff); R.kk[3] = *(const v4u*)(vp3 - kvoff);
    R.vv[0] = *(const v4u*)vp0; R.vv[1] = *(const v4u*)vp1; R.vv[2] = *(const v4u*)vp2; R.vv[3] = *(const v4u*)vp3;
}
__device__ __forceinline__ void attn_load_k(TileRegs& R, int kvoff, const bf16* vp0, const bf16* vp1, const bf16* vp2, const bf16* vp3) {
    R.kk[0] = *(const v4u*)(vp0 - kvoff); R.kk[1] = *(const v4u*)(vp1 - kvoff); R.kk[2] = *(const v4u*)(vp2 - kvoff); R.kk[3] = *(const v4u*)(vp3 - kvoff);
}
__device__ __forceinline__ void attn_load_v(TileRegs& R, const bf16* vp0, const bf16* vp1, const bf16* vp2, const bf16* vp3) {
    R.vv[0] = *(const v4u*)vp0; R.vv[1] = *(const v4u*)vp1; R.vv[2] = *(const v4u*)vp2; R.vv[3] = *(const v4u*)vp3;
}
template <int MODE>
__device__ __forceinline__ void attn_compute(AttnSt& st, const bf16x8 (&qf)[4], const TileRegs& R, LAS unsigned char* vl, int lane, bool keep, int dd0, int kmin) {
    const int r32 = lane & 31, hi = lane >> 5, grp = lane >> 4, qq = (lane & 15) >> 2, pp = lane & 3;
    LAS unsigned char* kl = vl + 32768;
#pragma unroll
    for (int it = 0; it < 4; ++it) { const int row = it * 8 + (lane >> 3); *(LAS v4u*)(kl + row * 128 + (((lane & 7) ^ (row & 7)) << 4)) = R.kk[it]; }
#pragma unroll
    for (int it = 0; it < 4; ++it) *(LAS v4u*)(vl + (it * 2 + ((lane & 7) >> 2)) * 512 + (lane >> 3) * 64 + (lane & 3) * 16) = R.vv[it];
    f32x16 s = f32x16{};
#pragma unroll
    for (int d0 = 0; d0 < 4; ++d0) {
        const v4u kw = *(const LAS v4u*)(kl + r32 * 128 + (((2 * d0 + hi) ^ (r32 & 7)) << 4));
        s = __builtin_amdgcn_mfma_f32_32x32x16_bf16(__builtin_bit_cast(bf16x8, kw), qf[d0], s, 0, 0, 0);
    }
    if (MODE == 1) {
#pragma unroll
        for (int r = 0; r < 16; ++r) if (crow(r, hi) > r32) s[r] = -INFINITY;
    } else if (MODE == 2) {
#pragma unroll
        for (int r = 0; r < 16; ++r) s[r] = keep ? s[r] : -INFINITY;
    } else if (MODE == 3) {
        const int ddh = dd0 - 4 * hi, kmh = kmin - 4 * hi;
#pragma unroll
        for (int r = 0; r < 16; ++r) { const int c = (r & 3) + 8 * (r >> 2); if ((unsigned)(ddh - c) > 128u || c < kmh) s[r] = -INFINITY; }
    }
    float mt = s[0];
#pragma unroll
    for (int r = 1; r < 16; ++r) mt = fmaxf(mt, s[r]);
    mt = fmaxf(mt, __shfl_xor(mt, 32));
    if (__any(mt > st.m + RESCALE_THR)) {
        const float mn = fmaxf(st.m, mt);
        const float f = __builtin_amdgcn_exp2f(st.m - mn); st.l *= f; st.m = mn;
#pragma unroll
        for (int r = 0; r < 16; ++r) { st.o0[r] *= f; st.o1[r] *= f; }
    }
    float ps = 0.f;
#pragma unroll
    for (int r = 0; r < 16; ++r) { s[r] = __builtin_amdgcn_exp2f(s[r] - st.m); ps += s[r]; }
    st.l += ps;
    v4u pw0, pw1;
    pw0.x = cvtpk_s(s[0], s[1]); pw0.y = cvtpk_s(s[2], s[3]); pw0.z = cvtpk_s(s[4], s[5]); pw0.w = cvtpk_s(s[6], s[7]);
    pw1.x = cvtpk_s(s[8], s[9]); pw1.y = cvtpk_s(s[10], s[11]); pw1.z = cvtpk_s(s[12], s[13]); pw1.w = cvtpk_s(s[14], s[15]);
    const bf16x8 pf0 = __builtin_bit_cast(bf16x8, pw0), pf1 = __builtin_bit_cast(bf16x8, pw1);
    const LAS unsigned char* tb = vl + (4 * hi + qq) * 64 + (16 * (grp & 1) + 4 * pp) * 2;
#define VFRAG(ks, d0) ({ const s16x4 lo_ = vtr(tb + ((2 * (ks)) * 2 + (d0)) * 512), hi_ = vtr(tb + ((2 * (ks) + 1) * 2 + (d0)) * 512); (bf16x8){lo_[0], lo_[1], lo_[2], lo_[3], hi_[0], hi_[1], hi_[2], hi_[3]}; })
    st.o0 = __builtin_amdgcn_mfma_f32_32x32x16_bf16(VFRAG(0, 0), pf0, st.o0, 0, 0, 0);
    st.o1 = __builtin_amdgcn_mfma_f32_32x32x16_bf16(VFRAG(0, 1), pf0, st.o1, 0, 0, 0);
    st.o0 = __builtin_amdgcn_mfma_f32_32x32x16_bf16(VFRAG(1, 0), pf1, st.o0, 0, 0, 0);
    st.o1 = __builtin_amdgcn_mfma_f32_32x32x16_bf16(VFRAG(1, 1), pf1, st.o1, 0, 0, 0);
#undef VFRAG
}

template <class MaskF>
__device__ __forceinline__ void attn_subtile_lds(AttnSt& st, const bf16x8 (&qf)[4], const LAS unsigned char* kb, const LAS unsigned char* vl, int lane, bool domask, MaskF mask) {
    const int r32 = lane & 31, hi = lane >> 5, grp = lane >> 4, qq = (lane & 15) >> 2, pp = lane & 3;
    f32x16 s = f32x16{};
#pragma unroll
    for (int d0 = 0; d0 < 4; ++d0) {
        const bf16x8 kf = *(const LAS bf16x8*)(kb + r32 * 128 + (((2 * d0 + hi) ^ (r32 & 7)) << 4));
        s = __builtin_amdgcn_mfma_f32_32x32x16_bf16(kf, qf[d0], s, 0, 0, 0);
    }
    if (domask) {
#pragma unroll
        for (int r = 0; r < 16; ++r) if (!mask(crow(r, hi))) s[r] = -INFINITY;
    }
    float mt = s[0];
#pragma unroll
    for (int r = 1; r < 16; ++r) mt = fmaxf(mt, s[r]);
    mt = fmaxf(mt, __shfl_xor(mt, 32));
    if (__any(mt > st.m + RESCALE_THR)) {
        const float mn = fmaxf(st.m, mt);
        const float f = __builtin_amdgcn_exp2f(st.m - mn); st.l *= f; st.m = mn;
#pragma unroll
        for (int r = 0; r < 16; ++r) { st.o0[r] *= f; st.o1[r] *= f; }
    }
    float ps = 0.f;
#pragma unroll
    for (int r = 0; r < 16; ++r) { s[r] = __builtin_amdgcn_exp2f(s[r] - st.m); ps += s[r]; }
    st.l += ps;
    v4u pw0, pw1;
    pw0.x = cvtpk_s(s[0], s[1]); pw0.y = cvtpk_s(s[2], s[3]); pw0.z = cvtpk_s(s[4], s[5]); pw0.w = cvtpk_s(s[6], s[7]);
    pw1.x = cvtpk_s(s[8], s[9]); pw1.y = cvtpk_s(s[10], s[11]); pw1.z = cvtpk_s(s[12], s[13]); pw1.w = cvtpk_s(s[14], s[15]);
    const bf16x8 pf0 = __builtin_bit_cast(bf16x8, pw0), pf1 = __builtin_bit_cast(bf16x8, pw1);
    const LAS unsigned char* tb = vl + (4 * hi + qq) * 64 + (16 * (grp & 1) + 4 * pp) * 2;
#define VFRAG(ks, d0) ({ const s16x4 lo_ = vtr(tb + ((2 * (ks)) * 2 + (d0)) * 512), hi_ = vtr(tb + ((2 * (ks) + 1) * 2 + (d0)) * 512); (bf16x8){lo_[0], lo_[1], lo_[2], lo_[3], hi_[0], hi_[1], hi_[2], hi_[3]}; })
    st.o0 = __builtin_amdgcn_mfma_f32_32x32x16_bf16(VFRAG(0, 0), pf0, st.o0, 0, 0, 0);
    st.o1 = __builtin_amdgcn_mfma_f32_32x32x16_bf16(VFRAG(0, 1), pf0, st.o1, 0, 0, 0);
    st.o0 = __builtin_amdgcn_mfma_f32_32x32x16_bf16(VFRAG(1, 0), pf1, st.o0, 0, 0, 0);
    st.o1 = __builtin_amdgcn_mfma_f32_32x32x16_bf16(VFRAG(1, 1), pf1, st.o1, 0, 0, 0);
#undef VFRAG
}
template <int M0, int M1>
__device__ __forceinline__ void attn_tile64_lds(AttnSt& st, const bf16x8 (&qf)[4], const LAS unsigned char* kb, const LAS unsigned char* vb, int lane, bool keep) {
    const int r32 = lane & 31, hi = lane >> 5, grp = lane >> 4, qq = (lane & 15) >> 2, pp = lane & 3;
    f32x16 s0 = f32x16{}, s1 = f32x16{};
#pragma unroll
    for (int d0 = 0; d0 < 4; ++d0) {
        const int ko = r32 * 128 + (((2 * d0 + hi) ^ (r32 & 7)) << 4);
        const v4u k0 = *(const LAS v4u*)(kb + ko), k1 = *(const LAS v4u*)(kb + 4096 + ko);
        s0 = __builtin_amdgcn_mfma_f32_32x32x16_bf16(__builtin_bit_cast(bf16x8, k0), qf[d0], s0, 0, 0, 0);
        s1 = __builtin_amdgcn_mfma_f32_32x32x16_bf16(__builtin_bit_cast(bf16x8, k1), qf[d0], s1, 0, 0, 0);
    }
    if (M0 == 1 || M1 == 1) {
#pragma unroll
        for (int r = 0; r < 16; ++r) {
            if (M0 == 1) { if (crow(r, hi) > r32) s0[r] = -INFINITY; }
            if (M1 == 1) { if (crow(r, hi) > r32) s1[r] = -INFINITY; }
        }
    }
    float mt = fmaxf(s0[0], s1[0]);
#pragma unroll
    for (int r = 1; r < 16; ++r) mt = fmaxf(mt, fmaxf(s0[r], s1[r]));
    mt = fmaxf(mt, __shfl_xor(mt, 32));
    if (__any(mt > st.m + RESCALE_THR)) {
        const float mn = fmaxf(st.m, mt);
        const float f = __builtin_amdgcn_exp2f(st.m - mn); st.l *= f; st.m = mn;
#pragma unroll
        for (int r = 0; r < 16; ++r) { st.o0[r] *= f; st.o1[r] *= f; }
    }
    const float mo = (M0 == 2 && !keep) ? INFINITY : st.m;
    const f32x2_t mo2 = {mo, mo}; f32x2_t acc2 = {0.f, 0.f};
#pragma unroll
    for (int r = 0; r < 16; r += 2) {
        f32x2_t v0 = (f32x2_t){s0[r], s0[r + 1]} - mo2, v1 = (f32x2_t){s1[r], s1[r + 1]} - mo2;
        v0.x = __builtin_amdgcn_exp2f(v0.x); v0.y = __builtin_amdgcn_exp2f(v0.y); v1.x = __builtin_amdgcn_exp2f(v1.x); v1.y = __builtin_amdgcn_exp2f(v1.y);
        acc2 += v0; acc2 += v1;
        s0[r] = v0.x; s0[r + 1] = v0.y; s1[r] = v1.x; s1[r + 1] = v1.y;
    }
    st.l += acc2.x + acc2.y;
    v4u p00, p01, p10, p11;
    p00.x = cvtpk_s(s0[0], s0[1]); p00.y = cvtpk_s(s0[2], s0[3]); p00.z = cvtpk_s(s0[4], s0[5]); p00.w = cvtpk_s(s0[6], s0[7]);
    p01.x = cvtpk_s(s0[8], s0[9]); p01.y = cvtpk_s(s0[10], s0[11]); p01.z = cvtpk_s(s0[12], s0[13]); p01.w = cvtpk_s(s0[14], s0[15]);
    p10.x = cvtpk_s(s1[0], s1[1]); p10.y = cvtpk_s(s1[2], s1[3]); p10.z = cvtpk_s(s1[4], s1[5]); p10.w = cvtpk_s(s1[6], s1[7]);
    p11.x = cvtpk_s(s1[8], s1[9]); p11.y = cvtpk_s(s1[10], s1[11]); p11.z = cvtpk_s(s1[12], s1[13]); p11.w = cvtpk_s(s1[14], s1[15]);
    const bf16x8 f00 = __builtin_bit_cast(bf16x8, p00), f01 = __builtin_bit_cast(bf16x8, p01), f10 = __builtin_bit_cast(bf16x8, p10), f11 = __builtin_bit_cast(bf16x8, p11);
    const LAS unsigned char* tb = vb + (4 * hi + qq) * 64 + (16 * (grp & 1) + 4 * pp) * 2;
#define VFRAG(sub, ks, d0) ({ const s16x4 lo_ = vtr(tb + (sub) * 4096 + ((2 * (ks)) * 2 + (d0)) * 512), hi_ = vtr(tb + (sub) * 4096 + ((2 * (ks) + 1) * 2 + (d0)) * 512); (bf16x8){lo_[0], lo_[1], lo_[2], lo_[3], hi_[0], hi_[1], hi_[2], hi_[3]}; })
    st.o0 = __builtin_amdgcn_mfma_f32_32x32x16_bf16(VFRAG(0, 0, 0), f00, st.o0, 0, 0, 0);
    st.o1 = __builtin_amdgcn_mfma_f32_32x32x16_bf16(VFRAG(0, 0, 1), f00, st.o1, 0, 0, 0);
    st.o0 = __builtin_amdgcn_mfma_f32_32x32x16_bf16(VFRAG(0, 1, 0), f01, st.o0, 0, 0, 0);
    st.o1 = __builtin_amdgcn_mfma_f32_32x32x16_bf16(VFRAG(0, 1, 1), f01, st.o1, 0, 0, 0);
    st.o0 = __builtin_amdgcn_mfma_f32_32x32x16_bf16(VFRAG(1, 0, 0), f10, st.o0, 0, 0, 0);
    st.o1 = __builtin_amdgcn_mfma_f32_32x32x16_bf16(VFRAG(1, 0, 1), f10, st.o1, 0, 0, 0);
    st.o0 = __builtin_amdgcn_mfma_f32_32x32x16_bf16(VFRAG(1, 1, 0), f11, st.o0, 0, 0, 0);
    st.o1 = __builtin_amdgcn_mfma_f32_32x32x16_bf16(VFRAG(1, 1, 1), f11, st.o1, 0, 0, 0);
#undef VFRAG
}
__device__ __forceinline__ void phase_moba_s(const Args& A, LAS unsigned char* lds, int G, int vcu, int wave, int lane) {
    const bf16* Z = (const bf16*)(A.ws + WS_Z); bf16* Y = (bf16*)(A.ws + WS_Y); const float* kmp = (const float*)(A.ws + WS_KMP);
    const int r32 = lane & 31, hi = lane >> 5, tid = wave * 64 + lane;
    const int skey = tid >> 3, sch = tid & 7;
    const int kwoff = skey * 128 + ((sch ^ (skey & 7)) << 4);
    const int vwoff = ((skey >> 3) * 2 + (sch >> 2)) * 512 + (skey & 7) * 64 + (sch & 3) * 16;
    for (int U = vcu; U < 2048; U += G) {
        const int it8 = U >> 8, v = U & 255, j = v & 7;
        const int blk = (it8 & 1) ? 15 - j : j, bh = (v >> 3) * 4 + (it8 >> 1);
        const int b = bh >> 3, hh = bh & 7, q0 = blk * 256 + 32 * wave;
        const size_t rowbase = (size_t)b * SEQ;
        const bf16* zq = Z + (rowbase + q0 + r32) * EVEN_IN;
        const bf16* Kh = Z + rowbase * EVEN_IN + 2048 + hh * 64 + (size_t)skey * EVEN_IN + 8 * sch; const bf16* Vh = Kh + 512;
        v4u kreg = *(const v4u*)(Kh + (size_t)(blk * 256) * EVEN_IN), vreg = *(const v4u*)(Vh + (size_t)(blk * 256) * EVEN_IN);
        bf16x8 qf[4];
#pragma unroll
        for (int d0 = 0; d0 < 4; ++d0) qf[d0] = *(const bf16x8*)(zq + 1536 + hh * 64 + 16 * d0 + 8 * hi);
        v2u gg[2][4]; attn_gate_load(gg, zq + 3072 + hh * 64, lane);
        unsigned sel = 0u;
        if (blk > 0) {
            f32x16 gt = f32x16{};
#pragma unroll
            for (int d0 = 0; d0 < 4; ++d0) {
                bf16x8 kmf = bf16x8{};
                if (r32 < 16) {
                    const float* p0 = kmp + (((size_t)b * 16 + r32) * 2) * 512 + hh * 64 + 16 * d0 + 8 * hi;
                    const f32x4 a0 = *(const f32x4*)p0, a1 = *(const f32x4*)(p0 + 4), b0 = *(const f32x4*)(p0 + 512), b1 = *(const f32x4*)(p0 + 516);
                    const f32x4 s0 = a0 + b0, s1 = a1 + b1;
                    v4u w; w.x = pk2(s0[0], s0[1]); w.y = pk2(s0[2], s0[3]); w.z = pk2(s1[0], s1[1]); w.w = pk2(s1[2], s1[3]);
                    kmf = __builtin_bit_cast(bf16x8, w);
                }
                gt = __builtin_amdgcn_mfma_f32_32x32x16_bf16(kmf, qf[d0], gt, 0, 0, 0);
            }
            float gv[16];
#pragma unroll
            for (int r = 0; r < 8; ++r) {
                const float mine = gt[r], oth = __shfl_xor(mine, 32);
                const float vlo = hi ? oth : mine, vhi = hi ? mine : oth;
                gv[(r & 3) + 8 * (r >> 2)] = vlo; gv[(r & 3) + 8 * (r >> 2) + 4] = vhi;
            }
#pragma unroll
            for (int n = 0; n < 16; ++n) if (n >= blk) gv[n] = -INFINITY;
#pragma unroll
            for (int it = 0; it < 3; ++it) {
                float best = -INFINITY; int bi = -1;
#pragma unroll
                for (int n = 0; n < 16; ++n) { const bool ok = (gv[n] > best) && !((sel >> n) & 1u); best = ok ? gv[n] : best; bi = ok ? n : bi; }
                if (bi >= 0) sel |= 1u << bi;
            }
        }
        AttnSt st; st.o0 = f32x16{}; st.o1 = f32x16{}; st.m = -1e30f; st.l = 0.f;
#define MB_LOAD(key0_) do { kreg = *(const v4u*)(Kh + (size_t)(key0_) * EVEN_IN); vreg = *(const v4u*)(Vh + (size_t)(key0_) * EVEN_IN); } while (0)
#define MB_STORE(buf_) do { *(LAS v4u*)(lds + (buf_) * 8192 + kwoff) = kreg; *(LAS v4u*)(lds + 16384 + (buf_) * 8192 + vwoff) = vreg; } while (0)
        MB_STORE(0);
        __syncthreads();
#pragma unroll 1
        for (int t = 0; t < 4; ++t) {
            const int buf = t & 1;
            if (t < 3) MB_LOAD(blk * 256 + 64 * (t + 1)); else if (blk > 0) MB_LOAD(0);
            const LAS unsigned char* kb = lds + buf * 8192; const LAS unsigned char* vb = lds + 16384 + buf * 8192;
            if (2 * t + 1 < wave) attn_tile64_lds<0, 0>(st, qf, kb, vb, lane, true);
            else if (2 * t + 1 == wave) attn_tile64_lds<0, 1>(st, qf, kb, vb, lane, true);
            else if (2 * t == wave) attn_subtile_lds(st, qf, kb, vb, lane, true, [&](int kk) { return kk <= r32; });
            if (t < 3 || blk > 0) MB_STORE(buf ^ 1);
            __syncthreads();
        }
        const int P = 4 * blk;
#pragma unroll 1
        for (int p = 0; p < P; ++p) {
            const int buf = p & 1;
            if (p + 1 < P) MB_LOAD(64 * (p + 1));
            const LAS unsigned char* kb = lds + buf * 8192; const LAS unsigned char* vb = lds + 16384 + buf * 8192;
            const bool mysel = (sel >> (p >> 2)) & 1u;
            if (__any(mysel)) {
                attn_tile64_lds<2, 2>(st, qf, kb, vb, lane, mysel);
            }
            if (p + 1 < P) MB_STORE(buf ^ 1);
            __syncthreads();
        }
#undef MB_LOAD
#undef MB_STORE
        attn_store_g(st, gg, Y + (rowbase + q0 + r32) * D + 512 + hh * 64, lane);
    }
}

__device__ __forceinline__ void phase_moba_old(const Args& A, LAS unsigned char* lds, int gwv, int NGW, int wave, int lane) {
    const bf16* Z = (const bf16*)(A.ws + WS_Z); bf16* Y = (bf16*)(A.ws + WS_Y); const float* kmp = (const float*)(A.ws + WS_KMP);
    LAS unsigned char* vl = lds + wave * 4096;
    const int r32 = lane & 31, hi = lane >> 5;
#ifdef OLD_NEWMAP
    for (int U = gwv >> 3; U < 2048; U += NGW >> 3) {
        const int it8 = U >> 8, v = U & 255, j = v & 7;
        const int blk = (it8 & 1) ? 15 - j : j, bh = (v >> 3) * 4 + (it8 >> 1);
        const int b = bh >> 3, hh = bh & 7, q0 = blk * 256 + 32 * wave;
#else
    for (int U = gwv; U < 16384; U += NGW) {
        const int rd = U >> 11, g2 = U & 2047, X = g2 >> 8, lwv = g2 & 255;
        const int bh = 16 * X + 2 * rd + (lwv >> 7); int gi = lwv & 127; if (rd & 1) gi = 127 - gi;
        const int b = bh >> 3, hh = bh & 7, q0 = gi * 32, blk = q0 >> 8;
#endif
        const size_t rowbase = (size_t)b * SEQ;
        const bf16* zq = Z + (rowbase + q0 + r32) * EVEN_IN;
        bf16x8 qf[4];
#pragma unroll
        for (int d0 = 0; d0 < 4; ++d0) qf[d0] = *(const bf16x8*)(zq + 1536 + hh * 64 + 16 * d0 + 8 * hi);
        unsigned sel = 0u;
        if (blk > 0) {
            f32x16 gt = f32x16{};
#pragma unroll
            for (int d0 = 0; d0 < 4; ++d0) {
                bf16x8 kmf = bf16x8{};
                if (r32 < 16) {
                    const float* p0 = kmp + (((size_t)b * 16 + r32) * 2) * 512 + hh * 64 + 16 * d0 + 8 * hi;
                    const f32x4 a0 = *(const f32x4*)p0, a1 = *(const f32x4*)(p0 + 4), b0 = *(const f32x4*)(p0 + 512), b1 = *(const f32x4*)(p0 + 516);
                    const f32x4 s0 = a0 + b0, s1 = a1 + b1;
                    v4u w; w.x = pk2(s0[0], s0[1]); w.y = pk2(s0[2], s0[3]); w.z = pk2(s1[0], s1[1]); w.w = pk2(s1[2], s1[3]);
                    kmf = __builtin_bit_cast(bf16x8, w);
                }
                gt = __builtin_amdgcn_mfma_f32_32x32x16_bf16(kmf, qf[d0], gt, 0, 0, 0);
            }
            float gv[16];
#pragma unroll
            for (int r = 0; r < 8; ++r) {
                const float mine = gt[r], oth = __shfl_xor(mine, 32);
                const float vlo = hi ? oth : mine, vhi = hi ? mine : oth;
                gv[(r & 3) + 8 * (r >> 2)] = vlo; gv[(r & 3) + 8 * (r >> 2) + 4] = vhi;
            }
#pragma unroll
            for (int n = 0; n < 16; ++n) if (n >= blk) gv[n] = -INFINITY;
#pragma unroll
            for (int it = 0; it < 3; ++it) {
                float best = -INFINITY; int bi = -1;
#pragma unroll
                for (int n = 0; n < 16; ++n) { const bool ok = (gv[n] > best) && !((sel >> n) & 1u); best = ok ? gv[n] : best; bi = ok ? n : bi; }
                if (bi >= 0) sel |= 1u << bi;
            }
        }
        AttnSt st; st.o0 = f32x16{}; st.o1 = f32x16{}; st.m = -1e30f; st.l = 0.f;
        const bf16* Kh = Z + rowbase * EVEN_IN + 2048 + hh * 64; const bf16* Vh = Z + rowbase * EVEN_IN + 2560 + hh * 64;
        const size_t vrow8 = (size_t)8 * EVEN_IN;
        const int ndiag = (q0 & 255) >> 5;
        for (int kt = 0; kt <= ndiag; ++kt) {
            const size_t k0 = (size_t)blk * 256 + kt * 32;
            const bf16* vp = Vh + (k0 + (lane >> 3)) * EVEN_IN + 8 * (lane & 7);
            attn_tile(st, qf, Kh + (k0 + r32) * EVEN_IN + 8 * hi, vp, vp + vrow8, vp + 2 * vrow8, vp + 3 * vrow8, vl, lane, kt == ndiag, [&](int kk) { return kk <= r32; });
        }
        for (int n = 0; n < blk; ++n) {
            const bool mysel = (sel >> n) & 1u;
            if (!__any(mysel)) continue;
            for (int kt = 0; kt < 8; ++kt) {
                const size_t k0 = (size_t)n * 256 + kt * 32;
                const bf16* vp = Vh + (k0 + (lane >> 3)) * EVEN_IN + 8 * (lane & 7);
                attn_tile(st, qf, Kh + (k0 + r32) * EVEN_IN + 8 * hi, vp, vp + vrow8, vp + 2 * vrow8, vp + 3 * vrow8, vl, lane, true, [&](int) { return mysel; });
            }
        }
        attn_store(st, zq + 3072 + hh * 64, Y + (rowbase + q0 + r32) * D + 512 + hh * 64, lane);
    }
}


__device__ __forceinline__ void phase_moba_p(const Args& A, LAS unsigned char* lds, int gwv, int NGW, int wave, int lane) {
    const bf16* Z = (const bf16*)(A.ws + WS_Z); bf16* Y = (bf16*)(A.ws + WS_Y); const float* kmp = (const float*)(A.ws + WS_KMP);
    LAS unsigned char* vl = lds + wave * 4096;
    const int r32 = lane & 31, hi = lane >> 5;
    for (int U = gwv; U < 16384; U += NGW) {
        const int rd = U >> 11, g2 = U & 2047, X = g2 >> 8, lwv = g2 & 255;
        const int bh = 16 * X + 2 * rd + (lwv >> 7); int gi = lwv & 127; if (rd & 1) gi = 127 - gi;
        const int b = bh >> 3, hh = bh & 7, q0 = gi * 32, blk = q0 >> 8;
        const size_t rowbase = (size_t)b * SEQ;
        const bf16* zq = Z + (rowbase + q0 + r32) * EVEN_IN;
        bf16x8 qf[4];
#pragma unroll
        for (int d0 = 0; d0 < 4; ++d0) qf[d0] = *(const bf16x8*)(zq + 1536 + hh * 64 + 16 * d0 + 8 * hi);
        unsigned sel = 0u;
        if (blk > 0) {
            f32x16 gt = f32x16{};
#pragma unroll
            for (int d0 = 0; d0 < 4; ++d0) {
                bf16x8 kmf = bf16x8{};
                if (r32 < 16) {
                    const float* p0 = kmp + (((size_t)b * 16 + r32) * 2) * 512 + hh * 64 + 16 * d0 + 8 * hi;
                    const f32x4 a0 = *(const f32x4*)p0, a1 = *(const f32x4*)(p0 + 4), b0 = *(const f32x4*)(p0 + 512), b1 = *(const f32x4*)(p0 + 516);
                    const f32x4 s0 = a0 + b0, s1 = a1 + b1;
                    v4u w; w.x = pk2(s0[0], s0[1]); w.y = pk2(s0[2], s0[3]); w.z = pk2(s1[0], s1[1]); w.w = pk2(s1[2], s1[3]);
                    kmf = __builtin_bit_cast(bf16x8, w);
                }
                gt = __builtin_amdgcn_mfma_f32_32x32x16_bf16(kmf, qf[d0], gt, 0, 0, 0);
            }
            float gv[16];
#pragma unroll
            for (int r = 0; r < 8; ++r) {
                const float mine = gt[r], oth = __shfl_xor(mine, 32);
                const float vlo = hi ? oth : mine, vhi = hi ? mine : oth;
                gv[(r & 3) + 8 * (r >> 2)] = vlo; gv[(r & 3) + 8 * (r >> 2) + 4] = vhi;
            }
#pragma unroll
            for (int n = 0; n < 16; ++n) if (n >= blk) gv[n] = -INFINITY;
#pragma unroll
            for (int it = 0; it < 3; ++it) {
                float best = -INFINITY; int bi = -1;
#pragma unroll
                for (int n = 0; n < 16; ++n) { const bool ok = (gv[n] > best) && !((sel >> n) & 1u); best = ok ? gv[n] : best; bi = ok ? n : bi; }
                if (bi >= 0) sel |= 1u << bi;
            }
        }
        unsigned anym = 0u;
#pragma unroll
        for (int n = 0; n < 15; ++n) if (__any((sel >> n) & 1u)) anym |= 1u << n;
        anym = (unsigned)__builtin_amdgcn_readfirstlane((int)anym);
        AttnSt st; st.o0 = f32x16{}; st.o1 = f32x16{}; st.m = -1e30f; st.l = 0.f;
        const bf16* Kh = Z + rowbase * EVEN_IN + 2048 + hh * 64; const bf16* Vh = Z + rowbase * EVEN_IN + 2560 + hh * 64;
        const size_t vrow8 = (size_t)8 * EVEN_IN;
        const int ndiag = (q0 & 255) >> 5;
#define MB_LOADT(R, nn, kk_) do { const size_t k0_ = (size_t)((nn) < 0 ? blk : (nn)) * 256 + (kk_) * 32; const bf16* vp_ = Vh + (k0_ + (lane >> 3)) * EVEN_IN + 8 * (lane & 7); \
            attn_load(R, 512, vp_, vp_ + vrow8, vp_ + 2 * vrow8, vp_ + 3 * vrow8); } while (0)
#define MB_COMP(R, nn, kk_) do { if ((nn) < 0) { if ((kk_) == ndiag) attn_compute<1>(st, qf, R, vl, lane, true, 0, 0); else attn_compute<0>(st, qf, R, vl, lane, true, 0, 0); } \
            else attn_compute<2>(st, qf, R, vl, lane, ((sel >> (nn)) & 1u) != 0u, 0, 0); } while (0)
#define MB_ADV(nn, kk_, more) do { more = true; if ((nn) < 0) { if ((kk_) < ndiag) ++(kk_); else { (kk_) = 0; if (anym) (nn) = __builtin_ctz(anym); else more = false; } } \
            else if ((kk_) < 7) ++(kk_); else { (kk_) = 0; const unsigned rest_ = anym & ~((2u << (nn)) - 1u); if (rest_) (nn) = __builtin_ctz(rest_); else more = false; } } while (0)
        TileRegs RA, RB; int cn = -1, ck = 0;
        MB_LOADT(RA, cn, ck);
        for (;;) {
            int nn = cn, nk = ck; bool more; MB_ADV(nn, nk, more);
            if (more) MB_LOADT(RB, nn, nk);
            MB_COMP(RA, cn, ck);
            if (!more) break;
            cn = nn; ck = nk; MB_ADV(nn, nk, more);
            if (more) MB_LOADT(RA, nn, nk);
            MB_COMP(RB, cn, ck);
            if (!more) break;
            cn = nn; ck = nk;
        }
#undef MB_LOADT
#undef MB_COMP
#undef MB_ADV
        attn_store(st, zq + 3072 + hh * 64, Y + (rowbase + q0 + r32) * D + 512 + hh * 64, lane);
    }
}

__device__ __forceinline__ void phase_dilated_p(const Args& A, LAS unsigned char* lds, int gwv, int NGW, int wave, int lane) {
    const bf16* Z = (const bf16*)(A.ws + WS_Z); bf16* Y = (bf16*)(A.ws + WS_Y);
    LAS unsigned char* vl = lds + wave * 4096;
    const int r32 = lane & 31, hi = lane >> 5;
    for (int U = gwv; U < 32768; U += NGW) {
        const int rd = U >> 11, g2 = U & 2047, X = g2 >> 8, lwv = g2 & 255;
        const int bh = 32 * X + 2 * rd + (lwv >> 7), gi = lwv & 127, c = gi >> 4, r16 = gi & 15;
        const int b = bh >> 4, hh = bh & 15;
        const size_t rowbase = (size_t)b * SEQ;
        const int tq = 512 * c + r16 + 16 * r32;
        const bf16* zq = Z + (rowbase + tq) * ODD_IN;
        bf16x8 qf[4];
#pragma unroll
        for (int d0 = 0; d0 < 4; ++d0) qf[d0] = *(const bf16x8*)(zq + hh * 64 + 16 * d0 + 8 * hi);
        AttnSt st; st.o0 = f32x16{}; st.o1 = f32x16{}; st.m = -1e30f; st.l = 0.f;
        const bf16* Kh = Z + rowbase * ODD_IN + 1024 + hh * 64; const bf16* Vh = Z + rowbase * ODD_IN + 2048 + hh * 64;
#define DL_DIL(cfg) ((cfg) == 0 ? 16 : (cfg) == 1 ? 4 : 1)
#define DL_NT(cfg) ((cfg) == 0 ? 5 : (cfg) == 1 ? 8 : 20)
#define DL_MBASE(cfg) ((512 * c + r16 - (r16 & (DL_DIL(cfg) - 1))) / DL_DIL(cfg) - 128)
#define DL_TAU0(cfg) (DL_MBASE(cfg) < 0 ? (-DL_MBASE(cfg)) / 32 : 0)
#define DL_LOADT(R, cfg, tau) do { const int dil_ = DL_DIL(cfg), rdl_ = r16 & (dil_ - 1), m0_ = DL_MBASE(cfg) + 32 * (tau); \
            const int mv_ = m0_ + (lane >> 3); const int mv0_ = mv_ < 0 ? 0 : mv_, mv1_ = mv_ + 8 < 0 ? 0 : mv_ + 8, mv2_ = mv_ + 16 < 0 ? 0 : mv_ + 16, mv3_ = mv_ + 24 < 0 ? 0 : mv_ + 24; \
            const bf16* vb_ = Vh + (size_t)rdl_ * ODD_IN + 8 * (lane & 7); const size_t vst_ = (size_t)dil_ * ODD_IN; \
            attn_load(R, 1024, vb_ + mv0_ * vst_, vb_ + mv1_ * vst_, vb_ + mv2_ * vst_, vb_ + mv3_ * vst_); } while (0)
#define DL_COMP(R, cfg, tau) do { const int m0_ = DL_MBASE(cfg) + 32 * (tau); \
            if ((cfg) == 0 && (tau) >= 1 && (tau) <= 3 && m0_ >= 0) attn_compute<0>(st, qf, R, vl, lane, true, 0, 0); \
            else attn_compute<3>(st, qf, R, vl, lane, true, 128 + (16 / DL_DIL(cfg)) * r32 - 32 * (tau), -m0_); } while (0)
#define DL_ADV(cfg, tau, more) do { more = true; if ((tau) + 1 < DL_NT(cfg)) ++(tau); else if ((cfg) < 2) { ++(cfg); (tau) = DL_TAU0(cfg); } else more = false; } while (0)
        TileRegs RA, RB; int cc = 0, ct = DL_TAU0(0);
        DL_LOADT(RA, cc, ct);
        for (;;) {
            int nc = cc, nt = ct; bool more; DL_ADV(nc, nt, more);
            if (more) DL_LOADT(RB, nc, nt);
            DL_COMP(RA, cc, ct);
            if (!more) break;
            cc = nc; ct = nt; DL_ADV(nc, nt, more);
            if (more) DL_LOADT(RA, nc, nt);
            DL_COMP(RB, cc, ct);
            if (!more) break;
            cc = nc; ct = nt;
        }
#undef DL_DIL
#undef DL_NT
#undef DL_MBASE
#undef DL_TAU0
#undef DL_LOADT
#undef DL_COMP
#undef DL_ADV
        attn_store(st, zq + 3072 + hh * 64, Y + (rowbase + tq) * D + hh * 64, lane);
    }
}


__device__ __forceinline__ void attn_stage2(const TileRegs& RA, const TileRegs& RB, LAS unsigned char* wl, int lane) {
    LAS unsigned char* vla = wl; LAS unsigned char* vlb = wl + 4096; LAS unsigned char* kla = wl + 8192; LAS unsigned char* klb = wl + 12288;
#pragma unroll
    for (int it = 0; it < 4; ++it) { const int row = it * 8 + (lane >> 3); const int ko = row * 128 + (((lane & 7) ^ (row & 7)) << 4); *(LAS v4u*)(kla + ko) = RA.kk[it]; *(LAS v4u*)(klb + ko) = RB.kk[it]; }
#pragma unroll
    for (int it = 0; it < 4; ++it) { const int vo = (it * 2 + ((lane & 7) >> 2)) * 512 + (lane >> 3) * 64 + (lane & 3) * 16; *(LAS v4u*)(vla + vo) = RA.vv[it]; *(LAS v4u*)(vlb + vo) = RB.vv[it]; }
}
template <int MODE, class MidF>
__device__ __forceinline__ void attn_compute2_lds(AttnSt& a, AttnSt& b, const bf16x8 (&qa)[4], const bf16x8 (&qb)[4], LAS unsigned char* wl, int lane, int dd0, int kmina, int kminb, MidF mid) {
    const int r32 = lane & 31, hi = lane >> 5, grp = lane >> 4, qq = (lane & 15) >> 2, pp = lane & 3;
    LAS unsigned char* vla = wl; LAS unsigned char* vlb = wl + 4096; LAS unsigned char* kla = wl + 8192; LAS unsigned char* klb = wl + 12288;
    f32x16 sa = f32x16{}, sb = f32x16{};
#pragma unroll
    for (int d0 = 0; d0 < 4; ++d0) {
        const int ko = r32 * 128 + (((2 * d0 + hi) ^ (r32 & 7)) << 4);
        const v4u kwa = *(const LAS v4u*)(kla + ko), kwb = *(const LAS v4u*)(klb + ko);
        sa = __builtin_amdgcn_mfma_f32_32x32x16_bf16(__builtin_bit_cast(bf16x8, kwa), qa[d0], sa, 0, 0, 0);
        sb = __builtin_amdgcn_mfma_f32_32x32x16_bf16(__builtin_bit_cast(bf16x8, kwb), qb[d0], sb, 0, 0, 0);
    }
    if (MODE == 3) {
        const int ddh = dd0 - 4 * hi, kma = kmina - 4 * hi, kmb = kminb - 4 * hi;
#pragma unroll
        for (int r = 0; r < 16; ++r) { const int c = (r & 3) + 8 * (r >> 2); const bool band = (unsigned)(ddh - c) <= 128u; if (!band || c < kma) sa[r] = -INFINITY; if (!band || c < kmb) sb[r] = -INFINITY; }
    }
    float mta = sa[0], mtb = sb[0];
#pragma unroll
    for (int r = 1; r < 16; ++r) { mta = fmaxf(mta, sa[r]); mtb = fmaxf(mtb, sb[r]); }
    mta = fmaxf(mta, __shfl_xor(mta, 32)); mtb = fmaxf(mtb, __shfl_xor(mtb, 32));
    if (__any(mta > a.m + RESCALE_THR || mtb > b.m + RESCALE_THR)) {
        const float mna_ = fmaxf(a.m, mta), mnb_ = fmaxf(b.m, mtb);
        const float fa = __builtin_amdgcn_exp2f(a.m - mna_), fb = __builtin_amdgcn_exp2f(b.m - mnb_);
        a.l *= fa; a.m = mna_; b.l *= fb; b.m = mnb_;
#pragma unroll
        for (int r = 0; r < 16; ++r) { a.o0[r] *= fa; a.o1[r] *= fa; b.o0[r] *= fb; b.o1[r] *= fb; }
    }
    const float mna = a.m, mnb = b.m;
    float psa = 0.f, psb = 0.f;
#pragma unroll
    for (int r = 0; r < 16; ++r) { sa[r] = __builtin_amdgcn_exp2f(sa[r] - mna); sb[r] = __builtin_amdgcn_exp2f(sb[r] - mnb); psa += sa[r]; psb += sb[r]; }
    a.l += psa; b.l += psb;
    v4u pa0, pa1, pb0, pb1;
    pa0.x = cvtpk_s(sa[0], sa[1]); pa0.y = cvtpk_s(sa[2], sa[3]); pa0.z = cvtpk_s(sa[4], sa[5]); pa0.w = cvtpk_s(sa[6], sa[7]);
    pa1.x = cvtpk_s(sa[8], sa[9]); pa1.y = cvtpk_s(sa[10], sa[11]); pa1.z = cvtpk_s(sa[12], sa[13]); pa1.w = cvtpk_s(sa[14], sa[15]);
    pb0.x = cvtpk_s(sb[0], sb[1]); pb0.y = cvtpk_s(sb[2], sb[3]); pb0.z = cvtpk_s(sb[4], sb[5]); pb0.w = cvtpk_s(sb[6], sb[7]);
    pb1.x = cvtpk_s(sb[8], sb[9]); pb1.y = cvtpk_s(sb[10], sb[11]); pb1.z = cvtpk_s(sb[12], sb[13]); pb1.w = cvtpk_s(sb[14], sb[15]);
    const bf16x8 fa0 = __builtin_bit_cast(bf16x8, pa0), fa1 = __builtin_bit_cast(bf16x8, pa1), fb0 = __builtin_bit_cast(bf16x8, pb0), fb1 = __builtin_bit_cast(bf16x8, pb1);
    __builtin_amdgcn_sched_barrier(0); mid(); __builtin_amdgcn_sched_barrier(0);
    const int to = (4 * hi + qq) * 64 + (16 * (grp & 1) + 4 * pp) * 2;
#define VFRAG2(base, ks, d0) ({ const s16x4 lo_ = vtr((base) + to + ((2 * (ks)) * 2 + (d0)) * 512), hi_ = vtr((base) + to + ((2 * (ks) + 1) * 2 + (d0)) * 512); (bf16x8){lo_[0], lo_[1], lo_[2], lo_[3], hi_[0], hi_[1], hi_[2], hi_[3]}; })
    a.o0 = __builtin_amdgcn_mfma_f32_32x32x16_bf16(VFRAG2(vla, 0, 0), fa0, a.o0, 0, 0, 0);
    b.o0 = __builtin_amdgcn_mfma_f32_32x32x16_bf16(VFRAG2(vlb, 0, 0), fb0, b.o0, 0, 0, 0);
    a.o1 = __builtin_amdgcn_mfma_f32_32x32x16_bf16(VFRAG2(vla, 0, 1), fa0, a.o1, 0, 0, 0);
    b.o1 = __builtin_amdgcn_mfma_f32_32x32x16_bf16(VFRAG2(vlb, 0, 1), fb0, b.o1, 0, 0, 0);
    a.o0 = __builtin_amdgcn_mfma_f32_32x32x16_bf16(VFRAG2(vla, 1, 0), fa1, a.o0, 0, 0, 0);
    b.o0 = __builtin_amdgcn_mfma_f32_32x32x16_bf16(VFRAG2(vlb, 1, 0), fb1, b.o0, 0, 0, 0);
    a.o1 = __builtin_amdgcn_mfma_f32_32x32x16_bf16(VFRAG2(vla, 1, 1), fa1, a.o1, 0, 0, 0);
    b.o1 = __builtin_amdgcn_mfma_f32_32x32x16_bf16(VFRAG2(vlb, 1, 1), fb1, b.o1, 0, 0, 0);
#undef VFRAG2
}
template <int MODE, class PreF, class MidF>
__device__ __forceinline__ void attn_compute2_kv(AttnSt& a, AttnSt& b, const bf16x8 (&qa)[4], const bf16x8 (&qb)[4], TileRegs& RA, TileRegs& RB, LAS unsigned char* wl, int lane, int dd0, int kmina, int kminb, PreF pre, MidF mid) {
    const int r32 = lane & 31, hi = lane >> 5, grp = lane >> 4, qq = (lane & 15) >> 2, pp = lane & 3;
    LAS unsigned char* vla = wl; LAS unsigned char* vlb = wl + 4096; LAS unsigned char* kla = wl + 8192; LAS unsigned char* klb = wl + 12288;
#pragma unroll
    for (int it = 0; it < 4; ++it) { const int row = it * 8 + (lane >> 3); const int ko = row * 128 + (((lane & 7) ^ (row & 7)) << 4); *(LAS v4u*)(kla + ko) = RA.kk[it]; *(LAS v4u*)(klb + ko) = RB.kk[it]; }
    pre();
#pragma unroll
    for (int it = 0; it < 4; ++it) { const int vo = (it * 2 + ((lane & 7) >> 2)) * 512 + (lane >> 3) * 64 + (lane & 3) * 16; *(LAS v4u*)(vla + vo) = RA.vv[it]; *(LAS v4u*)(vlb + vo) = RB.vv[it]; }
    f32x16 sa = f32x16{}, sb = f32x16{};
#pragma unroll
    for (int d0 = 0; d0 < 4; ++d0) {
        const int ko = r32 * 128 + (((2 * d0 + hi) ^ (r32 & 7)) << 4);
        const v4u kwa = *(const LAS v4u*)(kla + ko), kwb = *(const LAS v4u*)(klb + ko);
        sa = __builtin_amdgcn_mfma_f32_32x32x16_bf16(__builtin_bit_cast(bf16x8, kwa), qa[d0], sa, 0, 0, 0);
        sb = __builtin_amdgcn_mfma_f32_32x32x16_bf16(__builtin_bit_cast(bf16x8, kwb), qb[d0], sb, 0, 0, 0);
    }
    if (MODE == 3) {
        const int ddh = dd0 - 4 * hi;
        if (kmina <= 0 && kminb <= 0) {
#pragma unroll
            for (int r = 0; r < 16; ++r) { const int c = (r & 3) + 8 * (r >> 2); const bool band = (unsigned)(ddh - c) <= 128u; sa[r] = band ? sa[r] : -INFINITY; sb[r] = band ? sb[r] : -INFINITY; }
        } else {
            const int kma = kmina - 4 * hi, kmb = kminb - 4 * hi;
#pragma unroll
            for (int r = 0; r < 16; ++r) { const int c = (r & 3) + 8 * (r >> 2); const bool band = (unsigned)(ddh - c) <= 128u; if (!band || c < kma) sa[r] = -INFINITY; if (!band || c < kmb) sb[r] = -INFINITY; }
        }
    }
    float mta = sa[0], mtb = sb[0];
#pragma unroll
    for (int r = 1; r < 16; ++r) { mta = fmaxf(mta, sa[r]); mtb = fmaxf(mtb, sb[r]); }
    mta = fmaxf(mta, __shfl_xor(mta, 32)); mtb = fmaxf(mtb, __shfl_xor(mtb, 32));
    if (__any(mta > a.m + RESCALE_THR || mtb > b.m + RESCALE_THR)) {
        const float mna_ = fmaxf(a.m, mta), mnb_ = fmaxf(b.m, mtb);
        const float fa = __builtin_amdgcn_exp2f(a.m - mna_), fb = __builtin_amdgcn_exp2f(b.m - mnb_);
        a.l *= fa; a.m = mna_; b.l *= fb; b.m = mnb_;
#pragma unroll
        for (int r = 0; r < 16; ++r) { a.o0[r] *= fa; a.o1[r] *= fa; b.o0[r] *= fb; b.o1[r] *= fb; }
    }
    const float mna = a.m, mnb = b.m;
    const f32x2_t ma2 = {mna, mna}, mb2 = {mnb, mnb}; f32x2_t acca = {0.f, 0.f}, accb = {0.f, 0.f};
#pragma unroll
    for (int r = 0; r < 16; r += 2) {
        f32x2_t va = (f32x2_t){sa[r], sa[r + 1]} - ma2, vb = (f32x2_t){sb[r], sb[r + 1]} - mb2;
        va.x = __builtin_amdgcn_exp2f(va.x); va.y = __builtin_amdgcn_exp2f(va.y); vb.x = __builtin_amdgcn_exp2f(vb.x); vb.y = __builtin_amdgcn_exp2f(vb.y);
        acca += va; accb += vb;
        sa[r] = va.x; sa[r + 1] = va.y; sb[r] = vb.x; sb[r + 1] = vb.y;
    }
    a.l += acca.x + acca.y; b.l += accb.x + accb.y;
    v4u pa0, pa1, pb0, pb1;
    pa0.x = cvtpk_s(sa[0], sa[1]); pa0.y = cvtpk_s(sa[2], sa[3]); pa0.z = cvtpk_s(sa[4], sa[5]); pa0.w = cvtpk_s(sa[6], sa[7]);
    pa1.x = cvtpk_s(sa[8], sa[9]); pa1.y = cvtpk_s(sa[10], sa[11]); pa1.z = cvtpk_s(sa[12], sa[13]); pa1.w = cvtpk_s(sa[14], sa[15]);
    pb0.x = cvtpk_s(sb[0], sb[1]); pb0.y = cvtpk_s(sb[2], sb[3]); pb0.z = cvtpk_s(sb[4], sb[5]); pb0.w = cvtpk_s(sb[6], sb[7]);
    pb1.x = cvtpk_s(sb[8], sb[9]); pb1.y = cvtpk_s(sb[10], sb[11]); pb1.z = cvtpk_s(sb[12], sb[13]); pb1.w = cvtpk_s(sb[14], sb[15]);
    const bf16x8 fa0 = __builtin_bit_cast(bf16x8, pa0), fa1 = __builtin_bit_cast(bf16x8, pa1), fb0 = __builtin_bit_cast(bf16x8, pb0), fb1 = __builtin_bit_cast(bf16x8, pb1);
    __builtin_amdgcn_sched_barrier(0); mid(); __builtin_amdgcn_sched_barrier(0);
    const int to = (4 * hi + qq) * 64 + (16 * (grp & 1) + 4 * pp) * 2;
#define VFRAG2(base, ks, d0) ({ const s16x4 lo_ = vtr((base) + to + ((2 * (ks)) * 2 + (d0)) * 512), hi_ = vtr((base) + to + ((2 * (ks) + 1) * 2 + (d0)) * 512); (bf16x8){lo_[0], lo_[1], lo_[2], lo_[3], hi_[0], hi_[1], hi_[2], hi_[3]}; })
    a.o0 = __builtin_amdgcn_mfma_f32_32x32x16_bf16(VFRAG2(vla, 0, 0), fa0, a.o0, 0, 0, 0);
    b.o0 = __builtin_amdgcn_mfma_f32_32x32x16_bf16(VFRAG2(vlb, 0, 0), fb0, b.o0, 0, 0, 0);
    a.o1 = __builtin_amdgcn_mfma_f32_32x32x16_bf16(VFRAG2(vla, 0, 1), fa0, a.o1, 0, 0, 0);
    b.o1 = __builtin_amdgcn_mfma_f32_32x32x16_bf16(VFRAG2(vlb, 0, 1), fb0, b.o1, 0, 0, 0);
    a.o0 = __builtin_amdgcn_mfma_f32_32x32x16_bf16(VFRAG2(vla, 1, 0), fa1, a.o0, 0, 0, 0);
    b.o0 = __builtin_amdgcn_mfma_f32_32x32x16_bf16(VFRAG2(vlb, 1, 0), fb1, b.o0, 0, 0, 0);
    a.o1 = __builtin_amdgcn_mfma_f32_32x32x16_bf16(VFRAG2(vla, 1, 1), fa1, a.o1, 0, 0, 0);
    b.o1 = __builtin_amdgcn_mfma_f32_32x32x16_bf16(VFRAG2(vlb, 1, 1), fb1, b.o1, 0, 0, 0);
#undef VFRAG2
}
template <int MODE>
__device__ __forceinline__ void attn_compute2(AttnSt& a, AttnSt& b, const bf16x8 (&qa)[4], const bf16x8 (&qb)[4], const TileRegs& RA, const TileRegs& RB, LAS unsigned char* wl, int lane, int dd0, int kmina, int kminb) {
    attn_stage2(RA, RB, wl, lane); attn_compute2_lds<MODE>(a, b, qa, qb, wl, lane, dd0, kmina, kminb, [] {});
}

__device__ __forceinline__ void phase_dilated_2(const Args& A, LAS unsigned char* lds, int gwv, int NGW, int wave, int lane) {
    const bf16* Z = (const bf16*)(A.ws + WS_Z); bf16* Y = (bf16*)(A.ws + WS_Y);
    LAS unsigned char* wl = lds + wave * 16384;
    const int r32 = lane & 31, hi = lane >> 5;
    for (int U = gwv; U < 16384; U += NGW) {
        const int rd = U >> 10, g2 = U & 1023, X = g2 >> 7, lp = g2 & 127;
        const int bh = 32 * X + 2 * rd + (lp >> 6), pi = lp & 63, c = pi >> 3, r16a = 2 * (pi & 7);
        const int b = bh >> 4, hh = bh & 15;
        const size_t rowbase = (size_t)b * SEQ;
        const int tqa = 512 * c + r16a + 16 * r32;
        const bf16* zqa = Z + (rowbase + tqa) * ODD_IN; const bf16* zqb = zqa + ODD_IN;
        bf16x8 qa[4], qb[4];
#pragma unroll
        for (int d0 = 0; d0 < 4; ++d0) { qa[d0] = *(const bf16x8*)(zqa + hh * 64 + 16 * d0 + 8 * hi); qb[d0] = *(const bf16x8*)(zqb + hh * 64 + 16 * d0 + 8 * hi); }
        AttnSt sa, sb; sa.o0 = f32x16{}; sa.o1 = f32x16{}; sa.m = -1e30f; sa.l = 0.f; sb.o0 = f32x16{}; sb.o1 = f32x16{}; sb.m = -1e30f; sb.l = 0.f;
        const bf16* Vh = Z + rowbase * ODD_IN + 2048 + hh * 64 + 8 * (lane & 7);
#pragma unroll 1
        for (int cfg = 0; cfg < 3; ++cfg) {
            const int dil = (cfg == 0) ? 16 : (cfg == 1) ? 4 : 1, sstep = 16 / dil, ntile = (cfg == 0) ? 5 : (cfg == 1) ? 8 : 20;
            const int rdla = r16a & (dil - 1), rdlb = (r16a + 1) & (dil - 1);
            const int mba = (512 * c + r16a - rdla) / dil - 128, mbb = (512 * c + r16a + 1 - rdlb) / dil - 128;
            const int tau0 = mbb < 0 ? (-mbb) / 32 : 0;
            const size_t vst = (size_t)dil * ODD_IN;
#pragma unroll 1
            for (int tau = tau0; tau < ntile; ++tau) {
                TileRegs RA, RB;
                { const int mv = mba + 32 * tau + (lane >> 3); const int m0_ = mv < 0 ? 0 : mv, m1_ = mv + 8 < 0 ? 0 : mv + 8, m2_ = mv + 16 < 0 ? 0 : mv + 16, m3_ = mv + 24 < 0 ? 0 : mv + 24;
                  const bf16* vb = Vh + (size_t)rdla * ODD_IN; attn_load(RA, 1024, vb + m0_ * vst, vb + m1_ * vst, vb + m2_ * vst, vb + m3_ * vst); }
                { const int mv = mbb + 32 * tau + (lane >> 3); const int m0_ = mv < 0 ? 0 : mv, m1_ = mv + 8 < 0 ? 0 : mv + 8, m2_ = mv + 16 < 0 ? 0 : mv + 16, m3_ = mv + 24 < 0 ? 0 : mv + 24;
                  const bf16* vb = Vh + (size_t)rdlb * ODD_IN; attn_load(RB, 1024, vb + m0_ * vst, vb + m1_ * vst, vb + m2_ * vst, vb + m3_ * vst); }
                attn_compute2<3>(sa, sb, qa, qb, RA, RB, wl, lane, 128 + sstep * r32 - 32 * tau, -(mba + 32 * tau), -(mbb + 32 * tau));
            }
        }
        attn_store(sa, zqa + 3072 + hh * 64, Y + (rowbase + tqa) * D + hh * 64, lane);
        attn_store(sb, zqb + 3072 + hh * 64, Y + (rowbase + tqa + 1) * D + hh * 64, lane);
    }
}


__device__ __forceinline__ void attn_state_store(const AttnSt& st, bf16* orow, float* lsep, int lane) {
    const int hi = lane >> 5;
    const float lt = st.l + __shfl_xor(st.l, 32), inv = 1.0f / lt;
#pragma unroll
    for (int d0 = 0; d0 < 2; ++d0)
#pragma unroll
        for (int pr = 0; pr < 2; ++pr) {
            v2u w2[2];
#pragma unroll
            for (int k = 0; k < 2; ++k) { const int rq = 2 * pr + k; const f32x16& o = d0 ? st.o1 : st.o0; w2[k].x = cvtpk_s(o[4 * rq + 0] * inv, o[4 * rq + 1] * inv); w2[k].y = cvtpk_s(o[4 * rq + 2] * inv, o[4 * rq + 3] * inv); }
            *(v4u*)(orow + 32 * d0 + 16 * pr + 8 * hi) = pair_to_wide(w2[0], w2[1]);
        }
    if (hi == 0) *lsep = st.m + __builtin_amdgcn_logf(lt);
}
__device__ __forceinline__ void attn_state_load(AttnSt& st, const bf16* orow, const float* lsep, int lane) {
    const int hi = lane >> 5;
#pragma unroll
    for (int d0 = 0; d0 < 2; ++d0)
#pragma unroll
        for (int pr = 0; pr < 2; ++pr) {
            const v4u w = *(const v4u*)(orow + 32 * d0 + 16 * pr + 8 * hi); v2u g2[2]; wide_to_pair(w, g2[0], g2[1]);
            f32x16& o = d0 ? st.o1 : st.o0;
#pragma unroll
            for (int k = 0; k < 2; ++k) { const int rq = 2 * pr + k; o[4 * rq + 0] = bf_lo(g2[k].x); o[4 * rq + 1] = bf_hi(g2[k].x); o[4 * rq + 2] = bf_lo(g2[k].y); o[4 * rq + 3] = bf_hi(g2[k].y); }
        }
    st.m = *lsep; st.l = hi ? 0.f : 1.f;
}
__device__ __forceinline__ void attn_state_store_lds(const AttnSt& st, LAS unsigned char* ex, int p, int lane) {
    const int hi = lane >> 5, sw = (p & 7) ^ ((p >> 4) & 7);
    const float lt = st.l + __shfl_xor(st.l, 32), inv = 1.0f / lt;
#pragma unroll
    for (int d0 = 0; d0 < 2; ++d0)
#pragma unroll
        for (int pr = 0; pr < 2; ++pr) {
            v2u w2[2];
#pragma unroll
            for (int k = 0; k < 2; ++k) { const int rq = 2 * pr + k; const f32x16& o = d0 ? st.o1 : st.o0; w2[k].x = cvtpk_s(o[4 * rq + 0] * inv, o[4 * rq + 1] * inv); w2[k].y = cvtpk_s(o[4 * rq + 2] * inv, o[4 * rq + 3] * inv); }
            *(LAS v4u*)(ex + p * 128 + (((4 * d0 + 2 * pr + hi) ^ sw) << 4)) = pair_to_wide(w2[0], w2[1]);
        }
    if (hi == 0) *(LAS float*)(ex + 65536 + 4 * p) = st.m + __builtin_amdgcn_logf(lt);
}
__device__ __forceinline__ void attn_state_load_lds(AttnSt& st, const LAS unsigned char* ex, int p, int lane) {
    const int hi = lane >> 5, sw = (p & 7) ^ ((p >> 4) & 7);
#pragma unroll
    for (int d0 = 0; d0 < 2; ++d0)
#pragma unroll
        for (int pr = 0; pr < 2; ++pr) {
            const v4u w = *(const LAS v4u*)(ex + p * 128 + (((4 * d0 + 2 * pr + hi) ^ sw) << 4)); v2u g2[2]; wide_to_pair(w, g2[0], g2[1]);
            f32x16& o = d0 ? st.o1 : st.o0;
#pragma unroll
            for (int k = 0; k < 2; ++k) { const int rq = 2 * pr + k; o[4 * rq + 0] = bf_lo(g2[k].x); o[4 * rq + 1] = bf_hi(g2[k].x); o[4 * rq + 2] = bf_lo(g2[k].y); o[4 * rq + 3] = bf_hi(g2[k].y); }
        }
    st.m = *(const LAS float*)(ex + 65536 + 4 * p); st.l = hi ? 0.f : 1.f;
}

__device__ __forceinline__ void phase_dilated_3(const Args& A, LAS unsigned char* lds, int G, int vcu, int wave, int lane) {
    const bf16* Z = (const bf16*)(A.ws + WS_Z); bf16* Y = (bf16*)(A.ws + WS_Y);
    bf16* EX = (bf16*)A.out; float* LSE = A.out + (size_t)32 * 1024 * 1024;
    LAS unsigned char* wl = lds + wave * 16384;
    const int r32 = lane & 31, hi = lane >> 5;
    for (int U = vcu; U < 2048; U += G) {
        const int c = U >> 8, bh = U & 255, b = bh >> 4, hh = bh & 15, T0 = 512 * c;
        const size_t rowbase = (size_t)b * SEQ;
        const bf16* Vh = Z + rowbase * ODD_IN + 2048 + hh * 64 + 8 * (lane & 7);
        {
            const int r16a = 2 * wave, pa = r16a + 16 * r32;
            bf16x8 qa[4], qb[4];
            { const bf16* zqa = Z + (rowbase + T0 + pa) * ODD_IN + hh * 64 + 8 * hi;
#pragma unroll
              for (int d0 = 0; d0 < 4; ++d0) { qa[d0] = *(const bf16x8*)(zqa + 16 * d0); qb[d0] = *(const bf16x8*)(zqa + ODD_IN + 16 * d0); } }
            AttnSt sa, sb; sa.o0 = f32x16{}; sa.o1 = f32x16{}; sa.m = -1e30f; sa.l = 0.f; sb.o0 = f32x16{}; sb.o1 = f32x16{}; sb.m = -1e30f; sb.l = 0.f;
#define P1_PARAMS(ti) const int dil_ = (ti) < 5 ? 16 : 4, tau_ = (ti) < 5 ? (ti) : (ti) - 5; const int rdla_ = r16a & (dil_ - 1), rdlb_ = (r16a + 1) & (dil_ - 1); const int mba_ = (T0 + r16a - rdla_) / dil_ - 128 + 32 * tau_
#define P1_ADDR(ti) P1_PARAMS(ti); const size_t vst_ = (size_t)dil_ * ODD_IN; const int mv = mba_ + (lane >> 3); const int m0_ = mv < 0 ? 0 : mv, m1_ = mv + 8 < 0 ? 0 : mv + 8, m2_ = mv + 16 < 0 ? 0 : mv + 16, m3_ = mv + 24 < 0 ? 0 : mv + 24; \
                const bf16* va_ = Vh + (size_t)rdla_ * ODD_IN; const bf16* vb_ = Vh + (size_t)rdlb_ * ODD_IN
#define P1_LOADK(ti) do { P1_ADDR(ti); attn_load_k(RA, 1024, va_ + m0_ * vst_, va_ + m1_ * vst_, va_ + m2_ * vst_, va_ + m3_ * vst_); attn_load_k(RB, 1024, vb_ + m0_ * vst_, vb_ + m1_ * vst_, vb_ + m2_ * vst_, vb_ + m3_ * vst_); } while (0)
#define P1_LOADV(ti) do { P1_ADDR(ti); attn_load_v(RA, va_ + m0_ * vst_, va_ + m1_ * vst_, va_ + m2_ * vst_, va_ + m3_ * vst_); attn_load_v(RB, vb_ + m0_ * vst_, vb_ + m1_ * vst_, vb_ + m2_ * vst_, vb_ + m3_ * vst_); } while (0)
#pragma unroll 1
            for (int ti = 0; ti < 13; ++ti) {
                { P1_PARAMS(ti); if (mba_ + 31 < 0) continue; }
                TileRegs RA, RB;
                P1_LOADK(ti);
                P1_PARAMS(ti);
                attn_compute2_kv<3>(sa, sb, qa, qb, RA, RB, wl, lane, 128 + (16 / dil_) * r32 - 32 * tau_, -mba_, -mba_, [&] { P1_LOADV(ti); }, [] {});
            }
#undef P1_ADDR
#undef P1_LOADK
#undef P1_LOADV
#undef P1_PARAMS
            __syncthreads();
            attn_state_store_lds(sa, lds, pa, lane);
            attn_state_store_lds(sb, lds, pa + 1, lane);
        }
        {
            const int pa = 64 * wave + r32, pb = pa + 32;
            bf16x8 qa[4], qb[4];
            { const bf16* zqa = Z + (rowbase + T0 + pa) * ODD_IN + hh * 64 + 8 * hi;
#pragma unroll
              for (int d0 = 0; d0 < 4; ++d0) { qa[d0] = *(const bf16x8*)(zqa + 16 * d0); qb[d0] = *(const bf16x8*)(zqa + (size_t)32 * ODD_IN + 16 * d0); } }
            __syncthreads();
            AttnSt sa, sb;
            attn_state_load_lds(sa, lds, pa, lane);
            attn_state_load_lds(sb, lds, pb, lane);
            __syncthreads();
            v2u gga[2][4], ggb[2][4];
            { const bf16* zg = Z + (rowbase + T0 + pa) * ODD_IN + 3072 + hh * 64; attn_gate_load(gga, zg, lane); attn_gate_load(ggb, zg + (size_t)32 * ODD_IN, lane); }
            const int mba = T0 + 64 * wave - 128, mbb = mba + 32;
            const size_t vst = (size_t)ODD_IN;
#define P2_ADDR(tau) const int mva = mba + 32 * (tau) + (lane >> 3), mvb = mva + 32; \
                const int a0_ = mva < 0 ? 0 : mva, a1_ = mva + 8 < 0 ? 0 : mva + 8, a2_ = mva + 16 < 0 ? 0 : mva + 16, a3_ = mva + 24 < 0 ? 0 : mva + 24; \
                const int b0_ = mvb < 0 ? 0 : mvb, b1_ = mvb + 8 < 0 ? 0 : mvb + 8, b2_ = mvb + 16 < 0 ? 0 : mvb + 16, b3_ = mvb + 24 < 0 ? 0 : mvb + 24
#define P2_LOADK(tau) do { P2_ADDR(tau); attn_load_k(RA, 1024, Vh + a0_ * vst, Vh + a1_ * vst, Vh + a2_ * vst, Vh + a3_ * vst); attn_load_k(RB, 1024, Vh + b0_ * vst, Vh + b1_ * vst, Vh + b2_ * vst, Vh + b3_ * vst); } while (0)
#define P2_LOADV(tau) do { P2_ADDR(tau); attn_load_v(RA, Vh + a0_ * vst, Vh + a1_ * vst, Vh + a2_ * vst, Vh + a3_ * vst); attn_load_v(RB, Vh + b0_ * vst, Vh + b1_ * vst, Vh + b2_ * vst, Vh + b3_ * vst); } while (0)
#pragma unroll 1
            for (int tau = 0; tau < 5; ++tau) {
                if (mbb + 32 * tau + 31 < 0) continue;
                TileRegs RA, RB;
                P2_LOADK(tau);
                attn_compute2_kv<3>(sa, sb, qa, qb, RA, RB, wl, lane, 128 + r32 - 32 * tau, -(mba + 32 * tau), -(mbb + 32 * tau), [&] { P2_LOADV(tau); }, [] {});
            }
#undef P2_ADDR
#undef P2_LOADK
#undef P2_LOADV
            { int pa2 = pa; asm volatile("" : "+v"(pa2));
              bf16* yr = Y + (rowbase + T0 + pa2) * D + hh * 64;
              attn_store_g(sa, gga, yr, lane); attn_store_g(sb, ggb, yr + (size_t)32 * D, lane); }
        }
    }
}

__device__ __forceinline__ void phase_dilated(const Args& A, LAS unsigned char* lds, int gwv, int NGW, int wave, int lane) {
    const bf16* Z = (const bf16*)(A.ws + WS_Z); bf16* Y = (bf16*)(A.ws + WS_Y);
    LAS unsigned char* vl = lds + wave * 4096;
    const int r32 = lane & 31, hi = lane >> 5;
    for (int U = gwv; U < 32768; U += NGW) {
        const int rd = U >> 11, g2 = U & 2047, X = g2 >> 8, lwv = g2 & 255;
        const int bh = 32 * X + 2 * rd + (lwv >> 7), gi = lwv & 127, c = gi >> 4, r16 = gi & 15;
        const int b = bh >> 4, hh = bh & 15;
        const size_t rowbase = (size_t)b * SEQ;
        const int tq = 512 * c + r16 + 16 * r32;
        const bf16* zq = Z + (rowbase + tq) * ODD_IN;
        bf16x8 qf[4];
#pragma unroll
        for (int d0 = 0; d0 < 4; ++d0) qf[d0] = *(const bf16x8*)(zq + hh * 64 + 16 * d0 + 8 * hi);
        AttnSt st; st.o0 = f32x16{}; st.o1 = f32x16{}; st.m = -1e30f; st.l = 0.f;
        const bf16* Kh = Z + rowbase * ODD_IN + 1024 + hh * 64; const bf16* Vh = Z + rowbase * ODD_IN + 2048 + hh * 64;
#pragma unroll 1
        for (int cfg = 0; cfg < 3; ++cfg) {
            const int dil = (cfg == 0) ? 16 : (cfg == 1) ? 4 : 1, sstep = 16 / dil, ntile = (cfg == 0) ? 5 : (cfg == 1) ? 8 : 20;
            const int rdl = r16 & (dil - 1), mbase = (512 * c + r16 - rdl) / dil - 128;
            for (int tau = 0; tau < ntile; ++tau) {
                const int m0 = mbase + 32 * tau;
                if (m0 + 31 < 0) continue;
                const int mk = m0 + r32, mkc = mk < 0 ? 0 : mk;
                const bf16* kp = Kh + (size_t)(rdl + dil * mkc) * ODD_IN + 8 * hi;
                const int mv = m0 + (lane >> 3);
                const int mv0 = mv < 0 ? 0 : mv, mv1 = mv + 8 < 0 ? 0 : mv + 8, mv2 = mv + 16 < 0 ? 0 : mv + 16, mv3 = mv + 24 < 0 ? 0 : mv + 24;
                const bf16* vb = Vh + (size_t)rdl * ODD_IN + 8 * (lane & 7); const size_t vst = (size_t)dil * ODD_IN;
                const int dd0 = 128 + sstep * r32 - 32 * tau;
                attn_tile(st, qf, kp, vb + mv0 * vst, vb + mv1 * vst, vb + mv2 * vst, vb + mv3 * vst, vl, lane, true,
                          [&](int kk) { const int dd = dd0 - kk; return dd >= 0 && dd <= 128 && (m0 + kk) >= 0; });
            }
        }
        attn_store(st, zq + 3072 + hh * 64, Y + (rowbase + tq) * D + hh * 64, lane);
    }
}
#define XB_TMO      128
#define XB_XCNT(j)  (256  + 64 * (j))
#define XB_XSUB(j)  (1280 + 64 * (j))
#define XB_XGEN(j)  (2304 + 64 * (j))
#define XB_TOP      3328
#define XB_TOPGEN   3392
#define XCD_BAR_WORDS 3456
#define XB_SPIN_CAP (1u << 18)

__device__ __forceinline__ unsigned xb_ld(unsigned* p)              { return __hip_atomic_load(p, __ATOMIC_RELAXED, __HIP_MEMORY_SCOPE_AGENT); }
__device__ __forceinline__ unsigned xb_add(unsigned* p, unsigned v) { return __hip_atomic_fetch_add(p, v, __ATOMIC_RELAXED, __HIP_MEMORY_SCOPE_AGENT); }
__device__ __forceinline__ unsigned xb_xcc_id() { return (unsigned)__builtin_amdgcn_s_getreg((3 << 11) | 20) & 0xFu; }
#define XB_SPIN(cond, bar) do { unsigned _sp = 0; while (cond) { __builtin_amdgcn_s_sleep(1); \
    if ((++_sp & 255u) == 0u) { if (xb_ld(&(bar)[XB_TMO])) break; if (_sp > XB_SPIN_CAP) { atomicAdd(&(bar)[XB_TMO], 1u); break; } } } } while (0)

struct XcdBarrier {
    unsigned* bar; unsigned x;
    volatile LAS unsigned* st;
};

__device__ __forceinline__ XcdBarrier xcd_barrier_post(unsigned* bar, volatile LAS unsigned* st) {
    XcdBarrier b; b.bar = bar; b.x = xb_xcc_id(); b.st = st;
    if (threadIdx.x == 0) (void)xb_add(&bar[XB_XCNT(b.x)], 1u);
    return b;
}
__device__ __forceinline__ void xcd_barrier_complete(unsigned* bar, unsigned x, unsigned& nloc, unsigned& nx) {
    const unsigned G = gridDim.x * gridDim.y * gridDim.z;
    unsigned sum, cnt, mine, sp = 0u;
    for (;;) {
        sum = 0u; cnt = 0u; mine = 0u;
#pragma unroll
        for (unsigned j = 0; j < 16; ++j) { const unsigned c = xb_ld(&bar[XB_XCNT(j)]); sum += c; cnt += (c > 0u) ? 1u : 0u; mine = (j == x) ? c : mine; }
        if (sum == G) break;
        __builtin_amdgcn_s_sleep(1);
        if ((++sp & 255u) == 0u) { if (xb_ld(&bar[XB_TMO])) break; if (sp > XB_SPIN_CAP) { atomicAdd(&bar[XB_TMO], 1u); break; } }
    }
    nloc = mine > 0u ? mine : 1u; nx = cnt > 0u ? cnt : 1u;
}

__device__ __forceinline__ void xcd_barrier(const XcdBarrier& b) {
    asm volatile("s_waitcnt vmcnt(0)" ::: "memory");
    __syncthreads();
    if (threadIdx.x == 0) {
        unsigned* bar = b.bar;
        __builtin_amdgcn_s_waitcnt(0);
        unsigned nloc = b.st[0], nx = b.st[1];
        if (nloc == 0u) { xcd_barrier_complete(bar, b.x, nloc, nx); b.st[0] = nloc; b.st[1] = nx; }
        const unsigned old = xb_add(&bar[XB_XSUB(b.x)], 1u);
        const unsigned gen = old / nloc;
        if (old + 1u == (gen + 1u) * nloc) {
            __builtin_amdgcn_fence(__ATOMIC_RELEASE, "agent");
            asm volatile("s_waitcnt vmcnt(0)" ::: "memory");
            const unsigned og = xb_add(&bar[XB_TOP], 1u);
            const unsigned tg = og / nx;
            if (og + 1u == (tg + 1u) * nx) xb_add(&bar[XB_TOPGEN], 1u);
            else XB_SPIN(xb_ld(&bar[XB_TOPGEN]) == tg, bar);
            __builtin_amdgcn_fence(__ATOMIC_ACQUIRE, "agent");
            xb_add(&bar[XB_XGEN(b.x)], 1u);
            asm volatile("s_waitcnt vmcnt(0)" ::: "memory");
        } else {
            XB_SPIN(xb_ld(&bar[XB_XGEN(b.x)]) == gen, bar);
            __builtin_amdgcn_fence(__ATOMIC_ACQUIRE, "agent");
            asm volatile("s_waitcnt vmcnt(0)" ::: "memory");
        }
    }
    __syncthreads();
}
__device__ __forceinline__ void phase_final(const Args& A, int gwv, int NGW, int lane) {
    const float* ssqp = (const float*)(A.ws + WS_SSQ);
    f32x4 fg[4];
#pragma unroll
    for (int j = 0; j < 4; ++j) fg[j] = *((const f32x4*)A.final_g + lane + 64 * j);
    for (int m = gwv; m < M; m += 2 * NGW) {
        const int m2 = m + NGW;
        const f32x4* sp = (const f32x4*)(ssqp + (size_t)m * 16); const f32x4* sp2 = (const f32x4*)(ssqp + (size_t)m2 * 16);
        f32x4* hr = (f32x4*)(A.out + (size_t)m * D) + lane; f32x4* hr2 = (f32x4*)(A.out + (size_t)m2 * D) + lane;
        const f32x4 a = sp[0], b = sp[1], c = sp[2], d = sp[3], a2 = sp2[0], b2 = sp2[1], c2 = sp2[2], d2 = sp2[3];
        f32x4 v[4], w[4];
#pragma unroll
        for (int j = 0; j < 4; ++j) { v[j] = hr[64 * j]; w[j] = hr2[64 * j]; }
        const float ss = (((a[0] + a[1]) + (a[2] + a[3])) + ((b[0] + b[1]) + (b[2] + b[3]))) + (((c[0] + c[1]) + (c[2] + c[3])) + ((d[0] + d[1]) + (d[2] + d[3])));
        const float ss2 = (((a2[0] + a2[1]) + (a2[2] + a2[3])) + ((b2[0] + b2[1]) + (b2[2] + b2[3]))) + (((c2[0] + c2[1]) + (c2[2] + c2[3])) + ((d2[0] + d2[1]) + (d2[2] + d2[3])));
        const float rstd = __builtin_amdgcn_rsqf(ss * (1.0f / 1024.0f) + NORM_EPS), rstd2 = __builtin_amdgcn_rsqf(ss2 * (1.0f / 1024.0f) + NORM_EPS);
#pragma unroll
        for (int j = 0; j < 4; ++j) { hr[64 * j] = v[j] * rstd * fg[j]; hr2[64 * j] = w[j] * rstd2 * fg[j]; }
    }
}

#define CAS __attribute__((address_space(4)))
#define FRESH_IDS() int lane = lane_k, wave = wave_k, vcu = vcu_k; asm volatile("" : "+v"(lane), "+s"(wave), "+s"(vcu)); const int gwv = vcu * NWAVES + wave; (void)gwv;
#define GRID_SYNC() do { asm volatile("s_waitcnt vmcnt(0) lgkmcnt(0)" ::: "memory"); __syncthreads(); \
    if (wave_k == 0) { __builtin_amdgcn_fence(__ATOMIC_RELEASE, "agent"); asm volatile("s_waitcnt vmcnt(0)" ::: "memory"); } \
    grid.sync(); \
    if (wave_k == 0) { __builtin_amdgcn_fence(__ATOMIC_ACQUIRE, "agent"); asm volatile("s_waitcnt vmcnt(0)" ::: "memory"); } \
    __syncthreads(); } while (0)
#ifdef NO_XBAR
#define XBAR_SYNC() GRID_SYNC()
#else
#define XBAR_SYNC() xcd_barrier(xbar)
#endif
#define FRESH_ARGS() ({ const CAS Args* ap_ = (const CAS Args*)__builtin_amdgcn_kernarg_segment_ptr(); asm volatile("" : "+s"(ap_)); Args a_; a_ = *(const Args*)ap_; a_; })
__global__ void __launch_bounds__(NTHREADS, 2) mega_fwd(Args Akern) {
    extern __shared__ __attribute__((aligned(16))) unsigned char lds_raw[];
    cg::grid_group grid = cg::this_grid();
    LAS unsigned char* lds = (LAS unsigned char*)lds_raw;
    const int tid = threadIdx.x, lane_k = tid & 63, wave_k = __builtin_amdgcn_readfirstlane(tid >> 6);
    const int G = gridDim.x, bx = blockIdx.x;
    const int vcu_k = (G % 8 == 0) ? (bx % 8) * (G / 8) + bx / 8 : bx;
    const int NGW = G * NWAVES;
    if (tid < 2) ((volatile LAS unsigned*)(lds + 131072))[tid] = 0u;
    __syncthreads();
    const XcdBarrier xbar = xcd_barrier_post((unsigned*)(Akern.ws + WS_CTL), (volatile LAS unsigned*)(lds + 131072));

#ifndef NO_PRO
    { FRESH_IDS(); const Args A = FRESH_ARGS(); phase_prologue(A, lds, gwv, NGW, wave, lane); }
#endif
    GRID_SYNC();
#pragma unroll 1
    for (int layer = 0; layer < 4; ++layer) {
        const int li = layer >> 1; const int even = !(layer & 1);
        {
            const Args A = FRESH_ARGS(); bf16* hb = (bf16*)(A.ws + WS_HB); bf16* Zb = (bf16*)(A.ws + WS_Z); float* ssqp = (float*)(A.ws + WS_SSQ); float* kmp = (float*)(A.ws + WS_KMP);
            const int N = even ? EVEN_IN : ODD_IN;
            const bf16* Wt = even ? (const bf16*)(A.ws + WS_WE_IN) + (size_t)li * EVEN_IN * D : (const bf16*)(A.ws + WS_WO_IN) + (size_t)li * ODD_IN * D;
            pg8::Gemm g{hb, Wt, M, N, D}; pg8::StaticOrder S; S.init(M, N, G, bx);
            LAS float* rtab = (LAS float*)(lds + 131072 + 1024);
            {
                int tidl = tid; asm volatile("" : "+v"(tidl));
                const int rl = tidl & 255, half = tidl >> 8;
#pragma unroll 1
                for (int kb = 0; kb < 8; kb += 4) {
                    f32x4 pv[4][4]; int have[4];
#pragma unroll
                    for (int k = 0; k < 4; ++k) {
                        pg8::Unit uu; have[k] = S.next(2 * (kb + k) + half, uu) ? 1 : 0;
                        const float* sp = ssqp + ((size_t)(have[k] ? uu.pm : 0) * 256 + rl) * 16;
#pragma unroll
                        for (int q4 = 0; q4 < 4; ++q4) pv[k][q4] = *(const f32x4*)(sp + 4 * q4);
                    }
#pragma unroll
                    for (int k = 0; k < 4; ++k) {
                        const f32x4 a = pv[k][0], b = pv[k][1], c = pv[k][2], d = pv[k][3];
                        const float ss = (((a[0] + a[1]) + (a[2] + a[3])) + ((b[0] + b[1]) + (b[2] + b[3]))) + (((c[0] + c[1]) + (c[2] + c[3])) + ((d[0] + d[1]) + (d[2] + d[3])));
                        if (have[k]) rtab[(2 * (kb + k) + half) * 256 + rl] = __builtin_amdgcn_rsqf(ss * (1.0f / 1024.0f) + NORM_EPS);
                    }
                }
                __syncthreads();
            }
            int eseq = 0;
            pg8::EpiIn E{Zb, N, rtab, &eseq, kmp, even};
#ifdef PROBE_GIN2
            pg8::gemm_phase<pg8::EpiIn, pg8::StaticOrder, true, true>(lds, g, S, E);
#endif
#ifndef NO_GIN
            pg8::gemm_phase<pg8::EpiIn, pg8::StaticOrder, true, true>(lds, g, S, E);
#endif
        }
        XBAR_SYNC();
#ifdef PROBE_MIX2
        for (int rep = 0; rep < 2; ++rep)
#endif
#ifdef PROBE_MIX2_EVEN
        for (int rep = 0; rep < (even ? 2 : 1); ++rep)
#endif
        { __syncthreads(); FRESH_IDS(); const Args A = FRESH_ARGS();
        if (even) {
#ifndef NO_GMLP
            phase_gmlp(A, li, lds, vcu, G, wave, lane);
#endif
#ifdef PROBE_GMLP2
            phase_gmlp(A, li, lds, vcu, G, wave, lane);
#endif
#ifndef NO_MOBA
#if defined(NO_PIPE)
            phase_moba_old(A, lds, gwv, NGW, wave, lane);
#elif defined(MOBA_PIPE)
            phase_moba_p(A, lds, gwv, NGW, wave, lane);
#else
            phase_moba_s(A, lds, G, vcu, wave, lane);
#endif
#endif
        } else {
#ifndef NO_DIL
#if defined(NO_PIPE)
            phase_dilated(A, lds, gwv, NGW, wave, lane);
#elif defined(DIL_PIPE)
            phase_dilated_p(A, lds, gwv, NGW, wave, lane);
#elif defined(DIL_2)
            phase_dilated_2(A, lds, gwv, NGW, wave, lane);
#else
            phase_dilated_3(A, lds, G, vcu, wave, lane);
#endif
#endif
        } }
        XBAR_SYNC();
        {
            const Args A = FRESH_ARGS(); bf16* hb = (bf16*)(A.ws + WS_HB); bf16* Yb = (bf16*)(A.ws + WS_Y); float* ssqp = (float*)(A.ws + WS_SSQ);
            const bf16* Wt = even ? (const bf16*)(A.ws + WS_WE_OUT) + (size_t)li * D * D : (const bf16*)(A.ws + WS_WO_OUT) + (size_t)li * D * D;
            pg8::Gemm g{Yb, Wt, M, D, D}; pg8::StaticOrder S; S.init(M, D, G, bx);
            pg8::EpiOut E{layer == 0 ? A.x : nullptr, layer == 3 ? A.out : nullptr, hb, ssqp};
#ifndef NO_GOUT
            pg8::gemm_phase<pg8::EpiOut, pg8::StaticOrder, true, true>(lds, g, S, E);
#endif
        }
        XBAR_SYNC();
    }
#ifndef NO_FIN
    { FRESH_IDS(); const Args A = FRESH_ARGS(); phase_final(A, gwv, NGW, lane); }
#endif
}

extern "C" void kernel_launch(void* const* d_in, const int* in_sizes, int n_in, void* d_out, int out_size, void* d_ws, size_t ws_size, hipStream_t stream) {
    static int grid = 0;
    if (grid == 0) {
        if (n_in != 11 || in_sizes[0] != M * D || out_size != M * D || ws_size < WS_END) { fprintf(stderr, "kernel_launch: unexpected shapes (n_in %d, in0 %d, out %d, ws %zu)\n", n_in, n_in > 0 ? in_sizes[0] : -1, out_size, ws_size); grid = -1; return; }
        int dev = 0, cus = 0, per_cu = 0;
        if (hipGetDevice(&dev) != hipSuccess || hipDeviceGetAttribute(&cus, hipDeviceAttributeMultiprocessorCount, dev) != hipSuccess) { grid = -1; return; }
        if (hipFuncSetAttribute((const void*)mega_fwd, hipFuncAttributeMaxDynamicSharedMemorySize, LDS_BYTES) != hipSuccess) { fprintf(stderr, "kernel_launch: hipFuncSetAttribute failed\n"); grid = -1; return; }
        if (hipOccupancyMaxActiveBlocksPerMultiprocessor(&per_cu, (const void*)mega_fwd, NTHREADS, LDS_BYTES) != hipSuccess || per_cu < 1) { fprintf(stderr, "kernel_launch: occupancy query says %d\n", per_cu); per_cu = 1; }
        (void)hipGetLastError();
        grid = cus;
    }
    if (grid < 0) return;
    Args a{};
    a.x = (const float*)d_in[0]; a.norm_g = (const float*)d_in[1]; a.final_g = (const float*)d_in[2]; a.ab_w_in = (const float*)d_in[3]; a.ab_w_out = (const float*)d_in[4];
    a.ln_g = (const float*)d_in[5]; a.ln_b = (const float*)d_in[6]; a.w_s = (const float*)d_in[7]; a.b_s = (const float*)d_in[8]; a.c_w_in = (const float*)d_in[9]; a.c_w_out = (const float*)d_in[10];
    a.out = (float*)d_out; a.ws = (unsigned char*)d_ws;
    if (hipMemsetAsync((char*)d_ws + WS_CTL, 0, 16384, stream) != hipSuccess) { fprintf(stderr, "kernel_launch: hipMemsetAsync failed\n"); return; }
    void* args[] = {&a};
    const hipError_t e = hipLaunchCooperativeKernel((const void*)mega_fwd, dim3(grid), dim3(NTHREADS), args, LDS_BYTES, stream);
    if (e != hipSuccess) fprintf(stderr, "kernel_launch: cooperative launch failed: %s (grid %d)\n", hipGetErrorString(e), grid);
}
```

```cpp
#include <hip/hip_runtime.h>
#include <hip/hip_cooperative_groups.h>
#include <cstdio>
#include <cstdint>
#include <cmath>
namespace cg = cooperative_groups;
namespace pg8 {
#define PG8_LAS __attribute__((address_space(3)))
typedef unsigned short bf16_t;
typedef short bf16x8 __attribute__((ext_vector_type(8)));
typedef float f32x4 __attribute__((ext_vector_type(4)));
typedef unsigned u32x4 __attribute__((ext_vector_type(4)));
constexpr int BM = 256, BK = 64, HALF = 128, HTB = HALF * BK * 2  , STAGE_BYTES = 8 * HTB, NXCD = 8, WGM = 8;

__host__ __device__ __forceinline__ int lds_byte(int r, int c) { const int st = (r >> 4) * 2 + (c >> 5), rr = r & 15, cc = c & 31, ob = rr * 64 + cc * 2; return st * 1024 + (ob ^ (((ob >> 9) & 1) << 5)); }
__host__ __device__ __forceinline__ void stage_rc(int b, int& R, int& C) { const int st = b / 1024, sb = b % 1024, swz = sb ^ (((sb >> 9) & 1) << 5); R = (st >> 1) * 16 + swz / 64; C = (st & 1) * 32 + (swz % 64) / 2; }
__host__ __device__ __forceinline__ int perm32(int rho) { const int n = rho >> 4, i = rho & 15; return 8 * (i >> 2) + 4 * n + (i & 3); }

struct Unit { int pm, pn; };
struct Gemm { const bf16_t* A; const bf16_t* Bt; int M, N, K; };

struct StaticOrder {
    int nM, nN, nwg, G, c;
    __host__ __device__ void init(int M, int N, int G_, int c_) { nM = M / BM; nN = N / BM; nwg = nM * nN; G = G_; c = c_; }
    __host__ __device__ bool next(int i, Unit& u) const {
        const long L = (long)i * G + c; if (L >= nwg) return false;
        int wgid = (int)L; { const int q = nwg / NXCD, r = nwg % NXCD, xcd = wgid % NXCD, off = wgid / NXCD; wgid = (xcd < r ? xcd * (q + 1) : r * (q + 1) + (xcd - r) * q) + off; }
        const int nig = WGM * nN, gid = wgid / nig, fm = gid * WGM, gsz = (nM - fm) < WGM ? (nM - fm) : WGM;
        u.pm = fm + ((wgid % nig) % gsz); u.pn = (wgid % nig) / gsz; return true;
    }
    __device__ __forceinline__ void a_ready(const Unit&) const {}
    __device__ __forceinline__ void done(const Unit&) const {}
};

__device__ __forceinline__ unsigned cvt_pk_bf16(float lo, float hi) { unsigned r; asm volatile("v_cvt_pk_bf16_f32 %0, %1, %2" : "=v"(r) : "v"(lo), "v"(hi)); return r; }
typedef unsigned u32x2 __attribute__((ext_vector_type(2)));
__device__ __forceinline__ float act_gelu(float x) {
    const float t = x + 0.044715f * x * x * x;
    return x * __builtin_amdgcn_rcpf(1.f + __builtin_amdgcn_exp2f(-2.302208198f * t));
}
__device__ __forceinline__ float act_silu(float x) { return x * __builtin_amdgcn_rcpf(1.f + __builtin_amdgcn_exp2f(-1.4426950409f * x)); }
constexpr float QSCALE = 0.125f * 1.4426950408889634f;
constexpr float NORM_EPS = 1e-6f;

struct EpiIn {
    static constexpr bool PERM = true, AFTER_DRAIN = false;
    bf16_t* Z; int ldz; const PG8_LAS float* rtab; int* seq; float* kmp; int even;
    template <int ACT> __device__ __forceinline__ void body(const f32x4 (&acc)[2][2][4][2], const Unit& u, int wr, int wc, int fr, int fq, const PG8_LAS float* rt) const {
        const int row0 = u.pm * BM + wr * 64 + fr, col0 = u.pn * BM + wc * 32 + 8 * fq;
        float rs[2][4];
#pragma unroll
        for (int ai = 0; ai < 2; ++ai)
#pragma unroll
            for (int m = 0; m < 4; ++m) rs[ai][m] = rt[wr * 64 + fr + ai * HALF + m * 16];
        float cs[2][2][4];
        if (ACT == 4) {
#pragma unroll
            for (int bj = 0; bj < 2; ++bj)
#pragma unroll
                for (int n = 0; n < 2; ++n)
#pragma unroll
                    for (int e = 0; e < 4; ++e) cs[bj][n][e] = 0.f;
        }
#pragma unroll
        for (int ai = 0; ai < 2; ++ai)
#pragma unroll
            for (int m = 0; m < 4; ++m) {
                const int row = row0 + ai * HALF + m * 16;
                const float rstd = rs[ai][m];
                bf16_t* rowp = Z + (size_t)row * ldz + col0;
#pragma unroll
                for (int bj = 0; bj < 2; ++bj) {
                    f32x4 v[2];
#pragma unroll
                    for (int n = 0; n < 2; ++n) {
                        v[n] = acc[ai][bj][m][n] * rstd;
#pragma unroll
                        for (int e = 0; e < 4; ++e) {
                            if (ACT == 1) v[n][e] = act_gelu(v[n][e]);
                            if (ACT == 2) v[n][e] = act_silu(v[n][e]);
                            if (ACT == 3) v[n][e] = v[n][e] * QSCALE;
                            if (ACT == 4) cs[bj][n][e] += v[n][e];
                        }
                    }
                    u32x4 w; w.x = cvt_pk_bf16(v[0][0], v[0][1]); w.y = cvt_pk_bf16(v[0][2], v[0][3]); w.z = cvt_pk_bf16(v[1][0], v[1][1]); w.w = cvt_pk_bf16(v[1][2], v[1][3]);
                    *(u32x4*)(rowp + bj * HALF) = w;
                }
            }
        if (ACT == 4) {
#pragma unroll
            for (int bj = 0; bj < 2; ++bj)
#pragma unroll
                for (int n = 0; n < 2; ++n)
#pragma unroll
                    for (int e = 0; e < 4; ++e) {
                        float s = cs[bj][n][e];
                        s += __shfl_xor(s, 1); s += __shfl_xor(s, 2); s += __shfl_xor(s, 4); s += __shfl_xor(s, 8);
                        cs[bj][n][e] = s;
                    }
            if (fr == 0) {
                float* kp = kmp + ((size_t)u.pm * 2 + wr) * 512 + (col0 - 2048);
#pragma unroll
                for (int bj = 0; bj < 2; ++bj)
#pragma unroll
                    for (int n = 0; n < 2; ++n) *(f32x4*)(kp + bj * HALF + n * 4) = (f32x4){cs[bj][n][0], cs[bj][n][1], cs[bj][n][2], cs[bj][n][3]};
            }
        }
    }
    __device__ __forceinline__ void operator()(const f32x4 (&acc)[2][2][4][2], const Unit& u, int wr, int wc, int fr, int fq) const {
        int act;
        if (even) { const int seg = u.pn >> 1; act = (seg == 0 || seg == 1) ? 1 : (seg == 2 || seg == 6) ? 2 : (seg == 3) ? 3 : (seg == 4) ? 4 : 0; }
        else { const int seg = u.pn >> 2; act = (seg == 0) ? 3 : (seg == 3) ? 2 : 0; }
        const PG8_LAS float* rt = rtab + ((*seq)++) * 256;
        if (act == 0) body<0>(acc, u, wr, wc, fr, fq, rt);
        else if (act == 1) body<1>(acc, u, wr, wc, fr, fq, rt);
        else if (act == 2) body<2>(acc, u, wr, wc, fr, fq, rt);
        else if (act == 3) body<3>(acc, u, wr, wc, fr, fq, rt);
        else body<4>(acc, u, wr, wc, fr, fq, rt);
    }
};
struct EpiOut {
    static constexpr bool PERM = true, AFTER_DRAIN = false;
    const float* resid_f32; float* out_f32; bf16_t* hb; float* ssqp;
    template <bool RF32> __device__ __forceinline__ void body(const f32x4 (&acc)[2][2][4][2], const Unit& u, int wr, int wc, int fr, int fq) const {
        const int row0 = u.pm * BM + wr * 64 + fr, col0 = u.pn * BM + wc * 32 + 8 * fq;
        constexpr int MB = RF32 ? 2 : 4;
#pragma unroll
        for (int ai = 0; ai < 2; ++ai)
#pragma unroll
        for (int m0 = 0; m0 < 4; m0 += MB) {
            f32x4 rf[RF32 ? MB : 1][2][2]; u32x4 rb[RF32 ? 1 : MB][2];
#pragma unroll
            for (int mm = 0; mm < MB; ++mm)
#pragma unroll
                for (int bj = 0; bj < 2; ++bj) {
                    const size_t o2 = (size_t)(row0 + ai * HALF + (m0 + mm) * 16) * 1024 + col0 + bj * HALF;
                    if (RF32) { rf[RF32 ? mm : 0][bj][0] = *(const f32x4*)(resid_f32 + o2); rf[RF32 ? mm : 0][bj][1] = *(const f32x4*)(resid_f32 + o2 + 4); }
                    else rb[RF32 ? 0 : mm][bj] = *(const u32x4*)(hb + o2);
                }
#pragma unroll
            for (int mm = 0; mm < MB; ++mm) {
                const int m = m0 + mm;
                const int row = row0 + ai * HALF + m * 16; const size_t off = (size_t)row * 1024 + col0; float ss = 0.f;
#pragma unroll
                for (int bj = 0; bj < 2; ++bj) {
                    const size_t o2 = off + bj * HALF;
                    f32x4 r0, r1;
                    if (RF32) { r0 = rf[RF32 ? mm : 0][bj][0]; r1 = rf[RF32 ? mm : 0][bj][1]; }
                    else { const u32x4 w = rb[RF32 ? 0 : mm][bj];
                        r0[0] = __builtin_bit_cast(float, w.x << 16); r0[1] = __builtin_bit_cast(float, w.x & 0xffff0000u); r0[2] = __builtin_bit_cast(float, w.y << 16); r0[3] = __builtin_bit_cast(float, w.y & 0xffff0000u);
                        r1[0] = __builtin_bit_cast(float, w.z << 16); r1[1] = __builtin_bit_cast(float, w.z & 0xffff0000u); r1[2] = __builtin_bit_cast(float, w.w << 16); r1[3] = __builtin_bit_cast(float, w.w & 0xffff0000u); }
                    const f32x4 o0 = r0 + acc[ai][bj][m][0], o1 = r1 + acc[ai][bj][m][1];
                    ss += ((o0[0] * o0[0] + o0[1] * o0[1]) + (o0[2] * o0[2] + o0[3] * o0[3])) + ((o1[0] * o1[0] + o1[1] * o1[1]) + (o1[2] * o1[2] + o1[3] * o1[3]));
                    if (out_f32) { *(f32x4*)(out_f32 + o2) = o0; *(f32x4*)(out_f32 + o2 + 4) = o1; }
                    else { u32x4 w; w.x = cvt_pk_bf16(o0[0], o0[1]); w.y = cvt_pk_bf16(o0[2], o0[3]); w.z = cvt_pk_bf16(o1[0], o1[1]); w.w = cvt_pk_bf16(o1[2], o1[3]); *(u32x4*)(hb + o2) = w; }
                }
                ss += __shfl_xor(ss, 16); ss += __shfl_xor(ss, 32);
                if (fq == 0) ssqp[(size_t)row * 16 + u.pn * 4 + wc] = ss;
            }
        }
    }
    __device__ __forceinline__ void operator()(const f32x4 (&acc)[2][2][4][2], const Unit& u, int wr, int wc, int fr, int fq) const {
        if (resid_f32) body<true>(acc, u, wr, wc, fr, fq); else body<false>(acc, u, wr, wc, fr, fq);
    }
};
template <class Epi, class Sched, bool ALIGN_EPI = false, bool SP2 = false>
__device__ __forceinline__ void gemm_phase(PG8_LAS unsigned char* lds, const Gemm g, const Sched& S, const Epi& E) {
    int tid_ = threadIdx.x; asm volatile("" : "+v"(tid_));
    const int tid = tid_, wid = __builtin_amdgcn_readfirstlane(tid >> 6), lane = tid & 63, wr = wid >> 2, wc = wid & 3, fr = lane & 15, fq = lane >> 4;
    const int K = g.K, nt = K / BK;
    unsigned voffA[2], voffB[2];
#pragma unroll
    for (int i = 0; i < 2; ++i) { int R, C; stage_rc(tid * 16 + i * 8192, R, C); const int Rb = Epi::PERM ? ((R & ~31) + perm32(R & 31)) : R;
        voffA[i] = (unsigned)(R * K + C) * 2u; voffB[i] = (unsigned)(Rb * K + C) * 2u; }
    const size_t kstep = (size_t)(BK * 2);
    const size_t hstep = (size_t)HALF * K * 2;
    const size_t tstep = 2 * hstep;
    const unsigned ldsw = (unsigned)wid * 1024u;
    const int aoff = lds_byte(wr * 64 + fr, fq * 8), boff = lds_byte(wc * 32 + fr, fq * 8);
#define PG8_SA(b, h) (((b) * 2 + (h)) * HTB)
#define PG8_SB(b, h) ((4 + (b) * 2 + (h)) * HTB)
#define PG8_STAGE(bufoff, gbase, voff) do { _Pragma("unroll") for (int _i = 0; _i < 2; ++_i) \
        __builtin_amdgcn_global_load_lds((const unsigned*)((const char*)(gbase) + (voff)[_i]), (PG8_LAS unsigned*)(lds + (bufoff) + ldsw + _i * 8192), 16, 0, 0); } while (0)
#define PG8_LDA(dst, b, h) do { _Pragma("unroll") for (int m = 0; m < 4; ++m) _Pragma("unroll") for (int k = 0; k < 2; ++k) dst[m][k] = *(const PG8_LAS bf16x8*)(lds + PG8_SA(b, h) + aoff + m * 2048 + k * 1024); } while (0)
#define PG8_LDB(dst, b, h) do { _Pragma("unroll") for (int n = 0; n < 2; ++n) _Pragma("unroll") for (int k = 0; k < 2; ++k) dst[n][k] = *(const PG8_LAS bf16x8*)(lds + PG8_SB(b, h) + boff + n * 2048 + k * 1024); } while (0)
#define PG8_MMA(ai, bj, At, Bt) do { __builtin_amdgcn_s_setprio(1); _Pragma("unroll") for (int m = 0; m < 4; ++m) _Pragma("unroll") for (int n = 0; n < 2; ++n) _Pragma("unroll") for (int k = 0; k < 2; ++k) \
        acc[ai][bj][m][n] = __builtin_amdgcn_mfma_f32_16x16x32_bf16(Bt[n][k], At[m][k], acc[ai][bj][m][n], 0, 0, 0); __builtin_amdgcn_s_setprio(0); } while (0)
#define PG8_WAIT_V(n) asm volatile("s_waitcnt vmcnt(" #n ")" ::: "memory")
#define PG8_WAIT_L(n) asm volatile("s_waitcnt lgkmcnt(" #n ")" ::: "memory")
#define PG8_BAR __builtin_amdgcn_s_barrier()
#define PG8_SCHED __builtin_amdgcn_sched_barrier(0)
    Unit cur, nxt; int ui = 0;
    if (!S.next(0, cur)) return;
    f32x4 acc[2][2][4][2];
#pragma unroll
    for (int a = 0; a < 2; ++a)
#pragma unroll
        for (int b = 0; b < 2; ++b)
#pragma unroll
            for (int m = 0; m < 4; ++m)
#pragma unroll
                for (int n = 0; n < 2; ++n) acc[a][b][m][n] = (f32x4){0.f, 0.f, 0.f, 0.f};
    bf16x8 At[4][2], B0[2][2], B1[2][2];
    const char* cA = (const char*)g.A + (size_t)cur.pm * tstep; const char* cB = (const char*)g.Bt + (size_t)cur.pn * tstep;
    S.a_ready(cur);
    if constexpr (SP2) {
        PG8_STAGE(PG8_SB(0, 0), cB, voffB); PG8_STAGE(PG8_SB(0, 1), cB + hstep, voffB); PG8_STAGE(PG8_SA(0, 0), cA, voffA); PG8_STAGE(PG8_SA(0, 1), cA + hstep, voffA);
        if (wr == 1) PG8_BAR;
        PG8_WAIT_V(2); PG8_BAR;
        PG8_STAGE(PG8_SB(1, 0), cB + kstep, voffB); PG8_STAGE(PG8_SA(1, 0), cA + kstep, voffA); PG8_STAGE(PG8_SB(1, 1), cB + hstep + kstep, voffB);
        PG8_WAIT_V(6); PG8_BAR;
    } else {
        PG8_STAGE(PG8_SB(0, 0), cB, voffB); PG8_STAGE(PG8_SA(0, 0), cA, voffA); PG8_STAGE(PG8_SB(0, 1), cB + hstep, voffB); PG8_STAGE(PG8_SA(0, 1), cA + hstep, voffA);
        if (wr == 1) PG8_BAR;
        PG8_WAIT_V(4); PG8_BAR;
        PG8_STAGE(PG8_SB(1, 0), cB + kstep, voffB); PG8_STAGE(PG8_SA(1, 0), cA + kstep, voffA); PG8_STAGE(PG8_SB(1, 1), cB + hstep + kstep, voffB);
        PG8_WAIT_V(6); PG8_BAR;
    }
    for (;;) {
        const bool has_next = S.next(ui + 1, nxt);
        const char* nA = has_next ? (const char*)g.A + (size_t)nxt.pm * tstep : cA; const char* nB = has_next ? (const char*)g.Bt + (size_t)nxt.pn * tstep : cB;
        for (int t = 0; t < nt; t += 2) {
            const bool last = (t == nt - 2);
            const char* a1 = cA + (size_t)(t + 1) * kstep;
            const char* a2 = last ? nA : cA + (size_t)(t + 2) * kstep; const char* b2 = last ? nB : cB + (size_t)(t + 2) * kstep;
            const char* a3 = a2 + kstep; const char* b3 = b2 + kstep;
            if (last && has_next) S.a_ready(nxt);
            if constexpr (SP2) {
            PG8_LDB(B0, 0, 0); PG8_LDB(B1, 0, 1); PG8_SCHED; PG8_LDA(At, 0, 0); PG8_STAGE(PG8_SA(1, 1), a1 + hstep, voffA);
            PG8_WAIT_V(8); PG8_WAIT_L(0); PG8_BAR; PG8_MMA(0, 0, At, B0); PG8_MMA(0, 1, At, B1); PG8_BAR; PG8_SCHED;
            PG8_LDA(At, 0, 1); PG8_STAGE(PG8_SB(0, 0), b2, voffB); PG8_STAGE(PG8_SB(0, 1), b2 + hstep, voffB); PG8_STAGE(PG8_SA(0, 0), a2, voffA);
            PG8_WAIT_V(8); PG8_WAIT_L(0); PG8_BAR; PG8_MMA(1, 0, At, B0); PG8_MMA(1, 1, At, B1); PG8_BAR; PG8_SCHED;
            PG8_LDB(B0, 1, 0); PG8_LDB(B1, 1, 1); PG8_SCHED; PG8_LDA(At, 1, 0); PG8_STAGE(PG8_SA(0, 1), a2 + hstep, voffA);
            PG8_WAIT_V(8); PG8_WAIT_L(0); PG8_BAR; PG8_MMA(0, 0, At, B0); PG8_MMA(0, 1, At, B1); PG8_BAR; PG8_SCHED;
            PG8_LDA(At, 1, 1); PG8_STAGE(PG8_SB(1, 0), b3, voffB); PG8_STAGE(PG8_SB(1, 1), b3 + hstep, voffB); PG8_STAGE(PG8_SA(1, 0), a3, voffA);
            PG8_WAIT_V(8); PG8_WAIT_L(0); PG8_BAR; PG8_MMA(1, 0, At, B0); PG8_MMA(1, 1, At, B1); PG8_BAR; PG8_SCHED;
            } else {
            PG8_LDB(B0, 0, 0); PG8_SCHED; PG8_LDA(At, 0, 0); PG8_STAGE(PG8_SA(1, 1), a1 + hstep, voffA);
            PG8_WAIT_L(8); PG8_BAR; PG8_WAIT_L(0); PG8_MMA(0, 0, At, B0); PG8_BAR; PG8_SCHED;
            PG8_LDB(B1, 0, 1); PG8_STAGE(PG8_SB(0, 0), b2, voffB);
            PG8_BAR; PG8_WAIT_L(0); PG8_MMA(0, 1, At, B1); PG8_BAR;
            PG8_LDA(At, 0, 1); PG8_STAGE(PG8_SA(0, 0), a2, voffA);
            PG8_BAR; PG8_WAIT_L(0); PG8_MMA(1, 0, At, B0); PG8_BAR; PG8_SCHED;
            PG8_STAGE(PG8_SB(0, 1), b2 + hstep, voffB);
            PG8_WAIT_V(6); PG8_BAR; PG8_MMA(1, 1, At, B1); PG8_BAR;
            PG8_LDB(B0, 1, 0); PG8_SCHED; PG8_LDA(At, 1, 0); PG8_STAGE(PG8_SA(0, 1), a2 + hstep, voffA);
            PG8_WAIT_L(8); PG8_BAR; PG8_WAIT_L(0); PG8_MMA(0, 0, At, B0); PG8_BAR; PG8_SCHED;
            PG8_LDB(B1, 1, 1); PG8_STAGE(PG8_SB(1, 0), b3, voffB);
            PG8_BAR; PG8_WAIT_L(0); PG8_MMA(0, 1, At, B1); PG8_BAR;
            PG8_LDA(At, 1, 1); PG8_STAGE(PG8_SA(1, 0), a3, voffA);
            PG8_BAR; PG8_WAIT_L(0); PG8_MMA(1, 0, At, B0); PG8_BAR; PG8_SCHED;
            PG8_STAGE(PG8_SB(1, 1), b3 + hstep, voffB);
            PG8_WAIT_V(6); PG8_BAR; PG8_MMA(1, 1, At, B1); PG8_BAR;
            }
        }
        if constexpr (ALIGN_EPI) { if (wr == 0) PG8_BAR; }
        if constexpr (!Epi::AFTER_DRAIN) { E(acc, cur, wr, wc, fr, fq); S.done(cur); }
        if (!has_next) break;
#pragma unroll
        for (int a = 0; a < 2; ++a)
#pragma unroll
            for (int b = 0; b < 2; ++b)
#pragma unroll
                for (int m = 0; m < 4; ++m)
#pragma unroll
                    for (int n = 0; n < 2; ++n) acc[a][b][m][n] = (f32x4){0.f, 0.f, 0.f, 0.f};
        cur = nxt; cA = nA; cB = nB; ++ui;
        if constexpr (ALIGN_EPI) { if (wr == 1) PG8_BAR; }
    }
    PG8_WAIT_V(0);
    if constexpr (!ALIGN_EPI) { if (wr == 0) PG8_BAR; }
    PG8_BAR;
    if constexpr (Epi::AFTER_DRAIN) { E.fused(acc, cur, wr, wc, fr, fq, lds, wid, lane); S.done(cur); }
#undef PG8_SA
#undef PG8_SB
#undef PG8_STAGE
#undef PG8_LDA
#undef PG8_LDB
#undef PG8_MMA
#undef PG8_WAIT_V
#undef PG8_WAIT_L
#undef PG8_BAR
#undef PG8_SCHED
}
}
#define GAS __attribute__((address_space(1)))
#define LAS __attribute__((address_space(3)))
typedef unsigned short bf16;
typedef unsigned v4u __attribute__((ext_vector_type(4)));
typedef unsigned v2u __attribute__((ext_vector_type(2)));
typedef float f32x4 __attribute__((ext_vector_type(4)));
typedef float f32x16 __attribute__((ext_vector_type(16)));
typedef short bf16x8 __attribute__((ext_vector_type(8)));
typedef short s16x4 __attribute__((ext_vector_type(4)));
#define LDS_WAIT() asm volatile("s_waitcnt lgkmcnt(0)" ::: "memory")
using pg8::cvt_pk_bf16; using pg8::NORM_EPS; using pg8::QSCALE;

constexpr int NWAVES = 8, NTHREADS = 512;
constexpr float RESCALE_THR = 8.0f;
constexpr int D = 1024, BATCH = 16, SEQ = 4096, M = BATCH * SEQ;
constexpr int EVEN_IN = 3584, ODD_IN = 4096;
constexpr size_t MiB = 1u << 20;
constexpr size_t WS_WE_IN = 0, WS_WE_OUT = 14 * MiB, WS_WO_IN = 18 * MiB, WS_WO_OUT = 34 * MiB, WS_WS = 38 * MiB, WS_SSQ = 39 * MiB, WS_KMP = 43 * MiB,
                 WS_HB = 44 * MiB, WS_Y = 172 * MiB, WS_Z = 300 * MiB, WS_CTL = 812 * MiB, WS_END = 813 * MiB;
constexpr int LDS_BYTES = 131072 + 1024 + 16384;

__device__ __forceinline__ unsigned f2bf(float f) { unsigned u = __builtin_bit_cast(unsigned, f); return (u + 0x7fffu + ((u >> 16) & 1u)) >> 16; }
__device__ __forceinline__ unsigned pk2(float lo, float hi) { return f2bf(lo) | (f2bf(hi) << 16); }
__device__ __forceinline__ float bf_lo(unsigned w) { return __builtin_bit_cast(float, w << 16); }
__device__ __forceinline__ float bf_hi(unsigned w) { return __builtin_bit_cast(float, w & 0xffff0000u); }
__device__ __forceinline__ float wave_sum(float v) {
#pragma unroll
    for (int o = 1; o < 64; o <<= 1) v += __shfl_xor(v, o);
    return v;
}
typedef float f32x2_t __attribute__((ext_vector_type(2))); typedef __bf16 bf16x2_t __attribute__((ext_vector_type(2)));
__device__ __forceinline__ unsigned cvtpk_s(float lo, float hi) { f32x2_t v = {lo, hi}; bf16x2_t b = __builtin_convertvector(v, bf16x2_t); return __builtin_bit_cast(unsigned, b); }
__device__ __forceinline__ int crow(int r, int hi) { return (r & 3) + 8 * (r >> 2) + 4 * hi; }
__device__ __forceinline__ s16x4 vtr(const LAS unsigned char* p) { return __builtin_bit_cast(s16x4, __builtin_amdgcn_ds_read_tr16_b64_v4i16((LAS s16x4*)p)); }

__device__ __forceinline__ void transpose_item(const float* W, const float* g, int K, int N, bf16* WT, LAS float* scr, int item, int lane) {
    const int nblk = N / 32, kb = item / nblk, nb = item % nblk, k0 = 64 * kb, n0 = 32 * nb;
#pragma unroll 8
    for (int i = 0; i < 32; ++i) { const int kk = 2 * i + (lane >> 5); const float sc = g ? g[k0 + kk] : 1.f; scr[kk * 33 + (lane & 31)] = W[(size_t)(k0 + kk) * N + n0 + (lane & 31)] * sc; }
    LDS_WAIT(); asm volatile("" ::: "memory");
    const int c = lane & 7;
#pragma unroll
    for (int j = 0; j < 4; ++j) { const int n = (lane >> 3) + 8 * j; const LAS float* s = scr + (8 * c) * 33 + n;
        v4u o; o.x = pk2(s[0 * 33], s[1 * 33]); o.y = pk2(s[2 * 33], s[3 * 33]); o.z = pk2(s[4 * 33], s[5 * 33]); o.w = pk2(s[6 * 33], s[7 * 33]);
        *(v4u*)(WT + (size_t)(n0 + n) * K + k0 + 8 * c) = o; }
    LDS_WAIT(); asm volatile("" ::: "memory");
}

struct Args {
    const float *x, *norm_g, *final_g, *ab_w_in, *ab_w_out, *ln_g, *ln_b, *w_s, *b_s, *c_w_in, *c_w_out;
    float* out; unsigned char* ws;
};

__device__ __forceinline__ void phase_prologue(const Args& A, LAS unsigned char* lds, int gwv, int NGW, int wave, int lane) {
    LAS float* scr = (LAS float*)(lds + wave * 16384);
    constexpr int I_EIN = 16 * (EVEN_IN / 32), I_OUT = 16 * 32, I_OIN = 16 * (ODD_IN / 32), I_PAIR = I_EIN + I_OUT + I_OIN + I_OUT;
    for (int it = gwv; it < 2 * I_PAIR; it += NGW) {
        const int i = it / I_PAIR; int r = it % I_PAIR;
        if (r < I_EIN) { transpose_item(A.ab_w_in + (size_t)i * D * EVEN_IN, A.norm_g + (2 * i) * D, D, EVEN_IN, (bf16*)(A.ws + WS_WE_IN) + (size_t)i * EVEN_IN * D, scr, r, lane); continue; } r -= I_EIN;
        if (r < I_OUT) { transpose_item(A.ab_w_out + (size_t)i * D * D, nullptr, D, D, (bf16*)(A.ws + WS_WE_OUT) + (size_t)i * D * D, scr, r, lane); continue; } r -= I_OUT;
        if (r < I_OIN) { transpose_item(A.c_w_in + (size_t)i * D * ODD_IN, A.norm_g + (2 * i + 1) * D, D, ODD_IN, (bf16*)(A.ws + WS_WO_IN) + (size_t)i * ODD_IN * D, scr, r, lane); continue; } r -= I_OIN;
        transpose_item(A.c_w_out + (size_t)i * D * D, nullptr, D, D, (bf16*)(A.ws + WS_WO_OUT) + (size_t)i * D * D, scr, r, lane);
    }
    { bf16* wst = (bf16*)(A.ws + WS_WS);
      for (int e = gwv * 64 + lane; e < 2 * 4 * 128 * 128; e += NGW * 64) { const int s = e & 127, t = (e >> 7) & 127; wst[e] = (bf16)f2bf(s <= t ? A.w_s[e] : 0.f); } }
    bf16* hb = (bf16*)(A.ws + WS_HB); float* ssqp = (float*)(A.ws + WS_SSQ);
    for (int m = gwv; m < M; m += 2 * NGW) {
        const int m2 = m + NGW;
        const f32x4* xr = (const f32x4*)(A.x + (size_t)m * D) + lane; const f32x4* xr2 = (const f32x4*)(A.x + (size_t)m2 * D) + lane;
        f32x4 v[4], w4[4];
#pragma unroll
        for (int j = 0; j < 4; ++j) { v[j] = xr[64 * j]; w4[j] = xr2[64 * j]; }
        float s = 0.f, s2 = 0.f;
#pragma unroll
        for (int j = 0; j < 4; ++j) { s += (v[j][0] * v[j][0] + v[j][1] * v[j][1]) + (v[j][2] * v[j][2] + v[j][3] * v[j][3]); s2 += (w4[j][0] * w4[j][0] + w4[j][1] * w4[j][1]) + (w4[j][2] * w4[j][2] + w4[j][3] * w4[j][3]); }
        s = wave_sum(s); s2 = wave_sum(s2);
        v2u* o8 = (v2u*)(hb + (size_t)m * D) + lane; v2u* o82 = (v2u*)(hb + (size_t)m2 * D) + lane;
#pragma unroll
        for (int j = 0; j < 4; ++j) { v2u w; w.x = cvtpk_s(v[j][0], v[j][1]); w.y = cvtpk_s(v[j][2], v[j][3]); o8[64 * j] = w; v2u w2; w2.x = cvtpk_s(w4[j][0], w4[j][1]); w2.y = cvtpk_s(w4[j][2], w4[j][3]); o82[64 * j] = w2; }
        if (lane < 16) { ssqp[(size_t)m * 16 + lane] = (lane == 0) ? s : 0.f; ssqp[(size_t)m2 * 16 + lane] = (lane == 0) ? s2 : 0.f; }
    }
}

__device__ __forceinline__ v4u pair_to_wide(v2u gk, v2u gk1) {
    const auto sx = __builtin_amdgcn_permlane32_swap(gk.x, gk1.x, false, false), sy = __builtin_amdgcn_permlane32_swap(gk.y, gk1.y, false, false);
    return (v4u){sx[0], sy[0], sx[1], sy[1]};
}
__device__ __forceinline__ void wide_to_pair(v4u w, v2u& gk, v2u& gk1) {
    const auto sx = __builtin_amdgcn_permlane32_swap(w.x, w.z, false, false), sy = __builtin_amdgcn_permlane32_swap(w.y, w.w, false, false);
    gk.x = sx[0]; gk.y = sy[0]; gk1.x = sx[1]; gk1.y = sy[1];
}
__device__ __forceinline__ void phase_gmlp(const Args& A, int li, LAS unsigned char* lds, int vcu, int G, int wave, int lane) {
    const bf16* Z = (const bf16*)(A.ws + WS_Z); bf16* Y = (bf16*)(A.ws + WS_Y);
    const bf16* wst = (const bf16*)(A.ws + WS_WS) + (size_t)li * 4 * 128 * 128;
    const float* lng = A.ln_g + li * 512; const float* lnb = A.ln_b + li * 512; const float* bs = A.b_s + li * 4 * 128;
    const int r32 = lane & 31, hi = lane >> 5, grp = lane >> 4, qq = (lane & 15) >> 2, pp = lane & 3;
    float gg[8], gb[8];
#pragma unroll
    for (int j = 0; j < 8; ++j) { gg[j] = lng[8 * lane + j]; gb[j] = lnb[8 * lane + j]; }
    for (int u = vcu; u < M / 128; u += G) {
        const size_t row0 = (size_t)u * 128;
#pragma unroll 1
        for (int r4 = 0; r4 < 16; r4 += 8) {
            v4u wv[8];
#pragma unroll
            for (int k = 0; k < 8; ++k) wv[k] = *(const v4u*)(Z + (row0 + wave * 16 + r4 + k) * EVEN_IN + 512 + 8 * lane);
#pragma unroll
            for (int k = 0; k < 8; ++k) {
                const int s = wave * 16 + r4 + k; const v4u w = wv[k];
                float x[8] = {bf_lo(w.x), bf_hi(w.x), bf_lo(w.y), bf_hi(w.y), bf_lo(w.z), bf_hi(w.z), bf_lo(w.w), bf_hi(w.w)};
                float sm = 0.f;
#pragma unroll
                for (int j = 0; j < 8; ++j) sm += x[j];
                const float mean = wave_sum(sm) * (1.f / 512.f); float sq = 0.f;
#pragma unroll
                for (int j = 0; j < 8; ++j) { x[j] -= mean; sq += x[j] * x[j]; }
                const float rstd = __builtin_amdgcn_rsqf(wave_sum(sq) * (1.f / 512.f) + NORM_EPS);
#pragma unroll
                for (int j = 0; j < 8; ++j) x[j] = x[j] * rstd * gg[j] + gb[j];
                v4u o; o.x = cvtpk_s(x[0], x[1]); o.y = cvtpk_s(x[2], x[3]); o.z = cvtpk_s(x[4], x[5]); o.w = cvtpk_s(x[6], x[7]);
                *(LAS v4u*)(lds + ((s >> 3) * 16 + (lane >> 2)) * 512 + (s & 7) * 64 + (lane & 3) * 16) = o;
            }
        }
        __syncthreads();
        const int g = wave >> 1;
#pragma unroll 1
        for (int t2 = 0; t2 < 2; ++t2) {
            const int tt = (wave & 1) * 2 + t2;
            f32x16 acc[4];
#pragma unroll
            for (int ct = 0; ct < 4; ++ct) acc[ct] = f32x16{};
            const bf16* wrow = wst + ((size_t)g * 128 + 32 * tt + r32) * 128 + 8 * hi;
            bf16x8 bw[8];
#pragma unroll
            for (int ks = 0; ks < 8; ++ks) bw[ks] = *(const bf16x8*)(wrow + 16 * ks);
#pragma unroll
            for (int ks = 0; ks < 8; ++ks) {
                const bf16x8 bfrag = bw[ks];
#pragma unroll
                for (int ct = 0; ct < 4; ++ct) {
                    const LAS unsigned char* p = lds + ((2 * ks + hi) * 16 + 4 * g + ct) * 512 + qq * 64 + (16 * (grp & 1) + 4 * pp) * 2;
                    const s16x4 lo = vtr(p), hi4 = vtr(p + 256);
                    const bf16x8 afrag = (bf16x8){lo[0], lo[1], lo[2], lo[3], hi4[0], hi4[1], hi4[2], hi4[3]};
                    acc[ct] = __builtin_amdgcn_mfma_f32_32x32x16_bf16(afrag, bfrag, acc[ct], 0, 0, 0);
                }
            }
            const int t = 32 * tt + r32; const size_t row = row0 + t; const float bias = bs[g * 128 + t];
            v2u ub[4][4], gb2[4][4];
#pragma unroll
            for (int ct = 0; ct < 4; ++ct)
#pragma unroll
                for (int pr = 0; pr < 2; ++pr) {
                    const int c = g * 128 + 32 * ct + 16 * pr + 8 * hi;
                    const v4u wu = *(const v4u*)(Z + row * EVEN_IN + c), wg = *(const v4u*)(Z + row * EVEN_IN + 1024 + c);
                    wide_to_pair(wu, ub[ct][2 * pr], ub[ct][2 * pr + 1]); wide_to_pair(wg, gb2[ct][2 * pr], gb2[ct][2 * pr + 1]);
                }
#pragma unroll
            for (int ct = 0; ct < 4; ++ct)
#pragma unroll
                for (int pr = 0; pr < 2; ++pr) {
                    v2u o2[2];
#pragma unroll
                    for (int k = 0; k < 2; ++k) {
                        const int rq = 2 * pr + k; const v2u uu = ub[ct][rq], ga = gb2[ct][rq];
                        const float y0 = bf_lo(uu.x) * (acc[ct][4 * rq + 0] + bias) * bf_lo(ga.x), y1 = bf_hi(uu.x) * (acc[ct][4 * rq + 1] + bias) * bf_hi(ga.x);
                        const float y2 = bf_lo(uu.y) * (acc[ct][4 * rq + 2] + bias) * bf_lo(ga.y), y3 = bf_hi(uu.y) * (acc[ct][4 * rq + 3] + bias) * bf_hi(ga.y);
                        o2[k].x = cvtpk_s(y0, y1); o2[k].y = cvtpk_s(y2, y3);
                    }
                    *(v4u*)(Y + row * D + g * 128 + 32 * ct + 16 * pr + 8 * hi) = pair_to_wide(o2[0], o2[1]);
                }
        }
        __syncthreads();
    }
}

struct AttnSt { f32x16 o0, o1; float m, l; };
template <class MaskF>
__device__ __forceinline__ void attn_tile(AttnSt& st, const bf16x8 (&qf)[4], const bf16* kp, const bf16* vp0, const bf16* vp1, const bf16* vp2, const bf16* vp3, LAS unsigned char* vl, int lane, bool domask, MaskF mask) {
    const int hi = lane >> 5, grp = lane >> 4, qq = (lane & 15) >> 2, pp = lane & 3;
    bf16x8 kf[4]; v4u vv[4];
#pragma unroll
    for (int d0 = 0; d0 < 4; ++d0) kf[d0] = *(const bf16x8*)(kp + 16 * d0);
    vv[0] = *(const v4u*)vp0; vv[1] = *(const v4u*)vp1; vv[2] = *(const v4u*)vp2; vv[3] = *(const v4u*)vp3;
    f32x16 s = f32x16{};
#pragma unroll
    for (int d0 = 0; d0 < 4; ++d0) s = __builtin_amdgcn_mfma_f32_32x32x16_bf16(kf[d0], qf[d0], s, 0, 0, 0);
#pragma unroll
    for (int it = 0; it < 4; ++it) *(LAS v4u*)(vl + (it * 2 + ((lane & 7) >> 2)) * 512 + (lane >> 3) * 64 + (lane & 3) * 16) = vv[it];
    if (domask) {
#pragma unroll
        for (int r = 0; r < 16; ++r) if (!mask(crow(r, hi))) s[r] = -INFINITY;
    }
    float mt = s[0];
#pragma unroll
    for (int r = 1; r < 16; ++r) mt = fmaxf(mt, s[r]);
    mt = fmaxf(mt, __shfl_xor(mt, 32));
    if (__any(mt > st.m + RESCALE_THR)) {
        const float mn = fmaxf(st.m, mt);
        const float f = __builtin_amdgcn_exp2f(st.m - mn); st.l *= f; st.m = mn;
#pragma unroll
        for (int r = 0; r < 16; ++r) { st.o0[r] *= f; st.o1[r] *= f; }
    }
    float ps = 0.f;
#pragma unroll
    for (int r = 0; r < 16; ++r) { s[r] = __builtin_amdgcn_exp2f(s[r] - st.m); ps += s[r]; }
    st.l += ps;
    v4u pw0, pw1;
    pw0.x = cvtpk_s(s[0], s[1]); pw0.y = cvtpk_s(s[2], s[3]); pw0.z = cvtpk_s(s[4], s[5]); pw0.w = cvtpk_s(s[6], s[7]);
    pw1.x = cvtpk_s(s[8], s[9]); pw1.y = cvtpk_s(s[10], s[11]); pw1.z = cvtpk_s(s[12], s[13]); pw1.w = cvtpk_s(s[14], s[15]);
    const bf16x8 pf0 = __builtin_bit_cast(bf16x8, pw0), pf1 = __builtin_bit_cast(bf16x8, pw1);
    const LAS unsigned char* tb = vl + (4 * hi + qq) * 64 + (16 * (grp & 1) + 4 * pp) * 2;
#define VFRAG(ks, d0) ({ const s16x4 lo_ = vtr(tb + ((2 * (ks)) * 2 + (d0)) * 512), hi_ = vtr(tb + ((2 * (ks) + 1) * 2 + (d0)) * 512); (bf16x8){lo_[0], lo_[1], lo_[2], lo_[3], hi_[0], hi_[1], hi_[2], hi_[3]}; })
    st.o0 = __builtin_amdgcn_mfma_f32_32x32x16_bf16(VFRAG(0, 0), pf0, st.o0, 0, 0, 0);
    st.o1 = __builtin_amdgcn_mfma_f32_32x32x16_bf16(VFRAG(0, 1), pf0, st.o1, 0, 0, 0);
    st.o0 = __builtin_amdgcn_mfma_f32_32x32x16_bf16(VFRAG(1, 0), pf1, st.o0, 0, 0, 0);
    st.o1 = __builtin_amdgcn_mfma_f32_32x32x16_bf16(VFRAG(1, 1), pf1, st.o1, 0, 0, 0);
#undef VFRAG
}
__device__ __forceinline__ void attn_store(const AttnSt& st, const bf16* grow, bf16* yrow, int lane) {
    const int hi = lane >> 5;
    const float lt = st.l + __shfl_xor(st.l, 32), inv = 1.0f / lt;
    v2u ga[2][4];
#pragma unroll
    for (int d0 = 0; d0 < 2; ++d0)
#pragma unroll
        for (int rq = 0; rq < 4; ++rq) ga[d0][rq] = *(const v2u*)(grow + 32 * d0 + 8 * rq + 4 * hi);
#pragma unroll
    for (int d0 = 0; d0 < 2; ++d0)
#pragma unroll
        for (int rq = 0; rq < 4; ++rq) {
            const int d = 32 * d0 + 8 * rq + 4 * hi;
            const v2u g = ga[d0][rq];
            const f32x16& o = d0 ? st.o1 : st.o0;
            v2u w; w.x = cvtpk_s(o[4 * rq + 0] * inv * bf_lo(g.x), o[4 * rq + 1] * inv * bf_hi(g.x)); w.y = cvtpk_s(o[4 * rq + 2] * inv * bf_lo(g.y), o[4 * rq + 3] * inv * bf_hi(g.y));
            *(v2u*)(yrow + d) = w;
        }
}

__device__ __forceinline__ void attn_gate_load(v2u (&ga)[2][4], const bf16* grow, int lane) {
    const int hi = lane >> 5;
#pragma unroll
    for (int d0 = 0; d0 < 2; ++d0)
#pragma unroll
        for (int pr = 0; pr < 2; ++pr) { const v4u w = *(const v4u*)(grow + 32 * d0 + 16 * pr + 8 * hi); wide_to_pair(w, ga[d0][2 * pr], ga[d0][2 * pr + 1]); }
}
__device__ __forceinline__ void attn_store_g(const AttnSt& st, const v2u (&ga)[2][4], bf16* yrow, int lane) {
    const int hi = lane >> 5;
    const float lt = st.l + __shfl_xor(st.l, 32), inv = 1.0f / lt;
#pragma unroll
    for (int d0 = 0; d0 < 2; ++d0)
#pragma unroll
        for (int pr = 0; pr < 2; ++pr) {
            v2u w2[2];
#pragma unroll
            for (int k = 0; k < 2; ++k) {
                const int rq = 2 * pr + k; const v2u g = ga[d0][rq]; const f32x16& o = d0 ? st.o1 : st.o0;
                w2[k].x = cvtpk_s(o[4 * rq + 0] * inv * bf_lo(g.x), o[4 * rq + 1] * inv * bf_hi(g.x)); w2[k].y = cvtpk_s(o[4 * rq + 2] * inv * bf_lo(g.y), o[4 * rq + 3] * inv * bf_hi(g.y));
            }
            *(v4u*)(yrow + 32 * d0 + 16 * pr + 8 * hi) = pair_to_wide(w2[0], w2[1]);
        }
}

struct TileRegs { v4u kk[4]; v4u vv[4]; };
__device__ __forceinline__ void attn_load(TileRegs& R, int kvoff, const bf16* vp0, const bf16* vp1, const bf16* vp2, const bf16* vp3) {
    R.kk[0] = *(const v4u*)(vp0 - kvoff); R.kk[1] = *(const v4u*)(vp1 - kvoff); R.kk[2] = *(const v4u*)(vp2 - kvoff); R.kk[3] = *(const v4u*)(vp3 - kvoff);
    R.vv[0] = *(const v4u*)vp0; R.vv[1] = *(const v4u*)vp1; R.vv[2] = *(const v4u*)vp2; R.vv[3] = *(const v4u*)vp3;
}
__device__ __forceinline__ void attn_load_k(TileRegs& R, int kvoff, const bf16* vp0, const bf16* vp1, const bf16* vp2, const bf16* vp3) {
    R.kk[0] = *(const v4u*)(vp0 - kvoff); R.kk[1] = *(const v4u*)(vp1 - kvoff); R.kk[2] = *(const v4u*)(vp2 - kvoff); R.kk[3] = *(const v4u*)(vp3 - kvoff);
}
__device__ __forceinline__ void attn_load_v(TileRegs& R, const bf16* vp0, const bf16* vp1, const bf16* vp2, const bf16* vp3) {
    R.vv[0] = *(const v4u*)vp0; R.vv[1] = *(const v4u*)vp1; R.vv[2] = *(const v4u*)vp2; R.vv[3] = *(const v4u*)vp3;
}
template <int MODE>
__device__ __forceinline__ void attn_compute(AttnSt& st, const bf16x8 (&qf)[4], const TileRegs& R, LAS unsigned char* vl, int lane, bool keep, int dd0, int kmin) {
    const int r32 = lane & 31, hi = lane >> 5, grp = lane >> 4, qq = (lane & 15) >> 2, pp = lane & 3;
    LAS unsigned char* kl = vl + 32768;
#pragma unroll
    for (int it = 0; it < 4; ++it) { const int row = it * 8 + (lane >> 3); *(LAS v4u*)(kl + row * 128 + (((lane & 7) ^ (row & 7)) << 4)) = R.kk[it]; }
#pragma unroll
    for (int it = 0; it < 4; ++it) *(LAS v4u*)(vl + (it * 2 + ((lane & 7) >> 2)) * 512 + (lane >> 3) * 64 + (lane & 3) * 16) = R.vv[it];
    f32x16 s = f32x16{};
#pragma unroll
    for (int d0 = 0; d0 < 4; ++d0) {
        const v4u kw = *(const LAS v4u*)(kl + r32 * 128 + (((2 * d0 + hi) ^ (r32 & 7)) << 4));
        s = __builtin_amdgcn_mfma_f32_32x32x16_bf16(__builtin_bit_cast(bf16x8, kw), qf[d0], s, 0, 0, 0);
    }
    if (MODE == 1) {
#pragma unroll
        for (int r = 0; r < 16; ++r) if (crow(r, hi) > r32) s[r] = -INFINITY;
    } else if (MODE == 2) {
#pragma unroll
        for (int r = 0; r < 16; ++r) s[r] = keep ? s[r] : -INFINITY;
    } else if (MODE == 3) {
        const int ddh = dd0 - 4 * hi, kmh = kmin - 4 * hi;
#pragma unroll
        for (int r = 0; r < 16; ++r) { const int c = (r & 3) + 8 * (r >> 2); if ((unsigned)(ddh - c) > 128u || c < kmh) s[r] = -INFINITY; }
    }
    float mt = s[0];
#pragma unroll
    for (int r = 1; r < 16; ++r) mt = fmaxf(mt, s[r]);
    mt = fmaxf(mt, __shfl_xor(mt, 32));
    if (__any(mt > st.m + RESCALE_THR)) {
        const float mn = fmaxf(st.m, mt);
        const float f = __builtin_amdgcn_exp2f(st.m - mn); st.l *= f; st.m = mn;
#pragma unroll
        for (int r = 0; r < 16; ++r) { st.o0[r] *= f; st.o1[r] *= f; }
    }
    float ps = 0.f;
#pragma unroll
    for (int r = 0; r < 16; ++r) { s[r] = __builtin_amdgcn_exp2f(s[r] - st.m); ps += s[r]; }
    st.l += ps;
    v4u pw0, pw1;
    pw0.x = cvtpk_s(s[0], s[1]); pw0.y = cvtpk_s(s[2], s[3]); pw0.z = cvtpk_s(s[4], s[5]); pw0.w = cvtpk_s(s[6], s[7]);
    pw1.x = cvtpk_s(s[8], s[9]); pw1.y = cvtpk_s(s[10], s[11]); pw1.z = cvtpk_s(s[12], s[13]); pw1.w = cvtpk_s(s[14], s[15]);
    const bf16x8 pf0 = __builtin_bit_cast(bf16x8, pw0), pf1 = __builtin_bit_cast(bf16x8, pw1);
    const LAS unsigned char* tb = vl + (4 * hi + qq) * 64 + (16 * (grp & 1) + 4 * pp) * 2;
#define VFRAG(ks, d0) ({ const s16x4 lo_ = vtr(tb + ((2 * (ks)) * 2 + (d0)) * 512), hi_ = vtr(tb + ((2 * (ks) + 1) * 2 + (d0)) * 512); (bf16x8){lo_[0], lo_[1], lo_[2], lo_[3], hi_[0], hi_[1], hi_[2], hi_[3]}; })
    st.o0 = __builtin_amdgcn_mfma_f32_32x32x16_bf16(VFRAG(0, 0), pf0, st.o0, 0, 0, 0);
    st.o1 = __builtin_amdgcn_mfma_f32_32x32x16_bf16(VFRAG(0, 1), pf0, st.o1, 0, 0, 0);
    st.o0 = __builtin_amdgcn_mfma_f32_32x32x16_bf16(VFRAG(1, 0), pf1, st.o0, 0, 0, 0);
    st.o1 = __builtin_amdgcn_mfma_f32_32x32x16_bf16(VFRAG(1, 1), pf1, st.o1, 0, 0, 0);
#undef VFRAG
}

template <class MaskF>
__device__ __forceinline__ void attn_subtile_lds(AttnSt& st, const bf16x8 (&qf)[4], const LAS unsigned char* kb, const LAS unsigned char* vl, int lane, bool domask, MaskF mask) {
    const int r32 = lane & 31, hi = lane >> 5, grp = lane >> 4, qq = (lane & 15) >> 2, pp = lane & 3;
    f32x16 s = f32x16{};
#pragma unroll
    for (int d0 = 0; d0 < 4; ++d0) {
        const bf16x8 kf = *(const LAS bf16x8*)(kb + r32 * 128 + (((2 * d0 + hi) ^ (r32 & 7)) << 4));
        s = __builtin_amdgcn_mfma_f32_32x32x16_bf16(kf, qf[d0], s, 0, 0, 0);
    }
    if (domask) {
#pragma unroll
        for (int r = 0; r < 16; ++r) if (!mask(crow(r, hi))) s[r] = -INFINITY;
    }
    float mt = s[0];
#pragma unroll
    for (int r = 1; r < 16; ++r) mt = fmaxf(mt, s[r]);
    mt = fmaxf(mt, __shfl_xor(mt, 32));
    if (__any(mt > st.m + RESCALE_THR)) {
        const float mn = fmaxf(st.m, mt);
        const float f = __builtin_amdgcn_exp2f(st.m - mn); st.l *= f; st.m = mn;
#pragma unroll
        for (int r = 0; r < 16; ++r) { st.o0[r] *= f; st.o1[r] *= f; }
    }
    float ps = 0.f;
#pragma unroll
    for (int r = 0; r < 16; ++r) { s[r] = __builtin_amdgcn_exp2f(s[r] - st.m); ps += s[r]; }
    st.l += ps;
    v4u pw0, pw1;
    pw0.x = cvtpk_s(s[0], s[1]); pw0.y = cvtpk_s(s[2], s[3]); pw0.z = cvtpk_s(s[4], s[5]); pw0.w = cvtpk_s(s[6], s[7]);
    pw1.x = cvtpk_s(s[8], s[9]); pw1.y = cvtpk_s(s[10], s[11]); pw1.z = cvtpk_s(s[12], s[13]); pw1.w = cvtpk_s(s[14], s[15]);
    const bf16x8 pf0 = __builtin_bit_cast(bf16x8, pw0), pf1 = __builtin_bit_cast(bf16x8, pw1);
    const LAS unsigned char* tb = vl + (4 * hi + qq) * 64 + (16 * (grp & 1) + 4 * pp) * 2;
#define VFRAG(ks, d0) ({ const s16x4 lo_ = vtr(tb + ((2 * (ks)) * 2 + (d0)) * 512), hi_ = vtr(tb + ((2 * (ks) + 1) * 2 + (d0)) * 512); (bf16x8){lo_[0], lo_[1], lo_[2], lo_[3], hi_[0], hi_[1], hi_[2], hi_[3]}; })
    st.o0 = __builtin_amdgcn_mfma_f32_32x32x16_bf16(VFRAG(0, 0), pf0, st.o0, 0, 0, 0);
    st.o1 = __builtin_amdgcn_mfma_f32_32x32x16_bf16(VFRAG(0, 1), pf0, st.o1, 0, 0, 0);
    st.o0 = __builtin_amdgcn_mfma_f32_32x32x16_bf16(VFRAG(1, 0), pf1, st.o0, 0, 0, 0);
    st.o1 = __builtin_amdgcn_mfma_f32_32x32x16_bf16(VFRAG(1, 1), pf1, st.o1, 0, 0, 0);
#undef VFRAG
}
template <int M0, int M1>
__device__ __forceinline__ void attn_tile64_lds(AttnSt& st, const bf16x8 (&qf)[4], const LAS unsigned char* kb, const LAS unsigned char* vb, int lane, bool keep) {
    const int r32 = lane & 31, hi = lane >> 5, grp = lane >> 4, qq = (lane & 15) >> 2, pp = lane & 3;
    f32x16 s0 = f32x16{}, s1 = f32x16{};
#pragma unroll
    for (int d0 = 0; d0 < 4; ++d0) {
        const int ko = r32 * 128 + (((2 * d0 + hi) ^ (r32 & 7)) << 4);
        const v4u k0 = *(const LAS v4u*)(kb + ko), k1 = *(const LAS v4u*)(kb + 4096 + ko);
        s0 = __builtin_amdgcn_mfma_f32_32x32x16_bf16(__builtin_bit_cast(bf16x8, k0), qf[d0], s0, 0, 0, 0);
        s1 = __builtin_amdgcn_mfma_f32_32x32x16_bf16(__builtin_bit_cast(bf16x8, k1), qf[d0], s1, 0, 0, 0);
    }
    if (M0 == 1 || M1 == 1) {
#pragma unroll
        for (int r = 0; r < 16; ++r) {
            if (M0 == 1) { if (crow(r, hi) > r32) s0[r] = -INFINITY; }
            if (M1 == 1) { if (crow(r, hi) > r32) s1[r] = -INFINITY; }
        }
    }
    float mt = fmaxf(s0[0], s1[0]);
#pragma unroll
    for (int r = 1; r < 16; ++r) mt = fmaxf(mt, fmaxf(s0[r], s1[r]));
    mt = fmaxf(mt, __shfl_xor(mt, 32));
    if (__any(mt > st.m + RESCALE_THR)) {
        const float mn = fmaxf(st.m, mt);
        const float f = __builtin_amdgcn_exp2f(st.m - mn); st.l *= f; st.m = mn;
#pragma unroll
        for (int r = 0; r < 16; ++r) { st.o0[r] *= f; st.o1[r] *= f; }
    }
    const float mo = (M0 == 2 && !keep) ? INFINITY : st.m;
    const f32x2_t mo2 = {mo, mo}; f32x2_t acc2 = {0.f, 0.f};
#pragma unroll
    for (int r = 0; r < 16; r += 2) {
        f32x2_t v0 = (f32x2_t){s0[r], s0[r + 1]} - mo2, v1 = (f32x2_t){s1[r], s1[r + 1]} - mo2;
        v0.x = __builtin_amdgcn_exp2f(v0.x); v0.y = __builtin_amdgcn_exp2f(v0.y); v1.x = __builtin_amdgcn_exp2f(v1.x); v1.y = __builtin_amdgcn_exp2f(v1.y);
        acc2 += v0; acc2 += v1;
        s0[r] = v0.x; s0[r + 1] = v0.y; s1[r] = v1.x; s1[r + 1] = v1.y;
    }
    st.l += acc2.x + acc2.y;
    v4u p00, p01, p10, p11;
    p00.x = cvtpk_s(s0[0], s0[1]); p00.y = cvtpk_s(s0[2], s0[3]); p00.z = cvtpk_s(s0[4], s0[5]); p00.w = cvtpk_s(s0[6], s0[7]);
    p01.x = cvtpk_s(s0[8], s0[9]); p01.y = cvtpk_s(s0[10], s0[11]); p01.z = cvtpk_s(s0[12], s0[13]); p01.w = cvtpk_s(s0[14], s0[15]);
    p10.x = cvtpk_s(s1[0], s1[1]); p10.y = cvtpk_s(s1[2], s1[3]); p10.z = cvtpk_s(s1[4], s1[5]); p10.w = cvtpk_s(s1[6], s1[7]);
    p11.x = cvtpk_s(s1[8], s1[9]); p11.y = cvtpk_s(s1[10], s1[11]); p11.z = cvtpk_s(s1[12], s1[13]); p11.w = cvtpk_s(s1[14], s1[15]);
    const bf16x8 f00 = __builtin_bit_cast(bf16x8, p00), f01 = __builtin_bit_cast(bf16x8, p01), f10 = __builtin_bit_cast(bf16x8, p10), f11 = __builtin_bit_cast(bf16x8, p11);
    const LAS unsigned char* tb = vb + (4 * hi + qq) * 64 + (16 * (grp & 1) + 4 * pp) * 2;
#define VFRAG(sub, ks, d0) ({ const s16x4 lo_ = vtr(tb + (sub) * 4096 + ((2 * (ks)) * 2 + (d0)) * 512), hi_ = vtr(tb + (sub) * 4096 + ((2 * (ks) + 1) * 2 + (d0)) * 512); (bf16x8){lo_[0], lo_[1], lo_[2], lo_[3], hi_[0], hi_[1], hi_[2], hi_[3]}; })
    st.o0 = __builtin_amdgcn_mfma_f32_32x32x16_bf16(VFRAG(0, 0, 0), f00, st.o0, 0, 0, 0);
    st.o1 = __builtin_amdgcn_mfma_f32_32x32x16_bf16(VFRAG(0, 0, 1), f00, st.o1, 0, 0, 0);
    st.o0 = __builtin_amdgcn_mfma_f32_32x32x16_bf16(VFRAG(0, 1, 0), f01, st.o0, 0, 0, 0);
    st.o1 = __builtin_amdgcn_mfma_f32_32x32x16_bf16(VFRAG(0, 1, 1), f01, st.o1, 0, 0, 0);
    st.o0 = __builtin_amdgcn_mfma_f32_32x32x16_bf16(VFRAG(1, 0, 0), f10, st.o0, 0, 0, 0);
    st.o1 = __builtin_amdgcn_mfma_f32_32x32x16_bf16(VFRAG(1, 0, 1), f10, st.o1, 0, 0, 0);
    st.o0 = __builtin_amdgcn_mfma_f32_32x32x16_bf16(VFRAG(1, 1, 0), f11, st.o0, 0, 0, 0);
    st.o1 = __builtin_amdgcn_mfma_f32_32x32x16_bf16(VFRAG(1, 1, 1), f11, st.o1, 0, 0, 0);
#undef VFRAG
}
__device__ __forceinline__ void phase_moba_s(const Args& A, LAS unsigned char* lds, int G, int vcu, int wave, int lane) {
    const bf16* Z = (const bf16*)(A.ws + WS_Z); bf16* Y = (bf16*)(A.ws + WS_Y); const float* kmp = (const float*)(A.ws + WS_KMP);
    const int r32 = lane & 31, hi = lane >> 5, tid = wave * 64 + lane;
    const int skey = tid >> 3, sch = tid & 7;
    const int kwoff = skey * 128 + ((sch ^ (skey & 7)) << 4);
    const int vwoff = ((skey >> 3) * 2 + (sch >> 2)) * 512 + (skey & 7) * 64 + (sch & 3) * 16;
    for (int U = vcu; U < 2048; U += G) {
        const int it8 = U >> 8, v = U & 255, j = v & 7;
        const int blk = (it8 & 1) ? 15 - j : j, bh = (v >> 3) * 4 + (it8 >> 1);
        const int b = bh >> 3, hh = bh & 7, q0 = blk * 256 + 32 * wave;
        const size_t rowbase = (size_t)b * SEQ;
        const bf16* zq = Z + (rowbase + q0 + r32) * EVEN_IN;
        const bf16* Kh = Z + rowbase * EVEN_IN + 2048 + hh * 64 + (size_t)skey * EVEN_IN + 8 * sch; const bf16* Vh = Kh + 512;
        v4u kreg = *(const v4u*)(Kh + (size_t)(blk * 256) * EVEN_IN), vreg = *(const v4u*)(Vh + (size_t)(blk * 256) * EVEN_IN);
        bf16x8 qf[4];
#pragma unroll
        for (int d0 = 0; d0 < 4; ++d0) qf[d0] = *(const bf16x8*)(zq + 1536 + hh * 64 + 16 * d0 + 8 * hi);
        v2u gg[2][4]; attn_gate_load(gg, zq + 3072 + hh * 64, lane);
        unsigned sel = 0u;
        if (blk > 0) {
            f32x16 gt = f32x16{};
#pragma unroll
            for (int d0 = 0; d0 < 4; ++d0) {
                bf16x8 kmf = bf16x8{};
                if (r32 < 16) {
                    const float* p0 = kmp + (((size_t)b * 16 + r32) * 2) * 512 + hh * 64 + 16 * d0 + 8 * hi;
                    const f32x4 a0 = *(const f32x4*)p0, a1 = *(const f32x4*)(p0 + 4), b0 = *(const f32x4*)(p0 + 512), b1 = *(const f32x4*)(p0 + 516);
                    const f32x4 s0 = a0 + b0, s1 = a1 + b1;
                    v4u w; w.x = pk2(s0[0], s0[1]); w.y = pk2(s0[2], s0[3]); w.z = pk2(s1[0], s1[1]); w.w = pk2(s1[2], s1[3]);
                    kmf = __builtin_bit_cast(bf16x8, w);
                }
                gt = __builtin_amdgcn_mfma_f32_32x32x16_bf16(kmf, qf[d0], gt, 0, 0, 0);
            }
            float gv[16];
#pragma unroll
            for (int r = 0; r < 8; ++r) {
                const float mine = gt[r], oth = __shfl_xor(mine, 32);
                const float vlo = hi ? oth : mine, vhi = hi ? mine : oth;
                gv[(r & 3) + 8 * (r >> 2)] = vlo; gv[(r & 3) + 8 * (r >> 2) + 4] = vhi;
            }
#pragma unroll
            for (int n = 0; n < 16; ++n) if (n >= blk) gv[n] = -INFINITY;
#pragma unroll
            for (int it = 0; it < 3; ++it) {
                float best = -INFINITY; int bi = -1;
#pragma unroll
                for (int n = 0; n < 16; ++n) { const bool ok = (gv[n] > best) && !((sel >> n) & 1u); best = ok ? gv[n] : best; bi = ok ? n : bi; }
                if (bi >= 0) sel |= 1u << bi;
            }
        }
        AttnSt st; st.o0 = f32x16{}; st.o1 = f32x16{}; st.m = -1e30f; st.l = 0.f;
#define MB_LOAD(key0_) do { kreg = *(const v4u*)(Kh + (size_t)(key0_) * EVEN_IN); vreg = *(const v4u*)(Vh + (size_t)(key0_) * EVEN_IN); } while (0)
#define MB_STORE(buf_) do { *(LAS v4u*)(lds + (buf_) * 8192 + kwoff) = kreg; *(LAS v4u*)(lds + 16384 + (buf_) * 8192 + vwoff) = vreg; } while (0)
        MB_STORE(0);
        __syncthreads();
#pragma unroll 1
        for (int t = 0; t < 4; ++t) {
            const int buf = t & 1;
            if (t < 3) MB_LOAD(blk * 256 + 64 * (t + 1)); else if (blk > 0) MB_LOAD(0);
            const LAS unsigned char* kb = lds + buf * 8192; const LAS unsigned char* vb = lds + 16384 + buf * 8192;
            if (2 * t + 1 < wave) attn_tile64_lds<0, 0>(st, qf, kb, vb, lane, true);
            else if (2 * t + 1 == wave) attn_tile64_lds<0, 1>(st, qf, kb, vb, lane, true);
            else if (2 * t == wave) attn_subtile_lds(st, qf, kb, vb, lane, true, [&](int kk) { return kk <= r32; });
            if (t < 3 || blk > 0) MB_STORE(buf ^ 1);
            __syncthreads();
        }
        const int P = 4 * blk;
#pragma unroll 1
        for (int p = 0; p < P; ++p) {
            const int buf = p & 1;
            if (p + 1 < P) MB_LOAD(64 * (p + 1));
            const LAS unsigned char* kb = lds + buf * 8192; const LAS unsigned char* vb = lds + 16384 + buf * 8192;
            const bool mysel = (sel >> (p >> 2)) & 1u;
            if (__any(mysel)) {
                attn_tile64_lds<2, 2>(st, qf, kb, vb, lane, mysel);
            }
            if (p + 1 < P) MB_STORE(buf ^ 1);
            __syncthreads();
        }
#undef MB_LOAD
#undef MB_STORE
        attn_store_g(st, gg, Y + (rowbase + q0 + r32) * D + 512 + hh * 64, lane);
    }
}

__device__ __forceinline__ void phase_moba_old(const Args& A, LAS unsigned char* lds, int gwv, int NGW, int wave, int lane) {
    const bf16* Z = (const bf16*)(A.ws + WS_Z); bf16* Y = (bf16*)(A.ws + WS_Y); const float* kmp = (const float*)(A.ws + WS_KMP);
    LAS unsigned char* vl = lds + wave * 4096;
    const int r32 = lane & 31, hi = lane >> 5;
#ifdef OLD_NEWMAP
    for (int U = gwv >> 3; U < 2048; U += NGW >> 3) {
        const int it8 = U >> 8, v = U & 255, j = v & 7;
        const int blk = (it8 & 1) ? 15 - j : j, bh = (v >> 3) * 4 + (it8 >> 1);
        const int b = bh >> 3, hh = bh & 7, q0 = blk * 256 + 32 * wave;
#else
    for (int U = gwv; U < 16384; U += NGW) {
        const int rd = U >> 11, g2 = U & 2047, X = g2 >> 8, lwv = g2 & 255;
        const int bh = 16 * X + 2 * rd + (lwv >> 7); int gi = lwv & 127; if (rd & 1) gi = 127 - gi;
        const int b = bh >> 3, hh = bh & 7, q0 = gi * 32, blk = q0 >> 8;
#endif
        const size_t rowbase = (size_t)b * SEQ;
        const bf16* zq = Z + (rowbase + q0 + r32) * EVEN_IN;
        bf16x8 qf[4];
#pragma unroll
        for (int d0 = 0; d0 < 4; ++d0) qf[d0] = *(const bf16x8*)(zq + 1536 + hh * 64 + 16 * d0 + 8 * hi);
        unsigned sel = 0u;
        if (blk > 0) {
            f32x16 gt = f32x16{};
#pragma unroll
            for (int d0 = 0; d0 < 4; ++d0) {
                bf16x8 kmf = bf16x8{};
                if (r32 < 16) {
                    const float* p0 = kmp + (((size_t)b * 16 + r32) * 2) * 512 + hh * 64 + 16 * d0 + 8 * hi;
                    const f32x4 a0 = *(const f32x4*)p0, a1 = *(const f32x4*)(p0 + 4), b0 = *(const f32x4*)(p0 + 512), b1 = *(const f32x4*)(p0 + 516);
                    const f32x4 s0 = a0 + b0, s1 = a1 + b1;
                    v4u w; w.x = pk2(s0[0], s0[1]); w.y = pk2(s0[2], s0[3]); w.z = pk2(s1[0], s1[1]); w.w = pk2(s1[2], s1[3]);
                    kmf = __builtin_bit_cast(bf16x8, w);
                }
                gt = __builtin_amdgcn_mfma_f32_32x32x16_bf16(kmf, qf[d0], gt, 0, 0, 0);
            }
            float gv[16];
#pragma unroll
            for (int r = 0; r < 8; ++r) {
                const float mine = gt[r], oth = __shfl_xor(mine, 32);
                const float vlo = hi ? oth : mine, vhi = hi ? mine : oth;
                gv[(r & 3) + 8 * (r >> 2)] = vlo; gv[(r & 3) + 8 * (r >> 2) + 4] = vhi;
            }
#pragma unroll
            for (int n = 0; n < 16; ++n) if (n >= blk) gv[n] = -INFINITY;
#pragma unroll
            for (int it = 0; it < 3; ++it) {
                float best = -INFINITY; int bi = -1;
#pragma unroll
                for (int n = 0; n < 16; ++n) { const bool ok = (gv[n] > best) && !((sel >> n) & 1u); best = ok ? gv[n] : best; bi = ok ? n : bi; }
                if (bi >= 0) sel |= 1u << bi;
            }
        }
        AttnSt st; st.o0 = f32x16{}; st.o1 = f32x16{}; st.m = -1e30f; st.l = 0.f;
        const bf16* Kh = Z + rowbase * EVEN_IN + 2048 + hh * 64; const bf16* Vh = Z + rowbase * EVEN_IN + 2560 + hh * 64;
        const size_t vrow8 = (size_t)8 * EVEN_IN;
        const int ndiag = (q0 & 255) >> 5;
        for (int kt = 0; kt <= ndiag; ++kt) {
            const size_t k0 = (size_t)blk * 256 + kt * 32;
            const bf16* vp = Vh + (k0 + (lane >> 3)) * EVEN_IN + 8 * (lane & 7);
            attn_tile(st, qf, Kh + (k0 + r32) * EVEN_IN + 8 * hi, vp, vp + vrow8, vp + 2 * vrow8, vp + 3 * vrow8, vl, lane, kt == ndiag, [&](int kk) { return kk <= r32; });
        }
        for (int n = 0; n < blk; ++n) {
            const bool mysel = (sel >> n) & 1u;
            if (!__any(mysel)) continue;
            for (int kt = 0; kt < 8; ++kt) {
                const size_t k0 = (size_t)n * 256 + kt * 32;
                const bf16* vp = Vh + (k0 + (lane >> 3)) * EVEN_IN + 8 * (lane & 7);
                attn_tile(st, qf, Kh + (k0 + r32) * EVEN_IN + 8 * hi, vp, vp + vrow8, vp + 2 * vrow8, vp + 3 * vrow8, vl, lane, true, [&](int) { return mysel; });
            }
        }
        attn_store(st, zq + 3072 + hh * 64, Y + (rowbase + q0 + r32) * D + 512 + hh * 64, lane);
    }
}


__device__ __forceinline__ void phase_moba_p(const Args& A, LAS unsigned char* lds, int gwv, int NGW, int wave, int lane) {
    const bf16* Z = (const bf16*)(A.ws + WS_Z); bf16* Y = (bf16*)(A.ws + WS_Y); const float* kmp = (const float*)(A.ws + WS_KMP);
    LAS unsigned char* vl = lds + wave * 4096;
    const int r32 = lane & 31, hi = lane >> 5;
    for (int U = gwv; U < 16384; U += NGW) {
        const int rd = U >> 11, g2 = U & 2047, X = g2 >> 8, lwv = g2 & 255;
        const int bh = 16 * X + 2 * rd + (lwv >> 7); int gi = lwv & 127; if (rd & 1) gi = 127 - gi;
        const int b = bh >> 3, hh = bh & 7, q0 = gi * 32, blk = q0 >> 8;
        const size_t rowbase = (size_t)b * SEQ;
        const bf16* zq = Z + (rowbase + q0 + r32) * EVEN_IN;
        bf16x8 qf[4];
#pragma unroll
        for (int d0 = 0; d0 < 4; ++d0) qf[d0] = *(const bf16x8*)(zq + 1536 + hh * 64 + 16 * d0 + 8 * hi);
        unsigned sel = 0u;
        if (blk > 0) {
            f32x16 gt = f32x16{};
#pragma unroll
            for (int d0 = 0; d0 < 4; ++d0) {
                bf16x8 kmf = bf16x8{};
                if (r32 < 16) {
                    const float* p0 = kmp + (((size_t)b * 16 + r32) * 2) * 512 + hh * 64 + 16 * d0 + 8 * hi;
                    const f32x4 a0 = *(const f32x4*)p0, a1 = *(const f32x4*)(p0 + 4), b0 = *(const f32x4*)(p0 + 512), b1 = *(const f32x4*)(p0 + 516);
                    const f32x4 s0 = a0 + b0, s1 = a1 + b1;
                    v4u w; w.x = pk2(s0[0], s0[1]); w.y = pk2(s0[2], s0[3]); w.z = pk2(s1[0], s1[1]); w.w = pk2(s1[2], s1[3]);
                    kmf = __builtin_bit_cast(bf16x8, w);
                }
                gt = __builtin_amdgcn_mfma_f32_32x32x16_bf16(kmf, qf[d0], gt, 0, 0, 0);
            }
            float gv[16];
#pragma unroll
            for (int r = 0; r < 8; ++r) {
                const float mine = gt[r], oth = __shfl_xor(mine, 32);
                const float vlo = hi ? oth : mine, vhi = hi ? mine : oth;
                gv[(r & 3) + 8 * (r >> 2)] = vlo; gv[(r & 3) + 8 * (r >> 2) + 4] = vhi;
            }
#pragma unroll
            for (int n = 0; n < 16; ++n) if (n >= blk) gv[n] = -INFINITY;
#pragma unroll
            for (int it = 0; it < 3; ++it) {
                float best = -INFINITY; int bi = -1;
#pragma unroll
                for (int n = 0; n < 16; ++n) { const bool ok = (gv[n] > best) && !((sel >> n) & 1u); best = ok ? gv[n] : best; bi = ok ? n : bi; }
                if (bi >= 0) sel |= 1u << bi;
            }
        }
        unsigned anym = 0u;
#pragma unroll
        for (int n = 0; n < 15; ++n) if (__any((sel >> n) & 1u)) anym |= 1u << n;
        anym = (unsigned)__builtin_amdgcn_readfirstlane((int)anym);
        AttnSt st; st.o0 = f32x16{}; st.o1 = f32x16{}; st.m = -1e30f; st.l = 0.f;
        const bf16* Kh = Z + rowbase * EVEN_IN + 2048 + hh * 64; const bf16* Vh = Z + rowbase * EVEN_IN + 2560 + hh * 64;
        const size_t vrow8 = (size_t)8 * EVEN_IN;
        const int ndiag = (q0 & 255) >> 5;
#define MB_LOADT(R, nn, kk_) do { const size_t k0_ = (size_t)((nn) < 0 ? blk : (nn)) * 256 + (kk_) * 32; const bf16* vp_ = Vh + (k0_ + (lane >> 3)) * EVEN_IN + 8 * (lane & 7); \
            attn_load(R, 512, vp_, vp_ + vrow8, vp_ + 2 * vrow8, vp_ + 3 * vrow8); } while (0)
#define MB_COMP(R, nn, kk_) do { if ((nn) < 0) { if ((kk_) == ndiag) attn_compute<1>(st, qf, R, vl, lane, true, 0, 0); else attn_compute<0>(st, qf, R, vl, lane, true, 0, 0); } \
            else attn_compute<2>(st, qf, R, vl, lane, ((sel >> (nn)) & 1u) != 0u, 0, 0); } while (0)
#define MB_ADV(nn, kk_, more) do { more = true; if ((nn) < 0) { if ((kk_) < ndiag) ++(kk_); else { (kk_) = 0; if (anym) (nn) = __builtin_ctz(anym); else more = false; } } \
            else if ((kk_) < 7) ++(kk_); else { (kk_) = 0; const unsigned rest_ = anym & ~((2u << (nn)) - 1u); if (rest_) (nn) = __builtin_ctz(rest_); else more = false; } } while (0)
        TileRegs RA, RB; int cn = -1, ck = 0;
        MB_LOADT(RA, cn, ck);
        for (;;) {
            int nn = cn, nk = ck; bool more; MB_ADV(nn, nk, more);
            if (more) MB_LOADT(RB, nn, nk);
            MB_COMP(RA, cn, ck);
            if (!more) break;
            cn = nn; ck = nk; MB_ADV(nn, nk, more);
            if (more) MB_LOADT(RA, nn, nk);
            MB_COMP(RB, cn, ck);
            if (!more) break;
            cn = nn; ck = nk;
        }
#undef MB_LOADT
#undef MB_COMP
#undef MB_ADV
        attn_store(st, zq + 3072 + hh * 64, Y + (rowbase + q0 + r32) * D + 512 + hh * 64, lane);
    }
}

__device__ __forceinline__ void phase_dilated_p(const Args& A, LAS unsigned char* lds, int gwv, int NGW, int wave, int lane) {
    const bf16* Z = (const bf16*)(A.ws + WS_Z); bf16* Y = (bf16*)(A.ws + WS_Y);
    LAS unsigned char* vl = lds + wave * 4096;
    const int r32 = lane & 31, hi = lane >> 5;
    for (int U = gwv; U < 32768; U += NGW) {
        const int rd = U >> 11, g2 = U & 2047, X = g2 >> 8, lwv = g2 & 255;
        const int bh = 32 * X + 2 * rd + (lwv >> 7), gi = lwv & 127, c = gi >> 4, r16 = gi & 15;
        const int b = bh >> 4, hh = bh & 15;
        const size_t rowbase = (size_t)b * SEQ;
        const int tq = 512 * c + r16 + 16 * r32;
        const bf16* zq = Z + (rowbase + tq) * ODD_IN;
        bf16x8 qf[4];
#pragma unroll
        for (int d0 = 0; d0 < 4; ++d0) qf[d0] = *(const bf16x8*)(zq + hh * 64 + 16 * d0 + 8 * hi);
        AttnSt st; st.o0 = f32x16{}; st.o1 = f32x16{}; st.m = -1e30f; st.l = 0.f;
        const bf16* Kh = Z + rowbase * ODD_IN + 1024 + hh * 64; const bf16* Vh = Z + rowbase * ODD_IN + 2048 + hh * 64;
#define DL_DIL(cfg) ((cfg) == 0 ? 16 : (cfg) == 1 ? 4 : 1)
#define DL_NT(cfg) ((cfg) == 0 ? 5 : (cfg) == 1 ? 8 : 20)
#define DL_MBASE(cfg) ((512 * c + r16 - (r16 & (DL_DIL(cfg) - 1))) / DL_DIL(cfg) - 128)
#define DL_TAU0(cfg) (DL_MBASE(cfg) < 0 ? (-DL_MBASE(cfg)) / 32 : 0)
#define DL_LOADT(R, cfg, tau) do { const int dil_ = DL_DIL(cfg), rdl_ = r16 & (dil_ - 1), m0_ = DL_MBASE(cfg) + 32 * (tau); \
            const int mv_ = m0_ + (lane >> 3); const int mv0_ = mv_ < 0 ? 0 : mv_, mv1_ = mv_ + 8 < 0 ? 0 : mv_ + 8, mv2_ = mv_ + 16 < 0 ? 0 : mv_ + 16, mv3_ = mv_ + 24 < 0 ? 0 : mv_ + 24; \
            const bf16* vb_ = Vh + (size_t)rdl_ * ODD_IN + 8 * (lane & 7); const size_t vst_ = (size_t)dil_ * ODD_IN; \
            attn_load(R, 1024, vb_ + mv0_ * vst_, vb_ + mv1_ * vst_, vb_ + mv2_ * vst_, vb_ + mv3_ * vst_); } while (0)
#define DL_COMP(R, cfg, tau) do { const int m0_ = DL_MBASE(cfg) + 32 * (tau); \
            if ((cfg) == 0 && (tau) >= 1 && (tau) <= 3 && m0_ >= 0) attn_compute<0>(st, qf, R, vl, lane, true, 0, 0); \
            else attn_compute<3>(st, qf, R, vl, lane, true, 128 + (16 / DL_DIL(cfg)) * r32 - 32 * (tau), -m0_); } while (0)
#define DL_ADV(cfg, tau, more) do { more = true; if ((tau) + 1 < DL_NT(cfg)) ++(tau); else if ((cfg) < 2) { ++(cfg); (tau) = DL_TAU0(cfg); } else more = false; } while (0)
        TileRegs RA, RB; int cc = 0, ct = DL_TAU0(0);
        DL_LOADT(RA, cc, ct);
        for (;;) {
            int nc = cc, nt = ct; bool more; DL_ADV(nc, nt, more);
            if (more) DL_LOADT(RB, nc, nt);
            DL_COMP(RA, cc, ct);
            if (!more) break;
            cc = nc; ct = nt; DL_ADV(nc, nt, more);
            if (more) DL_LOADT(RA, nc, nt);
            DL_COMP(RB, cc, ct);
            if (!more) break;
            cc = nc; ct = nt;
        }
#undef DL_DIL
#undef DL_NT
#undef DL_MBASE
#undef DL_TAU0
#undef DL_LOADT
#undef DL_COMP
#undef DL_ADV
        attn_store(st, zq + 3072 + hh * 64, Y + (rowbase + tq) * D + hh * 64, lane);
    }
}


__device__ __forceinline__ void attn_stage2(const TileRegs& RA, const TileRegs& RB, LAS unsigned char* wl, int lane) {
    LAS unsigned char* vla = wl; LAS unsigned char* vlb = wl + 4096; LAS unsigned char* kla = wl + 8192; LAS unsigned char* klb = wl + 12288;
#pragma unroll
    for (int it = 0; it < 4; ++it) { const int row = it * 8 + (lane >> 3); const int ko = row * 128 + (((lane & 7) ^ (row & 7)) << 4); *(LAS v4u*)(kla + ko) = RA.kk[it]; *(LAS v4u*)(klb + ko) = RB.kk[it]; }
#pragma unroll
    for (int it = 0; it < 4; ++it) { const int vo = (it * 2 + ((lane & 7) >> 2)) * 512 + (lane >> 3) * 64 + (lane & 3) * 16; *(LAS v4u*)(vla + vo) = RA.vv[it]; *(LAS v4u*)(vlb + vo) = RB.vv[it]; }
}
template <int MODE, class MidF>
__device__ __forceinline__ void attn_compute2_lds(AttnSt& a, AttnSt& b, const bf16x8 (&qa)[4], const bf16x8 (&qb)[4], LAS unsigned char* wl, int lane, int dd0, int kmina, int kminb, MidF mid) {
    const int r32 = lane & 31, hi = lane >> 5, grp = lane >> 4, qq = (lane & 15) >> 2, pp = lane & 3;
    LAS unsigned char* vla = wl; LAS unsigned char* vlb = wl + 4096; LAS unsigned char* kla = wl + 8192; LAS unsigned char* klb = wl + 12288;
    f32x16 sa = f32x16{}, sb = f32x16{};
#pragma unroll
    for (int d0 = 0; d0 < 4; ++d0) {
        const int ko = r32 * 128 + (((2 * d0 + hi) ^ (r32 & 7)) << 4);
        const v4u kwa = *(const LAS v4u*)(kla + ko), kwb = *(const LAS v4u*)(klb + ko);
        sa = __builtin_amdgcn_mfma_f32_32x32x16_bf16(__builtin_bit_cast(bf16x8, kwa), qa[d0], sa, 0, 0, 0);
        sb = __builtin_amdgcn_mfma_f32_32x32x16_bf16(__builtin_bit_cast(bf16x8, kwb), qb[d0], sb, 0, 0, 0);
    }
    if (MODE == 3) {
        const int ddh = dd0 - 4 * hi, kma = kmina - 4 * hi, kmb = kminb - 4 * hi;
#pragma unroll
        for (int r = 0; r < 16; ++r) { const int c = (r & 3) + 8 * (r >> 2); const bool band = (unsigned)(ddh - c) <= 128u; if (!band || c < kma) sa[r] = -INFINITY; if (!band || c < kmb) sb[r] = -INFINITY; }
    }
    float mta = sa[0], mtb = sb[0];
#pragma unroll
    for (int r = 1; r < 16; ++r) { mta = fmaxf(mta, sa[r]); mtb = fmaxf(mtb, sb[r]); }
    mta = fmaxf(mta, __shfl_xor(mta, 32)); mtb = fmaxf(mtb, __shfl_xor(mtb, 32));
    if (__any(mta > a.m + RESCALE_THR || mtb > b.m + RESCALE_THR)) {
        const float mna_ = fmaxf(a.m, mta), mnb_ = fmaxf(b.m, mtb);
        const float fa = __builtin_amdgcn_exp2f(a.m - mna_), fb = __builtin_amdgcn_exp2f(b.m - mnb_);
        a.l *= fa; a.m = mna_; b.l *= fb; b.m = mnb_;
#pragma unroll
        for (int r = 0; r < 16; ++r) { a.o0[r] *= fa; a.o1[r] *= fa; b.o0[r] *= fb; b.o1[r] *= fb; }
    }
    const float mna = a.m, mnb = b.m;
    float psa = 0.f, psb = 0.f;
#pragma unroll
    for (int r = 0; r < 16; ++r) { sa[r] = __builtin_amdgcn_exp2f(sa[r] - mna); sb[r] = __builtin_amdgcn_exp2f(sb[r] - mnb); psa += sa[r]; psb += sb[r]; }
    a.l += psa; b.l += psb;
    v4u pa0, pa1, pb0, pb1;
    pa0.x = cvtpk_s(sa[0], sa[1]); pa0.y = cvtpk_s(sa[2], sa[3]); pa0.z = cvtpk_s(sa[4], sa[5]); pa0.w = cvtpk_s(sa[6], sa[7]);
    pa1.x = cvtpk_s(sa[8], sa[9]); pa1.y = cvtpk_s(sa[10], sa[11]); pa1.z = cvtpk_s(sa[12], sa[13]); pa1.w = cvtpk_s(sa[14], sa[15]);
    pb0.x = cvtpk_s(sb[0], sb[1]); pb0.y = cvtpk_s(sb[2], sb[3]); pb0.z = cvtpk_s(sb[4], sb[5]); pb0.w = cvtpk_s(sb[6], sb[7]);
    pb1.x = cvtpk_s(sb[8], sb[9]); pb1.y = cvtpk_s(sb[10], sb[11]); pb1.z = cvtpk_s(sb[12], sb[13]); pb1.w = cvtpk_s(sb[14], sb[15]);
    const bf16x8 fa0 = __builtin_bit_cast(bf16x8, pa0), fa1 = __builtin_bit_cast(bf16x8, pa1), fb0 = __builtin_bit_cast(bf16x8, pb0), fb1 = __builtin_bit_cast(bf16x8, pb1);
    __builtin_amdgcn_sched_barrier(0); mid(); __builtin_amdgcn_sched_barrier(0);
    const int to = (4 * hi + qq) * 64 + (16 * (grp & 1) + 4 * pp) * 2;
#define VFRAG2(base, ks, d0) ({ const s16x4 lo_ = vtr((base) + to + ((2 * (ks)) * 2 + (d0)) * 512), hi_ = vtr((base) + to + ((2 * (ks) + 1) * 2 + (d0)) * 512); (bf16x8){lo_[0], lo_[1], lo_[2], lo_[3], hi_[0], hi_[1], hi_[2], hi_[3]}; })
    a.o0 = __builtin_amdgcn_mfma_f32_32x32x16_bf16(VFRAG2(vla, 0, 0), fa0, a.o0, 0, 0, 0);
    b.o0 = __builtin_amdgcn_mfma_f32_32x32x16_bf16(VFRAG2(vlb, 0, 0), fb0, b.o0, 0, 0, 0);
    a.o1 = __builtin_amdgcn_mfma_f32_32x32x16_bf16(VFRAG2(vla, 0, 1), fa0, a.o1, 0, 0, 0);
    b.o1 = __builtin_amdgcn_mfma_f32_32x32x16_bf16(VFRAG2(vlb, 0, 1), fb0, b.o1, 0, 0, 0);
    a.o0 = __builtin_amdgcn_mfma_f32_32x32x16_bf16(VFRAG2(vla, 1, 0), fa1, a.o0, 0, 0, 0);
    b.o0 = __builtin_amdgcn_mfma_f32_32x32x16_bf16(VFRAG2(vlb, 1, 0), fb1, b.o0, 0, 0, 0);
    a.o1 = __builtin_amdgcn_mfma_f32_32x32x16_bf16(VFRAG2(vla, 1, 1), fa1, a.o1, 0, 0, 0);
    b.o1 = __builtin_amdgcn_mfma_f32_32x32x16_bf16(VFRAG2(vlb, 1, 1), fb1, b.o1, 0, 0, 0);
#undef VFRAG2
}
template <int MODE, class PreF, class MidF>
__device__ __forceinline__ void attn_compute2_kv(AttnSt& a, AttnSt& b, const bf16x8 (&qa)[4], const bf16x8 (&qb)[4], TileRegs& RA, TileRegs& RB, LAS unsigned char* wl, int lane, int dd0, int kmina, int kminb, PreF pre, MidF mid) {
    const int r32 = lane & 31, hi = lane >> 5, grp = lane >> 4, qq = (lane & 15) >> 2, pp = lane & 3;
    LAS unsigned char* vla = wl; LAS unsigned char* vlb = wl + 4096; LAS unsigned char* kla = wl + 8192; LAS unsigned char* klb = wl + 12288;
#pragma unroll
    for (int it = 0; it < 4; ++it) { const int row = it * 8 + (lane >> 3); const int ko = row * 128 + (((lane & 7) ^ (row & 7)) << 4); *(LAS v4u*)(kla + ko) = RA.kk[it]; *(LAS v4u*)(klb + ko) = RB.kk[it]; }
    pre();
#pragma unroll
    for (int it = 0; it < 4; ++it) { const int vo = (it * 2 + ((lane & 7) >> 2)) * 512 + (lane >> 3) * 64 + (lane & 3) * 16; *(LAS v4u*)(vla + vo) = RA.vv[it]; *(LAS v4u*)(vlb + vo) = RB.vv[it]; }
    f32x16 sa = f32x16{}, sb = f32x16{};
#pragma unroll
    for (int d0 = 0; d0 < 4; ++d0) {
        const int ko = r32 * 128 + (((2 * d0 + hi) ^ (r32 & 7)) << 4);
        const v4u kwa = *(const LAS v4u*)(kla + ko), kwb = *(const LAS v4u*)(klb + ko);
        sa = __builtin_amdgcn_mfma_f32_32x32x16_bf16(__builtin_bit_cast(bf16x8, kwa), qa[d0], sa, 0, 0, 0);
        sb = __builtin_amdgcn_mfma_f32_32x32x16_bf16(__builtin_bit_cast(bf16x8, kwb), qb[d0], sb, 0, 0, 0);
    }
    if (MODE == 3) {
        const int ddh = dd0 - 4 * hi;
        if (kmina <= 0 && kminb <= 0) {
#pragma unroll
            for (int r = 0; r < 16; ++r) { const int c = (r & 3) + 8 * (r >> 2); const bool band = (unsigned)(ddh - c) <= 128u; sa[r] = band ? sa[r] : -INFINITY; sb[r] = band ? sb[r] : -INFINITY; }
        } else {
            const int kma = kmina - 4 * hi, kmb = kminb - 4 * hi;
#pragma unroll
            for (int r = 0; r < 16; ++r) { const int c = (r & 3) + 8 * (r >> 2); const bool band = (unsigned)(ddh - c) <= 128u; if (!band || c < kma) sa[r] = -INFINITY; if (!band || c < kmb) sb[r] = -INFINITY; }
        }
    }
    float mta = sa[0], mtb = sb[0];
#pragma unroll
    for (int r = 1; r < 16; ++r) { mta = fmaxf(mta, sa[r]); mtb = fmaxf(mtb, sb[r]); }
    mta = fmaxf(mta, __shfl_xor(mta, 32)); mtb = fmaxf(mtb, __shfl_xor(mtb, 32));
    if (__any(mta > a.m + RESCALE_THR || mtb > b.m + RESCALE_THR)) {
        const float mna_ = fmaxf(a.m, mta), mnb_ = fmaxf(b.m, mtb);
        const float fa = __builtin_amdgcn_exp2f(a.m - mna_), fb = __builtin_amdgcn_exp2f(b.m - mnb_);
        a.l *= fa; a.m = mna_; b.l *= fb; b.m = mnb_;
#pragma unroll
        for (int r = 0; r < 16; ++r) { a.o0[r] *= fa; a.o1[r] *= fa; b.o0[r] *= fb; b.o1[r] *= fb; }
    }
    const float mna = a.m, mnb = b.m;
    const f32x2_t ma2 = {mna, mna}, mb2 = {mnb, mnb}; f32x2_t acca = {0.f, 0.f}, accb = {0.f, 0.f};
#pragma unroll
    for (int r = 0; r < 16; r += 2) {
        f32x2_t va = (f32x2_t){sa[r], sa[r + 1]} - ma2, vb = (f32x2_t){sb[r], sb[r + 1]} - mb2;
        va.x = __builtin_amdgcn_exp2f(va.x); va.y = __builtin_amdgcn_exp2f(va.y); vb.x = __builtin_amdgcn_exp2f(vb.x); vb.y = __builtin_amdgcn_exp2f(vb.y);
        acca += va; accb += vb;
        sa[r] = va.x; sa[r + 1] = va.y; sb[r] = vb.x; sb[r + 1] = vb.y;
    }
    a.l += acca.x + acca.y; b.l += accb.x + accb.y;
    v4u pa0, pa1, pb0, pb1;
    pa0.x = cvtpk_s(sa[0], sa[1]); pa0.y = cvtpk_s(sa[2], sa[3]); pa0.z = cvtpk_s(sa[4], sa[5]); pa0.w = cvtpk_s(sa[6], sa[7]);
    pa1.x = cvtpk_s(sa[8], sa[9]); pa1.y = cvtpk_s(sa[10], sa[11]); pa1.z = cvtpk_s(sa[12], sa[13]); pa1.w = cvtpk_s(sa[14], sa[15]);
    pb0.x = cvtpk_s(sb[0], sb[1]); pb0.y = cvtpk_s(sb[2], sb[3]); pb0.z = cvtpk_s(sb[4], sb[5]); pb0.w = cvtpk_s(sb[6], sb[7]);
    pb1.x = cvtpk_s(sb[8], sb[9]); pb1.y = cvtpk_s(sb[10], sb[11]); pb1.z = cvtpk_s(sb[12], sb[13]); pb1.w = cvtpk_s(sb[14], sb[15]);
    const bf16x8 fa0 = __builtin_bit_cast(bf16x8, pa0), fa1 = __builtin_bit_cast(bf16x8, pa1), fb0 = __builtin_bit_cast(bf16x8, pb0), fb1 = __builtin_bit_cast(bf16x8, pb1);
    __builtin_amdgcn_sched_barrier(0); mid(); __builtin_amdgcn_sched_barrier(0);
    const int to = (4 * hi + qq) * 64 + (16 * (grp & 1) + 4 * pp) * 2;
#define VFRAG2(base, ks, d0) ({ const s16x4 lo_ = vtr((base) + to + ((2 * (ks)) * 2 + (d0)) * 512), hi_ = vtr((base) + to + ((2 * (ks) + 1) * 2 + (d0)) * 512); (bf16x8){lo_[0], lo_[1], lo_[2], lo_[3], hi_[0], hi_[1], hi_[2], hi_[3]}; })
    a.o0 = __builtin_amdgcn_mfma_f32_32x32x16_bf16(VFRAG2(vla, 0, 0), fa0, a.o0, 0, 0, 0);
    b.o0 = __builtin_amdgcn_mfma_f32_32x32x16_bf16(VFRAG2(vlb, 0, 0), fb0, b.o0, 0, 0, 0);
    a.o1 = __builtin_amdgcn_mfma_f32_32x32x16_bf16(VFRAG2(vla, 0, 1), fa0, a.o1, 0, 0, 0);
    b.o1 = __builtin_amdgcn_mfma_f32_32x32x16_bf16(VFRAG2(vlb, 0, 1), fb0, b.o1, 0, 0, 0);
    a.o0 = __builtin_amdgcn_mfma_f32_32x32x16_bf16(VFRAG2(vla, 1, 0), fa1, a.o0, 0, 0, 0);
    b.o0 = __builtin_amdgcn_mfma_f32_32x32x16_bf16(VFRAG2(vlb, 1, 0), fb1, b.o0, 0, 0, 0);
    a.o1 = __builtin_amdgcn_mfma_f32_32x32x16_bf16(VFRAG2(vla, 1, 1), fa1, a.o1, 0, 0, 0);
    b.o1 = __builtin_amdgcn_mfma_f32_32x32x16_bf16(VFRAG2(vlb, 1, 1), fb1, b.o1, 0, 0, 0);
#undef VFRAG2
}
template <int MODE>
__device__ __forceinline__ void attn_compute2(AttnSt& a, AttnSt& b, const bf16x8 (&qa)[4], const bf16x8 (&qb)[4], const TileRegs& RA, const TileRegs& RB, LAS unsigned char* wl, int lane, int dd0, int kmina, int kminb) {
    attn_stage2(RA, RB, wl, lane); attn_compute2_lds<MODE>(a, b, qa, qb, wl, lane, dd0, kmina, kminb, [] {});
}

__device__ __forceinline__ void phase_dilated_2(const Args& A, LAS unsigned char* lds, int gwv, int NGW, int wave, int lane) {
    const bf16* Z = (const bf16*)(A.ws + WS_Z); bf16* Y = (bf16*)(A.ws + WS_Y);
    LAS unsigned char* wl = lds + wave * 16384;
    const int r32 = lane & 31, hi = lane >> 5;
    for (int U = gwv; U < 16384; U += NGW) {
        const int rd = U >> 10, g2 = U & 1023, X = g2 >> 7, lp = g2 & 127;
        const int bh = 32 * X + 2 * rd + (lp >> 6), pi = lp & 63, c = pi >> 3, r16a = 2 * (pi & 7);
        const int b = bh >> 4, hh = bh & 15;
        const size_t rowbase = (size_t)b * SEQ;
        const int tqa = 512 * c + r16a + 16 * r32;
        const bf16* zqa = Z + (rowbase + tqa) * ODD_IN; const bf16* zqb = zqa + ODD_IN;
        bf16x8 qa[4], qb[4];
#pragma unroll
        for (int d0 = 0; d0 < 4; ++d0) { qa[d0] = *(const bf16x8*)(zqa + hh * 64 + 16 * d0 + 8 * hi); qb[d0] = *(const bf16x8*)(zqb + hh * 64 + 16 * d0 + 8 * hi); }
        AttnSt sa, sb; sa.o0 = f32x16{}; sa.o1 = f32x16{}; sa.m = -1e30f; sa.l = 0.f; sb.o0 = f32x16{}; sb.o1 = f32x16{}; sb.m = -1e30f; sb.l = 0.f;
        const bf16* Vh = Z + rowbase * ODD_IN + 2048 + hh * 64 + 8 * (lane & 7);
#pragma unroll 1
        for (int cfg = 0; cfg < 3; ++cfg) {
            const int dil = (cfg == 0) ? 16 : (cfg == 1) ? 4 : 1, sstep = 16 / dil, ntile = (cfg == 0) ? 5 : (cfg == 1) ? 8 : 20;
            const int rdla = r16a & (dil - 1), rdlb = (r16a + 1) & (dil - 1);
            const int mba = (512 * c + r16a - rdla) / dil - 128, mbb = (512 * c + r16a + 1 - rdlb) / dil - 128;
            const int tau0 = mbb < 0 ? (-mbb) / 32 : 0;
            const size_t vst = (size_t)dil * ODD_IN;
#pragma unroll 1
            for (int tau = tau0; tau < ntile; ++tau) {
                TileRegs RA, RB;
                { const int mv = mba + 32 * tau + (lane >> 3); const int m0_ = mv < 0 ? 0 : mv, m1_ = mv + 8 < 0 ? 0 : mv + 8, m2_ = mv + 16 < 0 ? 0 : mv + 16, m3_ = mv + 24 < 0 ? 0 : mv + 24;
                  const bf16* vb = Vh + (size_t)rdla * ODD_IN; attn_load(RA, 1024, vb + m0_ * vst, vb + m1_ * vst, vb + m2_ * vst, vb + m3_ * vst); }
                { const int mv = mbb + 32 * tau + (lane >> 3); const int m0_ = mv < 0 ? 0 : mv, m1_ = mv + 8 < 0 ? 0 : mv + 8, m2_ = mv + 16 < 0 ? 0 : mv + 16, m3_ = mv + 24 < 0 ? 0 : mv + 24;
                  const bf16* vb = Vh + (size_t)rdlb * ODD_IN; attn_load(RB, 1024, vb + m0_ * vst, vb + m1_ * vst, vb + m2_ * vst, vb + m3_ * vst); }
                attn_compute2<3>(sa, sb, qa, qb, RA, RB, wl, lane, 128 + sstep * r32 - 32 * tau, -(mba + 32 * tau), -(mbb + 32 * tau));
            }
        }
        attn_store(sa, zqa + 3072 + hh * 64, Y + (rowbase + tqa) * D + hh * 64, lane);
        attn_store(sb, zqb + 3072 + hh * 64, Y + (rowbase + tqa + 1) * D + hh * 64, lane);
    }
}


__device__ __forceinline__ void attn_state_store(const AttnSt& st, bf16* orow, float* lsep, int lane) {
    const int hi = lane >> 5;
    const float lt = st.l + __shfl_xor(st.l, 32), inv = 1.0f / lt;
#pragma unroll
    for (int d0 = 0; d0 < 2; ++d0)
#pragma unroll
        for (int pr = 0; pr < 2; ++pr) {
            v2u w2[2];
#pragma unroll
            for (int k = 0; k < 2; ++k) { const int rq = 2 * pr + k; const f32x16& o = d0 ? st.o1 : st.o0; w2[k].x = cvtpk_s(o[4 * rq + 0] * inv, o[4 * rq + 1] * inv); w2[k].y = cvtpk_s(o[4 * rq + 2] * inv, o[4 * rq + 3] * inv); }
            *(v4u*)(orow + 32 * d0 + 16 * pr + 8 * hi) = pair_to_wide(w2[0], w2[1]);
        }
    if (hi == 0) *lsep = st.m + __builtin_amdgcn_logf(lt);
}
__device__ __forceinline__ void attn_state_load(AttnSt& st, const bf16* orow, const float* lsep, int lane) {
    const int hi = lane >> 5;
#pragma unroll
    for (int d0 = 0; d0 < 2; ++d0)
#pragma unroll
        for (int pr = 0; pr < 2; ++pr) {
            const v4u w = *(const v4u*)(orow + 32 * d0 + 16 * pr + 8 * hi); v2u g2[2]; wide_to_pair(w, g2[0], g2[1]);
            f32x16& o = d0 ? st.o1 : st.o0;
#pragma unroll
            for (int k = 0; k < 2; ++k) { const int rq = 2 * pr + k; o[4 * rq + 0] = bf_lo(g2[k].x); o[4 * rq + 1] = bf_hi(g2[k].x); o[4 * rq + 2] = bf_lo(g2[k].y); o[4 * rq + 3] = bf_hi(g2[k].y); }
        }
    st.m = *lsep; st.l = hi ? 0.f : 1.f;
}
__device__ __forceinline__ void attn_state_store_lds(const AttnSt& st, LAS unsigned char* ex, int p, int lane) {
    const int hi = lane >> 5, sw = (p & 7) ^ ((p >> 4) & 7);
    const float lt = st.l + __shfl_xor(st.l, 32), inv = 1.0f / lt;
#pragma unroll
    for (int d0 = 0; d0 < 2; ++d0)
#pragma unroll
        for (int pr = 0; pr < 2; ++pr) {
            v2u w2[2];
#pragma unroll
            for (int k = 0; k < 2; ++k) { const int rq = 2 * pr + k; const f32x16& o = d0 ? st.o1 : st.o0; w2[k].x = cvtpk_s(o[4 * rq + 0] * inv, o[4 * rq + 1] * inv); w2[k].y = cvtpk_s(o[4 * rq + 2] * inv, o[4 * rq + 3] * inv); }
            *(LAS v4u*)(ex + p * 128 + (((4 * d0 + 2 * pr + hi) ^ sw) << 4)) = pair_to_wide(w2[0], w2[1]);
        }
    if (hi == 0) *(LAS float*)(ex + 65536 + 4 * p) = st.m + __builtin_amdgcn_logf(lt);
}
__device__ __forceinline__ void attn_state_load_lds(AttnSt& st, const LAS unsigned char* ex, int p, int lane) {
    const int hi = lane >> 5, sw = (p & 7) ^ ((p >> 4) & 7);
#pragma unroll
    for (int d0 = 0; d0 < 2; ++d0)
#pragma unroll
        for (int pr = 0; pr < 2; ++pr) {
            const v4u w = *(const LAS v4u*)(ex + p * 128 + (((4 * d0 + 2 * pr + hi) ^ sw) << 4)); v2u g2[2]; wide_to_pair(w, g2[0], g2[1]);
            f32x16& o = d0 ? st.o1 : st.o0;
#pragma unroll
            for (int k = 0; k < 2; ++k) { const int rq = 2 * pr + k; o[4 * rq + 0] = bf_lo(g2[k].x); o[4 * rq + 1] = bf_hi(g2[k].x); o[4 * rq + 2] = bf_lo(g2[k].y); o[4 * rq + 3] = bf_hi(g2[k].y); }
        }
    st.m = *(const LAS float*)(ex + 65536 + 4 * p); st.l = hi ? 0.f : 1.f;
}

__device__ __forceinline__ void phase_dilated_3(const Args& A, LAS unsigned char* lds, int G, int vcu, int wave, int lane) {
    const bf16* Z = (const bf16*)(A.ws + WS_Z); bf16* Y = (bf16*)(A.ws + WS_Y);
    bf16* EX = (bf16*)A.out; float* LSE = A.out + (size_t)32 * 1024 * 1024;
    LAS unsigned char* wl = lds + wave * 16384;
    const int r32 = lane & 31, hi = lane >> 5;
    for (int U = vcu; U < 2048; U += G) {
        const int c = U >> 8, bh = U & 255, b = bh >> 4, hh = bh & 15, T0 = 512 * c;
        const size_t rowbase = (size_t)b * SEQ;
        const bf16* Vh = Z + rowbase * ODD_IN + 2048 + hh * 64 + 8 * (lane & 7);
        {
            const int r16a = 2 * wave, pa = r16a + 16 * r32;
            bf16x8 qa[4], qb[4];
            { const bf16* zqa = Z + (rowbase + T0 + pa) * ODD_IN + hh * 64 + 8 * hi;
#pragma unroll
              for (int d0 = 0; d0 < 4; ++d0) { qa[d0] = *(const bf16x8*)(zqa + 16 * d0); qb[d0] = *(const bf16x8*)(zqa + ODD_IN + 16 * d0); } }
            AttnSt sa, sb; sa.o0 = f32x16{}; sa.o1 = f32x16{}; sa.m = -1e30f; sa.l = 0.f; sb.o0 = f32x16{}; sb.o1 = f32x16{}; sb.m = -1e30f; sb.l = 0.f;
#define P1_PARAMS(ti) const int dil_ = 16, tau_ = (ti); const int rdla_ = r16a & (dil_ - 1), rdlb_ = (r16a + 1) & (dil_ - 1); const int mba_ = (T0 + r16a - rdla_) / dil_ - 128 + 32 * tau_
#define P1_ADDR(ti) P1_PARAMS(ti); const size_t vst_ = (size_t)dil_ * ODD_IN; const int mv = mba_ + (lane >> 3); const int m0_ = mv < 0 ? 0 : mv, m1_ = mv + 8 < 0 ? 0 : mv + 8, m2_ = mv + 16 < 0 ? 0 : mv + 16, m3_ = mv + 24 < 0 ? 0 : mv + 24; \
                const bf16* va_ = Vh + (size_t)rdla_ * ODD_IN; const bf16* vb_ = Vh + (size_t)rdlb_ * ODD_IN
#define P1_LOADK(ti) do { P1_ADDR(ti); attn_load_k(RA, 1024, va_ + m0_ * vst_, va_ + m1_ * vst_, va_ + m2_ * vst_, va_ + m3_ * vst_); attn_load_k(RB, 1024, vb_ + m0_ * vst_, vb_ + m1_ * vst_, vb_ + m2_ * vst_, vb_ + m3_ * vst_); } while (0)
#define P1_LOADV(ti) do { P1_ADDR(ti); attn_load_v(RA, va_ + m0_ * vst_, va_ + m1_ * vst_, va_ + m2_ * vst_, va_ + m3_ * vst_); attn_load_v(RB, vb_ + m0_ * vst_, vb_ + m1_ * vst_, vb_ + m2_ * vst_, vb_ + m3_ * vst_); } while (0)
#pragma unroll 1
            for (int ti = 0; ti < 5; ++ti) {
                { P1_PARAMS(ti); if (mba_ + 31 < 0) continue; }
                TileRegs RA, RB;
                P1_LOADK(ti);
                P1_PARAMS(ti);
                attn_compute2_kv<3>(sa, sb, qa, qb, RA, RB, wl, lane, 128 + (16 / dil_) * r32 - 32 * tau_, -mba_, -mba_, [&] { P1_LOADV(ti); }, [] {});
            }
#undef P1_ADDR
#undef P1_LOADK
#undef P1_LOADV
#undef P1_PARAMS
            __syncthreads();
            attn_state_store_lds(sa, lds, pa, lane);
            attn_state_store_lds(sb, lds, pa + 1, lane);
        }
        {
            const int g4 = wave >> 1, r4a = 2 * (wave & 1), p4 = r4a + 128 * g4 + 4 * r32;
            __syncthreads();
            AttnSt sa, sb;
            attn_state_load_lds(sa, lds, p4, lane);
            attn_state_load_lds(sb, lds, p4 + 1, lane);
            bf16x8 qa[4], qb[4];
            { const bf16* zqa = Z + (rowbase + T0 + p4) * ODD_IN + hh * 64 + 8 * hi;
#pragma unroll
              for (int d0 = 0; d0 < 4; ++d0) { qa[d0] = *(const bf16x8*)(zqa + 16 * d0); qb[d0] = *(const bf16x8*)(zqa + ODD_IN + 16 * d0); } }
            __syncthreads();
            const int mb = T0 / 4 + 32 * g4 - 128;
            const size_t vst = (size_t)4 * ODD_IN;
#pragma unroll 1
            for (int tau = 0; tau < 5; ++tau) {
                const int m0 = mb + 32 * tau;
                if (m0 + 31 < 0) continue;
                const int mv = m0 + (lane >> 3); const int m0_ = mv < 0 ? 0 : mv, m1_ = mv + 8 < 0 ? 0 : mv + 8, m2_ = mv + 16 < 0 ? 0 : mv + 16, m3_ = mv + 24 < 0 ? 0 : mv + 24;
                const bf16* va_ = Vh + (size_t)r4a * ODD_IN; const bf16* vb_ = va_ + ODD_IN;
                TileRegs RA, RB;
                attn_load_k(RA, 1024, va_ + m0_ * vst, va_ + m1_ * vst, va_ + m2_ * vst, va_ + m3_ * vst); attn_load_k(RB, 1024, vb_ + m0_ * vst, vb_ + m1_ * vst, vb_ + m2_ * vst, vb_ + m3_ * vst);
                attn_compute2_kv<3>(sa, sb, qa, qb, RA, RB, wl, lane, 128 + r32 - 32 * tau, -m0, -m0,
                                    [&] { attn_load_v(RA, va_ + m0_ * vst, va_ + m1_ * vst, va_ + m2_ * vst, va_ + m3_ * vst); attn_load_v(RB, vb_ + m0_ * vst, vb_ + m1_ * vst, vb_ + m2_ * vst, vb_ + m3_ * vst); }, [] {});
            }
            __syncthreads();
            attn_state_store_lds(sa, lds, p4, lane);
            attn_state_store_lds(sb, lds, p4 + 1, lane);
        }
        {
            const int pa = 64 * wave + r32, pb = pa + 32;
            bf16x8 qa[4], qb[4];
            { const bf16* zqa = Z + (rowbase + T0 + pa) * ODD_IN + hh * 64 + 8 * hi;
#pragma unroll
              for (int d0 = 0; d0 < 4; ++d0) { qa[d0] = *(const bf16x8*)(zqa + 16 * d0); qb[d0] = *(const bf16x8*)(zqa + (size_t)32 * ODD_IN + 16 * d0); } }
            __syncthreads();
            AttnSt sa, sb;
            attn_state_load_lds(sa, lds, pa, lane);
            attn_state_load_lds(sb, lds, pb, lane);
            __syncthreads();
            const int mba = T0 + 64 * wave - 128, mbb = mba + 32;
            const size_t vst = (size_t)ODD_IN;
#define P2_ADDR(tau) const int mva = mba + 32 * (tau) + (lane >> 3), mvb = mva + 32; \
                const int a0_ = mva < 0 ? 0 : mva, a1_ = mva + 8 < 0 ? 0 : mva + 8, a2_ = mva + 16 < 0 ? 0 : mva + 16, a3_ = mva + 24 < 0 ? 0 : mva + 24; \
                const int b0_ = mvb < 0 ? 0 : mvb, b1_ = mvb + 8 < 0 ? 0 : mvb + 8, b2_ = mvb + 16 < 0 ? 0 : mvb + 16, b3_ = mvb + 24 < 0 ? 0 : mvb + 24
#define P2_LOADK(tau) do { P2_ADDR(tau); attn_load_k(RA, 1024, Vh + a0_ * vst, Vh + a1_ * vst, Vh + a2_ * vst, Vh + a3_ * vst); attn_load_k(RB, 1024, Vh + b0_ * vst, Vh + b1_ * vst, Vh + b2_ * vst, Vh + b3_ * vst); } while (0)
#define P2_LOADV(tau) do { P2_ADDR(tau); attn_load_v(RA, Vh + a0_ * vst, Vh + a1_ * vst, Vh + a2_ * vst, Vh + a3_ * vst); attn_load_v(RB, Vh + b0_ * vst, Vh + b1_ * vst, Vh + b2_ * vst, Vh + b3_ * vst); } while (0)
#pragma unroll 1
            for (int tau = 0; tau < 5; ++tau) {
                if (mbb + 32 * tau + 31 < 0) continue;
                TileRegs RA, RB;
                P2_LOADK(tau);
                attn_compute2_kv<3>(sa, sb, qa, qb, RA, RB, wl, lane, 128 + r32 - 32 * tau, -(mba + 32 * tau), -(mbb + 32 * tau), [&] { P2_LOADV(tau); }, [] {});
            }
#undef P2_ADDR
#undef P2_LOADK
#undef P2_LOADV
            { int pa2 = pa; asm volatile("" : "+v"(pa2));
              bf16* yr = Y + (rowbase + T0 + pa2) * D + hh * 64; const bf16* zg = Z + (rowbase + T0 + pa2) * ODD_IN + 3072 + hh * 64;
              v2u gga[2][4], ggb[2][4]; attn_gate_load(gga, zg, lane); attn_gate_load(ggb, zg + (size_t)32 * ODD_IN, lane);
              attn_store_g(sa, gga, yr, lane); attn_store_g(sb, ggb, yr + (size_t)32 * D, lane); }
        }
    }
}

__device__ __forceinline__ void phase_dilated(const Args& A, LAS unsigned char* lds, int gwv, int NGW, int wave, int lane) {
    const bf16* Z = (const bf16*)(A.ws + WS_Z); bf16* Y = (bf16*)(A.ws + WS_Y);
    LAS unsigned char* vl = lds + wave * 4096;
    const int r32 = lane & 31, hi = lane >> 5;
    for (int U = gwv; U < 32768; U += NGW) {
        const int rd = U >> 11, g2 = U & 2047, X = g2 >> 8, lwv = g2 & 255;
        const int bh = 32 * X + 2 * rd + (lwv >> 7), gi = lwv & 127, c = gi >> 4, r16 = gi & 15;
        const int b = bh >> 4, hh = bh & 15;
        const size_t rowbase = (size_t)b * SEQ;
        const int tq = 512 * c + r16 + 16 * r32;
        const bf16* zq = Z + (rowbase + tq) * ODD_IN;
        bf16x8 qf[4];
#pragma unroll
        for (int d0 = 0; d0 < 4; ++d0) qf[d0] = *(const bf16x8*)(zq + hh * 64 + 16 * d0 + 8 * hi);
        AttnSt st; st.o0 = f32x16{}; st.o1 = f32x16{}; st.m = -1e30f; st.l = 0.f;
        const bf16* Kh = Z + rowbase * ODD_IN + 1024 + hh * 64; const bf16* Vh = Z + rowbase * ODD_IN + 2048 + hh * 64;
#pragma unroll 1
        for (int cfg = 0; cfg < 3; ++cfg) {
            const int dil = (cfg == 0) ? 16 : (cfg == 1) ? 4 : 1, sstep = 16 / dil, ntile = (cfg == 0) ? 5 : (cfg == 1) ? 8 : 20;
            const int rdl = r16 & (dil - 1), mbase = (512 * c + r16 - rdl) / dil - 128;
            for (int tau = 0; tau < ntile; ++tau) {
                const int m0 = mbase + 32 * tau;
                if (m0 + 31 < 0) continue;
                const int mk = m0 + r32, mkc = mk < 0 ? 0 : mk;
                const bf16* kp = Kh + (size_t)(rdl + dil * mkc) * ODD_IN + 8 * hi;
                const int mv = m0 + (lane >> 3);
                const int mv0 = mv < 0 ? 0 : mv, mv1 = mv + 8 < 0 ? 0 : mv + 8, mv2 = mv + 16 < 0 ? 0 : mv + 16, mv3 = mv + 24 < 0 ? 0 : mv + 24;
                const bf16* vb = Vh + (size_t)rdl * ODD_IN + 8 * (lane & 7); const size_t vst = (size_t)dil * ODD_IN;
                const int dd0 = 128 + sstep * r32 - 32 * tau;
                attn_tile(st, qf, kp, vb + mv0 * vst, vb + mv1 * vst, vb + mv2 * vst, vb + mv3 * vst, vl, lane, true,
                          [&](int kk) { const int dd = dd0 - kk; return dd >= 0 && dd <= 128 && (m0 + kk) >= 0; });
            }
        }
        attn_store(st, zq + 3072 + hh * 64, Y + (rowbase + tq) * D + hh * 64, lane);
    }
}
#define XB_TMO      128
#define XB_XCNT(j)  (256  + 64 * (j))
#define XB_XSUB(j)  (1280 + 64 * (j))
#define XB_XGEN(j)  (2304 + 64 * (j))
#define XB_TOP      3328
#define XB_TOPGEN   3392
#define XCD_BAR_WORDS 3456
#define XB_SPIN_CAP (1u << 18)

__device__ __forceinline__ unsigned xb_ld(unsigned* p)              { return __hip_atomic_load(p, __ATOMIC_RELAXED, __HIP_MEMORY_SCOPE_AGENT); }
__device__ __forceinline__ unsigned xb_add(unsigned* p, unsigned v) { return __hip_atomic_fetch_add(p, v, __ATOMIC_RELAXED, __HIP_MEMORY_SCOPE_AGENT); }
__device__ __forceinline__ unsigned xb_xcc_id() { return (unsigned)__builtin_amdgcn_s_getreg((3 << 11) | 20) & 0xFu; }
#define XB_SPIN(cond, bar) do { unsigned _sp = 0; while (cond) { __builtin_amdgcn_s_sleep(1); \
    if ((++_sp & 255u) == 0u) { if (xb_ld(&(bar)[XB_TMO])) break; if (_sp > XB_SPIN_CAP) { atomicAdd(&(bar)[XB_TMO], 1u); break; } } } } while (0)

struct XcdBarrier {
    unsigned* bar; unsigned x;
    volatile LAS unsigned* st;
};

__device__ __forceinline__ XcdBarrier xcd_barrier_post(unsigned* bar, volatile LAS unsigned* st) {
    XcdBarrier b; b.bar = bar; b.x = xb_xcc_id(); b.st = st;
    if (threadIdx.x == 0) (void)xb_add(&bar[XB_XCNT(b.x)], 1u);
    return b;
}
__device__ __forceinline__ void xcd_barrier_complete(unsigned* bar, unsigned x, unsigned& nloc, unsigned& nx) {
    const unsigned G = gridDim.x * gridDim.y * gridDim.z;
    unsigned sum, cnt, mine, sp = 0u;
    for (;;) {
        sum = 0u; cnt = 0u; mine = 0u;
#pragma unroll
        for (unsigned j = 0; j < 16; ++j) { const unsigned c = xb_ld(&bar[XB_XCNT(j)]); sum += c; cnt += (c > 0u) ? 1u : 0u; mine = (j == x) ? c : mine; }
        if (sum == G) break;
        __builtin_amdgcn_s_sleep(1);
        if ((++sp & 255u) == 0u) { if (xb_ld(&bar[XB_TMO])) break; if (sp > XB_SPIN_CAP) { atomicAdd(&bar[XB_TMO], 1u); break; } }
    }
    nloc = mine > 0u ? mine : 1u; nx = cnt > 0u ? cnt : 1u;
}

__device__ __forceinline__ void xcd_barrier(const XcdBarrier& b) {
    asm volatile("s_waitcnt vmcnt(0)" ::: "memory");
    __syncthreads();
    if (threadIdx.x == 0) {
        unsigned* bar = b.bar;
        __builtin_amdgcn_s_waitcnt(0);
        unsigned nloc = b.st[0], nx = b.st[1];
        if (nloc == 0u) { xcd_barrier_complete(bar, b.x, nloc, nx); b.st[0] = nloc; b.st[1] = nx; }
        const unsigned old = xb_add(&bar[XB_XSUB(b.x)], 1u);
        const unsigned gen = old / nloc;
        if (old + 1u == (gen + 1u) * nloc) {
            __builtin_amdgcn_fence(__ATOMIC_RELEASE, "agent");
            asm volatile("s_waitcnt vmcnt(0)" ::: "memory");
            const unsigned og = xb_add(&bar[XB_TOP], 1u);
            const unsigned tg = og / nx;
            if (og + 1u == (tg + 1u) * nx) xb_add(&bar[XB_TOPGEN], 1u);
            else XB_SPIN(xb_ld(&bar[XB_TOPGEN]) == tg, bar);
            __builtin_amdgcn_fence(__ATOMIC_ACQUIRE, "agent");
            xb_add(&bar[XB_XGEN(b.x)], 1u);
            asm volatile("s_waitcnt vmcnt(0)" ::: "memory");
        } else {
            XB_SPIN(xb_ld(&bar[XB_XGEN(b.x)]) == gen, bar);
            __builtin_amdgcn_fence(__ATOMIC_ACQUIRE, "agent");
            asm volatile("s_waitcnt vmcnt(0)" ::: "memory");
        }
    }
    __syncthreads();
}
__device__ __forceinline__ void phase_final(const Args& A, int gwv, int NGW, int lane) {
    const float* ssqp = (const float*)(A.ws + WS_SSQ);
    f32x4 fg[4];
#pragma unroll
    for (int j = 0; j < 4; ++j) fg[j] = *((const f32x4*)A.final_g + lane + 64 * j);
    for (int m = gwv; m < M; m += 2 * NGW) {
        const int m2 = m + NGW;
        const f32x4* sp = (const f32x4*)(ssqp + (size_t)m * 16); const f32x4* sp2 = (const f32x4*)(ssqp + (size_t)m2 * 16);
        f32x4* hr = (f32x4*)(A.out + (size_t)m * D) + lane; f32x4* hr2 = (f32x4*)(A.out + (size_t)m2 * D) + lane;
        const f32x4 a = sp[0], b = sp[1], c = sp[2], d = sp[3], a2 = sp2[0], b2 = sp2[1], c2 = sp2[2], d2 = sp2[3];
        f32x4 v[4], w[4];
#pragma unroll
        for (int j = 0; j < 4; ++j) { v[j] = hr[64 * j]; w[j] = hr2[64 * j]; }
        const float ss = (((a[0] + a[1]) + (a[2] + a[3])) + ((b[0] + b[1]) + (b[2] + b[3]))) + (((c[0] + c[1]) + (c[2] + c[3])) + ((d[0] + d[1]) + (d[2] + d[3])));
        const float ss2 = (((a2[0] + a2[1]) + (a2[2] + a2[3])) + ((b2[0] + b2[1]) + (b2[2] + b2[3]))) + (((c2[0] + c2[1]) + (c2[2] + c2[3])) + ((d2[0] + d2[1]) + (d2[2] + d2[3])));
        const float rstd = __builtin_amdgcn_rsqf(ss * (1.0f / 1024.0f) + NORM_EPS), rstd2 = __builtin_amdgcn_rsqf(ss2 * (1.0f / 1024.0f) + NORM_EPS);
#pragma unroll
        for (int j = 0; j < 4; ++j) { hr[64 * j] = v[j] * rstd * fg[j]; hr2[64 * j] = w[j] * rstd2 * fg[j]; }
    }
}

#define CAS __attribute__((address_space(4)))
#define FRESH_IDS() int lane = lane_k, wave = wave_k, vcu = vcu_k; asm volatile("" : "+v"(lane), "+s"(wave), "+s"(vcu)); const int gwv = vcu * NWAVES + wave; (void)gwv;
#define GRID_SYNC() do { asm volatile("s_waitcnt vmcnt(0) lgkmcnt(0)" ::: "memory"); __syncthreads(); \
    if (wave_k == 0) { __builtin_amdgcn_fence(__ATOMIC_RELEASE, "agent"); asm volatile("s_waitcnt vmcnt(0)" ::: "memory"); } \
    grid.sync(); \
    if (wave_k == 0) { __builtin_amdgcn_fence(__ATOMIC_ACQUIRE, "agent"); asm volatile("s_waitcnt vmcnt(0)" ::: "memory"); } \
    __syncthreads(); } while (0)
#ifdef NO_XBAR
#define XBAR_SYNC() GRID_SYNC()
#else
#define XBAR_SYNC() xcd_barrier(xbar)
#endif
#define FRESH_ARGS() ({ const CAS Args* ap_ = (const CAS Args*)__builtin_amdgcn_kernarg_segment_ptr(); asm volatile("" : "+s"(ap_)); Args a_; a_ = *(const Args*)ap_; a_; })
__global__ void __launch_bounds__(NTHREADS, 2) mega_fwd(Args Akern) {
    extern __shared__ __attribute__((aligned(16))) unsigned char lds_raw[];
    cg::grid_group grid = cg::this_grid();
    LAS unsigned char* lds = (LAS unsigned char*)lds_raw;
    const int tid = threadIdx.x, lane_k = tid & 63, wave_k = __builtin_amdgcn_readfirstlane(tid >> 6);
    const int G = gridDim.x, bx = blockIdx.x;
    const int vcu_k = (G % 8 == 0) ? (bx % 8) * (G / 8) + bx / 8 : bx;
    const int NGW = G * NWAVES;
    if (tid < 2) ((volatile LAS unsigned*)(lds + 131072))[tid] = 0u;
    __syncthreads();
    const XcdBarrier xbar = xcd_barrier_post((unsigned*)(Akern.ws + WS_CTL), (volatile LAS unsigned*)(lds + 131072));

#ifndef NO_PRO
    { FRESH_IDS(); const Args A = FRESH_ARGS(); phase_prologue(A, lds, gwv, NGW, wave, lane); }
#endif
    GRID_SYNC();
#pragma unroll 1
    for (int layer = 0; layer < 4; ++layer) {
        const int li = layer >> 1; const int even = !(layer & 1);
        {
            const Args A = FRESH_ARGS(); bf16* hb = (bf16*)(A.ws + WS_HB); bf16* Zb = (bf16*)(A.ws + WS_Z); float* ssqp = (float*)(A.ws + WS_SSQ); float* kmp = (float*)(A.ws + WS_KMP);
            const int N = even ? EVEN_IN : ODD_IN;
            const bf16* Wt = even ? (const bf16*)(A.ws + WS_WE_IN) + (size_t)li * EVEN_IN * D : (const bf16*)(A.ws + WS_WO_IN) + (size_t)li * ODD_IN * D;
            pg8::Gemm g{hb, Wt, M, N, D}; pg8::StaticOrder S; S.init(M, N, G, bx);
            LAS float* rtab = (LAS float*)(lds + 131072 + 1024);
            {
                int tidl = tid; asm volatile("" : "+v"(tidl));
                const int rl = tidl & 255, half = tidl >> 8;
#pragma unroll 1
                for (int kb = 0; kb < 8; kb += 4) {
                    f32x4 pv[4][4]; int have[4];
#pragma unroll
                    for (int k = 0; k < 4; ++k) {
                        pg8::Unit uu; have[k] = S.next(2 * (kb + k) + half, uu) ? 1 : 0;
                        const float* sp = ssqp + ((size_t)(have[k] ? uu.pm : 0) * 256 + rl) * 16;
#pragma unroll
                        for (int q4 = 0; q4 < 4; ++q4) pv[k][q4] = *(const f32x4*)(sp + 4 * q4);
                    }
#pragma unroll
                    for (int k = 0; k < 4; ++k) {
                        const f32x4 a = pv[k][0], b = pv[k][1], c = pv[k][2], d = pv[k][3];
                        const float ss = (((a[0] + a[1]) + (a[2] + a[3])) + ((b[0] + b[1]) + (b[2] + b[3]))) + (((c[0] + c[1]) + (c[2] + c[3])) + ((d[0] + d[1]) + (d[2] + d[3])));
                        if (have[k]) rtab[(2 * (kb + k) + half) * 256 + rl] = __builtin_amdgcn_rsqf(ss * (1.0f / 1024.0f) + NORM_EPS);
                    }
                }
                __syncthreads();
            }
            int eseq = 0;
            pg8::EpiIn E{Zb, N, rtab, &eseq, kmp, even};
#ifdef PROBE_GIN2
            pg8::gemm_phase<pg8::EpiIn, pg8::StaticOrder, true, true>(lds, g, S, E);
#endif
#ifndef NO_GIN
            pg8::gemm_phase<pg8::EpiIn, pg8::StaticOrder, true, true>(lds, g, S, E);
#endif
        }
        XBAR_SYNC();
#ifdef PROBE_MIX2
        for (int rep = 0; rep < 2; ++rep)
#endif
#ifdef PROBE_MIX2_EVEN
        for (int rep = 0; rep < (even ? 2 : 1); ++rep)
#endif
        { __syncthreads(); FRESH_IDS(); const Args A = FRESH_ARGS();
        if (even) {
#ifndef NO_GMLP
            phase_gmlp(A, li, lds, vcu, G, wave, lane);
#endif
#ifdef PROBE_GMLP2
            phase_gmlp(A, li, lds, vcu, G, wave, lane);
#endif
#ifndef NO_MOBA
#if defined(NO_PIPE)
            phase_moba_old(A, lds, gwv, NGW, wave, lane);
#elif defined(MOBA_PIPE)
            phase_moba_p(A, lds, gwv, NGW, wave, lane);
#else
            phase_moba_s(A, lds, G, vcu, wave, lane);
#endif
#endif
        } else {
#ifndef NO_DIL
#if defined(NO_PIPE)
            phase_dilated(A, lds, gwv, NGW, wave, lane);
#elif defined(DIL_PIPE)
            phase_dilated_p(A, lds, gwv, NGW, wave, lane);
#elif defined(DIL_2)
            phase_dilated_2(A, lds, gwv, NGW, wave, lane);
#else
            phase_dilated_3(A, lds, G, vcu, wave, lane);
#endif
#endif
        } }
        XBAR_SYNC();
        {
            const Args A = FRESH_ARGS(); bf16* hb = (bf16*)(A.ws + WS_HB); bf16* Yb = (bf16*)(A.ws + WS_Y); float* ssqp = (float*)(A.ws + WS_SSQ);
            const bf16* Wt = even ? (const bf16*)(A.ws + WS_WE_OUT) + (size_t)li * D * D : (const bf16*)(A.ws + WS_WO_OUT) + (size_t)li * D * D;
            pg8::Gemm g{Yb, Wt, M, D, D}; pg8::StaticOrder S; S.init(M, D, G, bx);
            pg8::EpiOut E{layer == 0 ? A.x : nullptr, layer == 3 ? A.out : nullptr, hb, ssqp};
#ifndef NO_GOUT
            pg8::gemm_phase<pg8::EpiOut, pg8::StaticOrder, true, true>(lds, g, S, E);
#endif
        }
        XBAR_SYNC();
    }
#ifndef NO_FIN
    { FRESH_IDS(); const Args A = FRESH_ARGS(); phase_final(A, gwv, NGW, lane); }
#endif
}

extern "C" void kernel_launch(void* const* d_in, const int* in_sizes, int n_in, void* d_out, int out_size, void* d_ws, size_t ws_size, hipStream_t stream) {
    static int grid = 0;
    if (grid == 0) {
        if (n_in != 11 || in_sizes[0] != M * D || out_size != M * D || ws_size < WS_END) { fprintf(stderr, "kernel_launch: unexpected shapes (n_in %d, in0 %d, out %d, ws %zu)\n", n_in, n_in > 0 ? in_sizes[0] : -1, out_size, ws_size); grid = -1; return; }
        int dev = 0, cus = 0, per_cu = 0;
        if (hipGetDevice(&dev) != hipSuccess || hipDeviceGetAttribute(&cus, hipDeviceAttributeMultiprocessorCount, dev) != hipSuccess) { grid = -1; return; }
        if (hipFuncSetAttribute((const void*)mega_fwd, hipFuncAttributeMaxDynamicSharedMemorySize, LDS_BYTES) != hipSuccess) { fprintf(stderr, "kernel_launch: hipFuncSetAttribute failed\n"); grid = -1; return; }
        if (hipOccupancyMaxActiveBlocksPerMultiprocessor(&per_cu, (const void*)mega_fwd, NTHREADS, LDS_BYTES) != hipSuccess || per_cu < 1) { fprintf(stderr, "kernel_launch: occupancy query says %d\n", per_cu); per_cu = 1; }
        (void)hipGetLastError();
        grid = cus;
    }
    if (grid < 0) return;
    Args a{};
    a.x = (const float*)d_in[0]; a.norm_g = (const float*)d_in[1]; a.final_g = (const float*)d_in[2]; a.ab_w_in = (const float*)d_in[3]; a.ab_w_out = (const float*)d_in[4];
    a.ln_g = (const float*)d_in[5]; a.ln_b = (const float*)d_in[6]; a.w_s = (const float*)d_in[7]; a.b_s = (const float*)d_in[8]; a.c_w_in = (const float*)d_in[9]; a.c_w_out = (const float*)d_in[10];
    a.out = (float*)d_out; a.ws = (unsigned char*)d_ws;
    if (hipMemsetAsync((char*)d_ws + WS_CTL, 0, 16384, stream) != hipSuccess) { fprintf(stderr, "kernel_launch: hipMemsetAsync failed\n"); return; }
    void* args[] = {&a};
    const hipError_t e = hipLaunchCooperativeKernel((const void*)mega_fwd, dim3(grid), dim3(NTHREADS), args, LDS_BYTES, stream);
    if (e != hipSuccess) fprintf(stderr, "kernel_launch: cooperative launch failed: %s (grid %d)\n", hipGetErrorString(e), grid);
}
```

```cpp
#include <hip/hip_runtime.h>
#include <hip/hip_cooperative_groups.h>
#include <cstdio>
#include <cstdint>
#include <cmath>
namespace cg = cooperative_groups;
namespace pg8 {
#define PG8_LAS __attribute__((address_space(3)))
typedef unsigned short bf16_t;
typedef short bf16x8 __attribute__((ext_vector_type(8)));
typedef float f32x4 __attribute__((ext_vector_type(4)));
typedef unsigned u32x4 __attribute__((ext_vector_type(4)));
constexpr int BM = 256, BK = 64, HALF = 128, HTB = HALF * BK * 2  , STAGE_BYTES = 8 * HTB, NXCD = 8, WGM = 8;

__host__ __device__ __forceinline__ int lds_byte(int r, int c) { const int st = (r >> 4) * 2 + (c >> 5), rr = r & 15, cc = c & 31, ob = rr * 64 + cc * 2; return st * 1024 + (ob ^ (((ob >> 9) & 1) << 5)); }
__host__ __device__ __forceinline__ void stage_rc(int b, int& R, int& C) { const int st = b / 1024, sb = b % 1024, swz = sb ^ (((sb >> 9) & 1) << 5); R = (st >> 1) * 16 + swz / 64; C = (st & 1) * 32 + (swz % 64) / 2; }
__host__ __device__ __forceinline__ int perm32(int rho) { const int n = rho >> 4, i = rho & 15; return 8 * (i >> 2) + 4 * n + (i & 3); }

struct Unit { int pm, pn; };
struct Gemm { const bf16_t* A; const bf16_t* Bt; int M, N, K; };

struct StaticOrder {
    int nM, nN, nwg, G, c;
    __host__ __device__ void init(int M, int N, int G_, int c_) { nM = M / BM; nN = N / BM; nwg = nM * nN; G = G_; c = c_; }
    __host__ __device__ bool next(int i, Unit& u) const {
        const long L = (long)i * G + c; if (L >= nwg) return false;
        int wgid = (int)L; { const int q = nwg / NXCD, r = nwg % NXCD, xcd = wgid % NXCD, off = wgid / NXCD; wgid = (xcd < r ? xcd * (q + 1) : r * (q + 1) + (xcd - r) * q) + off; }
        const int nig = WGM * nN, gid = wgid / nig, fm = gid * WGM, gsz = (nM - fm) < WGM ? (nM - fm) : WGM;
        u.pm = fm + ((wgid % nig) % gsz); u.pn = (wgid % nig) / gsz; return true;
    }
    __device__ __forceinline__ void a_ready(const Unit&) const {}
    __device__ __forceinline__ void done(const Unit&) const {}
};

__device__ __forceinline__ unsigned cvt_pk_bf16(float lo, float hi) { unsigned r; asm volatile("v_cvt_pk_bf16_f32 %0, %1, %2" : "=v"(r) : "v"(lo), "v"(hi)); return r; }
typedef unsigned u32x2 __attribute__((ext_vector_type(2)));
__device__ __forceinline__ float act_gelu(float x) {
    const float t = x + 0.044715f * x * x * x;
    return x * __builtin_amdgcn_rcpf(1.f + __builtin_amdgcn_exp2f(-2.302208198f * t));
}
__device__ __forceinline__ float act_silu(float x) { return x * __builtin_amdgcn_rcpf(1.f + __builtin_amdgcn_exp2f(-1.4426950409f * x)); }
constexpr float QSCALE = 0.125f * 1.4426950408889634f;
constexpr float NORM_EPS = 1e-6f;

struct EpiIn {
    static constexpr bool PERM = true, AFTER_DRAIN = false;
    bf16_t* Z; int ldz; const PG8_LAS float* rtab; int* seq; float* kmp; int even;
    template <int ACT> __device__ __forceinline__ void body(const f32x4 (&acc)[2][2][4][2], const Unit& u, int wr, int wc, int fr, int fq, const PG8_LAS float* rt) const {
        const int row0 = u.pm * BM + wr * 64 + fr, col0 = u.pn * BM + wc * 32 + 8 * fq;
        float rs[2][4];
#pragma unroll
        for (int ai = 0; ai < 2; ++ai)
#pragma unroll
            for (int m = 0; m < 4; ++m) rs[ai][m] = rt[wr * 64 + fr + ai * HALF + m * 16];
        float cs[2][2][4];
        if (ACT == 4) {
#pragma unroll
            for (int bj = 0; bj < 2; ++bj)
#pragma unroll
                for (int n = 0; n < 2; ++n)
#pragma unroll
                    for (int e = 0; e < 4; ++e) cs[bj][n][e] = 0.f;
        }
#pragma unroll
        for (int ai = 0; ai < 2; ++ai)
#pragma unroll
            for (int m = 0; m < 4; ++m) {
                const int row = row0 + ai * HALF + m * 16;
                const float rstd = rs[ai][m];
                bf16_t* rowp = Z + (size_t)row * ldz + col0;
#pragma unroll
                for (int bj = 0; bj < 2; ++bj) {
                    f32x4 v[2];
#pragma unroll
                    for (int n = 0; n < 2; ++n) {
                        v[n] = acc[ai][bj][m][n] * rstd;
#pragma unroll
                        for (int e = 0; e < 4; ++e) {
                            if (ACT == 1) v[n][e] = act_gelu(v[n][e]);
                            if (ACT == 2) v[n][e] = act_silu(v[n][e]);
                            if (ACT == 3) v[n][e] = v[n][e] * QSCALE;
                            if (ACT == 4) cs[bj][n][e] += v[n][e];
                        }
                    }
                    u32x4 w; w.x = cvt_pk_bf16(v[0][0], v[0][1]); w.y = cvt_pk_bf16(v[0][2], v[0][3]); w.z = cvt_pk_bf16(v[1][0], v[1][1]); w.w = cvt_pk_bf16(v[1][2], v[1][3]);
                    *(u32x4*)(rowp + bj * HALF) = w;
                }
            }
        if (ACT == 4) {
#pragma unroll
            for (int bj = 0; bj < 2; ++bj)
#pragma unroll
                for (int n = 0; n < 2; ++n)
#pragma unroll
                    for (int e = 0; e < 4; ++e) {
                        float s = cs[bj][n][e];
                        s += __shfl_xor(s, 1); s += __shfl_xor(s, 2); s += __shfl_xor(s, 4); s += __shfl_xor(s, 8);
                        cs[bj][n][e] = s;
                    }
            if (fr == 0) {
                float* kp = kmp + ((size_t)u.pm * 2 + wr) * 512 + (col0 - 2048);
#pragma unroll
                for (int bj = 0; bj < 2; ++bj)
#pragma unroll
                    for (int n = 0; n < 2; ++n) *(f32x4*)(kp + bj * HALF + n * 4) = (f32x4){cs[bj][n][0], cs[bj][n][1], cs[bj][n][2], cs[bj][n][3]};
            }
        }
    }
    __device__ __forceinline__ void operator()(const f32x4 (&acc)[2][2][4][2], const Unit& u, int wr, int wc, int fr, int fq) const {
        int act;
        if (even) { const int seg = u.pn >> 1; act = (seg == 0 || seg == 1) ? 1 : (seg == 2 || seg == 6) ? 2 : (seg == 3) ? 3 : (seg == 4) ? 4 : 0; }
        else { const int seg = u.pn >> 2; act = (seg == 0) ? 3 : (seg == 3) ? 2 : 0; }
        const PG8_LAS float* rt = rtab + ((*seq)++) * 256;
        if (act == 0) body<0>(acc, u, wr, wc, fr, fq, rt);
        else if (act == 1) body<1>(acc, u, wr, wc, fr, fq, rt);
        else if (act == 2) body<2>(acc, u, wr, wc, fr, fq, rt);
        else if (act == 3) body<3>(acc, u, wr, wc, fr, fq, rt);
        else body<4>(acc, u, wr, wc, fr, fq, rt);
    }
};
struct EpiOut {
    static constexpr bool PERM = true, AFTER_DRAIN = false;
    const float* resid_f32; float* out_f32; bf16_t* hb; float* ssqp;
    template <bool RF32> __device__ __forceinline__ void body(const f32x4 (&acc)[2][2][4][2], const Unit& u, int wr, int wc, int fr, int fq) const {
        const int row0 = u.pm * BM + wr * 64 + fr, col0 = u.pn * BM + wc * 32 + 8 * fq;
        constexpr int MB = RF32 ? 2 : 4;
#pragma unroll
        for (int ai = 0; ai < 2; ++ai)
#pragma unroll
        for (int m0 = 0; m0 < 4; m0 += MB) {
            f32x4 rf[RF32 ? MB : 1][2][2]; u32x4 rb[RF32 ? 1 : MB][2];
#pragma unroll
            for (int mm = 0; mm < MB; ++mm)
#pragma unroll
                for (int bj = 0; bj < 2; ++bj) {
                    const size_t o2 = (size_t)(row0 + ai * HALF + (m0 + mm) * 16) * 1024 + col0 + bj * HALF;
                    if (RF32) { rf[RF32 ? mm : 0][bj][0] = *(const f32x4*)(resid_f32 + o2); rf[RF32 ? mm : 0][bj][1] = *(const f32x4*)(resid_f32 + o2 + 4); }
                    else rb[RF32 ? 0 : mm][bj] = *(const u32x4*)(hb + o2);
                }
#pragma unroll
            for (int mm = 0; mm < MB; ++mm) {
                const int m = m0 + mm;
                const int row = row0 + ai * HALF + m * 16; const size_t off = (size_t)row * 1024 + col0; float ss = 0.f;
#pragma unroll
                for (int bj = 0; bj < 2; ++bj) {
                    const size_t o2 = off + bj * HALF;
                    f32x4 r0, r1;
                    if (RF32) { r0 = rf[RF32 ? mm : 0][bj][0]; r1 = rf[RF32 ? mm : 0][bj][1]; }
                    else { const u32x4 w = rb[RF32 ? 0 : mm][bj];
                        r0[0] = __builtin_bit_cast(float, w.x << 16); r0[1] = __builtin_bit_cast(float, w.x & 0xffff0000u); r0[2] = __builtin_bit_cast(float, w.y << 16); r0[3] = __builtin_bit_cast(float, w.y & 0xffff0000u);
                        r1[0] = __builtin_bit_cast(float, w.z << 16); r1[1] = __builtin_bit_cast(float, w.z & 0xffff0000u); r1[2] = __builtin_bit_cast(float, w.w << 16); r1[3] = __builtin_bit_cast(float, w.w & 0xffff0000u); }
                    const f32x4 o0 = r0 + acc[ai][bj][m][0], o1 = r1 + acc[ai][bj][m][1];
                    ss += ((o0[0] * o0[0] + o0[1] * o0[1]) + (o0[2] * o0[2] + o0[3] * o0[3])) + ((o1[0] * o1[0] + o1[1] * o1[1]) + (o1[2] * o1[2] + o1[3] * o1[3]));
                    if (out_f32) { *(f32x4*)(out_f32 + o2) = o0; *(f32x4*)(out_f32 + o2 + 4) = o1; }
                    else { u32x4 w; w.x = cvt_pk_bf16(o0[0], o0[1]); w.y = cvt_pk_bf16(o0[2], o0[3]); w.z = cvt_pk_bf16(o1[0], o1[1]); w.w = cvt_pk_bf16(o1[2], o1[3]); *(u32x4*)(hb + o2) = w; }
                }
                ss += __shfl_xor(ss, 16); ss += __shfl_xor(ss, 32);
                if (fq == 0) ssqp[(size_t)row * 16 + u.pn * 4 + wc] = ss;
            }
        }
    }
    __device__ __forceinline__ void operator()(const f32x4 (&acc)[2][2][4][2], const Unit& u, int wr, int wc, int fr, int fq) const {
        if (resid_f32) body<true>(acc, u, wr, wc, fr, fq); else body<false>(acc, u, wr, wc, fr, fq);
    }
};
template <class Epi, class Sched, bool ALIGN_EPI = false, bool SP2 = false>
__device__ __forceinline__ void gemm_phase(PG8_LAS unsigned char* lds, const Gemm g, const Sched& S, const Epi& E) {
    int tid_ = threadIdx.x; asm volatile("" : "+v"(tid_));
    const int tid = tid_, wid = __builtin_amdgcn_readfirstlane(tid >> 6), lane = tid & 63, wr = wid >> 2, wc = wid & 3, fr = lane & 15, fq = lane >> 4;
    const int K = g.K, nt = K / BK;
    unsigned voffA[2], voffB[2];
#pragma unroll
    for (int i = 0; i < 2; ++i) { int R, C; stage_rc(tid * 16 + i * 8192, R, C); const int Rb = Epi::PERM ? ((R & ~31) + perm32(R & 31)) : R;
        voffA[i] = (unsigned)(R * K + C) * 2u; voffB[i] = (unsigned)(Rb * K + C) * 2u; }
    const size_t kstep = (size_t)(BK * 2);
    const size_t hstep = (size_t)HALF * K * 2;
    const size_t tstep = 2 * hstep;
    const unsigned ldsw = (unsigned)wid * 1024u;
    const int aoff = lds_byte(wr * 64 + fr, fq * 8), boff = lds_byte(wc * 32 + fr, fq * 8);
#define PG8_SA(b, h) (((b) * 2 + (h)) * HTB)
#define PG8_SB(b, h) ((4 + (b) * 2 + (h)) * HTB)
#define PG8_STAGE(bufoff, gbase, voff) do { _Pragma("unroll") for (int _i = 0; _i < 2; ++_i) \
        __builtin_amdgcn_global_load_lds((const unsigned*)((const char*)(gbase) + (voff)[_i]), (PG8_LAS unsigned*)(lds + (bufoff) + ldsw + _i * 8192), 16, 0, 0); } while (0)
#define PG8_LDA(dst, b, h) do { _Pragma("unroll") for (int m = 0; m < 4; ++m) _Pragma("unroll") for (int k = 0; k < 2; ++k) dst[m][k] = *(const PG8_LAS bf16x8*)(lds + PG8_SA(b, h) + aoff + m * 2048 + k * 1024); } while (0)
#define PG8_LDB(dst, b, h) do { _Pragma("unroll") for (int n = 0; n < 2; ++n) _Pragma("unroll") for (int k = 0; k < 2; ++k) dst[n][k] = *(const PG8_LAS bf16x8*)(lds + PG8_SB(b, h) + boff + n * 2048 + k * 1024); } while (0)
#define PG8_MMA(ai, bj, At, Bt) do { __builtin_amdgcn_s_setprio(1); _Pragma("unroll") for (int m = 0; m < 4; ++m) _Pragma("unroll") for (int n = 0; n < 2; ++n) _Pragma("unroll") for (int k = 0; k < 2; ++k) \
        acc[ai][bj][m][n] = __builtin_amdgcn_mfma_f32_16x16x32_bf16(Bt[n][k], At[m][k], acc[ai][bj][m][n], 0, 0, 0); __builtin_amdgcn_s_setprio(0); } while (0)
#define PG8_WAIT_V(n) asm volatile("s_waitcnt vmcnt(" #n ")" ::: "memory")
#define PG8_WAIT_L(n) asm volatile("s_waitcnt lgkmcnt(" #n ")" ::: "memory")
#define PG8_BAR __builtin_amdgcn_s_barrier()
#define PG8_SCHED __builtin_amdgcn_sched_barrier(0)
    Unit cur, nxt; int ui = 0;
    if (!S.next(0, cur)) return;
    f32x4 acc[2][2][4][2];
#pragma unroll
    for (int a = 0; a < 2; ++a)
#pragma unroll
        for (int b = 0; b < 2; ++b)
#pragma unroll
            for (int m = 0; m < 4; ++m)
#pragma unroll
                for (int n = 0; n < 2; ++n) acc[a][b][m][n] = (f32x4){0.f, 0.f, 0.f, 0.f};
    bf16x8 At[4][2], B0[2][2], B1[2][2];
    const char* cA = (const char*)g.A + (size_t)cur.pm * tstep; const char* cB = (const char*)g.Bt + (size_t)cur.pn * tstep;
    S.a_ready(cur);
    if constexpr (SP2) {
        PG8_STAGE(PG8_SB(0, 0), cB, voffB); PG8_STAGE(PG8_SB(0, 1), cB + hstep, voffB); PG8_STAGE(PG8_SA(0, 0), cA, voffA); PG8_STAGE(PG8_SA(0, 1), cA + hstep, voffA);
        if (wr == 1) PG8_BAR;
        PG8_WAIT_V(2); PG8_BAR;
        PG8_STAGE(PG8_SB(1, 0), cB + kstep, voffB); PG8_STAGE(PG8_SA(1, 0), cA + kstep, voffA); PG8_STAGE(PG8_SB(1, 1), cB + hstep + kstep, voffB);
        PG8_WAIT_V(6); PG8_BAR;
    } else {
        PG8_STAGE(PG8_SB(0, 0), cB, voffB); PG8_STAGE(PG8_SA(0, 0), cA, voffA); PG8_STAGE(PG8_SB(0, 1), cB + hstep, voffB); PG8_STAGE(PG8_SA(0, 1), cA + hstep, voffA);
        if (wr == 1) PG8_BAR;
        PG8_WAIT_V(4); PG8_BAR;
        PG8_STAGE(PG8_SB(1, 0), cB + kstep, voffB); PG8_STAGE(PG8_SA(1, 0), cA + kstep, voffA); PG8_STAGE(PG8_SB(1, 1), cB + hstep + kstep, voffB);
        PG8_WAIT_V(6); PG8_BAR;
    }
    for (;;) {
        const bool has_next = S.next(ui + 1, nxt);
        const char* nA = has_next ? (const char*)g.A + (size_t)nxt.pm * tstep : cA; const char* nB = has_next ? (const char*)g.Bt + (size_t)nxt.pn * tstep : cB;
        for (int t = 0; t < nt; t += 2) {
            const bool last = (t == nt - 2);
            const char* a1 = cA + (size_t)(t + 1) * kstep;
            const char* a2 = last ? nA : cA + (size_t)(t + 2) * kstep; const char* b2 = last ? nB : cB + (size_t)(t + 2) * kstep;
            const char* a3 = a2 + kstep; const char* b3 = b2 + kstep;
            if (last && has_next) S.a_ready(nxt);
            if constexpr (SP2) {
            PG8_LDB(B0, 0, 0); PG8_LDB(B1, 0, 1); PG8_SCHED; PG8_LDA(At, 0, 0); PG8_STAGE(PG8_SA(1, 1), a1 + hstep, voffA);
            PG8_WAIT_V(8); PG8_WAIT_L(0); PG8_BAR; PG8_MMA(0, 0, At, B0); PG8_MMA(0, 1, At, B1); PG8_BAR; PG8_SCHED;
            PG8_LDA(At, 0, 1); PG8_STAGE(PG8_SB(0, 0), b2, voffB); PG8_STAGE(PG8_SB(0, 1), b2 + hstep, voffB); PG8_STAGE(PG8_SA(0, 0), a2, voffA);
            PG8_WAIT_V(8); PG8_WAIT_L(0); PG8_BAR; PG8_MMA(1, 0, At, B0); PG8_MMA(1, 1, At, B1); PG8_BAR; PG8_SCHED;
            PG8_LDB(B0, 1, 0); PG8_LDB(B1, 1, 1); PG8_SCHED; PG8_LDA(At, 1, 0); PG8_STAGE(PG8_SA(0, 1), a2 + hstep, voffA);
            PG8_WAIT_V(8); PG8_WAIT_L(0); PG8_BAR; PG8_MMA(0, 0, At, B0); PG8_MMA(0, 1, At, B1); PG8_BAR; PG8_SCHED;
            PG8_LDA(At, 1, 1); PG8_STAGE(PG8_SB(1, 0), b3, voffB); PG8_STAGE(PG8_SB(1, 1), b3 + hstep, voffB); PG8_STAGE(PG8_SA(1, 0), a3, voffA);
            PG8_WAIT_V(8); PG8_WAIT_L(0); PG8_BAR; PG8_MMA(1, 0, At, B0); PG8_MMA(1, 1, At, B1); PG8_BAR; PG8_SCHED;
            } else {
            PG8_LDB(B0, 0, 0); PG8_SCHED; PG8_LDA(At, 0, 0); PG8_STAGE(PG8_SA(1, 1), a1 + hstep, voffA);
            PG8_WAIT_L(8); PG8_BAR; PG8_WAIT_L(0); PG8_MMA(0, 0, At, B0); PG8_BAR; PG8_SCHED;
            PG8_LDB(B1, 0, 1); PG8_STAGE(PG8_SB(0, 0), b2, voffB);
            PG8_BAR; PG8_WAIT_L(0); PG8_MMA(0, 1, At, B1); PG8_BAR;
            PG8_LDA(At, 0, 1); PG8_STAGE(PG8_SA(0, 0), a2, voffA);
            PG8_BAR; PG8_WAIT_L(0); PG8_MMA(1, 0, At, B0); PG8_BAR; PG8_SCHED;
            PG8_STAGE(PG8_SB(0, 1), b2 + hstep, voffB);
            PG8_WAIT_V(6); PG8_BAR; PG8_MMA(1, 1, At, B1); PG8_BAR;
            PG8_LDB(B0, 1, 0); PG8_SCHED; PG8_LDA(At, 1, 0); PG8_STAGE(PG8_SA(0, 1), a2 + hstep, voffA);
            PG8_WAIT_L(8); PG8_BAR; PG8_WAIT_L(0); PG8_MMA(0, 0, At, B0); PG8_BAR; PG8_SCHED;
            PG8_LDB(B1, 1, 1); PG8_STAGE(PG8_SB(1, 0), b3, voffB);
            PG8_BAR; PG8_WAIT_L(0); PG8_MMA(0, 1, At, B1); PG8_BAR;
            PG8_LDA(At, 1, 1); PG8_STAGE(PG8_SA(1, 0), a3, voffA);
            PG8_BAR; PG8_WAIT_L(0); PG8_MMA(1, 0, At, B0); PG8_BAR; PG8_SCHED;
            PG8_STAGE(PG8_SB(1, 1), b3 + hstep, voffB);
            PG8_WAIT_V(6); PG8_BAR; PG8_MMA(1, 1, At, B1); PG8_BAR;
            }
        }
        if constexpr (ALIGN_EPI) { if (wr == 0) PG8_BAR; }
        if constexpr (!Epi::AFTER_DRAIN) { E(acc, cur, wr, wc, fr, fq); S.done(cur); }
        if (!has_next) break;
#pragma unroll
        for (int a = 0; a < 2; ++a)
#pragma unroll
            for (int b = 0; b < 2; ++b)
#pragma unroll
                for (int m = 0; m < 4; ++m)
#pragma unroll
                    for (int n = 0; n < 2; ++n) acc[a][b][m][n] = (f32x4){0.f, 0.f, 0.f, 0.f};
        cur = nxt; cA = nA; cB = nB; ++ui;
        if constexpr (ALIGN_EPI) { if (wr == 1) PG8_BAR; }
    }
    PG8_WAIT_V(0);
    if constexpr (!ALIGN_EPI) { if (wr == 0) PG8_BAR; }
    PG8_BAR;
    if constexpr (Epi::AFTER_DRAIN) { E.fused(acc, cur, wr, wc, fr, fq, lds, wid, lane); S.done(cur); }
#undef PG8_SA
#undef PG8_SB
#undef PG8_STAGE
#undef PG8_LDA
#undef PG8_LDB
#undef PG8_MMA
#undef PG8_WAIT_V
#undef PG8_WAIT_L
#undef PG8_BAR
#undef PG8_SCHED
}
}
#define GAS __attribute__((address_space(1)))
#define LAS __attribute__((address_space(3)))
typedef unsigned short bf16;
typedef unsigned v4u __attribute__((ext_vector_type(4)));
typedef unsigned v2u __attribute__((ext_vector_type(2)));
typedef float f32x4 __attribute__((ext_vector_type(4)));
typedef float f32x16 __attribute__((ext_vector_type(16)));
typedef short bf16x8 __attribute__((ext_vector_type(8)));
typedef short s16x4 __attribute__((ext_vector_type(4)));
#define LDS_WAIT() asm volatile("s_waitcnt lgkmcnt(0)" ::: "memory")
using pg8::cvt_pk_bf16; using pg8::NORM_EPS; using pg8::QSCALE;

constexpr int NWAVES = 8, NTHREADS = 512;
constexpr float RESCALE_THR = 8.0f;
constexpr int D = 1024, BATCH = 16, SEQ = 4096, M = BATCH * SEQ;
constexpr int EVEN_IN = 3584, ODD_IN = 4096;
constexpr size_t MiB = 1u << 20;
constexpr size_t WS_WE_IN = 0, WS_WE_OUT = 14 * MiB, WS_WO_IN = 18 * MiB, WS_WO_OUT = 34 * MiB, WS_WS = 38 * MiB, WS_SSQ = 39 * MiB, WS_KMP = 43 * MiB,
                 WS_HB = 44 * MiB, WS_Y = 172 * MiB, WS_Z = 300 * MiB, WS_CTL = 812 * MiB, WS_END = 813 * MiB;
constexpr int LDS_BYTES = 131072 + 1024 + 16384;

__device__ __forceinline__ unsigned f2bf(float f) { unsigned u = __builtin_bit_cast(unsigned, f); return (u + 0x7fffu + ((u >> 16) & 1u)) >> 16; }
__device__ __forceinline__ unsigned pk2(float lo, float hi) { return f2bf(lo) | (f2bf(hi) << 16); }
__device__ __forceinline__ float bf_lo(unsigned w) { return __builtin_bit_cast(float, w << 16); }
__device__ __forceinline__ float bf_hi(unsigned w) { return __builtin_bit_cast(float, w & 0xffff0000u); }
__device__ __forceinline__ float wave_sum(float v) {
#pragma unroll
    for (int o = 1; o < 64; o <<= 1) v += __shfl_xor(v, o);
    return v;
}
typedef float f32x2_t __attribute__((ext_vector_type(2))); typedef __bf16 bf16x2_t __attribute__((ext_vector_type(2)));
__device__ __forceinline__ unsigned cvtpk_s(float lo, float hi) { f32x2_t v = {lo, hi}; bf16x2_t b = __builtin_convertvector(v, bf16x2_t); return __builtin_bit_cast(unsigned, b); }
__device__ __forceinline__ int crow(int r, int hi) { return (r & 3) + 8 * (r >> 2) + 4 * hi; }
__device__ __forceinline__ s16x4 vtr(const LAS unsigned char* p) { return __builtin_bit_cast(s16x4, __builtin_amdgcn_ds_read_tr16_b64_v4i16((LAS s16x4*)p)); }

__device__ __forceinline__ void transpose_item(const float* W, const float* g, int K, int N, bf16* WT, LAS float* scr, int item, int lane) {
    const int nblk = N / 32, kb = item / nblk, nb = item % nblk, k0 = 64 * kb, n0 = 32 * nb;
#pragma unroll 8
    for (int i = 0; i < 32; ++i) { const int kk = 2 * i + (lane >> 5); const float sc = g ? g[k0 + kk] : 1.f; scr[kk * 33 + (lane & 31)] = W[(size_t)(k0 + kk) * N + n0 + (lane & 31)] * sc; }
    LDS_WAIT(); asm volatile("" ::: "memory");
    const int c = lane & 7;
#pragma unroll
    for (int j = 0; j < 4; ++j) { const int n = (lane >> 3) + 8 * j; const LAS float* s = scr + (8 * c) * 33 + n;
        v4u o; o.x = pk2(s[0 * 33], s[1 * 33]); o.y = pk2(s[2 * 33], s[3 * 33]); o.z = pk2(s[4 * 33], s[5 * 33]); o.w = pk2(s[6 * 33], s[7 * 33]);
        *(v4u*)(WT + (size_t)(n0 + n) * K + k0 + 8 * c) = o; }
    LDS_WAIT(); asm volatile("" ::: "memory");
}

struct Args {
    const float *x, *norm_g, *final_g, *ab_w_in, *ab_w_out, *ln_g, *ln_b, *w_s, *b_s, *c_w_in, *c_w_out;
    float* out; unsigned char* ws;
};

__device__ __forceinline__ void phase_prologue(const Args& A, LAS unsigned char* lds, int gwv, int NGW, int wave, int lane) {
    LAS float* scr = (LAS float*)(lds + wave * 16384);
    constexpr int I_EIN = 16 * (EVEN_IN / 32), I_OUT = 16 * 32, I_OIN = 16 * (ODD_IN / 32), I_PAIR = I_EIN + I_OUT + I_OIN + I_OUT;
    for (int it = gwv; it < 2 * I_PAIR; it += NGW) {
        const int i = it / I_PAIR; int r = it % I_PAIR;
        if (r < I_EIN) { transpose_item(A.ab_w_in + (size_t)i * D * EVEN_IN, A.norm_g + (2 * i) * D, D, EVEN_IN, (bf16*)(A.ws + WS_WE_IN) + (size_t)i * EVEN_IN * D, scr, r, lane); continue; } r -= I_EIN;
        if (r < I_OUT) { transpose_item(A.ab_w_out + (size_t)i * D * D, nullptr, D, D, (bf16*)(A.ws + WS_WE_OUT) + (size_t)i * D * D, scr, r, lane); continue; } r -= I_OUT;
        if (r < I_OIN) { transpose_item(A.c_w_in + (size_t)i * D * ODD_IN, A.norm_g + (2 * i + 1) * D, D, ODD_IN, (bf16*)(A.ws + WS_WO_IN) + (size_t)i * ODD_IN * D, scr, r, lane); continue; } r -= I_OIN;
        transpose_item(A.c_w_out + (size_t)i * D * D, nullptr, D, D, (bf16*)(A.ws + WS_WO_OUT) + (size_t)i * D * D, scr, r, lane);
    }
    { bf16* wst = (bf16*)(A.ws + WS_WS);
      for (int e = gwv * 64 + lane; e < 2 * 4 * 128 * 128; e += NGW * 64) { const int s = e & 127, t = (e >> 7) & 127; wst[e] = (bf16)f2bf(s <= t ? A.w_s[e] : 0.f); } }
    bf16* hb = (bf16*)(A.ws + WS_HB); float* ssqp = (float*)(A.ws + WS_SSQ);
    for (int m = gwv; m < M; m += 2 * NGW) {
        const int m2 = m + NGW;
        const f32x4* xr = (const f32x4*)(A.x + (size_t)m * D) + lane; const f32x4* xr2 = (const f32x4*)(A.x + (size_t)m2 * D) + lane;
        f32x4 v[4], w4[4];
#pragma unroll
        for (int j = 0; j < 4; ++j) { v[j] = __builtin_nontemporal_load(xr + 64 * j); w4[j] = __builtin_nontemporal_load(xr2 + 64 * j); }
        float s = 0.f, s2 = 0.f;
#pragma unroll
        for (int j = 0; j < 4; ++j) { s += (v[j][0] * v[j][0] + v[j][1] * v[j][1]) + (v[j][2] * v[j][2] + v[j][3] * v[j][3]); s2 += (w4[j][0] * w4[j][0] + w4[j][1] * w4[j][1]) + (w4[j][2] * w4[j][2] + w4[j][3] * w4[j][3]); }
        s = wave_sum(s); s2 = wave_sum(s2);
        v2u* o8 = (v2u*)(hb + (size_t)m * D) + lane; v2u* o82 = (v2u*)(hb + (size_t)m2 * D) + lane;
#pragma unroll
        for (int j = 0; j < 4; ++j) { v2u w; w.x = cvtpk_s(v[j][0], v[j][1]); w.y = cvtpk_s(v[j][2], v[j][3]); o8[64 * j] = w; v2u w2; w2.x = cvtpk_s(w4[j][0], w4[j][1]); w2.y = cvtpk_s(w4[j][2], w4[j][3]); o82[64 * j] = w2; }
        if (lane < 16) { ssqp[(size_t)m * 16 + lane] = (lane == 0) ? s : 0.f; ssqp[(size_t)m2 * 16 + lane] = (lane == 0) ? s2 : 0.f; }
    }
}

__device__ __forceinline__ v4u pair_to_wide(v2u gk, v2u gk1) {
    const auto sx = __builtin_amdgcn_permlane32_swap(gk.x, gk1.x, false, false), sy = __builtin_amdgcn_permlane32_swap(gk.y, gk1.y, false, false);
    return (v4u){sx[0], sy[0], sx[1], sy[1]};
}
__device__ __forceinline__ void wide_to_pair(v4u w, v2u& gk, v2u& gk1) {
    const auto sx = __builtin_amdgcn_permlane32_swap(w.x, w.z, false, false), sy = __builtin_amdgcn_permlane32_swap(w.y, w.w, false, false);
    gk.x = sx[0]; gk.y = sy[0]; gk1.x = sx[1]; gk1.y = sy[1];
}
__device__ __forceinline__ void phase_gmlp(const Args& A, int li, LAS unsigned char* lds, int vcu, int G, int wave, int lane) {
    const bf16* Z = (const bf16*)(A.ws + WS_Z); bf16* Y = (bf16*)(A.ws + WS_Y);
    const bf16* wst = (const bf16*)(A.ws + WS_WS) + (size_t)li * 4 * 128 * 128;
    const float* lng = A.ln_g + li * 512; const float* lnb = A.ln_b + li * 512; const float* bs = A.b_s + li * 4 * 128;
    const int r32 = lane & 31, hi = lane >> 5, grp = lane >> 4, qq = (lane & 15) >> 2, pp = lane & 3;
    float gg[8], gb[8];
#pragma unroll
    for (int j = 0; j < 8; ++j) { gg[j] = lng[8 * lane + j]; gb[j] = lnb[8 * lane + j]; }
    for (int u = vcu; u < M / 128; u += G) {
        const size_t row0 = (size_t)u * 128;
#pragma unroll 1
        for (int r4 = 0; r4 < 16; r4 += 8) {
            v4u wv[8];
#pragma unroll
            for (int k = 0; k < 8; ++k) wv[k] = *(const v4u*)(Z + (row0 + wave * 16 + r4 + k) * EVEN_IN + 512 + 8 * lane);
#pragma unroll
            for (int k = 0; k < 8; ++k) {
                const int s = wave * 16 + r4 + k; const v4u w = wv[k];
                float x[8] = {bf_lo(w.x), bf_hi(w.x), bf_lo(w.y), bf_hi(w.y), bf_lo(w.z), bf_hi(w.z), bf_lo(w.w), bf_hi(w.w)};
                float sm = 0.f;
#pragma unroll
                for (int j = 0; j < 8; ++j) sm += x[j];
                const float mean = wave_sum(sm) * (1.f / 512.f); float sq = 0.f;
#pragma unroll
                for (int j = 0; j < 8; ++j) { x[j] -= mean; sq += x[j] * x[j]; }
                const float rstd = __builtin_amdgcn_rsqf(wave_sum(sq) * (1.f / 512.f) + NORM_EPS);
#pragma unroll
                for (int j = 0; j < 8; ++j) x[j] = x[j] * rstd * gg[j] + gb[j];
                v4u o; o.x = cvtpk_s(x[0], x[1]); o.y = cvtpk_s(x[2], x[3]); o.z = cvtpk_s(x[4], x[5]); o.w = cvtpk_s(x[6], x[7]);
                *(LAS v4u*)(lds + ((s >> 3) * 16 + (lane >> 2)) * 512 + (s & 7) * 64 + (lane & 3) * 16) = o;
            }
        }
        __syncthreads();
        const int g = wave >> 1;
#pragma unroll 1
        for (int t2 = 0; t2 < 2; ++t2) {
            const int tt = (wave & 1) * 2 + t2;
            f32x16 acc[4];
#pragma unroll
            for (int ct = 0; ct < 4; ++ct) acc[ct] = f32x16{};
            const bf16* wrow = wst + ((size_t)g * 128 + 32 * tt + r32) * 128 + 8 * hi;
            bf16x8 bw[8];
#pragma unroll
            for (int ks = 0; ks < 8; ++ks) bw[ks] = *(const bf16x8*)(wrow + 16 * ks);
#pragma unroll
            for (int ks = 0; ks < 8; ++ks) {
                const bf16x8 bfrag = bw[ks];
#pragma unroll
                for (int ct = 0; ct < 4; ++ct) {
                    const LAS unsigned char* p = lds + ((2 * ks + hi) * 16 + 4 * g + ct) * 512 + qq * 64 + (16 * (grp & 1) + 4 * pp) * 2;
                    const s16x4 lo = vtr(p), hi4 = vtr(p + 256);
                    const bf16x8 afrag = (bf16x8){lo[0], lo[1], lo[2], lo[3], hi4[0], hi4[1], hi4[2], hi4[3]};
                    acc[ct] = __builtin_amdgcn_mfma_f32_32x32x16_bf16(afrag, bfrag, acc[ct], 0, 0, 0);
                }
            }
            const int t = 32 * tt + r32; const size_t row = row0 + t; const float bias = bs[g * 128 + t];
            v2u ub[4][4], gb2[4][4];
#pragma unroll
            for (int ct = 0; ct < 4; ++ct)
#pragma unroll
                for (int pr = 0; pr < 2; ++pr) {
                    const int c = g * 128 + 32 * ct + 16 * pr + 8 * hi;
                    const v4u wu = *(const v4u*)(Z + row * EVEN_IN + c), wg = *(const v4u*)(Z + row * EVEN_IN + 1024 + c);
                    wide_to_pair(wu, ub[ct][2 * pr], ub[ct][2 * pr + 1]); wide_to_pair(wg, gb2[ct][2 * pr], gb2[ct][2 * pr + 1]);
                }
#pragma unroll
            for (int ct = 0; ct < 4; ++ct)
#pragma unroll
                for (int pr = 0; pr < 2; ++pr) {
                    v2u o2[2];
#pragma unroll
                    for (int k = 0; k < 2; ++k) {
                        const int rq = 2 * pr + k; const v2u uu = ub[ct][rq], ga = gb2[ct][rq];
                        const float y0 = bf_lo(uu.x) * (acc[ct][4 * rq + 0] + bias) * bf_lo(ga.x), y1 = bf_hi(uu.x) * (acc[ct][4 * rq + 1] + bias) * bf_hi(ga.x);
                        const float y2 = bf_lo(uu.y) * (acc[ct][4 * rq + 2] + bias) * bf_lo(ga.y), y3 = bf_hi(uu.y) * (acc[ct][4 * rq + 3] + bias) * bf_hi(ga.y);
                        o2[k].x = cvtpk_s(y0, y1); o2[k].y = cvtpk_s(y2, y3);
                    }
                    *(v4u*)(Y + row * D + g * 128 + 32 * ct + 16 * pr + 8 * hi) = pair_to_wide(o2[0], o2[1]);
                }
        }
        __syncthreads();
    }
}

struct AttnSt { f32x16 o0, o1; float m, l; };
template <class MaskF>
__device__ __forceinline__ void attn_tile(AttnSt& st, const bf16x8 (&qf)[4], const bf16* kp, const bf16* vp0, const bf16* vp1, const bf16* vp2, const bf16* vp3, LAS unsigned char* vl, int lane, bool domask, MaskF mask) {
    const int hi = lane >> 5, grp = lane >> 4, qq = (lane & 15) >> 2, pp = lane & 3;
    bf16x8 kf[4]; v4u vv[4];
#pragma unroll
    for (int d0 = 0; d0 < 4; ++d0) kf[d0] = *(const bf16x8*)(kp + 16 * d0);
    vv[0] = *(const v4u*)vp0; vv[1] = *(const v4u*)vp1; vv[2] = *(const v4u*)vp2; vv[3] = *(const v4u*)vp3;
    f32x16 s = f32x16{};
#pragma unroll
    for (int d0 = 0; d0 < 4; ++d0) s = __builtin_amdgcn_mfma_f32_32x32x16_bf16(kf[d0], qf[d0], s, 0, 0, 0);
#pragma unroll
    for (int it = 0; it < 4; ++it) *(LAS v4u*)(vl + (it * 2 + ((lane & 7) >> 2)) * 512 + (lane >> 3) * 64 + (lane & 3) * 16) = vv[it];
    if (domask) {
#pragma unroll
        for (int r = 0; r < 16; ++r) if (!mask(crow(r, hi))) s[r] = -INFINITY;
    }
    float mt = s[0];
#pragma unroll
    for (int r = 1; r < 16; ++r) mt = fmaxf(mt, s[r]);
    mt = fmaxf(mt, __shfl_xor(mt, 32));
    if (__any(mt > st.m + RESCALE_THR)) {
        const float mn = fmaxf(st.m, mt);
        const float f = __builtin_amdgcn_exp2f(st.m - mn); st.l *= f; st.m = mn;
#pragma unroll
        for (int r = 0; r < 16; ++r) { st.o0[r] *= f; st.o1[r] *= f; }
    }
    float ps = 0.f;
#pragma unroll
    for (int r = 0; r < 16; ++r) { s[r] = __builtin_amdgcn_exp2f(s[r] - st.m); ps += s[r]; }
    st.l += ps;
    v4u pw0, pw1;
    pw0.x = cvtpk_s(s[0], s[1]); pw0.y = cvtpk_s(s[2], s[3]); pw0.z = cvtpk_s(s[4], s[5]); pw0.w = cvtpk_s(s[6], s[7]);
    pw1.x = cvtpk_s(s[8], s[9]); pw1.y = cvtpk_s(s[10], s[11]); pw1.z = cvtpk_s(s[12], s[13]); pw1.w = cvtpk_s(s[14], s[15]);
    const bf16x8 pf0 = __builtin_bit_cast(bf16x8, pw0), pf1 = __builtin_bit_cast(bf16x8, pw1);
    const LAS unsigned char* tb = vl + (4 * hi + qq) * 64 + (16 * (grp & 1) + 4 * pp) * 2;
#define VFRAG(ks, d0) ({ const s16x4 lo_ = vtr(tb + ((2 * (ks)) * 2 + (d0)) * 512), hi_ = vtr(tb + ((2 * (ks) + 1) * 2 + (d0)) * 512); (bf16x8){lo_[0], lo_[1], lo_[2], lo_[3], hi_[0], hi_[1], hi_[2], hi_[3]}; })
    st.o0 = __builtin_amdgcn_mfma_f32_32x32x16_bf16(VFRAG(0, 0), pf0, st.o0, 0, 0, 0);
    st.o1 = __builtin_amdgcn_mfma_f32_32x32x16_bf16(VFRAG(0, 1), pf0, st.o1, 0, 0, 0);
    st.o0 = __builtin_amdgcn_mfma_f32_32x32x16_bf16(VFRAG(1, 0), pf1, st.o0, 0, 0, 0);
    st.o1 = __builtin_amdgcn_mfma_f32_32x32x16_bf16(VFRAG(1, 1), pf1, st.o1, 0, 0, 0);
#undef VFRAG
}
__device__ __forceinline__ void attn_store(const AttnSt& st, const bf16* grow, bf16* yrow, int lane) {
    const int hi = lane >> 5;
    const float lt = st.l + __shfl_xor(st.l, 32), inv = 1.0f / lt;
    v2u ga[2][4];
#pragma unroll
    for (int d0 = 0; d0 < 2; ++d0)
#pragma unroll
        for (int rq = 0; rq < 4; ++rq) ga[d0][rq] = *(const v2u*)(grow + 32 * d0 + 8 * rq + 4 * hi);
#pragma unroll
    for (int d0 = 0; d0 < 2; ++d0)
#pragma unroll
        for (int rq = 0; rq < 4; ++rq) {
            const int d = 32 * d0 + 8 * rq + 4 * hi;
            const v2u g = ga[d0][rq];
            const f32x16& o = d0 ? st.o1 : st.o0;
            v2u w; w.x = cvtpk_s(o[4 * rq + 0] * inv * bf_lo(g.x), o[4 * rq + 1] * inv * bf_hi(g.x)); w.y = cvtpk_s(o[4 * rq + 2] * inv * bf_lo(g.y), o[4 * rq + 3] * inv * bf_hi(g.y));
            *(v2u*)(yrow + d) = w;
        }
}

__device__ __forceinline__ void attn_gate_load(v2u (&ga)[2][4], const bf16* grow, int lane) {
    const int hi = lane >> 5;
#pragma unroll
    for (int d0 = 0; d0 < 2; ++d0)
#pragma unroll
        for (int pr = 0; pr < 2; ++pr) { const v4u w = *(const v4u*)(grow + 32 * d0 + 16 * pr + 8 * hi); wide_to_pair(w, ga[d0][2 * pr], ga[d0][2 * pr + 1]); }
}
__device__ __forceinline__ void attn_store_g(const AttnSt& st, const v2u (&ga)[2][4], bf16* yrow, int lane) {
    const int hi = lane >> 5;
    const float lt = st.l + __shfl_xor(st.l, 32), inv = 1.0f / lt;
#pragma unroll
    for (int d0 = 0; d0 < 2; ++d0)
#pragma unroll
        for (int pr = 0; pr < 2; ++pr) {
            v2u w2[2];
#pragma unroll
            for (int k = 0; k < 2; ++k) {
                const int rq = 2 * pr + k; const v2u g = ga[d0][rq]; const f32x16& o = d0 ? st.o1 : st.o0;
                w2[k].x = cvtpk_s(o[4 * rq + 0] * inv * bf_lo(g.x), o[4 * rq + 1] * inv * bf_hi(g.x)); w2[k].y = cvtpk_s(o[4 * rq + 2] * inv * bf_lo(g.y), o[4 * rq + 3] * inv * bf_hi(g.y));
            }
            *(v4u*)(yrow + 32 * d0 + 16 * pr + 8 * hi) = pair_to_wide(w2[0], w2[1]);
        }
}

struct TileRegs { v4u kk[4]; v4u vv[4]; };
__device__ __forceinline__ void attn_load(TileRegs& R, int kvoff, const bf16* vp0, const bf16* vp1, const bf16* vp2, const bf16* vp3) {
    R.kk[0] = *(const v4u*)(vp0 - kvoff); R.kk[1] = *(const v4u*)(vp1 - kvoff); R.kk[2] = *(const v4u*)(vp2 - kvoff); R.kk[3] = *(const v4u*)(vp3 - kvoff);
    R.vv[0] = *(const v4u*)vp0; R.vv[1] = *(const v4u*)vp1; R.vv[2] = *(const v4u*)vp2; R.vv[3] = *(const v4u*)vp3;
}
__device__ __forceinline__ void attn_load_k(TileRegs& R, int kvoff, const bf16* vp0, const bf16* vp1, const bf16* vp2, const bf16* vp3) {
    R.kk[0] = *(const v4u*)(vp0 - kvoff); R.kk[1] = *(const v4u*)(vp1 - kvoff); R.kk[2] = *(const v4u*)(vp2 - kvoff); R.kk[3] = *(const v4u*)(vp3 - kvoff);
}
__device__ __forceinline__ void attn_load_v(TileRegs& R, const bf16* vp0, const bf16* vp1, const bf16* vp2, const bf16* vp3) {
    R.vv[0] = *(const v4u*)vp0; R.vv[1] = *(const v4u*)vp1; R.vv[2] = *(const v4u*)vp2; R.vv[3] = *(const v4u*)vp3;
}
template <int MODE>
__device__ __forceinline__ void attn_compute(AttnSt& st, const bf16x8 (&qf)[4], const TileRegs& R, LAS unsigned char* vl, int lane, bool keep, int dd0, int kmin) {
    const int r32 = lane & 31, hi = lane >> 5, grp = lane >> 4, qq = (lane & 15) >> 2, pp = lane & 3;
    LAS unsigned char* kl = vl + 32768;
#pragma unroll
    for (int it = 0; it < 4; ++it) { const int row = it * 8 + (lane >> 3); *(LAS v4u*)(kl + row * 128 + (((lane & 7) ^ (row & 7)) << 4)) = R.kk[it]; }
#pragma unroll
    for (int it = 0; it < 4; ++it) *(LAS v4u*)(vl + (it * 2 + ((lane & 7) >> 2)) * 512 + (lane >> 3) * 64 + (lane & 3) * 16) = R.vv[it];
    f32x16 s = f32x16{};
#pragma unroll
    for (int d0 = 0; d0 < 4; ++d0) {
        const v4u kw = *(const LAS v4u*)(kl + r32 * 128 + (((2 * d0 + hi) ^ (r32 & 7)) << 4));
        s = __builtin_amdgcn_mfma_f32_32x32x16_bf16(__builtin_bit_cast(bf16x8, kw), qf[d0], s, 0, 0, 0);
    }
    if (MODE == 1) {
#pragma unroll
        for (int r = 0; r < 16; ++r) if (crow(r, hi) > r32) s[r] = -INFINITY;
    } else if (MODE == 2) {
#pragma unroll
        for (int r = 0; r < 16; ++r) s[r] = keep ? s[r] : -INFINITY;
    } else if (MODE == 3) {
        const int ddh = dd0 - 4 * hi, kmh = kmin - 4 * hi;
#pragma unroll
        for (int r = 0; r < 16; ++r) { const int c = (r & 3) + 8 * (r >> 2); if ((unsigned)(ddh - c) > 128u || c < kmh) s[r] = -INFINITY; }
    }
    float mt = s[0];
#pragma unroll
    for (int r = 1; r < 16; ++r) mt = fmaxf(mt, s[r]);
    mt = fmaxf(mt, __shfl_xor(mt, 32));
    if (__any(mt > st.m + RESCALE_THR)) {
        const float mn = fmaxf(st.m, mt);
        const float f = __builtin_amdgcn_exp2f(st.m - mn); st.l *= f; st.m = mn;
#pragma unroll
        for (int r = 0; r < 16; ++r) { st.o0[r] *= f; st.o1[r] *= f; }
    }
    float ps = 0.f;
#pragma unroll
    for (int r = 0; r < 16; ++r) { s[r] = __builtin_amdgcn_exp2f(s[r] - st.m); ps += s[r]; }
    st.l += ps;
    v4u pw0, pw1;
    pw0.x = cvtpk_s(s[0], s[1]); pw0.y = cvtpk_s(s[2], s[3]); pw0.z = cvtpk_s(s[4], s[5]); pw0.w = cvtpk_s(s[6], s[7]);
    pw1.x = cvtpk_s(s[8], s[9]); pw1.y = cvtpk_s(s[10], s[11]); pw1.z = cvtpk_s(s[12], s[13]); pw1.w = cvtpk_s(s[14], s[15]);
    const bf16x8 pf0 = __builtin_bit_cast(bf16x8, pw0), pf1 = __builtin_bit_cast(bf16x8, pw1);
    const LAS unsigned char* tb = vl + (4 * hi + qq) * 64 + (16 * (grp & 1) + 4 * pp) * 2;
#define VFRAG(ks, d0) ({ const s16x4 lo_ = vtr(tb + ((2 * (ks)) * 2 + (d0)) * 512), hi_ = vtr(tb + ((2 * (ks) + 1) * 2 + (d0)) * 512); (bf16x8){lo_[0], lo_[1], lo_[2], lo_[3], hi_[0], hi_[1], hi_[2], hi_[3]}; })
    st.o0 = __builtin_amdgcn_mfma_f32_32x32x16_bf16(VFRAG(0, 0), pf0, st.o0, 0, 0, 0);
    st.o1 = __builtin_amdgcn_mfma_f32_32x32x16_bf16(VFRAG(0, 1), pf0, st.o1, 0, 0, 0);
    st.o0 = __builtin_amdgcn_mfma_f32_32x32x16_bf16(VFRAG(1, 0), pf1, st.o0, 0, 0, 0);
    st.o1 = __builtin_amdgcn_mfma_f32_32x32x16_bf16(VFRAG(1, 1), pf1, st.o1, 0, 0, 0);
#undef VFRAG
}

template <class MaskF>
__device__ __forceinline__ void attn_subtile_lds(AttnSt& st, const bf16x8 (&qf)[4], const LAS unsigned char* kb, const LAS unsigned char* vl, int lane, bool domask, MaskF mask) {
    const int r32 = lane & 31, hi = lane >> 5, grp = lane >> 4, qq = (lane & 15) >> 2, pp = lane & 3;
    f32x16 s = f32x16{};
#pragma unroll
    for (int d0 = 0; d0 < 4; ++d0) {
        const bf16x8 kf = *(const LAS bf16x8*)(kb + r32 * 128 + (((2 * d0 + hi) ^ (r32 & 7)) << 4));
        s = __builtin_amdgcn_mfma_f32_32x32x16_bf16(kf, qf[d0], s, 0, 0, 0);
    }
    if (domask) {
#pragma unroll
        for (int r = 0; r < 16; ++r) if (!mask(crow(r, hi))) s[r] = -INFINITY;
    }
    float mt = s[0];
#pragma unroll
    for (int r = 1; r < 16; ++r) mt = fmaxf(mt, s[r]);
    mt = fmaxf(mt, __shfl_xor(mt, 32));
    if (__any(mt > st.m + RESCALE_THR)) {
        const float mn = fmaxf(st.m, mt);
        const float f = __builtin_amdgcn_exp2f(st.m - mn); st.l *= f; st.m = mn;
#pragma unroll
        for (int r = 0; r < 16; ++r) { st.o0[r] *= f; st.o1[r] *= f; }
    }
    float ps = 0.f;
#pragma unroll
    for (int r = 0; r < 16; ++r) { s[r] = __builtin_amdgcn_exp2f(s[r] - st.m); ps += s[r]; }
    st.l += ps;
    v4u pw0, pw1;
    pw0.x = cvtpk_s(s[0], s[1]); pw0.y = cvtpk_s(s[2], s[3]); pw0.z = cvtpk_s(s[4], s[5]); pw0.w = cvtpk_s(s[6], s[7]);
    pw1.x = cvtpk_s(s[8], s[9]); pw1.y = cvtpk_s(s[10], s[11]); pw1.z = cvtpk_s(s[12], s[13]); pw1.w = cvtpk_s(s[14], s[15]);
    const bf16x8 pf0 = __builtin_bit_cast(bf16x8, pw0), pf1 = __builtin_bit_cast(bf16x8, pw1);
    const LAS unsigned char* tb = vl + (4 * hi + qq) * 64 + (16 * (grp & 1) + 4 * pp) * 2;
#define VFRAG(ks, d0) ({ const s16x4 lo_ = vtr(tb + ((2 * (ks)) * 2 + (d0)) * 512), hi_ = vtr(tb + ((2 * (ks) + 1) * 2 + (d0)) * 512); (bf16x8){lo_[0], lo_[1], lo_[2], lo_[3], hi_[0], hi_[1], hi_[2], hi_[3]}; })
    st.o0 = __builtin_amdgcn_mfma_f32_32x32x16_bf16(VFRAG(0, 0), pf0, st.o0, 0, 0, 0);
    st.o1 = __builtin_amdgcn_mfma_f32_32x32x16_bf16(VFRAG(0, 1), pf0, st.o1, 0, 0, 0);
    st.o0 = __builtin_amdgcn_mfma_f32_32x32x16_bf16(VFRAG(1, 0), pf1, st.o0, 0, 0, 0);
    st.o1 = __builtin_amdgcn_mfma_f32_32x32x16_bf16(VFRAG(1, 1), pf1, st.o1, 0, 0, 0);
#undef VFRAG
}
template <int M0, int M1>
__device__ __forceinline__ void attn_tile64_lds(AttnSt& st, const bf16x8 (&qf)[4], const LAS unsigned char* kb, const LAS unsigned char* vb, int lane, bool keep) {
    const int r32 = lane & 31, hi = lane >> 5, grp = lane >> 4, qq = (lane & 15) >> 2, pp = lane & 3;
    f32x16 s0 = f32x16{}, s1 = f32x16{};
#pragma unroll
    for (int d0 = 0; d0 < 4; ++d0) {
        const int ko = r32 * 128 + (((2 * d0 + hi) ^ (r32 & 7)) << 4);
        const v4u k0 = *(const LAS v4u*)(kb + ko), k1 = *(const LAS v4u*)(kb + 4096 + ko);
        s0 = __builtin_amdgcn_mfma_f32_32x32x16_bf16(__builtin_bit_cast(bf16x8, k0), qf[d0], s0, 0, 0, 0);
        s1 = __builtin_amdgcn_mfma_f32_32x32x16_bf16(__builtin_bit_cast(bf16x8, k1), qf[d0], s1, 0, 0, 0);
    }
    if (M0 == 1 || M1 == 1) {
#pragma unroll
        for (int r = 0; r < 16; ++r) {
            if (M0 == 1) { if (crow(r, hi) > r32) s0[r] = -INFINITY; }
            if (M1 == 1) { if (crow(r, hi) > r32) s1[r] = -INFINITY; }
        }
    }
    float mt = fmaxf(s0[0], s1[0]);
#pragma unroll
    for (int r = 1; r < 16; ++r) mt = fmaxf(mt, fmaxf(s0[r], s1[r]));
    mt = fmaxf(mt, __shfl_xor(mt, 32));
    if (__any(mt > st.m + RESCALE_THR)) {
        const float mn = fmaxf(st.m, mt);
        const float f = __builtin_amdgcn_exp2f(st.m - mn); st.l *= f; st.m = mn;
#pragma unroll
        for (int r = 0; r < 16; ++r) { st.o0[r] *= f; st.o1[r] *= f; }
    }
    const float mo = (M0 == 2 && !keep) ? INFINITY : st.m;
    const f32x2_t mo2 = {mo, mo}; f32x2_t acc2 = {0.f, 0.f};
#pragma unroll
    for (int r = 0; r < 16; r += 2) {
        f32x2_t v0 = (f32x2_t){s0[r], s0[r + 1]} - mo2, v1 = (f32x2_t){s1[r], s1[r + 1]} - mo2;
        v0.x = __builtin_amdgcn_exp2f(v0.x); v0.y = __builtin_amdgcn_exp2f(v0.y); v1.x = __builtin_amdgcn_exp2f(v1.x); v1.y = __builtin_amdgcn_exp2f(v1.y);
        acc2 += v0; acc2 += v1;
        s0[r] = v0.x; s0[r + 1] = v0.y; s1[r] = v1.x; s1[r + 1] = v1.y;
    }
    st.l += acc2.x + acc2.y;
    v4u p00, p01, p10, p11;
    p00.x = cvtpk_s(s0[0], s0[1]); p00.y = cvtpk_s(s0[2], s0[3]); p00.z = cvtpk_s(s0[4], s0[5]); p00.w = cvtpk_s(s0[6], s0[7]);
    p01.x = cvtpk_s(s0[8], s0[9]); p01.y = cvtpk_s(s0[10], s0[11]); p01.z = cvtpk_s(s0[12], s0[13]); p01.w = cvtpk_s(s0[14], s0[15]);
    p10.x = cvtpk_s(s1[0], s1[1]); p10.y = cvtpk_s(s1[2], s1[3]); p10.z = cvtpk_s(s1[4], s1[5]); p10.w = cvtpk_s(s1[6], s1[7]);
    p11.x = cvtpk_s(s1[8], s1[9]); p11.y = cvtpk_s(s1[10], s1[11]); p11.z = cvtpk_s(s1[12], s1[13]); p11.w = cvtpk_s(s1[14], s1[15]);
    const bf16x8 f00 = __builtin_bit_cast(bf16x8, p00), f01 = __builtin_bit_cast(bf16x8, p01), f10 = __builtin_bit_cast(bf16x8, p10), f11 = __builtin_bit_cast(bf16x8, p11);
    const LAS unsigned char* tb = vb + (4 * hi + qq) * 64 + (16 * (grp & 1) + 4 * pp) * 2;
#define VFRAG(sub, ks, d0) ({ const s16x4 lo_ = vtr(tb + (sub) * 4096 + ((2 * (ks)) * 2 + (d0)) * 512), hi_ = vtr(tb + (sub) * 4096 + ((2 * (ks) + 1) * 2 + (d0)) * 512); (bf16x8){lo_[0], lo_[1], lo_[2], lo_[3], hi_[0], hi_[1], hi_[2], hi_[3]}; })
    st.o0 = __builtin_amdgcn_mfma_f32_32x32x16_bf16(VFRAG(0, 0, 0), f00, st.o0, 0, 0, 0);
    st.o1 = __builtin_amdgcn_mfma_f32_32x32x16_bf16(VFRAG(0, 0, 1), f00, st.o1, 0, 0, 0);
    st.o0 = __builtin_amdgcn_mfma_f32_32x32x16_bf16(VFRAG(0, 1, 0), f01, st.o0, 0, 0, 0);
    st.o1 = __builtin_amdgcn_mfma_f32_32x32x16_bf16(VFRAG(0, 1, 1), f01, st.o1, 0, 0, 0);
    st.o0 = __builtin_amdgcn_mfma_f32_32x32x16_bf16(VFRAG(1, 0, 0), f10, st.o0, 0, 0, 0);
    st.o1 = __builtin_amdgcn_mfma_f32_32x32x16_bf16(VFRAG(1, 0, 1), f10, st.o1, 0, 0, 0);
    st.o0 = __builtin_amdgcn_mfma_f32_32x32x16_bf16(VFRAG(1, 1, 0), f11, st.o0, 0, 0, 0);
    st.o1 = __builtin_amdgcn_mfma_f32_32x32x16_bf16(VFRAG(1, 1, 1), f11, st.o1, 0, 0, 0);
#undef VFRAG
}
__device__ __forceinline__ void phase_moba_s(const Args& A, LAS unsigned char* lds, int G, int vcu, int wave, int lane) {
    const bf16* Z = (const bf16*)(A.ws + WS_Z); bf16* Y = (bf16*)(A.ws + WS_Y); const float* kmp = (const float*)(A.ws + WS_KMP);
    const int r32 = lane & 31, hi = lane >> 5, tid = wave * 64 + lane;
    const int skey = tid >> 3, sch = tid & 7;
    const int kwoff = skey * 128 + ((sch ^ (skey & 7)) << 4);
    const int vwoff = ((skey >> 3) * 2 + (sch >> 2)) * 512 + (skey & 7) * 64 + (sch & 3) * 16;
    for (int U = vcu; U < 2048; U += G) {
        const int it8 = U >> 8, v = U & 255, j = v & 7;
        const int blk = (it8 & 1) ? 15 - j : j, bh = (v >> 3) * 4 + (it8 >> 1);
        const int b = bh >> 3, hh = bh & 7, q0 = blk * 256 + 32 * wave;
        const size_t rowbase = (size_t)b * SEQ;
        const bf16* zq = Z + (rowbase + q0 + r32) * EVEN_IN;
        const bf16* Kh = Z + rowbase * EVEN_IN + 2048 + hh * 64 + (size_t)skey * EVEN_IN + 8 * sch; const bf16* Vh = Kh + 512;
        v4u kreg = *(const v4u*)(Kh + (size_t)(blk * 256) * EVEN_IN), vreg = *(const v4u*)(Vh + (size_t)(blk * 256) * EVEN_IN);
        bf16x8 qf[4];
#pragma unroll
        for (int d0 = 0; d0 < 4; ++d0) qf[d0] = *(const bf16x8*)(zq + 1536 + hh * 64 + 16 * d0 + 8 * hi);
        v2u gg[2][4]; attn_gate_load(gg, zq + 3072 + hh * 64, lane);
        unsigned sel = 0u;
        if (blk > 0) {
            f32x16 gt = f32x16{};
#pragma unroll
            for (int d0 = 0; d0 < 4; ++d0) {
                bf16x8 kmf = bf16x8{};
                if (r32 < 16) {
                    const float* p0 = kmp + (((size_t)b * 16 + r32) * 2) * 512 + hh * 64 + 16 * d0 + 8 * hi;
                    const f32x4 a0 = *(const f32x4*)p0, a1 = *(const f32x4*)(p0 + 4), b0 = *(const f32x4*)(p0 + 512), b1 = *(const f32x4*)(p0 + 516);
                    const f32x4 s0 = a0 + b0, s1 = a1 + b1;
                    v4u w; w.x = pk2(s0[0], s0[1]); w.y = pk2(s0[2], s0[3]); w.z = pk2(s1[0], s1[1]); w.w = pk2(s1[2], s1[3]);
                    kmf = __builtin_bit_cast(bf16x8, w);
                }
                gt = __builtin_amdgcn_mfma_f32_32x32x16_bf16(kmf, qf[d0], gt, 0, 0, 0);
            }
            float gv[16];
#pragma unroll
            for (int r = 0; r < 8; ++r) {
                const float mine = gt[r], oth = __shfl_xor(mine, 32);
                const float vlo = hi ? oth : mine, vhi = hi ? mine : oth;
                gv[(r & 3) + 8 * (r >> 2)] = vlo; gv[(r & 3) + 8 * (r >> 2) + 4] = vhi;
            }
#pragma unroll
            for (int n = 0; n < 16; ++n) if (n >= blk) gv[n] = -INFINITY;
#pragma unroll
            for (int it = 0; it < 3; ++it) {
                float best = -INFINITY; int bi = -1;
#pragma unroll
                for (int n = 0; n < 16; ++n) { const bool ok = (gv[n] > best) && !((sel >> n) & 1u); best = ok ? gv[n] : best; bi = ok ? n : bi; }
                if (bi >= 0) sel |= 1u << bi;
            }
        }
        AttnSt st; st.o0 = f32x16{}; st.o1 = f32x16{}; st.m = -1e30f; st.l = 0.f;
#define MB_LOAD(key0_) do { kreg = *(const v4u*)(Kh + (size_t)(key0_) * EVEN_IN); vreg = *(const v4u*)(Vh + (size_t)(key0_) * EVEN_IN); } while (0)
#define MB_STORE(buf_) do { *(LAS v4u*)(lds + (buf_) * 8192 + kwoff) = kreg; *(LAS v4u*)(lds + 16384 + (buf_) * 8192 + vwoff) = vreg; } while (0)
        MB_STORE(0);
        __syncthreads();
#pragma unroll 1
        for (int t = 0; t < 4; ++t) {
            const int buf = t & 1;
            if (t < 3) MB_LOAD(blk * 256 + 64 * (t + 1)); else if (blk > 0) MB_LOAD(0);
            const LAS unsigned char* kb = lds + buf * 8192; const LAS unsigned char* vb = lds + 16384 + buf * 8192;
            if (2 * t + 1 < wave) attn_tile64_lds<0, 0>(st, qf, kb, vb, lane, true);
            else if (2 * t + 1 == wave) attn_tile64_lds<0, 1>(st, qf, kb, vb, lane, true);
            else if (2 * t == wave) attn_subtile_lds(st, qf, kb, vb, lane, true, [&](int kk) { return kk <= r32; });
            if (t < 3 || blk > 0) MB_STORE(buf ^ 1);
            __syncthreads();
        }
        const int P = 4 * blk;
#pragma unroll 1
        for (int p = 0; p < P; ++p) {
            const int buf = p & 1;
            if (p + 1 < P) MB_LOAD(64 * (p + 1));
            const LAS unsigned char* kb = lds + buf * 8192; const LAS unsigned char* vb = lds + 16384 + buf * 8192;
            const bool mysel = (sel >> (p >> 2)) & 1u;
            if (__any(mysel)) {
                attn_tile64_lds<2, 2>(st, qf, kb, vb, lane, mysel);
            }
            if (p + 1 < P) MB_STORE(buf ^ 1);
            __syncthreads();
        }
#undef MB_LOAD
#undef MB_STORE
        attn_store_g(st, gg, Y + (rowbase + q0 + r32) * D + 512 + hh * 64, lane);
    }
}

__device__ __forceinline__ void phase_moba_old(const Args& A, LAS unsigned char* lds, int gwv, int NGW, int wave, int lane) {
    const bf16* Z = (const bf16*)(A.ws + WS_Z); bf16* Y = (bf16*)(A.ws + WS_Y); const float* kmp = (const float*)(A.ws + WS_KMP);
    LAS unsigned char* vl = lds + wave * 4096;
    const int r32 = lane & 31, hi = lane >> 5;
#ifdef OLD_NEWMAP
    for (int U = gwv >> 3; U < 2048; U += NGW >> 3) {
        const int it8 = U >> 8, v = U & 255, j = v & 7;
        const int blk = (it8 & 1) ? 15 - j : j, bh = (v >> 3) * 4 + (it8 >> 1);
        const int b = bh >> 3, hh = bh & 7, q0 = blk * 256 + 32 * wave;
#else
    for (int U = gwv; U < 16384; U += NGW) {
        const int rd = U >> 11, g2 = U & 2047, X = g2 >> 8, lwv = g2 & 255;
        const int bh = 16 * X + 2 * rd + (lwv >> 7); int gi = lwv & 127; if (rd & 1) gi = 127 - gi;
        const int b = bh >> 3, hh = bh & 7, q0 = gi * 32, blk = q0 >> 8;
#endif
        const size_t rowbase = (size_t)b * SEQ;
        const bf16* zq = Z + (rowbase + q0 + r32) * EVEN_IN;
        bf16x8 qf[4];
#pragma unroll
        for (int d0 = 0; d0 < 4; ++d0) qf[d0] = *(const bf16x8*)(zq + 1536 + hh * 64 + 16 * d0 + 8 * hi);
        unsigned sel = 0u;
        if (blk > 0) {
            f32x16 gt = f32x16{};
#pragma unroll
            for (int d0 = 0; d0 < 4; ++d0) {
                bf16x8 kmf = bf16x8{};
                if (r32 < 16) {
                    const float* p0 = kmp + (((size_t)b * 16 + r32) * 2) * 512 + hh * 64 + 16 * d0 + 8 * hi;
                    const f32x4 a0 = *(const f32x4*)p0, a1 = *(const f32x4*)(p0 + 4), b0 = *(const f32x4*)(p0 + 512), b1 = *(const f32x4*)(p0 + 516);
                    const f32x4 s0 = a0 + b0, s1 = a1 + b1;
                    v4u w; w.x = pk2(s0[0], s0[1]); w.y = pk2(s0[2], s0[3]); w.z = pk2(s1[0], s1[1]); w.w = pk2(s1[2], s1[3]);
                    kmf = __builtin_bit_cast(bf16x8, w);
                }
                gt = __builtin_amdgcn_mfma_f32_32x32x16_bf16(kmf, qf[d0], gt, 0, 0, 0);
            }
            float gv[16];
#pragma unroll
            for (int r = 0; r < 8; ++r) {
                const float mine = gt[r], oth = __shfl_xor(mine, 32);
                const float vlo = hi ? oth : mine, vhi = hi ? mine : oth;
                gv[(r & 3) + 8 * (r >> 2)] = vlo; gv[(r & 3) + 8 * (r >> 2) + 4] = vhi;
            }
#pragma unroll
            for (int n = 0; n < 16; ++n) if (n >= blk) gv[n] = -INFINITY;
#pragma unroll
            for (int it = 0; it < 3; ++it) {
                float best = -INFINITY; int bi = -1;
#pragma unroll
                for (int n = 0; n < 16; ++n) { const bool ok = (gv[n] > best) && !((sel >> n) & 1u); best = ok ? gv[n] : best; bi = ok ? n : bi; }
                if (bi >= 0) sel |= 1u << bi;
            }
        }
        AttnSt st; st.o0 = f32x16{}; st.o1 = f32x16{}; st.m = -1e30f; st.l = 0.f;
        const bf16* Kh = Z + rowbase * EVEN_IN + 2048 + hh * 64; const bf16* Vh = Z + rowbase * EVEN_IN + 2560 + hh * 64;
        const size_t vrow8 = (size_t)8 * EVEN_IN;
        const int ndiag = (q0 & 255) >> 5;
        for (int kt = 0; kt <= ndiag; ++kt) {
            const size_t k0 = (size_t)blk * 256 + kt * 32;
            const bf16* vp = Vh + (k0 + (lane >> 3)) * EVEN_IN + 8 * (lane & 7);
            attn_tile(st, qf, Kh + (k0 + r32) * EVEN_IN + 8 * hi, vp, vp + vrow8, vp + 2 * vrow8, vp + 3 * vrow8, vl, lane, kt == ndiag, [&](int kk) { return kk <= r32; });
        }
        for (int n = 0; n < blk; ++n) {
            const bool mysel = (sel >> n) & 1u;
            if (!__any(mysel)) continue;
            for (int kt = 0; kt < 8; ++kt) {
                const size_t k0 = (size_t)n * 256 + kt * 32;
                const bf16* vp = Vh + (k0 + (lane >> 3)) * EVEN_IN + 8 * (lane & 7);
                attn_tile(st, qf, Kh + (k0 + r32) * EVEN_IN + 8 * hi, vp, vp + vrow8, vp + 2 * vrow8, vp + 3 * vrow8, vl, lane, true, [&](int) { return mysel; });
            }
        }
        attn_store(st, zq + 3072 + hh * 64, Y + (rowbase + q0 + r32) * D + 512 + hh * 64, lane);
    }
}


__device__ __forceinline__ void phase_moba_p(const Args& A, LAS unsigned char* lds, int gwv, int NGW, int wave, int lane) {
    const bf16* Z = (const bf16*)(A.ws + WS_Z); bf16* Y = (bf16*)(A.ws + WS_Y); const float* kmp = (const float*)(A.ws + WS_KMP);
    LAS unsigned char* vl = lds + wave * 4096;
    const int r32 = lane & 31, hi = lane >> 5;
    for (int U = gwv; U < 16384; U += NGW) {
        const int rd = U >> 11, g2 = U & 2047, X = g2 >> 8, lwv = g2 & 255;
        const int bh = 16 * X + 2 * rd + (lwv >> 7); int gi = lwv & 127; if (rd & 1) gi = 127 - gi;
        const int b = bh >> 3, hh = bh & 7, q0 = gi * 32, blk = q0 >> 8;
        const size_t rowbase = (size_t)b * SEQ;
        const bf16* zq = Z + (rowbase + q0 + r32) * EVEN_IN;
        bf16x8 qf[4];
#pragma unroll
        for (int d0 = 0; d0 < 4; ++d0) qf[d0] = *(const bf16x8*)(zq + 1536 + hh * 64 + 16 * d0 + 8 * hi);
        unsigned sel = 0u;
        if (blk > 0) {
            f32x16 gt = f32x16{};
#pragma unroll
            for (int d0 = 0; d0 < 4; ++d0) {
                bf16x8 kmf = bf16x8{};
                if (r32 < 16) {
                    const float* p0 = kmp + (((size_t)b * 16 + r32) * 2) * 512 + hh * 64 + 16 * d0 + 8 * hi;
                    const f32x4 a0 = *(const f32x4*)p0, a1 = *(const f32x4*)(p0 + 4), b0 = *(const f32x4*)(p0 + 512), b1 = *(const f32x4*)(p0 + 516);
                    const f32x4 s0 = a0 + b0, s1 = a1 + b1;
                    v4u w; w.x = pk2(s0[0], s0[1]); w.y = pk2(s0[2], s0[3]); w.z = pk2(s1[0], s1[1]); w.w = pk2(s1[2], s1[3]);
                    kmf = __builtin_bit_cast(bf16x8, w);
                }
                gt = __builtin_amdgcn_mfma_f32_32x32x16_bf16(kmf, qf[d0], gt, 0, 0, 0);
            }
            float gv[16];
#pragma unroll
            for (int r = 0; r < 8; ++r) {
                const float mine = gt[r], oth = __shfl_xor(mine, 32);
                const float vlo = hi ? oth : mine, vhi = hi ? mine : oth;
                gv[(r & 3) + 8 * (r >> 2)] = vlo; gv[(r & 3) + 8 * (r >> 2) + 4] = vhi;
            }
#pragma unroll
            for (int n = 0; n < 16; ++n) if (n >= blk) gv[n] = -INFINITY;
#pragma unroll
            for (int it = 0; it < 3; ++it) {
                float best = -INFINITY; int bi = -1;
#pragma unroll
                for (int n = 0; n < 16; ++n) { const bool ok = (gv[n] > best) && !((sel >> n) & 1u); best = ok ? gv[n] : best; bi = ok ? n : bi; }
                if (bi >= 0) sel |= 1u << bi;
            }
        }
        unsigned anym = 0u;
#pragma unroll
        for (int n = 0; n < 15; ++n) if (__any((sel >> n) & 1u)) anym |= 1u << n;
        anym = (unsigned)__builtin_amdgcn_readfirstlane((int)anym);
        AttnSt st; st.o0 = f32x16{}; st.o1 = f32x16{}; st.m = -1e30f; st.l = 0.f;
        const bf16* Kh = Z + rowbase * EVEN_IN + 2048 + hh * 64; const bf16* Vh = Z + rowbase * EVEN_IN + 2560 + hh * 64;
        const size_t vrow8 = (size_t)8 * EVEN_IN;
        const int ndiag = (q0 & 255) >> 5;
#define MB_LOADT(R, nn, kk_) do { const size_t k0_ = (size_t)((nn) < 0 ? blk : (nn)) * 256 + (kk_) * 32; const bf16* vp_ = Vh + (k0_ + (lane >> 3)) * EVEN_IN + 8 * (lane & 7); \
            attn_load(R, 512, vp_, vp_ + vrow8, vp_ + 2 * vrow8, vp_ + 3 * vrow8); } while (0)
#define MB_COMP(R, nn, kk_) do { if ((nn) < 0) { if ((kk_) == ndiag) attn_compute<1>(st, qf, R, vl, lane, true, 0, 0); else attn_compute<0>(st, qf, R, vl, lane, true, 0, 0); } \
            else attn_compute<2>(st, qf, R, vl, lane, ((sel >> (nn)) & 1u) != 0u, 0, 0); } while (0)
#define MB_ADV(nn, kk_, more) do { more = true; if ((nn) < 0) { if ((kk_) < ndiag) ++(kk_); else { (kk_) = 0; if (anym) (nn) = __builtin_ctz(anym); else more = false; } } \
            else if ((kk_) < 7) ++(kk_); else { (kk_) = 0; const unsigned rest_ = anym & ~((2u << (nn)) - 1u); if (rest_) (nn) = __builtin_ctz(rest_); else more = false; } } while (0)
        TileRegs RA, RB; int cn = -1, ck = 0;
        MB_LOADT(RA, cn, ck);
        for (;;) {
            int nn = cn, nk = ck; bool more; MB_ADV(nn, nk, more);
            if (more) MB_LOADT(RB, nn, nk);
            MB_COMP(RA, cn, ck);
            if (!more) break;
            cn = nn; ck = nk; MB_ADV(nn, nk, more);
            if (more) MB_LOADT(RA, nn, nk);
            MB_COMP(RB, cn, ck);
            if (!more) break;
            cn = nn; ck = nk;
        }
#undef MB_LOADT
#undef MB_COMP
#undef MB_ADV
        attn_store(st, zq + 3072 + hh * 64, Y + (rowbase + q0 + r32) * D + 512 + hh * 64, lane);
    }
}

__device__ __forceinline__ void phase_dilated_p(const Args& A, LAS unsigned char* lds, int gwv, int NGW, int wave, int lane) {
    const bf16* Z = (const bf16*)(A.ws + WS_Z); bf16* Y = (bf16*)(A.ws + WS_Y);
    LAS unsigned char* vl = lds + wave * 4096;
    const int r32 = lane & 31, hi = lane >> 5;
    for (int U = gwv; U < 32768; U += NGW) {
        const int rd = U >> 11, g2 = U & 2047, X = g2 >> 8, lwv = g2 & 255;
        const int bh = 32 * X + 2 * rd + (lwv >> 7), gi = lwv & 127, c = gi >> 4, r16 = gi & 15;
        const int b = bh >> 4, hh = bh & 15;
        const size_t rowbase = (size_t)b * SEQ;
        const int tq = 512 * c + r16 + 16 * r32;
        const bf16* zq = Z + (rowbase + tq) * ODD_IN;
        bf16x8 qf[4];
#pragma unroll
        for (int d0 = 0; d0 < 4; ++d0) qf[d0] = *(const bf16x8*)(zq + hh * 64 + 16 * d0 + 8 * hi);
        AttnSt st; st.o0 = f32x16{}; st.o1 = f32x16{}; st.m = -1e30f; st.l = 0.f;
        const bf16* Kh = Z + rowbase * ODD_IN + 1024 + hh * 64; const bf16* Vh = Z + rowbase * ODD_IN + 2048 + hh * 64;
#define DL_DIL(cfg) ((cfg) == 0 ? 16 : (cfg) == 1 ? 4 : 1)
#define DL_NT(cfg) ((cfg) == 0 ? 5 : (cfg) == 1 ? 8 : 20)
#define DL_MBASE(cfg) ((512 * c + r16 - (r16 & (DL_DIL(cfg) - 1))) / DL_DIL(cfg) - 128)
#define DL_TAU0(cfg) (DL_MBASE(cfg) < 0 ? (-DL_MBASE(cfg)) / 32 : 0)
#define DL_LOADT(R, cfg, tau) do { const int dil_ = DL_DIL(cfg), rdl_ = r16 & (dil_ - 1), m0_ = DL_MBASE(cfg) + 32 * (tau); \
            const int mv_ = m0_ + (lane >> 3); const int mv0_ = mv_ < 0 ? 0 : mv_, mv1_ = mv_ + 8 < 0 ? 0 : mv_ + 8, mv2_ = mv_ + 16 < 0 ? 0 : mv_ + 16, mv3_ = mv_ + 24 < 0 ? 0 : mv_ + 24; \
            const bf16* vb_ = Vh + (size_t)rdl_ * ODD_IN + 8 * (lane & 7); const size_t vst_ = (size_t)dil_ * ODD_IN; \
            attn_load(R, 1024, vb_ + mv0_ * vst_, vb_ + mv1_ * vst_, vb_ + mv2_ * vst_, vb_ + mv3_ * vst_); } while (0)
#define DL_COMP(R, cfg, tau) do { const int m0_ = DL_MBASE(cfg) + 32 * (tau); \
            if ((cfg) == 0 && (tau) >= 1 && (tau) <= 3 && m0_ >= 0) attn_compute<0>(st, qf, R, vl, lane, true, 0, 0); \
            else attn_compute<3>(st, qf, R, vl, lane, true, 128 + (16 / DL_DIL(cfg)) * r32 - 32 * (tau), -m0_); } while (0)
#define DL_ADV(cfg, tau, more) do { more = true; if ((tau) + 1 < DL_NT(cfg)) ++(tau); else if ((cfg) < 2) { ++(cfg); (tau) = DL_TAU0(cfg); } else more = false; } while (0)
        TileRegs RA, RB; int cc = 0, ct = DL_TAU0(0);
        DL_LOADT(RA, cc, ct);
        for (;;) {
            int nc = cc, nt = ct; bool more; DL_ADV(nc, nt, more);
            if (more) DL_LOADT(RB, nc, nt);
            DL_COMP(RA, cc, ct);
            if (!more) break;
            cc = nc; ct = nt; DL_ADV(nc, nt, more);
            if (more) DL_LOADT(RA, nc, nt);
            DL_COMP(RB, cc, ct);
            if (!more) break;
            cc = nc; ct = nt;
        }
#undef DL_DIL
#undef DL_NT
#undef DL_MBASE
#undef DL_TAU0
#undef DL_LOADT
#undef DL_COMP
#undef DL_ADV
        attn_store(st, zq + 3072 + hh * 64, Y + (rowbase + tq) * D + hh * 64, lane);
    }
}


__device__ __forceinline__ void attn_stage2(const TileRegs& RA, const TileRegs& RB, LAS unsigned char* wl, int lane) {
    LAS unsigned char* vla = wl; LAS unsigned char* vlb = wl + 4096; LAS unsigned char* kla = wl + 8192; LAS unsigned char* klb = wl + 12288;
#pragma unroll
    for (int it = 0; it < 4; ++it) { const int row = it * 8 + (lane >> 3); const int ko = row * 128 + (((lane & 7) ^ (row & 7)) << 4); *(LAS v4u*)(kla + ko) = RA.kk[it]; *(LAS v4u*)(klb + ko) = RB.kk[it]; }
#pragma unroll
    for (int it = 0; it < 4; ++it) { const int vo = (it * 2 + ((lane & 7) >> 2)) * 512 + (lane >> 3) * 64 + (lane & 3) * 16; *(LAS v4u*)(vla + vo) = RA.vv[it]; *(LAS v4u*)(vlb + vo) = RB.vv[it]; }
}
template <int MODE, class MidF>
__device__ __forceinline__ void attn_compute2_lds(AttnSt& a, AttnSt& b, const bf16x8 (&qa)[4], const bf16x8 (&qb)[4], LAS unsigned char* wl, int lane, int dd0, int kmina, int kminb, MidF mid) {
    const int r32 = lane & 31, hi = lane >> 5, grp = lane >> 4, qq = (lane & 15) >> 2, pp = lane & 3;
    LAS unsigned char* vla = wl; LAS unsigned char* vlb = wl + 4096; LAS unsigned char* kla = wl + 8192; LAS unsigned char* klb = wl + 12288;
    f32x16 sa = f32x16{}, sb = f32x16{};
#pragma unroll
    for (int d0 = 0; d0 < 4; ++d0) {
        const int ko = r32 * 128 + (((2 * d0 + hi) ^ (r32 & 7)) << 4);
        const v4u kwa = *(const LAS v4u*)(kla + ko), kwb = *(const LAS v4u*)(klb + ko);
        sa = __builtin_amdgcn_mfma_f32_32x32x16_bf16(__builtin_bit_cast(bf16x8, kwa), qa[d0], sa, 0, 0, 0);
        sb = __builtin_amdgcn_mfma_f32_32x32x16_bf16(__builtin_bit_cast(bf16x8, kwb), qb[d0], sb, 0, 0, 0);
    }
    if (MODE == 3) {
        const int ddh = dd0 - 4 * hi, kma = kmina - 4 * hi, kmb = kminb - 4 * hi;
#pragma unroll
        for (int r = 0; r < 16; ++r) { const int c = (r & 3) + 8 * (r >> 2); const bool band = (unsigned)(ddh - c) <= 128u; if (!band || c < kma) sa[r] = -INFINITY; if (!band || c < kmb) sb[r] = -INFINITY; }
    }
    float mta = sa[0], mtb = sb[0];
#pragma unroll
    for (int r = 1; r < 16; ++r) { mta = fmaxf(mta, sa[r]); mtb = fmaxf(mtb, sb[r]); }
    mta = fmaxf(mta, __shfl_xor(mta, 32)); mtb = fmaxf(mtb, __shfl_xor(mtb, 32));
    if (__any(mta > a.m + RESCALE_THR || mtb > b.m + RESCALE_THR)) {
        const float mna_ = fmaxf(a.m, mta), mnb_ = fmaxf(b.m, mtb);
        const float fa = __builtin_amdgcn_exp2f(a.m - mna_), fb = __builtin_amdgcn_exp2f(b.m - mnb_);
        a.l *= fa; a.m = mna_; b.l *= fb; b.m = mnb_;
#pragma unroll
        for (int r = 0; r < 16; ++r) { a.o0[r] *= fa; a.o1[r] *= fa; b.o0[r] *= fb; b.o1[r] *= fb; }
    }
    const float mna = a.m, mnb = b.m;
    float psa = 0.f, psb = 0.f;
#pragma unroll
    for (int r = 0; r < 16; ++r) { sa[r] = __builtin_amdgcn_exp2f(sa[r] - mna); sb[r] = __builtin_amdgcn_exp2f(sb[r] - mnb); psa += sa[r]; psb += sb[r]; }
    a.l += psa; b.l += psb;
    v4u pa0, pa1, pb0, pb1;
    pa0.x = cvtpk_s(sa[0], sa[1]); pa0.y = cvtpk_s(sa[2], sa[3]); pa0.z = cvtpk_s(sa[4], sa[5]); pa0.w = cvtpk_s(sa[6], sa[7]);
    pa1.x = cvtpk_s(sa[8], sa[9]); pa1.y = cvtpk_s(sa[10], sa[11]); pa1.z = cvtpk_s(sa[12], sa[13]); pa1.w = cvtpk_s(sa[14], sa[15]);
    pb0.x = cvtpk_s(sb[0], sb[1]); pb0.y = cvtpk_s(sb[2], sb[3]); pb0.z = cvtpk_s(sb[4], sb[5]); pb0.w = cvtpk_s(sb[6], sb[7]);
    pb1.x = cvtpk_s(sb[8], sb[9]); pb1.y = cvtpk_s(sb[10], sb[11]); pb1.z = cvtpk_s(sb[12], sb[13]); pb1.w = cvtpk_s(sb[14], sb[15]);
    const bf16x8 fa0 = __builtin_bit_cast(bf16x8, pa0), fa1 = __builtin_bit_cast(bf16x8, pa1), fb0 = __builtin_bit_cast(bf16x8, pb0), fb1 = __builtin_bit_cast(bf16x8, pb1);
    __builtin_amdgcn_sched_barrier(0); mid(); __builtin_amdgcn_sched_barrier(0);
    const int to = (4 * hi + qq) * 64 + (16 * (grp & 1) + 4 * pp) * 2;
#define VFRAG2(base, ks, d0) ({ const s16x4 lo_ = vtr((base) + to + ((2 * (ks)) * 2 + (d0)) * 512), hi_ = vtr((base) + to + ((2 * (ks) + 1) * 2 + (d0)) * 512); (bf16x8){lo_[0], lo_[1], lo_[2], lo_[3], hi_[0], hi_[1], hi_[2], hi_[3]}; })
    a.o0 = __builtin_amdgcn_mfma_f32_32x32x16_bf16(VFRAG2(vla, 0, 0), fa0, a.o0, 0, 0, 0);
    b.o0 = __builtin_amdgcn_mfma_f32_32x32x16_bf16(VFRAG2(vlb, 0, 0), fb0, b.o0, 0, 0, 0);
    a.o1 = __builtin_amdgcn_mfma_f32_32x32x16_bf16(VFRAG2(vla, 0, 1), fa0, a.o1, 0, 0, 0);
    b.o1 = __builtin_amdgcn_mfma_f32_32x32x16_bf16(VFRAG2(vlb, 0, 1), fb0, b.o1, 0, 0, 0);
    a.o0 = __builtin_amdgcn_mfma_f32_32x32x16_bf16(VFRAG2(vla, 1, 0), fa1, a.o0, 0, 0, 0);
    b.o0 = __builtin_amdgcn_mfma_f32_32x32x16_bf16(VFRAG2(vlb, 1, 0), fb1, b.o0, 0, 0, 0);
    a.o1 = __builtin_amdgcn_mfma_f32_32x32x16_bf16(VFRAG2(vla, 1, 1), fa1, a.o1, 0, 0, 0);
    b.o1 = __builtin_amdgcn_mfma_f32_32x32x16_bf16(VFRAG2(vlb, 1, 1), fb1, b.o1, 0, 0, 0);
#undef VFRAG2
}
template <int MODE, class PreF, class MidF>
__device__ __forceinline__ void attn_compute2_kv(AttnSt& a, AttnSt& b, const bf16x8 (&qa)[4], const bf16x8 (&qb)[4], TileRegs& RA, TileRegs& RB, LAS unsigned char* wl, int lane, int dd0, int kmina, int kminb, PreF pre, MidF mid) {
    const int r32 = lane & 31, hi = lane >> 5, grp = lane >> 4, qq = (lane & 15) >> 2, pp = lane & 3;
    LAS unsigned char* vla = wl; LAS unsigned char* vlb = wl + 4096; LAS unsigned char* kla = wl + 8192; LAS unsigned char* klb = wl + 12288;
#pragma unroll
    for (int it = 0; it < 4; ++it) { const int row = it * 8 + (lane >> 3); const int ko = row * 128 + (((lane & 7) ^ (row & 7)) << 4); *(LAS v4u*)(kla + ko) = RA.kk[it]; *(LAS v4u*)(klb + ko) = RB.kk[it]; }
    pre();
#pragma unroll
    for (int it = 0; it < 4; ++it) { const int vo = (it * 2 + ((lane & 7) >> 2)) * 512 + (lane >> 3) * 64 + (lane & 3) * 16; *(LAS v4u*)(vla + vo) = RA.vv[it]; *(LAS v4u*)(vlb + vo) = RB.vv[it]; }
    f32x16 sa = f32x16{}, sb = f32x16{};
#pragma unroll
    for (int d0 = 0; d0 < 4; ++d0) {
        const int ko = r32 * 128 + (((2 * d0 + hi) ^ (r32 & 7)) << 4);
        const v4u kwa = *(const LAS v4u*)(kla + ko), kwb = *(const LAS v4u*)(klb + ko);
        sa = __builtin_amdgcn_mfma_f32_32x32x16_bf16(__builtin_bit_cast(bf16x8, kwa), qa[d0], sa, 0, 0, 0);
        sb = __builtin_amdgcn_mfma_f32_32x32x16_bf16(__builtin_bit_cast(bf16x8, kwb), qb[d0], sb, 0, 0, 0);
    }
    if (MODE == 3) {
        const int ddh = dd0 - 4 * hi;
        if (kmina <= 0 && kminb <= 0) {
#pragma unroll
            for (int r = 0; r < 16; ++r) { const int c = (r & 3) + 8 * (r >> 2); const bool band = (unsigned)(ddh - c) <= 128u; sa[r] = band ? sa[r] : -INFINITY; sb[r] = band ? sb[r] : -INFINITY; }
        } else {
            const int kma = kmina - 4 * hi, kmb = kminb - 4 * hi;
#pragma unroll
            for (int r = 0; r < 16; ++r) { const int c = (r & 3) + 8 * (r >> 2); const bool band = (unsigned)(ddh - c) <= 128u; if (!band || c < kma) sa[r] = -INFINITY; if (!band || c < kmb) sb[r] = -INFINITY; }
        }
    }
    float mta = sa[0], mtb = sb[0];
#pragma unroll
    for (int r = 1; r < 16; ++r) { mta = fmaxf(mta, sa[r]); mtb = fmaxf(mtb, sb[r]); }
    mta = fmaxf(mta, __shfl_xor(mta, 32)); mtb = fmaxf(mtb, __shfl_xor(mtb, 32));
    if (__any(mta > a.m + RESCALE_THR || mtb > b.m + RESCALE_THR)) {
        const float mna_ = fmaxf(a.m, mta), mnb_ = fmaxf(b.m, mtb);
        const float fa = __builtin_amdgcn_exp2f(a.m - mna_), fb = __builtin_amdgcn_exp2f(b.m - mnb_);
        a.l *= fa; a.m = mna_; b.l *= fb; b.m = mnb_;
#pragma unroll
        for (int r = 0; r < 16; ++r) { a.o0[r] *= fa; a.o1[r] *= fa; b.o0[r] *= fb; b.o1[r] *= fb; }
    }
    const float mna = a.m, mnb = b.m;
    const f32x2_t ma2 = {mna, mna}, mb2 = {mnb, mnb}; f32x2_t acca = {0.f, 0.f}, accb = {0.f, 0.f};
#pragma unroll
    for (int r = 0; r < 16; r += 2) {
        f32x2_t va = (f32x2_t){sa[r], sa[r + 1]} - ma2, vb = (f32x2_t){sb[r], sb[r + 1]} - mb2;
        va.x = __builtin_amdgcn_exp2f(va.x); va.y = __builtin_amdgcn_exp2f(va.y); vb.x = __builtin_amdgcn_exp2f(vb.x); vb.y = __builtin_amdgcn_exp2f(vb.y);
        acca += va; accb += vb;
        sa[r] = va.x; sa[r + 1] = va.y; sb[r] = vb.x; sb[r + 1] = vb.y;
    }
    a.l += acca.x + acca.y; b.l += accb.x + accb.y;
    v4u pa0, pa1, pb0, pb1;
    pa0.x = cvtpk_s(sa[0], sa[1]); pa0.y = cvtpk_s(sa[2], sa[3]); pa0.z = cvtpk_s(sa[4], sa[5]); pa0.w = cvtpk_s(sa[6], sa[7]);
    pa1.x = cvtpk_s(sa[8], sa[9]); pa1.y = cvtpk_s(sa[10], sa[11]); pa1.z = cvtpk_s(sa[12], sa[13]); pa1.w = cvtpk_s(sa[14], sa[15]);
    pb0.x = cvtpk_s(sb[0], sb[1]); pb0.y = cvtpk_s(sb[2], sb[3]); pb0.z = cvtpk_s(sb[4], sb[5]); pb0.w = cvtpk_s(sb[6], sb[7]);
    pb1.x = cvtpk_s(sb[8], sb[9]); pb1.y = cvtpk_s(sb[10], sb[11]); pb1.z = cvtpk_s(sb[12], sb[13]); pb1.w = cvtpk_s(sb[14], sb[15]);
    const bf16x8 fa0 = __builtin_bit_cast(bf16x8, pa0), fa1 = __builtin_bit_cast(bf16x8, pa1), fb0 = __builtin_bit_cast(bf16x8, pb0), fb1 = __builtin_bit_cast(bf16x8, pb1);
    __builtin_amdgcn_sched_barrier(0); mid(); __builtin_amdgcn_sched_barrier(0);
    const int to = (4 * hi + qq) * 64 + (16 * (grp & 1) + 4 * pp) * 2;
#define VFRAG2(base, ks, d0) ({ const s16x4 lo_ = vtr((base) + to + ((2 * (ks)) * 2 + (d0)) * 512), hi_ = vtr((base) + to + ((2 * (ks) + 1) * 2 + (d0)) * 512); (bf16x8){lo_[0], lo_[1], lo_[2], lo_[3], hi_[0], hi_[1], hi_[2], hi_[3]}; })
    a.o0 = __builtin_amdgcn_mfma_f32_32x32x16_bf16(VFRAG2(vla, 0, 0), fa0, a.o0, 0, 0, 0);
    b.o0 = __builtin_amdgcn_mfma_f32_32x32x16_bf16(VFRAG2(vlb, 0, 0), fb0, b.o0, 0, 0, 0);
    a.o1 = __builtin_amdgcn_mfma_f32_32x32x16_bf16(VFRAG2(vla, 0, 1), fa0, a.o1, 0, 0, 0);
    b.o1 = __builtin_amdgcn_mfma_f32_32x32x16_bf16(VFRAG2(vlb, 0, 1), fb0, b.o1, 0, 0, 0);
    a.o0 = __builtin_amdgcn_mfma_f32_32x32x16_bf16(VFRAG2(vla, 1, 0), fa1, a.o0, 0, 0, 0);
    b.o0 = __builtin_amdgcn_mfma_f32_32x32x16_bf16(VFRAG2(vlb, 1, 0), fb1, b.o0, 0, 0, 0);
    a.o1 = __builtin_amdgcn_mfma_f32_32x32x16_bf16(VFRAG2(vla, 1, 1), fa1, a.o1, 0, 0, 0);
    b.o1 = __builtin_amdgcn_mfma_f32_32x32x16_bf16(VFRAG2(vlb, 1, 1), fb1, b.o1, 0, 0, 0);
#undef VFRAG2
}
template <int MODE>
__device__ __forceinline__ void attn_compute2(AttnSt& a, AttnSt& b, const bf16x8 (&qa)[4], const bf16x8 (&qb)[4], const TileRegs& RA, const TileRegs& RB, LAS unsigned char* wl, int lane, int dd0, int kmina, int kminb) {
    attn_stage2(RA, RB, wl, lane); attn_compute2_lds<MODE>(a, b, qa, qb, wl, lane, dd0, kmina, kminb, [] {});
}

__device__ __forceinline__ void phase_dilated_2(const Args& A, LAS unsigned char* lds, int gwv, int NGW, int wave, int lane) {
    const bf16* Z = (const bf16*)(A.ws + WS_Z); bf16* Y = (bf16*)(A.ws + WS_Y);
    LAS unsigned char* wl = lds + wave * 16384;
    const int r32 = lane & 31, hi = lane >> 5;
    for (int U = gwv; U < 16384; U += NGW) {
        const int rd = U >> 10, g2 = U & 1023, X = g2 >> 7, lp = g2 & 127;
        const int bh = 32 * X + 2 * rd + (lp >> 6), pi = lp & 63, c = pi >> 3, r16a = 2 * (pi & 7);
        const int b = bh >> 4, hh = bh & 15;
        const size_t rowbase = (size_t)b * SEQ;
        const int tqa = 512 * c + r16a + 16 * r32;
        const bf16* zqa = Z + (rowbase + tqa) * ODD_IN; const bf16* zqb = zqa + ODD_IN;
        bf16x8 qa[4], qb[4];
#pragma unroll
        for (int d0 = 0; d0 < 4; ++d0) { qa[d0] = *(const bf16x8*)(zqa + hh * 64 + 16 * d0 + 8 * hi); qb[d0] = *(const bf16x8*)(zqb + hh * 64 + 16 * d0 + 8 * hi); }
        AttnSt sa, sb; sa.o0 = f32x16{}; sa.o1 = f32x16{}; sa.m = -1e30f; sa.l = 0.f; sb.o0 = f32x16{}; sb.o1 = f32x16{}; sb.m = -1e30f; sb.l = 0.f;
        const bf16* Vh = Z + rowbase * ODD_IN + 2048 + hh * 64 + 8 * (lane & 7);
#pragma unroll 1
        for (int cfg = 0; cfg < 3; ++cfg) {
            const int dil = (cfg == 0) ? 16 : (cfg == 1) ? 4 : 1, sstep = 16 / dil, ntile = (cfg == 0) ? 5 : (cfg == 1) ? 8 : 20;
            const int rdla = r16a & (dil - 1), rdlb = (r16a + 1) & (dil - 1);
            const int mba = (512 * c + r16a - rdla) / dil - 128, mbb = (512 * c + r16a + 1 - rdlb) / dil - 128;
            const int tau0 = mbb < 0 ? (-mbb) / 32 : 0;
            const size_t vst = (size_t)dil * ODD_IN;
#pragma unroll 1
            for (int tau = tau0; tau < ntile; ++tau) {
                TileRegs RA, RB;
                { const int mv = mba + 32 * tau + (lane >> 3); const int m0_ = mv < 0 ? 0 : mv, m1_ = mv + 8 < 0 ? 0 : mv + 8, m2_ = mv + 16 < 0 ? 0 : mv + 16, m3_ = mv + 24 < 0 ? 0 : mv + 24;
                  const bf16* vb = Vh + (size_t)rdla * ODD_IN; attn_load(RA, 1024, vb + m0_ * vst, vb + m1_ * vst, vb + m2_ * vst, vb + m3_ * vst); }
                { const int mv = mbb + 32 * tau + (lane >> 3); const int m0_ = mv < 0 ? 0 : mv, m1_ = mv + 8 < 0 ? 0 : mv + 8, m2_ = mv + 16 < 0 ? 0 : mv + 16, m3_ = mv + 24 < 0 ? 0 : mv + 24;
                  const bf16* vb = Vh + (size_t)rdlb * ODD_IN; attn_load(RB, 1024, vb + m0_ * vst, vb + m1_ * vst, vb + m2_ * vst, vb + m3_ * vst); }
                attn_compute2<3>(sa, sb, qa, qb, RA, RB, wl, lane, 128 + sstep * r32 - 32 * tau, -(mba + 32 * tau), -(mbb + 32 * tau));
            }
        }
        attn_store(sa, zqa + 3072 + hh * 64, Y + (rowbase + tqa) * D + hh * 64, lane);
        attn_store(sb, zqb + 3072 + hh * 64, Y + (rowbase + tqa + 1) * D + hh * 64, lane);
    }
}


__device__ __forceinline__ void attn_state_store(const AttnSt& st, bf16* orow, float* lsep, int lane) {
    const int hi = lane >> 5;
    const float lt = st.l + __shfl_xor(st.l, 32), inv = 1.0f / lt;
#pragma unroll
    for (int d0 = 0; d0 < 2; ++d0)
#pragma unroll
        for (int pr = 0; pr < 2; ++pr) {
            v2u w2[2];
#pragma unroll
            for (int k = 0; k < 2; ++k) { const int rq = 2 * pr + k; const f32x16& o = d0 ? st.o1 : st.o0; w2[k].x = cvtpk_s(o[4 * rq + 0] * inv, o[4 * rq + 1] * inv); w2[k].y = cvtpk_s(o[4 * rq + 2] * inv, o[4 * rq + 3] * inv); }
            *(v4u*)(orow + 32 * d0 + 16 * pr + 8 * hi) = pair_to_wide(w2[0], w2[1]);
        }
    if (hi == 0) *lsep = st.m + __builtin_amdgcn_logf(lt);
}
__device__ __forceinline__ void attn_state_load(AttnSt& st, const bf16* orow, const float* lsep, int lane) {
    const int hi = lane >> 5;
#pragma unroll
    for (int d0 = 0; d0 < 2; ++d0)
#pragma unroll
        for (int pr = 0; pr < 2; ++pr) {
            const v4u w = *(const v4u*)(orow + 32 * d0 + 16 * pr + 8 * hi); v2u g2[2]; wide_to_pair(w, g2[0], g2[1]);
            f32x16& o = d0 ? st.o1 : st.o0;
#pragma unroll
            for (int k = 0; k < 2; ++k) { const int rq = 2 * pr + k; o[4 * rq + 0] = bf_lo(g2[k].x); o[4 * rq + 1] = bf_hi(g2[k].x); o[4 * rq + 2] = bf_lo(g2[k].y); o[4 * rq + 3] = bf_hi(g2[k].y); }
        }
    st.m = *lsep; st.l = hi ? 0.f : 1.f;
}
__device__ __forceinline__ void attn_state_store_lds(const AttnSt& st, LAS unsigned char* ex, int p, int lane) {
    const int hi = lane >> 5, sw = (p & 7) ^ ((p >> 4) & 7);
    const float lt = st.l + __shfl_xor(st.l, 32), inv = 1.0f / lt;
#pragma unroll
    for (int d0 = 0; d0 < 2; ++d0)
#pragma unroll
        for (int pr = 0; pr < 2; ++pr) {
            v2u w2[2];
#pragma unroll
            for (int k = 0; k < 2; ++k) { const int rq = 2 * pr + k; const f32x16& o = d0 ? st.o1 : st.o0; w2[k].x = cvtpk_s(o[4 * rq + 0] * inv, o[4 * rq + 1] * inv); w2[k].y = cvtpk_s(o[4 * rq + 2] * inv, o[4 * rq + 3] * inv); }
            *(LAS v4u*)(ex + p * 128 + (((4 * d0 + 2 * pr + hi) ^ sw) << 4)) = pair_to_wide(w2[0], w2[1]);
        }
    if (hi == 0) *(LAS float*)(ex + 65536 + 4 * p) = st.m + __builtin_amdgcn_logf(lt);
}
__device__ __forceinline__ void attn_state_load_lds(AttnSt& st, const LAS unsigned char* ex, int p, int lane) {
    const int hi = lane >> 5, sw = (p & 7) ^ ((p >> 4) & 7);
#pragma unroll
    for (int d0 = 0; d0 < 2; ++d0)
#pragma unroll
        for (int pr = 0; pr < 2; ++pr) {
            const v4u w = *(const LAS v4u*)(ex + p * 128 + (((4 * d0 + 2 * pr + hi) ^ sw) << 4)); v2u g2[2]; wide_to_pair(w, g2[0], g2[1]);
            f32x16& o = d0 ? st.o1 : st.o0;
#pragma unroll
            for (int k = 0; k < 2; ++k) { const int rq = 2 * pr + k; o[4 * rq + 0] = bf_lo(g2[k].x); o[4 * rq + 1] = bf_hi(g2[k].x); o[4 * rq + 2] = bf_lo(g2[k].y); o[4 * rq + 3] = bf_hi(g2[k].y); }
        }
    st.m = *(const LAS float*)(ex + 65536 + 4 * p); st.l = hi ? 0.f : 1.f;
}

__device__ __forceinline__ void phase_dilated_3(const Args& A, LAS unsigned char* lds, int G, int vcu, int wave, int lane) {
    const bf16* Z = (const bf16*)(A.ws + WS_Z); bf16* Y = (bf16*)(A.ws + WS_Y);
    bf16* EX = (bf16*)A.out; float* LSE = A.out + (size_t)32 * 1024 * 1024;
    LAS unsigned char* wl = lds + wave * 16384;
    const int r32 = lane & 31, hi = lane >> 5;
    for (int U = vcu; U < 2048; U += G) {
        const int c = U >> 8, bh = U & 255, b = bh >> 4, hh = bh & 15, T0 = 512 * c;
        const size_t rowbase = (size_t)b * SEQ;
        const bf16* Vh = Z + rowbase * ODD_IN + 2048 + hh * 64 + 8 * (lane & 7);
        {
            const int r16a = 2 * wave, pa = r16a + 16 * r32;
            bf16x8 qa[4], qb[4];
            { const bf16* zqa = Z + (rowbase + T0 + pa) * ODD_IN + hh * 64 + 8 * hi;
#pragma unroll
              for (int d0 = 0; d0 < 4; ++d0) { qa[d0] = *(const bf16x8*)(zqa + 16 * d0); qb[d0] = *(const bf16x8*)(zqa + ODD_IN + 16 * d0); } }
            AttnSt sa, sb; sa.o0 = f32x16{}; sa.o1 = f32x16{}; sa.m = -1e30f; sa.l = 0.f; sb.o0 = f32x16{}; sb.o1 = f32x16{}; sb.m = -1e30f; sb.l = 0.f;
#define P1_PARAMS(ti) const int dil_ = 16, tau_ = (ti); const int rdla_ = r16a & (dil_ - 1), rdlb_ = (r16a + 1) & (dil_ - 1); const int mba_ = (T0 + r16a - rdla_) / dil_ - 128 + 32 * tau_
#define P1_ADDR(ti) P1_PARAMS(ti); const size_t vst_ = (size_t)dil_ * ODD_IN; const int mv = mba_ + (lane >> 3); const int m0_ = mv < 0 ? 0 : mv, m1_ = mv + 8 < 0 ? 0 : mv + 8, m2_ = mv + 16 < 0 ? 0 : mv + 16, m3_ = mv + 24 < 0 ? 0 : mv + 24; \
                const bf16* va_ = Vh + (size_t)rdla_ * ODD_IN; const bf16* vb_ = Vh + (size_t)rdlb_ * ODD_IN
#define P1_LOADK(ti) do { P1_ADDR(ti); attn_load_k(RA, 1024, va_ + m0_ * vst_, va_ + m1_ * vst_, va_ + m2_ * vst_, va_ + m3_ * vst_); attn_load_k(RB, 1024, vb_ + m0_ * vst_, vb_ + m1_ * vst_, vb_ + m2_ * vst_, vb_ + m3_ * vst_); } while (0)
#define P1_LOADV(ti) do { P1_ADDR(ti); attn_load_v(RA, va_ + m0_ * vst_, va_ + m1_ * vst_, va_ + m2_ * vst_, va_ + m3_ * vst_); attn_load_v(RB, vb_ + m0_ * vst_, vb_ + m1_ * vst_, vb_ + m2_ * vst_, vb_ + m3_ * vst_); } while (0)
#pragma unroll 1
            for (int ti = 0; ti < 5; ++ti) {
                { P1_PARAMS(ti); if (mba_ + 31 < 0) continue; }
                TileRegs RA, RB;
                P1_LOADK(ti);
                P1_PARAMS(ti);
                attn_compute2_kv<3>(sa, sb, qa, qb, RA, RB, wl, lane, 128 + (16 / dil_) * r32 - 32 * tau_, -mba_, -mba_, [&] { P1_LOADV(ti); }, [] {});
            }
#undef P1_ADDR
#undef P1_LOADK
#undef P1_LOADV
#undef P1_PARAMS
            __syncthreads();
            attn_state_store_lds(sa, lds, pa, lane);
            attn_state_store_lds(sb, lds, pa + 1, lane);
        }
        {
            const int g4 = wave >> 1, r4a = 2 * (wave & 1), p4 = r4a + 128 * g4 + 4 * r32;
            __syncthreads();
            AttnSt sa, sb;
            attn_state_load_lds(sa, lds, p4, lane);
            attn_state_load_lds(sb, lds, p4 + 1, lane);
            bf16x8 qa[4], qb[4];
            { const bf16* zqa = Z + (rowbase + T0 + p4) * ODD_IN + hh * 64 + 8 * hi;
#pragma unroll
              for (int d0 = 0; d0 < 4; ++d0) { qa[d0] = *(const bf16x8*)(zqa + 16 * d0); qb[d0] = *(const bf16x8*)(zqa + ODD_IN + 16 * d0); } }
            __syncthreads();
            const int mb = T0 / 4 + 32 * g4 - 128;
            const size_t vst = (size_t)4 * ODD_IN;
#pragma unroll 1
            for (int tau = 0; tau < 5; ++tau) {
                const int m0 = mb + 32 * tau;
                if (m0 + 31 < 0) continue;
                const int mv = m0 + (lane >> 3); const int m0_ = mv < 0 ? 0 : mv, m1_ = mv + 8 < 0 ? 0 : mv + 8, m2_ = mv + 16 < 0 ? 0 : mv + 16, m3_ = mv + 24 < 0 ? 0 : mv + 24;
                const bf16* va_ = Vh + (size_t)r4a * ODD_IN; const bf16* vb_ = va_ + ODD_IN;
                TileRegs RA, RB;
                attn_load_k(RA, 1024, va_ + m0_ * vst, va_ + m1_ * vst, va_ + m2_ * vst, va_ + m3_ * vst); attn_load_k(RB, 1024, vb_ + m0_ * vst, vb_ + m1_ * vst, vb_ + m2_ * vst, vb_ + m3_ * vst);
                attn_compute2_kv<3>(sa, sb, qa, qb, RA, RB, wl, lane, 128 + r32 - 32 * tau, -m0, -m0,
                                    [&] { attn_load_v(RA, va_ + m0_ * vst, va_ + m1_ * vst, va_ + m2_ * vst, va_ + m3_ * vst); attn_load_v(RB, vb_ + m0_ * vst, vb_ + m1_ * vst, vb_ + m2_ * vst, vb_ + m3_ * vst); }, [] {});
            }
            __syncthreads();
            attn_state_store_lds(sa, lds, p4, lane);
            attn_state_store_lds(sb, lds, p4 + 1, lane);
        }
        {
            const int pa = 64 * wave + r32, pb = pa + 32;
            bf16x8 qa[4], qb[4];
            { const bf16* zqa = Z + (rowbase + T0 + pa) * ODD_IN + hh * 64 + 8 * hi;
#pragma unroll
              for (int d0 = 0; d0 < 4; ++d0) { qa[d0] = *(const bf16x8*)(zqa + 16 * d0); qb[d0] = *(const bf16x8*)(zqa + (size_t)32 * ODD_IN + 16 * d0); } }
            __syncthreads();
            AttnSt sa, sb;
            attn_state_load_lds(sa, lds, pa, lane);
            attn_state_load_lds(sb, lds, pb, lane);
            __syncthreads();
            const int mba = T0 + 64 * wave - 128, mbb = mba + 32;
            const size_t vst = (size_t)ODD_IN;
#define P2_ADDR(tau) const int mva = mba + 32 * (tau) + (lane >> 3), mvb = mva + 32; \
                const int a0_ = mva < 0 ? 0 : mva, a1_ = mva + 8 < 0 ? 0 : mva + 8, a2_ = mva + 16 < 0 ? 0 : mva + 16, a3_ = mva + 24 < 0 ? 0 : mva + 24; \
                const int b0_ = mvb < 0 ? 0 : mvb, b1_ = mvb + 8 < 0 ? 0 : mvb + 8, b2_ = mvb + 16 < 0 ? 0 : mvb + 16, b3_ = mvb + 24 < 0 ? 0 : mvb + 24
#define P2_LOADK(tau) do { P2_ADDR(tau); attn_load_k(RA, 1024, Vh + a0_ * vst, Vh + a1_ * vst, Vh + a2_ * vst, Vh + a3_ * vst); attn_load_k(RB, 1024, Vh + b0_ * vst, Vh + b1_ * vst, Vh + b2_ * vst, Vh + b3_ * vst); } while (0)
#define P2_LOADV(tau) do { P2_ADDR(tau); attn_load_v(RA, Vh + a0_ * vst, Vh + a1_ * vst, Vh + a2_ * vst, Vh + a3_ * vst); attn_load_v(RB, Vh + b0_ * vst, Vh + b1_ * vst, Vh + b2_ * vst, Vh + b3_ * vst); } while (0)
#pragma unroll 1
            for (int tau = 0; tau < 5; ++tau) {
                if (mbb + 32 * tau + 31 < 0) continue;
                TileRegs RA, RB;
                P2_LOADK(tau);
                attn_compute2_kv<3>(sa, sb, qa, qb, RA, RB, wl, lane, 128 + r32 - 32 * tau, -(mba + 32 * tau), -(mbb + 32 * tau), [&] { P2_LOADV(tau); }, [] {});
            }
#undef P2_ADDR
#undef P2_LOADK
#undef P2_LOADV
            { int pa2 = pa; asm volatile("" : "+v"(pa2));
              bf16* yr = Y + (rowbase + T0 + pa2) * D + hh * 64; const bf16* zg = Z + (rowbase + T0 + pa2) * ODD_IN + 3072 + hh * 64;
              v2u gga[2][4], ggb[2][4]; attn_gate_load(gga, zg, lane); attn_gate_load(ggb, zg + (size_t)32 * ODD_IN, lane);
              attn_store_g(sa, gga, yr, lane); attn_store_g(sb, ggb, yr + (size_t)32 * D, lane); }
        }
    }
}

__device__ __forceinline__ void phase_dilated(const Args& A, LAS unsigned char* lds, int gwv, int NGW, int wave, int lane) {
    const bf16* Z = (const bf16*)(A.ws + WS_Z); bf16* Y = (bf16*)(A.ws + WS_Y);
    LAS unsigned char* vl = lds + wave * 4096;
    const int r32 = lane & 31, hi = lane >> 5;
    for (int U = gwv; U < 32768; U += NGW) {
        const int rd = U >> 11, g2 = U & 2047, X = g2 >> 8, lwv = g2 & 255;
        const int bh = 32 * X + 2 * rd + (lwv >> 7), gi = lwv & 127, c = gi >> 4, r16 = gi & 15;
        const int b = bh >> 4, hh = bh & 15;
        const size_t rowbase = (size_t)b * SEQ;
        const int tq = 512 * c + r16 + 16 * r32;
        const bf16* zq = Z + (rowbase + tq) * ODD_IN;
        bf16x8 qf[4];
#pragma unroll
        for (int d0 = 0; d0 < 4; ++d0) qf[d0] = *(const bf16x8*)(zq + hh * 64 + 16 * d0 + 8 * hi);
        AttnSt st; st.o0 = f32x16{}; st.o1 = f32x16{}; st.m = -1e30f; st.l = 0.f;
        const bf16* Kh = Z + rowbase * ODD_IN + 1024 + hh * 64; const bf16* Vh = Z + rowbase * ODD_IN + 2048 + hh * 64;
#pragma unroll 1
        for (int cfg = 0; cfg < 3; ++cfg) {
            const int dil = (cfg == 0) ? 16 : (cfg == 1) ? 4 : 1, sstep = 16 / dil, ntile = (cfg == 0) ? 5 : (cfg == 1) ? 8 : 20;
            const int rdl = r16 & (dil - 1), mbase = (512 * c + r16 - rdl) / dil - 128;
            for (int tau = 0; tau < ntile; ++tau) {
                const int m0 = mbase + 32 * tau;
                if (m0 + 31 < 0) continue;
                const int mk = m0 + r32, mkc = mk < 0 ? 0 : mk;
                const bf16* kp = Kh + (size_t)(rdl + dil * mkc) * ODD_IN + 8 * hi;
                const int mv = m0 + (lane >> 3);
                const int mv0 = mv < 0 ? 0 : mv, mv1 = mv + 8 < 0 ? 0 : mv + 8, mv2 = mv + 16 < 0 ? 0 : mv + 16, mv3 = mv + 24 < 0 ? 0 : mv + 24;
                const bf16* vb = Vh + (size_t)rdl * ODD_IN + 8 * (lane & 7); const size_t vst = (size_t)dil * ODD_IN;
                const int dd0 = 128 + sstep * r32 - 32 * tau;
                attn_tile(st, qf, kp, vb + mv0 * vst, vb + mv1 * vst, vb + mv2 * vst, vb + mv3 * vst, vl, lane, true,
                          [&](int kk) { const int dd = dd0 - kk; return dd >= 0 && dd <= 128 && (m0 + kk) >= 0; });
            }
        }
        attn_store(st, zq + 3072 + hh * 64, Y + (rowbase + tq) * D + hh * 64, lane);
    }
}
#define XB_TMO      128
#define XB_XCNT(j)  (256  + 64 * (j))
#define XB_XSUB(j)  (1280 + 64 * (j))
#define XB_XGEN(j)  (2304 + 64 * (j))
#define XB_TOP      3328
#define XB_TOPGEN   3392
#define XCD_BAR_WORDS 3456
#define XB_SPIN_CAP (1u << 18)

__device__ __forceinline__ unsigned xb_ld(unsigned* p)              { return __hip_atomic_load(p, __ATOMIC_RELAXED, __HIP_MEMORY_SCOPE_AGENT); }
__device__ __forceinline__ unsigned xb_add(unsigned* p, unsigned v) { return __hip_atomic_fetch_add(p, v, __ATOMIC_RELAXED, __HIP_MEMORY_SCOPE_AGENT); }
__device__ __forceinline__ unsigned xb_xcc_id() { return (unsigned)__builtin_amdgcn_s_getreg((3 << 11) | 20) & 0xFu; }
#define XB_SPIN(cond, bar) do { unsigned _sp = 0; while (cond) { __builtin_amdgcn_s_sleep(1); \
    if ((++_sp & 255u) == 0u) { if (xb_ld(&(bar)[XB_TMO])) break; if (_sp > XB_SPIN_CAP) { atomicAdd(&(bar)[XB_TMO], 1u); break; } } } } while (0)

struct XcdBarrier {
    unsigned* bar; unsigned x;
    volatile LAS unsigned* st;
};

__device__ __forceinline__ XcdBarrier xcd_barrier_post(unsigned* bar, volatile LAS unsigned* st) {
    XcdBarrier b; b.bar = bar; b.x = xb_xcc_id(); b.st = st;
    if (threadIdx.x == 0) (void)xb_add(&bar[XB_XCNT(b.x)], 1u);
    return b;
}
__device__ __forceinline__ void xcd_barrier_complete(unsigned* bar, unsigned x, unsigned& nloc, unsigned& nx) {
    const unsigned G = gridDim.x * gridDim.y * gridDim.z;
    unsigned sum, cnt, mine, sp = 0u;
    for (;;) {
        sum = 0u; cnt = 0u; mine = 0u;
#pragma unroll
        for (unsigned j = 0; j < 16; ++j) { const unsigned c = xb_ld(&bar[XB_XCNT(j)]); sum += c; cnt += (c > 0u) ? 1u : 0u; mine = (j == x) ? c : mine; }
        if (sum == G) break;
        __builtin_amdgcn_s_sleep(1);
        if ((++sp & 255u) == 0u) { if (xb_ld(&bar[XB_TMO])) break; if (sp > XB_SPIN_CAP) { atomicAdd(&bar[XB_TMO], 1u); break; } }
    }
    nloc = mine > 0u ? mine : 1u; nx = cnt > 0u ? cnt : 1u;
}

__device__ __forceinline__ void xcd_barrier(const XcdBarrier& b) {
    asm volatile("s_waitcnt vmcnt(0)" ::: "memory");
    __syncthreads();
    if (threadIdx.x == 0) {
        unsigned* bar = b.bar;
        __builtin_amdgcn_s_waitcnt(0);
        unsigned nloc = b.st[0], nx = b.st[1];
        if (nloc == 0u) { xcd_barrier_complete(bar, b.x, nloc, nx); b.st[0] = nloc; b.st[1] = nx; }
        const unsigned old = xb_add(&bar[XB_XSUB(b.x)], 1u);
        const unsigned gen = old / nloc;
        if (old + 1u == (gen + 1u) * nloc) {
            __builtin_amdgcn_fence(__ATOMIC_RELEASE, "agent");
            asm volatile("s_waitcnt vmcnt(0)" ::: "memory");
            const unsigned og = xb_add(&bar[XB_TOP], 1u);
            const unsigned tg = og / nx;
            if (og + 1u == (tg + 1u) * nx) xb_add(&bar[XB_TOPGEN], 1u);
            else XB_SPIN(xb_ld(&bar[XB_TOPGEN]) == tg, bar);
            __builtin_amdgcn_fence(__ATOMIC_ACQUIRE, "agent");
            xb_add(&bar[XB_XGEN(b.x)], 1u);
            asm volatile("s_waitcnt vmcnt(0)" ::: "memory");
        } else {
            XB_SPIN(xb_ld(&bar[XB_XGEN(b.x)]) == gen, bar);
            __builtin_amdgcn_fence(__ATOMIC_ACQUIRE, "agent");
            asm volatile("s_waitcnt vmcnt(0)" ::: "memory");
        }
    }
    __syncthreads();
}
__device__ __forceinline__ void phase_final(const Args& A, int gwv, int NGW, int lane) {
    const float* ssqp = (const float*)(A.ws + WS_SSQ);
    f32x4 fg[4];
#pragma unroll
    for (int j = 0; j < 4; ++j) fg[j] = *((const f32x4*)A.final_g + lane + 64 * j);
    for (int m = gwv; m < M; m += 2 * NGW) {
        const int m2 = m + NGW;
        const f32x4* sp = (const f32x4*)(ssqp + (size_t)m * 16); const f32x4* sp2 = (const f32x4*)(ssqp + (size_t)m2 * 16);
        f32x4* hr = (f32x4*)(A.out + (size_t)m * D) + lane; f32x4* hr2 = (f32x4*)(A.out + (size_t)m2 * D) + lane;
        const f32x4 a = sp[0], b = sp[1], c = sp[2], d = sp[3], a2 = sp2[0], b2 = sp2[1], c2 = sp2[2], d2 = sp2[3];
        f32x4 v[4], w[4];
#pragma unroll
        for (int j = 0; j < 4; ++j) { v[j] = hr[64 * j]; w[j] = hr2[64 * j]; }
        const float ss = (((a[0] + a[1]) + (a[2] + a[3])) + ((b[0] + b[1]) + (b[2] + b[3]))) + (((c[0] + c[1]) + (c[2] + c[3])) + ((d[0] + d[1]) + (d[2] + d[3])));
        const float ss2 = (((a2[0] + a2[1]) + (a2[2] + a2[3])) + ((b2[0] + b2[1]) + (b2[2] + b2[3]))) + (((c2[0] + c2[1]) + (c2[2] + c2[3])) + ((d2[0] + d2[1]) + (d2[2] + d2[3])));
        const float rstd = __builtin_amdgcn_rsqf(ss * (1.0f / 1024.0f) + NORM_EPS), rstd2 = __builtin_amdgcn_rsqf(ss2 * (1.0f / 1024.0f) + NORM_EPS);
#pragma unroll
        for (int j = 0; j < 4; ++j) { __builtin_nontemporal_store(v[j] * rstd * fg[j], hr + 64 * j); __builtin_nontemporal_store(w[j] * rstd2 * fg[j], hr2 + 64 * j); }
    }
}

#define CAS __attribute__((address_space(4)))
#define FRESH_IDS() int lane = lane_k, wave = wave_k, vcu = vcu_k; asm volatile("" : "+v"(lane), "+s"(wave), "+s"(vcu)); const int gwv = vcu * NWAVES + wave; (void)gwv;
#define GRID_SYNC() do { asm volatile("s_waitcnt vmcnt(0) lgkmcnt(0)" ::: "memory"); __syncthreads(); \
    if (wave_k == 0) { __builtin_amdgcn_fence(__ATOMIC_RELEASE, "agent"); asm volatile("s_waitcnt vmcnt(0)" ::: "memory"); } \
    grid.sync(); \
    if (wave_k == 0) { __builtin_amdgcn_fence(__ATOMIC_ACQUIRE, "agent"); asm volatile("s_waitcnt vmcnt(0)" ::: "memory"); } \
    __syncthreads(); } while (0)
#ifdef NO_XBAR
#define XBAR_SYNC() GRID_SYNC()
#else
#define XBAR_SYNC() xcd_barrier(xbar)
#endif
#define FRESH_ARGS() ({ const CAS Args* ap_ = (const CAS Args*)__builtin_amdgcn_kernarg_segment_ptr(); asm volatile("" : "+s"(ap_)); Args a_; a_ = *(const Args*)ap_; a_; })
__global__ void __launch_bounds__(NTHREADS, 2) mega_fwd(Args Akern) {
    extern __shared__ __attribute__((aligned(16))) unsigned char lds_raw[];
    cg::grid_group grid = cg::this_grid();
    LAS unsigned char* lds = (LAS unsigned char*)lds_raw;
    const int tid = threadIdx.x, lane_k = tid & 63, wave_k = __builtin_amdgcn_readfirstlane(tid >> 6);
    const int G = gridDim.x, bx = blockIdx.x;
    const int vcu_k = (G % 8 == 0) ? (bx % 8) * (G / 8) + bx / 8 : bx;
    const int NGW = G * NWAVES;
    if (tid < 2) ((volatile LAS unsigned*)(lds + 131072))[tid] = 0u;
    __syncthreads();
    const XcdBarrier xbar = xcd_barrier_post((unsigned*)(Akern.ws + WS_CTL), (volatile LAS unsigned*)(lds + 131072));

#ifndef NO_PRO
    { FRESH_IDS(); const Args A = FRESH_ARGS(); phase_prologue(A, lds, gwv, NGW, wave, lane); }
#endif
    GRID_SYNC();
#pragma unroll 1
    for (int layer = 0; layer < 4; ++layer) {
        const int li = layer >> 1; const int even = !(layer & 1);
        {
            const Args A = FRESH_ARGS(); bf16* hb = (bf16*)(A.ws + WS_HB); bf16* Zb = (bf16*)(A.ws + WS_Z); float* ssqp = (float*)(A.ws + WS_SSQ); float* kmp = (float*)(A.ws + WS_KMP);
            const int N = even ? EVEN_IN : ODD_IN;
            const bf16* Wt = even ? (const bf16*)(A.ws + WS_WE_IN) + (size_t)li * EVEN_IN * D : (const bf16*)(A.ws + WS_WO_IN) + (size_t)li * ODD_IN * D;
            pg8::Gemm g{hb, Wt, M, N, D}; pg8::StaticOrder S; S.init(M, N, G, bx);
            LAS float* rtab = (LAS float*)(lds + 131072 + 1024);
            {
                int tidl = tid; asm volatile("" : "+v"(tidl));
                const int rl = tidl & 255, half = tidl >> 8;
#pragma unroll 1
                for (int kb = 0; kb < 8; kb += 4) {
                    f32x4 pv[4][4]; int have[4];
#pragma unroll
                    for (int k = 0; k < 4; ++k) {
                        pg8::Unit uu; have[k] = S.next(2 * (kb + k) + half, uu) ? 1 : 0;
                        const float* sp = ssqp + ((size_t)(have[k] ? uu.pm : 0) * 256 + rl) * 16;
#pragma unroll
                        for (int q4 = 0; q4 < 4; ++q4) pv[k][q4] = *(const f32x4*)(sp + 4 * q4);
                    }
#pragma unroll
                    for (int k = 0; k < 4; ++k) {
                        const f32x4 a = pv[k][0], b = pv[k][1], c = pv[k][2], d = pv[k][3];
                        const float ss = (((a[0] + a[1]) + (a[2] + a[3])) + ((b[0] + b[1]) + (b[2] + b[3]))) + (((c[0] + c[1]) + (c[2] + c[3])) + ((d[0] + d[1]) + (d[2] + d[3])));
                        if (have[k]) rtab[(2 * (kb + k) + half) * 256 + rl] = __builtin_amdgcn_rsqf(ss * (1.0f / 1024.0f) + NORM_EPS);
                    }
                }
                __syncthreads();
            }
            int eseq = 0;
            pg8::EpiIn E{Zb, N, rtab, &eseq, kmp, even};
#ifdef PROBE_GIN2
            pg8::gemm_phase<pg8::EpiIn, pg8::StaticOrder, true, true>(lds, g, S, E);
#endif
#ifndef NO_GIN
            pg8::gemm_phase<pg8::EpiIn, pg8::StaticOrder, true, true>(lds, g, S, E);
#endif
        }
        XBAR_SYNC();
#ifdef PROBE_MIX2
        for (int rep = 0; rep < 2; ++rep)
#endif
#ifdef PROBE_MIX2_EVEN
        for (int rep = 0; rep < (even ? 2 : 1); ++rep)
#endif
        { __syncthreads(); FRESH_IDS(); const Args A = FRESH_ARGS();
        if (even) {
#ifndef NO_GMLP
            phase_gmlp(A, li, lds, vcu, G, wave, lane);
#endif
#ifdef PROBE_GMLP2
            phase_gmlp(A, li, lds, vcu, G, wave, lane);
#endif
#ifndef NO_MOBA
#if defined(NO_PIPE)
            phase_moba_old(A, lds, gwv, NGW, wave, lane);
#elif defined(MOBA_PIPE)
            phase_moba_p(A, lds, gwv, NGW, wave, lane);
#else
            phase_moba_s(A, lds, G, vcu, wave, lane);
#endif
#endif
        } else {
#ifndef NO_DIL
#if defined(NO_PIPE)
            phase_dilated(A, lds, gwv, NGW, wave, lane);
#elif defined(DIL_PIPE)
            phase_dilated_p(A, lds, gwv, NGW, wave, lane);
#elif defined(DIL_2)
            phase_dilated_2(A, lds, gwv, NGW, wave, lane);
#else
            phase_dilated_3(A, lds, G, vcu, wave, lane);
#endif
#endif
        } }
        XBAR_SYNC();
        {
            const Args A = FRESH_ARGS(); bf16* hb = (bf16*)(A.ws + WS_HB); bf16* Yb = (bf16*)(A.ws + WS_Y); float* ssqp = (float*)(A.ws + WS_SSQ);
            const bf16* Wt = even ? (const bf16*)(A.ws + WS_WE_OUT) + (size_t)li * D * D : (const bf16*)(A.ws + WS_WO_OUT) + (size_t)li * D * D;
            pg8::Gemm g{Yb, Wt, M, D, D}; pg8::StaticOrder S; S.init(M, D, G, bx);
            pg8::EpiOut E{layer == 0 ? A.x : nullptr, layer == 3 ? A.out : nullptr, hb, ssqp};
#ifndef NO_GOUT
            pg8::gemm_phase<pg8::EpiOut, pg8::StaticOrder, true, true>(lds, g, S, E);
#endif
        }
        XBAR_SYNC();
    }
#ifndef NO_FIN
    { FRESH_IDS(); const Args A = FRESH_ARGS(); phase_final(A, gwv, NGW, lane); }
#endif
}

extern "C" void kernel_launch(void* const* d_in, const int* in_sizes, int n_in, void* d_out, int out_size, void* d_ws, size_t ws_size, hipStream_t stream) {
    static int grid = 0;
    if (grid == 0) {
        if (n_in != 11 || in_sizes[0] != M * D || out_size != M * D || ws_size < WS_END) { fprintf(stderr, "kernel_launch: unexpected shapes (n_in %d, in0 %d, out %d, ws %zu)\n", n_in, n_in > 0 ? in_sizes[0] : -1, out_size, ws_size); grid = -1; return; }
        int dev = 0, cus = 0, per_cu = 0;
        if (hipGetDevice(&dev) != hipSuccess || hipDeviceGetAttribute(&cus, hipDeviceAttributeMultiprocessorCount, dev) != hipSuccess) { grid = -1; return; }
        if (hipFuncSetAttribute((const void*)mega_fwd, hipFuncAttributeMaxDynamicSharedMemorySize, LDS_BYTES) != hipSuccess) { fprintf(stderr, "kernel_launch: hipFuncSetAttribute failed\n"); grid = -1; return; }
        if (hipOccupancyMaxActiveBlocksPerMultiprocessor(&per_cu, (const void*)mega_fwd, NTHREADS, LDS_BYTES) != hipSuccess || per_cu < 1) { fprintf(stderr, "kernel_launch: occupancy query says %d\n", per_cu); per_cu = 1; }
        (void)hipGetLastError();
        grid = cus;
    }
    if (grid < 0) return;
    Args a{};
    a.x = (const float*)d_in[0]; a.norm_g = (const float*)d_in[1]; a.final_g = (const float*)d_in[2]; a.ab_w_in = (const float*)d_in[3]; a.ab_w_out = (const float*)d_in[4];
    a.ln_g = (const float*)d_in[5]; a.ln_b = (const float*)d_in[6]; a.w_s = (const float*)d_in[7]; a.b_s = (const float*)d_in[8]; a.c_w_in = (const float*)d_in[9]; a.c_w_out = (const float*)d_in[10];
    a.out = (float*)d_out; a.ws = (unsigned char*)d_ws;
    if (hipMemsetAsync((char*)d_ws + WS_CTL, 0, 16384, stream) != hipSuccess) { fprintf(stderr, "kernel_launch: hipMemsetAsync failed\n"); return; }
    void* args[] = {&a};
    const hipError_t e = hipLaunchCooperativeKernel((const void*)mega_fwd, dim3(grid), dim3(NTHREADS), args, LDS_BYTES, stream);
    if (e != hipSuccess) fprintf(stderr, "kernel_launch: cooperative launch failed: %s (grid %d)\n", hipGetErrorString(e), grid);
}
```
